# Optimizing an MI355X kernel written in HIP

```python
import jax
import jax.numpy as jnp
from jax import lax
import numpy as np

D_MODEL = 2048
BATCH = 4
SEQ = 2048
DEPTH = 4

CTX_LEN = 256
GRID_W = 64
EPS = 1e-6
F32 = jnp.float32

MLA_HEADS = 8
MLA_NOPE = 64
MLA_ROPE = 32
MLA_V = 64
MLA_Q_RANK = 512
MLA_KV_RANK = 256
ROPE_THETA = 10000.0
Q_BLOCK = 128
CF_WIDTH = 512
CF_KERNEL = 31
GLA_HEADS = 4
GLA_DK = 64
GLA_DV = 128
GLA_GATE_RANK = 16
GLA_GATE_TAU = 16.0
GLA_CHUNK = 64
SC_WIDTH = 512
SC_KERNEL = 3
N_BRANCHES = 4
N_EXPERTS = 16
N_GROUPS = 4
TOP_K = 2
EXPERT_FF = 512

PROJ_PARTS = (
    ('mla_cq', MLA_Q_RANK),
    ('mla_ckv', MLA_KV_RANK),
    ('mla_kr', MLA_ROPE),
    ('cf_in', 2 * CF_WIDTH),
    ('gla_q', GLA_HEADS * GLA_DK),
    ('gla_k', GLA_HEADS * GLA_DK),
    ('gla_v', GLA_HEADS * GLA_DV),
    ('gla_gf', GLA_GATE_RANK),
    ('gla_gb', GLA_GATE_RANK),
    ('gla_r', GLA_HEADS * GLA_DV),
    ('sc_in', 3 * SC_WIDTH),
    ('merge_gate', N_BRANCHES * D_MODEL),
)
PROJ_WIDTH = sum(width for _, width in PROJ_PARTS)
CTX_STATE_PARTS = ('mla_ckv', 'mla_kr', 'gla_k', 'gla_v', 'gla_gf', 'gla_gb')

kernel_name = 'hybrid_prefix_diffusion_trunk'


def proj_offsets():
    offsets, start = {}, 0
    for name, width in PROJ_PARTS:
        offsets[name] = (start, start + width)
        start += width
    return offsets


def split_parts(u, offsets):
    return {name: u[..., a:b] for name, (a, b) in offsets.items()}


def rmsnorm(x, g):
    x32 = x.astype(F32)
    y = x32 * lax.rsqrt(jnp.mean(x32 * x32, axis=-1, keepdims=True) + EPS)
    return y.astype(x.dtype) * g


def layernorm(x, g, b):
    x32 = x.astype(F32)
    xc = x32 - jnp.mean(x32, axis=-1, keepdims=True)
    y = xc * lax.rsqrt(jnp.mean(xc * xc, axis=-1, keepdims=True) + EPS)
    return y.astype(x.dtype) * g + b


def modulate(x, shift, scale):
    return x * (1.0 + scale) + shift


def dwconv(x, w):
    return lax.conv_general_dilated(x, w[:, None, :], window_strides=(1,), padding='SAME',
                                    dimension_numbers=('NWC', 'WIO', 'NWC'),
                                    feature_group_count=x.shape[-1])


def flip(t):
    return jnp.flip(t, axis=1)


def axial_rope_tables(rows, dtype):
    pos = jnp.arange(rows * GRID_W)
    row = (pos // GRID_W).astype(F32)
    col = (pos % GRID_W).astype(F32)
    n_freq = MLA_ROPE // 4
    freqs = ROPE_THETA ** (-jnp.arange(n_freq, dtype=F32) / n_freq)
    ang = jnp.concatenate([row[:, None] * freqs, col[:, None] * freqs], axis=-1)
    return jnp.cos(ang).astype(dtype), jnp.sin(ang).astype(dtype)


def apply_axial_rope(x, cos, sin):
    n_freq = MLA_ROPE // 4
    half = MLA_ROPE // 2
    cos, sin = cos[:, None, :], sin[:, None, :]

    def rot(t, cs, sn):
        t1, t2 = t[..., :n_freq], t[..., n_freq:]
        return jnp.concatenate([t1 * cs - t2 * sn, t1 * sn + t2 * cs], axis=-1)

    return jnp.concatenate([rot(x[..., :half], cos[..., :n_freq], sin[..., :n_freq]),
                            rot(x[..., half:], cos[..., n_freq:], sin[..., n_freq:])], axis=-1)


def mla_branch(p, pc, lp, cos, sin, need_ctx):
    heads, nope = MLA_HEADS, MLA_NOPE
    scale = (MLA_NOPE + MLA_ROPE) ** -0.5

    def q_proj(cq):
        q = (rmsnorm(cq, lp['g_q']) @ lp['w_uq']).reshape(*cq.shape[:2], heads, MLA_NOPE + MLA_ROPE)
        return q[..., :nope], q[..., nope:]

    def kv_proj(ckv):
        kv = (rmsnorm(ckv, lp['g_kv']) @ lp['w_ukv']).reshape(*ckv.shape[:2], heads, MLA_NOPE + MLA_V)
        return kv[..., :nope], kv[..., nope:]

    def probs(s):
        return jax.nn.softmax(s.astype(F32) * scale, axis=-1)

    kn_c, v_c = kv_proj(pc['mla_ckv'])
    kr_c = pc['mla_kr']
    qn, qr = q_proj(p['mla_cq'])
    kn, v = kv_proj(p['mla_ckv'])
    qr_rot = apply_axial_rope(qr, cos, sin)
    kr_rot = apply_axial_rope(p['mla_kr'][:, :, None, :], cos, sin)[:, :, 0]
    bsz, seq = qn.shape[:2]
    n_blk = seq // Q_BLOCK

    def to_blocks(t):
        return t.reshape(bsz, n_blk, Q_BLOCK, *t.shape[2:]).swapaxes(0, 1)

    def attend_block(blk):
        qn_b, qr_b, qp_b = blk
        s_lat = jnp.einsum('bqhd,bkhd->bhqk', qn_b, kn) + jnp.einsum('bqhr,bkr->bhqk', qr_b, kr_rot)
        s_ctx = jnp.einsum('bqhd,bkhd->bhqk', qn_b, kn_c) + jnp.einsum('bqhr,bkr->bhqk', qp_b, kr_c)
        pr = probs(jnp.concatenate([s_lat, s_ctx], axis=-1)).astype(v.dtype)
        return (jnp.einsum('bhqk,bkhd->bqhd', pr[..., :seq], v)
                + jnp.einsum('bhqk,bkhd->bqhd', pr[..., seq:], v_c))

    o = lax.map(attend_block, (to_blocks(qn), to_blocks(qr_rot), to_blocks(qr)))
    y_lat = o.swapaxes(0, 1).reshape(bsz, seq, heads * MLA_V) @ lp['w_mla_o']
    if not need_ctx:
        return y_lat, None
    qn_c, qr_c = q_proj(pc['mla_cq'])
    s = jnp.einsum('bqhd,bkhd->bhqk', qn_c, kn_c) + jnp.einsum('bqhr,bkr->bhqk', qr_c, kr_c)
    o_c = jnp.einsum('bhqk,bkhd->bqhd', probs(s).astype(v_c.dtype), v_c)
    y_ctx = o_c.reshape(*o_c.shape[:2], heads * MLA_V) @ lp['w_mla_o']
    return y_lat, y_ctx


def conformer_branch(u, lp):
    a, b = jnp.split(u, 2, axis=-1)
    h = a * jax.nn.sigmoid(b)
    h = dwconv(h, lp['w_cf_dw']) + lp['b_cf_dw']
    h = jax.nn.silu(layernorm(h, lp['g_cf_ln'], lp['b_cf_ln']))
    return h @ lp['w_cf_o']


def shortconv_branch(u, lp):
    gate_b, gate_c, h = jnp.split(u, 3, axis=-1)
    return (gate_b * dwconv(gate_c * h, lp['w_sc_conv'])) @ lp['w_sc_o']


def gla_chunk_scan(q, k, v, log_a, s0):
    bsz, length, n_heads, _ = q.shape
    n_chunk = length // GLA_CHUNK
    causal = jnp.tril(jnp.ones((GLA_CHUNK, GLA_CHUNK), dtype=jnp.bool_))

    def chunks(t):
        return t.astype(F32).reshape(bsz, n_chunk, GLA_CHUNK, n_heads, t.shape[-1]).transpose(1, 0, 3, 2, 4)

    def step(state, inp):
        qc, kc, vc, ac = inp
        b = jnp.cumsum(ac, axis=2)
        diff = b[:, :, :, None, :] - b[:, :, None, :, :]
        decay = jnp.where(causal[:, :, None], jnp.exp(jnp.minimum(diff, 0.0)), 0.0)
        attn = jnp.einsum('bhtd,bhtsd,bhsd->bhts', qc, decay, kc)
        o = jnp.einsum('bhts,bhsv->bhtv', attn, vc) + jnp.einsum('bhtd,bhdv->bhtv', qc * jnp.exp(b), state)
        b_last = b[:, :, -1:, :]
        state = (jnp.exp(b_last[:, :, 0, :])[..., None] * state
                 + jnp.einsum('bhsd,bhsv->bhdv', kc * jnp.exp(b_last - b), vc))
        return state, o

    state, o = lax.scan(step, s0, (chunks(q), chunks(k), chunks(v), chunks(log_a)))
    o = o.transpose(1, 0, 3, 2, 4).reshape(bsz, length, n_heads, v.shape[-1]).astype(v.dtype)
    return o, state


def gla_final_state(k, v, log_a):
    b = jnp.cumsum(log_a, axis=1)
    w = jnp.exp(b[:, -1:] - b)
    return jnp.einsum('blhd,blhv->bhdv', k.astype(F32) * w, v.astype(F32))


def gla_branch(p, pc, lp, need_ctx):
    scale = GLA_DK ** -0.5

    def heads(t, dim):
        return t.reshape(*t.shape[:2], GLA_HEADS, dim)

    def log_decay(low, w2, b2):
        return heads(jax.nn.log_sigmoid((low @ w2 + b2).astype(F32)) / GLA_GATE_TAU, GLA_DK)

    def readout(o, r):
        o = rmsnorm(o, lp['g_gla_norm']) * jax.nn.silu(heads(r, GLA_DV))
        return o.reshape(*o.shape[:2], GLA_HEADS * GLA_DV) @ lp['w_gla_o']

    k_c, v_c = heads(pc['gla_k'], GLA_DK), heads(pc['gla_v'], GLA_DV)
    af_c = log_decay(pc['gla_gf'], lp['w_gla_gf'], lp['b_gla_gf'])
    ab_c = log_decay(pc['gla_gb'], lp['w_gla_gb'], lp['b_gla_gb'])
    y_ctx = None
    if need_ctx:
        q_c = heads(pc['gla_q'], GLA_DK) * scale
        zero = jnp.zeros((k_c.shape[0], GLA_HEADS, GLA_DK, GLA_DV), F32)
        o_cf, s_f = gla_chunk_scan(q_c, k_c, v_c, af_c, zero)
        o_cb, s_b = gla_chunk_scan(flip(q_c), flip(k_c), flip(v_c), flip(ab_c), zero)
        y_ctx = readout(o_cf + flip(o_cb), pc['gla_r'])
    else:
        s_f = gla_final_state(k_c, v_c, af_c)
        s_b = gla_final_state(flip(k_c), flip(v_c), flip(ab_c))
    q = heads(p['gla_q'], GLA_DK) * scale
    k, v = heads(p['gla_k'], GLA_DK), heads(p['gla_v'], GLA_DV)
    af = log_decay(p['gla_gf'], lp['w_gla_gf'], lp['b_gla_gf'])
    ab = log_decay(p['gla_gb'], lp['w_gla_gb'], lp['b_gla_gb'])
    o_f, _ = gla_chunk_scan(q, k, v, af, s_f)
    o_b, _ = gla_chunk_scan(flip(q), flip(k), flip(v), flip(ab), s_b)
    return readout(o_f + flip(o_b), p['gla_r']), y_ctx


def moe(h, w_router, b_router, w_gate, w_up, w_down):
    n_tok = h.shape[0]
    per_group = N_EXPERTS // N_GROUPS
    affinity = jax.nn.sigmoid((h @ w_router).astype(F32))
    select = (affinity + b_router.astype(F32)).reshape(n_tok, N_GROUPS, per_group)
    group_score = lax.top_k(select, TOP_K)[0].sum(axis=-1)
    in_group = jax.nn.one_hot(jnp.argmax(group_score, axis=-1), N_GROUPS, dtype=jnp.bool_)
    masked = jnp.where(in_group[:, :, None], select, -jnp.inf).reshape(n_tok, N_EXPERTS)
    _, idx = lax.top_k(masked, TOP_K)
    w = jnp.take_along_axis(affinity, idx, axis=-1)
    w = w / jnp.sum(w, axis=-1, keepdims=True)
    combine = jnp.sum(jax.nn.one_hot(idx, N_EXPERTS, dtype=F32) * w[..., None], axis=1)
    g = jnp.einsum('td,edf->etf', h, w_gate)
    u = jnp.einsum('td,edf->etf', h, w_up)
    act = jax.nn.silu(g) * u * combine.T[:, :, None].astype(h.dtype)
    return jnp.einsum('etf,efd->td', act, w_down)


def mixer(h, hc, lp, cos, sin, need_ctx):
    offsets = proj_offsets()
    p = split_parts(h @ lp['w_in'], offsets)
    if need_ctx:
        pc = split_parts(hc @ lp['w_in'], offsets)
    else:
        pc = {name: hc @ lp['w_in'][:, offsets[name][0]:offsets[name][1]] for name in CTX_STATE_PARTS}
    a_lat, a_ctx = mla_branch(p, pc, lp, cos, sin, need_ctx)
    g_lat, g_ctx = gla_branch(p, pc, lp, need_ctx)

    def merge(parts, branches):
        logits = parts['merge_gate']
        gates = jax.nn.sigmoid(logits).reshape(*logits.shape[:-1], N_BRANCHES, -1)
        y = gates[..., 0, :] * branches[0]
        for i in range(1, N_BRANCHES):
            y = y + gates[..., i, :] * branches[i]
        return y @ lp['w_mix_o']

    y_lat = merge(p, (a_lat, conformer_branch(p['cf_in'], lp), g_lat, shortconv_branch(p['sc_in'], lp)))
    if not need_ctx:
        return y_lat, None
    y_ctx = merge(pc, (a_ctx, conformer_branch(pc['cf_in'], lp), g_ctx, shortconv_branch(pc['sc_in'], lp)))
    return y_lat, y_ctx


def setup_inputs(seed: int = 0) -> dict:
    key = jax.random.key(seed)
    keys = iter(jax.random.split(key, 40))

    def normal(shape, scale):
        return jax.random.normal(next(keys), shape, F32) * scale

    def gain(shape):
        return 1.0 + normal(shape, 0.05)

    L, D = DEPTH, D_MODEL
    return {
        'x': normal((BATCH, SEQ, D), 1.0),
        'c': normal((BATCH, D), 1.0),
        'ctx': normal((BATCH, CTX_LEN, D), 1.0),
        'c_ctx': normal((D,), 1.0),
        'w_mod': normal((L, D, 6 * D), 0.5 * D ** -0.5),
        'b_mod': normal((L, 6 * D), 0.01),
        'g_mix': gain((L, D)),
        'g_ffn': gain((L, D)),
        'w_in': normal((L, D, PROJ_WIDTH), D ** -0.5),
        'g_q': gain((L, MLA_Q_RANK)),
        'w_uq': normal((L, MLA_Q_RANK, MLA_HEADS * (MLA_NOPE + MLA_ROPE)), MLA_Q_RANK ** -0.5),
        'g_kv': gain((L, MLA_KV_RANK)),
        'w_ukv': normal((L, MLA_KV_RANK, MLA_HEADS * (MLA_NOPE + MLA_V)), MLA_KV_RANK ** -0.5),
        'w_mla_o': normal((L, MLA_HEADS * MLA_V, D), (MLA_HEADS * MLA_V) ** -0.5),
        'w_cf_dw': normal((L, CF_KERNEL, CF_WIDTH), CF_KERNEL ** -0.5),
        'b_cf_dw': normal((L, CF_WIDTH), 0.01),
        'g_cf_ln': gain((L, CF_WIDTH)),
        'b_cf_ln': normal((L, CF_WIDTH), 0.01),
        'w_cf_o': normal((L, CF_WIDTH, D), CF_WIDTH ** -0.5),
        'w_gla_gf': normal((L, GLA_GATE_RANK, GLA_HEADS * GLA_DK), GLA_GATE_RANK ** -0.5),
        'b_gla_gf': normal((L, GLA_HEADS * GLA_DK), 0.1),
        'w_gla_gb': normal((L, GLA_GATE_RANK, GLA_HEADS * GLA_DK), GLA_GATE_RANK ** -0.5),
        'b_gla_gb': normal((L, GLA_HEADS * GLA_DK), 0.1),
        'g_gla_norm': gain((L, GLA_DV)),
        'w_gla_o': normal((L, GLA_HEADS * GLA_DV, D), (GLA_HEADS * GLA_DV) ** -0.5),
        'w_sc_conv': normal((L, SC_KERNEL, SC_WIDTH), SC_KERNEL ** -0.5),
        'w_sc_o': normal((L, SC_WIDTH, D), SC_WIDTH ** -0.5),
        'w_mix_o': normal((L, D, D), D ** -0.5),
        'w_router': normal((D, N_EXPERTS), D ** -0.5),
        'b_router': normal((N_EXPERTS,), 0.01),
        'w_e_gate': normal((L, N_EXPERTS, D, EXPERT_FF), D ** -0.5),
        'w_e_up': normal((L, N_EXPERTS, D, EXPERT_FF), D ** -0.5),
        'w_e_down': normal((L, N_EXPERTS, EXPERT_FF, D), EXPERT_FF ** -0.5),
        'g_final': gain((D,)),
    }


def reference(x, c, ctx, c_ctx, w_mod, b_mod, g_mix, g_ffn, w_in, g_q, w_uq, g_kv, w_ukv, w_mla_o,
              w_cf_dw, b_cf_dw, g_cf_ln, b_cf_ln, w_cf_o, w_gla_gf, b_gla_gf, w_gla_gb, b_gla_gb,
              g_gla_norm, w_gla_o, w_sc_conv, w_sc_o, w_mix_o, w_router, b_router,
              w_e_gate, w_e_up, w_e_down, g_final):
    bsz, seq, d = x.shape
    n_ctx = ctx.shape[1]
    rows = seq // GRID_W
    cos, sin = axial_rope_tables(rows, x.dtype)
    silu_c = jax.nn.silu(c)
    silu_cc = jax.nn.silu(c_ctx)
    xc = ctx
    for l in range(DEPTH):
        need_ctx = l < DEPTH - 1
        lp = {
            'w_in': w_in[l], 'g_q': g_q[l], 'w_uq': w_uq[l], 'g_kv': g_kv[l], 'w_ukv': w_ukv[l],
            'w_mla_o': w_mla_o[l], 'w_cf_dw': w_cf_dw[l], 'b_cf_dw': b_cf_dw[l], 'g_cf_ln': g_cf_ln[l],
            'b_cf_ln': b_cf_ln[l], 'w_cf_o': w_cf_o[l], 'w_gla_gf': w_gla_gf[l], 'b_gla_gf': b_gla_gf[l],
            'w_gla_gb': w_gla_gb[l], 'b_gla_gb': b_gla_gb[l], 'g_gla_norm': g_gla_norm[l],
            'w_gla_o': w_gla_o[l], 'w_sc_conv': w_sc_conv[l], 'w_sc_o': w_sc_o[l], 'w_mix_o': w_mix_o[l],
        }
        sh1, sc1, gt1, sh2, sc2, gt2 = [m[:, None, :] for m in jnp.split(silu_c @ w_mod[l] + b_mod[l], 6, axis=-1)]
        sh1c, sc1c, gt1c, sh2c, sc2c, gt2c = jnp.split(silu_cc @ w_mod[l] + b_mod[l], 6, axis=-1)
        h = modulate(rmsnorm(x, g_mix[l]), sh1, sc1)
        hc = modulate(rmsnorm(xc, g_mix[l]), sh1c, sc1c)
        y, yc = mixer(h, hc, lp, cos, sin, need_ctx)
        x = x + gt1 * y
        hf = modulate(rmsnorm(x, g_ffn[l]), sh2, sc2).reshape(bsz * seq, d)
        if need_ctx:
            xc = xc + gt1c * yc
            hfc = modulate(rmsnorm(xc, g_ffn[l]), sh2c, sc2c).reshape(bsz * n_ctx, d)
            f = moe(jnp.concatenate([hf, hfc], axis=0), w_router, b_router, w_e_gate[l], w_e_up[l], w_e_down[l])
            x = x + gt2 * f[:bsz * seq].reshape(bsz, seq, d)
            xc = xc + gt2c * f[bsz * seq:].reshape(bsz, n_ctx, d)
        else:
            f = moe(hf, w_router, b_router, w_e_gate[l], w_e_up[l], w_e_down[l])
            x = x + gt2 * f.reshape(bsz, seq, d)
    return rmsnorm(x, g_final)
```

```cpp
#include <hip/hip_runtime.h>
#include <cstdio>
#include <cstdint>

#define DI __device__ __forceinline__
#define LAS __attribute__((address_space(3)))
typedef unsigned short bf16_t;
typedef short bf16x8 __attribute__((ext_vector_type(8)));
typedef short s16x4 __attribute__((ext_vector_type(4)));
typedef float f32x4 __attribute__((ext_vector_type(4)));
typedef float f32x16 __attribute__((ext_vector_type(16)));
typedef unsigned u32x4 __attribute__((ext_vector_type(4)));
typedef unsigned u32x2 __attribute__((ext_vector_type(2)));
typedef float f32x2_t __attribute__((ext_vector_type(2)));
typedef __bf16 bf16x2_t __attribute__((ext_vector_type(2)));
typedef int v4i_t __attribute__((ext_vector_type(4)));

constexpr int DM = 2048, NB = 4, SEQ = 2048, DEPTH = 4, CTXL = 256;
constexpr int TLAT = NB * SEQ, TCTX = NB * CTXL, TT = TLAT + TCTX;
constexpr int PW = 13120, PWP = 13312;
constexpr int O_CQ = 0, O_CKV = 512, O_KR = 768, O_CF = 800, O_GQ = 1824, O_GK = 2080, O_GV = 2336, O_GF = 2848, O_GB = 2864, O_GR = 2880, O_SC = 3392, O_MG = 4928;
constexpr int GCOL0 = 5120; constexpr float GATE_CLIP = 8.f;
DI int wcol_dest(int n0) { return n0 < O_MG ? n0 : n0 + (GCOL0 - O_MG); }
constexpr int NEXP = 16, EFF = 512, MOE_ROWS = 22528;
constexpr float EPS = 1e-6f;
constexpr int NCHAIN = 36;

DI float bflo(unsigned w) { return __uint_as_float(w << 16); }
DI float bfhi(unsigned w) { return __uint_as_float(w & 0xffff0000u); }
DI float bf2f(bf16_t v) { return __uint_as_float(((unsigned)v) << 16); }
DI unsigned pk2(float lo, float hi) { f32x2_t v = {lo, hi}; bf16x2_t b = __builtin_convertvector(v, bf16x2_t); return __builtin_bit_cast(unsigned, b); }
DI bf16_t f2bf(float f) { return (bf16_t)(pk2(f, 0.f) & 0xffffu); }
DI unsigned q8(float v) { int q = __float2int_rn(v); q = q > 127 ? 127 : q; q = q < -127 ? -127 : q; return (unsigned)q & 255u; }
DI float dpp_f(float v, int ctrl_sel) {
    const int x = __float_as_int(v); int r;
    switch (ctrl_sel) { case 0: r = __builtin_amdgcn_mov_dpp(x, 0xB1, 0xF, 0xF, true); break;
                        case 1: r = __builtin_amdgcn_mov_dpp(x, 0x4E, 0xF, 0xF, true); break;
                        case 2: r = __builtin_amdgcn_mov_dpp(x, 0x141, 0xF, 0xF, true); break;
                        default: r = __builtin_amdgcn_mov_dpp(x, 0x140, 0xF, 0xF, true); break; }
    return __int_as_float(r);
}
DI float wave_sum(float v) {
    v += dpp_f(v, 0); v += dpp_f(v, 1); v += dpp_f(v, 2); v += dpp_f(v, 3);
    { const auto r = __builtin_amdgcn_permlane16_swap(__float_as_uint(v), __float_as_uint(v), false, false); v = __uint_as_float(r[0]) + __uint_as_float(r[1]); }
    { const auto r = __builtin_amdgcn_permlane32_swap(__float_as_uint(v), __float_as_uint(v), false, false); v = __uint_as_float(r[0]) + __uint_as_float(r[1]); }
    return v;
}
DI float sigm(float x) { return __builtin_amdgcn_rcpf(1.f + __expf(-x)); }
DI float siluf(float x) { return x * __builtin_amdgcn_rcpf(1.f + __expf(-x)); }
#define LDS_WAIT() asm volatile("s_waitcnt lgkmcnt(0)" ::: "memory")
#define VM_WAIT() asm volatile("s_waitcnt vmcnt(0)" ::: "memory")

namespace pg8 {
constexpr int BM = 256, BK = 64, HALF = 128, HTB = HALF * BK * 2, STAGE_BYTES = 8 * HTB, NXCD = 8, WGM = 8;
DI int lds_byte(int r, int c) { const int st = (r >> 4) * 2 + (c >> 5), rr = r & 15, cc = c & 31, ob = rr * 64 + cc * 2; return st * 1024 + (ob ^ (((ob >> 9) & 1) << 5)); }
DI void stage_rc(int b, int& R, int& C) { const int st = b / 1024, sb = b % 1024, swz = sb ^ (((sb >> 9) & 1) << 5); R = (st >> 1) * 16 + swz / 64; C = (st & 1) * 32 + (swz % 64) / 2; }
DI int perm32(int rho) { const int n = rho >> 4, i = rho & 15; return 8 * (i >> 2) + 4 * n + (i & 3); }

struct Unit { int pm, pn, grp; };
struct Gemm { const bf16_t* A; const bf16_t* Bt; int K; size_t gsA, gsB; };

DI void tile_of(int wgid0, int nM, int nN, int& pm, int& pn) {
    const int nwg = nM * nN; int wgid = wgid0;
    { const int q = nwg / NXCD, r = nwg % NXCD, xcd = wgid % NXCD, off = wgid / NXCD; wgid = (xcd < r ? xcd * (q + 1) : r * (q + 1) + (xcd - r) * q) + off; }
    const int nig = WGM * nN, gid = wgid / nig, fm = gid * WGM, gsz = (nM - fm) < WGM ? (nM - fm) : WGM;
    pm = fm + ((wgid % nig) % gsz); pn = (wgid % nig) / gsz;
}
struct StaticOrder {
    int nM, nN, nwg, G, c;
    DI void init(int M, int N, int G_, int c_) { nM = M / BM; nN = N / BM; nwg = nM * nN; G = G_; c = c_; }
    DI bool next(int i, Unit& u) const { const int L = i * G + c; if (L >= nwg) return false; tile_of(L, nM, nN, u.pm, u.pn); u.grp = 0; return true; }
};
struct TrimOrder {
    int nM1, nN, n1, nctx, G, c;
    DI bool next(int i, Unit& u) const { const int L = i * G + c; u.grp = 0;
        if (L < n1) { tile_of(L, nM1, nN, u.pm, u.pn); return true; }
        const int q = L - n1; if (q >= nctx) return false; const int j = q % 6; u.pm = nM1 + q / 6; u.pn = j < 2 ? 2 + j : 6 + j; return true; }
};
struct RangeOrder {
    int first, count, nN, G, c;
    DI bool next(int i, Unit& u) const { const int L = i * G + c - first; if (L < 0 || L >= count) return false; u.pm = L / nN; u.pn = L % nN; u.grp = 0; return true; }
};
struct Range2Order {
    int first, count0, nN0, count1, nN1, G, c;
    DI bool next(int i, Unit& u) const { int L = i * G + c - first; if (L < 0) return false;
        if (L < count0) { u.pm = L / nN0; u.pn = L % nN0; u.grp = 0; return true; }
        L -= count0; if (L >= count1) return false; u.pm = L / nN1; u.pn = L % nN1; u.grp = 1; return true; }
};
struct MergeOrder {
    int nM, nN, nwg, G, c;
    DI void init(int M, int N, int G_, int c_) { nM = M / BM; nN = N / BM; nwg = nM * nN; G = G_; c = c_; }
    DI bool next(int i, Unit& u) const { const int L = (i >> 2) * G + c; if (L >= nwg) return false; tile_of(L, nM, nN, u.pm, u.pn); u.grp = i & 3; return true; }
};
struct MoeOrder {
    const LAS int* tp; int ncol, G, c;
    DI bool next(int i, Unit& u) const {
        const int L = i * G + c, ntile = tp[16]; if (L >= ntile * ncol) return false;
        const int rt = L / ncol; int e = 0;
#pragma unroll
        for (int j = 1; j < 16; ++j) e += (rt >= tp[j]) ? 1 : 0;
        u.pm = rt; u.pn = L % ncol; u.grp = e; return true;
    }
};

struct EpiStore {
    static constexpr bool PERM = true;
    bf16_t* O; int ldc;
    DI bool operator()(f32x4 (&acc)[2][2][4][2], const Unit& u, int wr, int wc, int fr, int fq) const {
        const int row0 = u.pm * BM + wr * 64 + fr, col0 = u.pn * BM + wc * 32 + 8 * fq;
#pragma unroll
        for (int ai = 0; ai < 2; ++ai)
#pragma unroll
            for (int m = 0; m < 4; ++m) { bf16_t* rowp = O + (size_t)(row0 + ai * HALF + m * 16) * ldc + col0;
#pragma unroll
                for (int bj = 0; bj < 2; ++bj) { const f32x4 v0 = acc[ai][bj][m][0], v1 = acc[ai][bj][m][1];
                    u32x4 w; w.x = pk2(v0[0], v0[1]); w.y = pk2(v0[2], v0[3]); w.z = pk2(v1[0], v1[1]); w.w = pk2(v1[2], v1[3]);
                    *(u32x4*)(rowp + bj * HALF) = w; } }
        return false;
    }
};
struct EpiStoreQ {
    static constexpr bool PERM = true;
    bf16_t* O; int ldc; const float* rA; const float* rB; unsigned char* G8;
    DI bool operator()(v4i_t (&acc)[2][2][4][2], const Unit& u, int wr, int wc, int fr, int fq) const {
        const int row0 = u.pm * BM + wr * 64 + fr, col0 = u.pn * BM + wc * 32 + 8 * fq;
        f32x4 cb[2][2];
#pragma unroll
        for (int bj = 0; bj < 2; ++bj) { cb[bj][0] = *(const f32x4*)(rB + col0 + bj * HALF); cb[bj][1] = *(const f32x4*)(rB + col0 + bj * HALF + 4); }
        if (col0 >= GCOL0) {
            const float qs = 127.f / GATE_CLIP;
#pragma unroll
            for (int ai = 0; ai < 2; ++ai)
#pragma unroll
                for (int m = 0; m < 4; ++m) { const int row = row0 + ai * HALF + m * 16; const float ra = rA[row] * qs; unsigned char* rowp = G8 + (size_t)row * (4 * DM) + (col0 - GCOL0);
#pragma unroll
                    for (int bj = 0; bj < 2; ++bj) { const v4i_t a0 = acc[ai][bj][m][0], a1 = acc[ai][bj][m][1]; const f32x4 c0 = cb[bj][0] * ra, c1 = cb[bj][1] * ra;
                        unsigned w0 = 0u, w1 = 0u;
#pragma unroll
                        for (int j = 0; j < 4; ++j) { w0 = __builtin_amdgcn_cvt_pk_u8_f32((float)a0[j] * c0[j] + 128.0f, j, w0); w1 = __builtin_amdgcn_cvt_pk_u8_f32((float)a1[j] * c1[j] + 128.0f, j, w1); }
                        *(u32x2*)(rowp + bj * HALF) = (u32x2){w0, w1}; } }
            return false;
        }
#pragma unroll
        for (int ai = 0; ai < 2; ++ai)
#pragma unroll
            for (int m = 0; m < 4; ++m) { const int row = row0 + ai * HALF + m * 16; const float ra = rA[row]; bf16_t* rowp = O + (size_t)row * ldc + col0;
#pragma unroll
                for (int bj = 0; bj < 2; ++bj) { const v4i_t a0 = acc[ai][bj][m][0], a1 = acc[ai][bj][m][1]; const f32x4 c0 = cb[bj][0] * ra, c1 = cb[bj][1] * ra;
                    u32x4 w; w.x = pk2((float)a0[0] * c0[0], (float)a0[1] * c0[1]); w.y = pk2((float)a0[2] * c0[2], (float)a0[3] * c0[3]);
                    w.z = pk2((float)a1[0] * c1[0], (float)a1[1] * c1[1]); w.w = pk2((float)a1[2] * c1[2], (float)a1[3] * c1[3]);
                    *(u32x4*)(rowp + bj * HALF) = w; } }
        return false;
    }
};
struct EpiStore2 {
    static constexpr bool PERM = true;
    bf16_t* O0; int ldc0; bf16_t* O1; int ldc1;
    DI bool operator()(f32x4 (&acc)[2][2][4][2], const Unit& u, int wr, int wc, int fr, int fq) const {
        const EpiStore E{u.grp ? O1 : O0, u.grp ? ldc1 : ldc0}; return E(acc, u, wr, wc, fr, fq);
    }
};
struct EpiMerge {
    static constexpr bool PERM = true;
    bf16_t* Y; const unsigned char* G8;
    const LAS float* tab;
    DI static int qi(unsigned w, int i) { return (int)((w >> (8 * i)) & 255u); }
    DI bool operator()(f32x4 (&acc)[2][2][4][2], const Unit& u, int wr, int wc, int fr, int fq) const {
        const int row0 = u.pm * BM + wr * 64 + fr, col0 = u.pn * BM + wc * 32 + 8 * fq; const int grp = u.grp;
        if (grp < 3) {
#pragma unroll
            for (int ai = 0; ai < 2; ++ai)
#pragma unroll
                for (int m = 0; m < 4; ++m) { const int row = row0 + ai * HALF + m * 16; const unsigned char* gp = G8 + (size_t)row * (4 * DM) + grp * DM + col0;
#pragma unroll
                    for (int bj = 0; bj < 2; ++bj) { const u32x2 a = *(const u32x2*)(gp + bj * HALF), b = *(const u32x2*)(gp + DM + bj * HALF);
                        f32x4& a0 = acc[ai][bj][m][0]; f32x4& a1 = acc[ai][bj][m][1];
#pragma unroll
                        for (int j = 0; j < 4; ++j) { a0[j] *= tab[qi(a.x, j)] * tab[256 + qi(b.x, j)]; a1[j] *= tab[qi(a.y, j)] * tab[256 + qi(b.y, j)]; } } }
            return true;
        }
#pragma unroll
        for (int ai = 0; ai < 2; ++ai)
#pragma unroll
            for (int m = 0; m < 4; ++m) { const int row = row0 + ai * HALF + m * 16;
                bf16_t* yp = Y + (size_t)row * DM + col0; const unsigned char* gp = G8 + (size_t)row * (4 * DM) + 3 * DM + col0;
#pragma unroll
                for (int bj = 0; bj < 2; ++bj) { const u32x2 g = *(const u32x2*)(gp + bj * HALF); const f32x4 a0 = acc[ai][bj][m][0], a1 = acc[ai][bj][m][1];
                    u32x4 w; w.x = pk2(a0[0] * tab[qi(g.x, 0)], a0[1] * tab[qi(g.x, 1)]); w.y = pk2(a0[2] * tab[qi(g.x, 2)], a0[3] * tab[qi(g.x, 3)]);
                    w.z = pk2(a1[0] * tab[qi(g.y, 0)], a1[1] * tab[qi(g.y, 1)]); w.w = pk2(a1[2] * tab[qi(g.y, 2)], a1[3] * tab[qi(g.y, 3)]);
                    *(u32x4*)(yp + bj * HALF) = w; } }
        return false;
    }
};
struct EpiResid {
    static constexpr bool PERM = true;
    bf16_t* X; const float* gate; bf16_t* XO;
    DI bool operator()(f32x4 (&acc)[2][2][4][2], const Unit& u, int wr, int wc, int fr, int fq) const {
        const int row0 = u.pm * BM + wr * 64 + fr, col0 = u.pn * BM + wc * 32 + 8 * fq;
        const int r = (u.pm < TLAT / BM) ? (u.pm >> 3) : 4; const float* gp = gate + (size_t)r * (6 * DM) + col0;
        f32x4 gv[2][2];
#pragma unroll
        for (int bj = 0; bj < 2; ++bj)
#pragma unroll
            for (int n = 0; n < 2; ++n) gv[bj][n] = *(const f32x4*)(gp + bj * HALF + n * 4);
#pragma unroll
        for (int ai = 0; ai < 2; ++ai)
#pragma unroll
            for (int m = 0; m < 4; ++m) { const size_t ro = (size_t)(row0 + ai * HALF + m * 16) * DM + col0;
#pragma unroll
                for (int bj = 0; bj < 2; ++bj) { const u32x4 x = *(const u32x4*)(X + ro + bj * HALF); const f32x4 a0 = gv[bj][0] * acc[ai][bj][m][0], a1 = gv[bj][1] * acc[ai][bj][m][1];
                    u32x4 o; o.x = pk2(bflo(x.x) + a0[0], bfhi(x.x) + a0[1]); o.y = pk2(bflo(x.y) + a0[2], bfhi(x.y) + a0[3]); o.z = pk2(bflo(x.z) + a1[0], bfhi(x.z) + a1[1]); o.w = pk2(bflo(x.w) + a1[2], bfhi(x.w) + a1[3]);
                    *(u32x4*)(XO + ro + bj * HALF) = o; } }
        return false;
    }
};
struct EpiSwiGLUQ {
    static constexpr bool PERM = true;
    bf16_t* O; const float* roww; const float* rs; const float* rb1;
    DI bool operator()(v4i_t (&acc)[2][2][4][2], const Unit& u, int wr, int wc, int fr, int fq) const {
        const int row0 = u.pm * BM + wr * 64 + fr, col0 = u.pn * HALF + wc * 32 + 8 * fq; const float* rb = rb1 + (size_t)u.grp * 1024 + u.pn * BM + wc * 32 + 8 * fq;
        const f32x4 bg0 = *(const f32x4*)rb, bg1 = *(const f32x4*)(rb + 4), bu0 = *(const f32x4*)(rb + HALF), bu1 = *(const f32x4*)(rb + HALF + 4);
#pragma unroll
        for (int ai = 0; ai < 2; ++ai)
#pragma unroll
            for (int m = 0; m < 4; ++m) { const int row = row0 + ai * HALF + m * 16; const float w = roww[row], sa = rs[row];
                const v4i_t g0 = acc[ai][0][m][0], g1 = acc[ai][0][m][1], u0 = acc[ai][1][m][0], u1 = acc[ai][1][m][1];
                float v[8];
#pragma unroll
                for (int j = 0; j < 4; ++j) { v[j] = siluf((float)g0[j] * sa * bg0[j]) * ((float)u0[j] * sa * bu0[j]) * w; v[4 + j] = siluf((float)g1[j] * sa * bg1[j]) * ((float)u1[j] * sa * bu1[j]) * w; }
                u32x4 o; o.x = pk2(v[0], v[1]); o.y = pk2(v[2], v[3]); o.z = pk2(v[4], v[5]); o.w = pk2(v[6], v[7]);
                *(u32x4*)(O + (size_t)row * EFF + col0) = o; }
        return false;
    }
};
struct EpiSwiGLUQG {
    static constexpr bool PERM = true;
    bf16_t* O; const float* erw; const float* ers; const float* rb1; const LAS int* tpt;
    DI bool operator()(v4i_t (&acc)[2][2][4][2], const Unit& u, int wr, int wc, int fr, int fq) const {
        const int row0 = u.pm * BM + wr * 64 + fr, col0 = u.pn * HALF + wc * 32 + 8 * fq; const float* rb = rb1 + (size_t)u.grp * 1024 + u.pn * BM + wc * 32 + 8 * fq;
        const int s0 = (u.pm - tpt[u.grp]) * 256 + wr * 64 + fr, cn = tpt[32 + u.grp]; const float* pw = erw + u.grp * TT; const float* ps = ers + u.grp * TT;
        const f32x4 bg0 = *(const f32x4*)rb, bg1 = *(const f32x4*)(rb + 4), bu0 = *(const f32x4*)(rb + HALF), bu1 = *(const f32x4*)(rb + HALF + 4);
#pragma unroll
        for (int ai = 0; ai < 2; ++ai)
#pragma unroll
            for (int m = 0; m < 4; ++m) { const int row = row0 + ai * HALF + m * 16, sl = s0 + ai * HALF + m * 16; const bool ok = sl < cn; const float w = ok ? pw[ok ? sl : 0] : 0.f, sa = ok ? ps[ok ? sl : 0] : 0.f;
                const v4i_t g0 = acc[ai][0][m][0], g1 = acc[ai][0][m][1], u0 = acc[ai][1][m][0], u1 = acc[ai][1][m][1];
                float v[8];
#pragma unroll
                for (int j = 0; j < 4; ++j) { v[j] = siluf((float)g0[j] * sa * bg0[j]) * ((float)u0[j] * sa * bu0[j]) * w; v[4 + j] = siluf((float)g1[j] * sa * bg1[j]) * ((float)u1[j] * sa * bu1[j]) * w; }
                u32x4 o; o.x = pk2(v[0], v[1]); o.y = pk2(v[2], v[3]); o.z = pk2(v[4], v[5]); o.w = pk2(v[6], v[7]);
                *(u32x4*)(O + (size_t)row * EFF + col0) = o; }
        return false;
    }
};
struct EpiSwiGLU {
    static constexpr bool PERM = true;
    bf16_t* O; const float* roww;
    DI bool operator()(f32x4 (&acc)[2][2][4][2], const Unit& u, int wr, int wc, int fr, int fq) const {
        const int row0 = u.pm * BM + wr * 64 + fr, col0 = u.pn * HALF + wc * 32 + 8 * fq;
#pragma unroll
        for (int ai = 0; ai < 2; ++ai)
#pragma unroll
            for (int m = 0; m < 4; ++m) { const int row = row0 + ai * HALF + m * 16; const float w = roww[row];
                const f32x4 g0 = acc[ai][0][m][0], g1 = acc[ai][0][m][1], u0 = acc[ai][1][m][0], u1 = acc[ai][1][m][1];
                float v[8];
#pragma unroll
                for (int j = 0; j < 4; ++j) { v[j] = siluf(g0[j]) * u0[j] * w; v[4 + j] = siluf(g1[j]) * u1[j] * w; }
                u32x4 o; o.x = pk2(v[0], v[1]); o.y = pk2(v[2], v[3]); o.z = pk2(v[4], v[5]); o.w = pk2(v[6], v[7]);
                *(u32x4*)(O + (size_t)row * EFF + col0) = o; }
        return false;
    }
};

template <class Epi, class Sched>
DI void gemm_phase(LAS unsigned char* lds, const Gemm g, const Sched& S, const Epi& E) {
    int tid = threadIdx.x; asm volatile("" : "+v"(tid));
    const int wid = __builtin_amdgcn_readfirstlane(tid >> 6), lane = tid & 63, wr = wid >> 2, wc = wid & 3, fr = lane & 15, fq = lane >> 4;
    int K = g.K; asm volatile("" : "+s"(K));
    const int nt = K / BK;
    unsigned voffA[2], voffB[2], gC[2]; int gR[2];
#pragma unroll
    for (int i = 0; i < 2; ++i) { int R, C; stage_rc(tid * 16 + i * 8192, R, C); const int Rb = Epi::PERM ? ((R & ~31) + perm32(R & 31)) : R;
        voffA[i] = (unsigned)(R * K + C) * 2u; voffB[i] = (unsigned)(Rb * K + C) * 2u; gR[i] = R; gC[i] = (unsigned)C * 2u; }
    const size_t kstep = (size_t)(BK * 2);
    const size_t hstep = (size_t)HALF * K * 2;
    const size_t tstep = 2 * hstep;
    const unsigned ldsw = (unsigned)wid * 1024u;
    const int aoff = lds_byte(wr * 64 + fr, fq * 8), boff = lds_byte(wc * 32 + fr, fq * 8);
#define PG8_SA(b, h) (((b) * 2 + (h)) * HTB)
#define PG8_SB(b, h) ((4 + (b) * 2 + (h)) * HTB)
#define PG8_STAGE(bufoff, gbase, voff) do { _Pragma("unroll") for (int _i = 0; _i < 2; ++_i) \
        __builtin_amdgcn_global_load_lds((const unsigned*)((const char*)(gbase) + (voff)[_i]), (LAS unsigned*)(lds + (bufoff) + ldsw + _i * 8192), 16, 0, 0); } while (0)
#define PG8_STAGE2(bufoff, gbase, o0, o1) do { \
        __builtin_amdgcn_global_load_lds((const unsigned*)((const char*)(gbase) + (o0)), (LAS unsigned*)(lds + (bufoff) + ldsw), 16, 0, 0); \
        __builtin_amdgcn_global_load_lds((const unsigned*)((const char*)(gbase) + (o1)), (LAS unsigned*)(lds + (bufoff) + ldsw + 8192), 16, 0, 0); } while (0)
#define PG8_GATH(u, v) do { const int e_ = (u).grp, b_ = ((u).pm - tpt[e_]) * 256, c_ = tpt[32 + e_]; const int* et_ = etok + e_ * TT; \
        _Pragma("unroll") for (int h_ = 0; h_ < 2; ++h_) _Pragma("unroll") for (int i_ = 0; i_ < 2; ++i_) { const int s_ = b_ + h_ * 128 + gR[i_]; const int t_ = (s_ < c_) ? et_[s_] : 0; \
            v[h_][i_] = (unsigned)t_ * (unsigned)(K * 2) + gC[i_]; } } while (0)
#define PG8_LDA(dst, b, h) do { _Pragma("unroll") for (int m = 0; m < 4; ++m) _Pragma("unroll") for (int k = 0; k < 2; ++k) dst[m][k] = *(const LAS bf16x8*)(lds + PG8_SA(b, h) + aoff + m * 2048 + k * 1024); } while (0)
#define PG8_LDB(dst, b, h) do { _Pragma("unroll") for (int n = 0; n < 2; ++n) _Pragma("unroll") for (int k = 0; k < 2; ++k) dst[n][k] = *(const LAS bf16x8*)(lds + PG8_SB(b, h) + boff + n * 2048 + k * 1024); } while (0)
#define PG8_MMA(ai, bj, At, Bt) do { __builtin_amdgcn_s_setprio(1); _Pragma("unroll") for (int m = 0; m < 4; ++m) _Pragma("unroll") for (int n = 0; n < 2; ++n) _Pragma("unroll") for (int k = 0; k < 2; ++k) \
        acc[ai][bj][m][n] = __builtin_amdgcn_mfma_f32_16x16x32_bf16(Bt[n][k], At[m][k], acc[ai][bj][m][n], 0, 0, 0); __builtin_amdgcn_s_setprio(0); } while (0)
#define PG8_WAIT_V(n) asm volatile("s_waitcnt vmcnt(" #n ")" ::: "memory")
#define PG8_WAIT_L(n) asm volatile("s_waitcnt lgkmcnt(" #n ")" ::: "memory")
#define PG8_BAR __builtin_amdgcn_s_barrier()
#define PG8_SCHED __builtin_amdgcn_sched_barrier(0)
    Unit cur, nxt; int ui = 0;
    if (!S.next(0, cur)) return;
    cur.pm = __builtin_amdgcn_readfirstlane(cur.pm); cur.pn = __builtin_amdgcn_readfirstlane(cur.pn); cur.grp = __builtin_amdgcn_readfirstlane(cur.grp);
    f32x4 acc[2][2][4][2];
#pragma unroll
    for (int a = 0; a < 2; ++a)
#pragma unroll
        for (int b = 0; b < 2; ++b)
#pragma unroll
            for (int m = 0; m < 4; ++m)
#pragma unroll
                for (int n = 0; n < 2; ++n) acc[a][b][m][n] = (f32x4){0.f, 0.f, 0.f, 0.f};
    bf16x8 At[4][2], B0[2][2], B1[2][2];
    const char* cA = (const char*)g.A + (size_t)cur.grp * g.gsA + (size_t)cur.pm * tstep; const char* cB = (const char*)g.Bt + (size_t)cur.grp * g.gsB + (size_t)cur.pn * tstep;
    PG8_STAGE(PG8_SB(0, 0), cB, voffB); PG8_STAGE(PG8_SB(0, 1), cB + hstep, voffB); PG8_STAGE(PG8_SA(0, 0), cA, voffA); PG8_STAGE(PG8_SA(0, 1), cA + hstep, voffA);
    if (wr == 1) PG8_BAR;
    PG8_WAIT_V(2); PG8_BAR;
    PG8_STAGE(PG8_SB(1, 0), cB + kstep, voffB); PG8_STAGE(PG8_SA(1, 0), cA + kstep, voffA); PG8_STAGE(PG8_SB(1, 1), cB + hstep + kstep, voffB);
    PG8_WAIT_V(6); PG8_BAR;
    for (;;) {
        const bool has_next = S.next(ui + 1, nxt);
        nxt.pm = __builtin_amdgcn_readfirstlane(nxt.pm); nxt.pn = __builtin_amdgcn_readfirstlane(nxt.pn); nxt.grp = __builtin_amdgcn_readfirstlane(nxt.grp);
        const char* nA = has_next ? (const char*)g.A + (size_t)nxt.grp * g.gsA + (size_t)nxt.pm * tstep : cA; const char* nB = has_next ? (const char*)g.Bt + (size_t)nxt.grp * g.gsB + (size_t)nxt.pn * tstep : cB;
        for (int t = 0; t < nt; t += 2) {
            const bool last = (t == nt - 2);
            const char* a1 = cA + (size_t)(t + 1) * kstep;
            const char* a2 = last ? nA : cA + (size_t)(t + 2) * kstep; const char* b2 = last ? nB : cB + (size_t)(t + 2) * kstep;
            const char* a3 = a2 + kstep; const char* b3 = b2 + kstep;
            PG8_LDB(B0, 0, 0); PG8_LDB(B1, 0, 1); PG8_SCHED; PG8_LDA(At, 0, 0); PG8_STAGE(PG8_SA(1, 1), a1 + hstep, voffA);
            PG8_WAIT_V(8); PG8_WAIT_L(0); PG8_BAR; PG8_MMA(0, 0, At, B0); PG8_MMA(0, 1, At, B1); PG8_BAR; PG8_SCHED;
            PG8_LDA(At, 0, 1); PG8_STAGE(PG8_SB(0, 0), b2, voffB); PG8_STAGE(PG8_SB(0, 1), b2 + hstep, voffB); PG8_STAGE(PG8_SA(0, 0), a2, voffA);
            PG8_WAIT_V(8); PG8_WAIT_L(0); PG8_BAR; PG8_MMA(1, 0, At, B0); PG8_MMA(1, 1, At, B1); PG8_BAR; PG8_SCHED;
            PG8_LDB(B0, 1, 0); PG8_LDB(B1, 1, 1); PG8_SCHED; PG8_LDA(At, 1, 0); PG8_STAGE(PG8_SA(0, 1), a2 + hstep, voffA);
            PG8_WAIT_V(8); PG8_WAIT_L(0); PG8_BAR; PG8_MMA(0, 0, At, B0); PG8_MMA(0, 1, At, B1); PG8_BAR; PG8_SCHED;
            PG8_LDA(At, 1, 1); PG8_STAGE(PG8_SB(1, 0), b3, voffB); PG8_STAGE(PG8_SB(1, 1), b3 + hstep, voffB); PG8_STAGE(PG8_SA(1, 0), a3, voffA);
            PG8_WAIT_V(8); PG8_WAIT_L(0); PG8_BAR; PG8_MMA(1, 0, At, B0); PG8_MMA(1, 1, At, B1); PG8_BAR; PG8_SCHED;
        }
        bool keep = false;
        if (wr == 0) PG8_BAR;
        { Unit eu; eu.pm = __builtin_amdgcn_readfirstlane(cur.pm); eu.pn = __builtin_amdgcn_readfirstlane(cur.pn); eu.grp = __builtin_amdgcn_readfirstlane(cur.grp); asm volatile("" : "+s"(eu.pm), "+s"(eu.pn), "+s"(eu.grp)); keep = E(acc, eu, wr, wc, fr, fq); }
        if (!has_next) break;
        if (!keep) {
#pragma unroll
        for (int a = 0; a < 2; ++a)
#pragma unroll
            for (int b = 0; b < 2; ++b)
#pragma unroll
                for (int m = 0; m < 4; ++m)
#pragma unroll
                    for (int n = 0; n < 2; ++n) acc[a][b][m][n] = (f32x4){0.f, 0.f, 0.f, 0.f};
        }
        cur = nxt; cA = nA; cB = nB; ++ui;
        if (wr == 1) PG8_BAR;
    }
    PG8_WAIT_V(0);
    PG8_BAR;
#undef PG8_SA
#undef PG8_SB
#undef PG8_STAGE
#undef PG8_LDA
#undef PG8_LDB
#undef PG8_MMA
#undef PG8_WAIT_V
#undef PG8_WAIT_L
#undef PG8_BAR
#undef PG8_SCHED
}
template <class Epi, class Sched, bool GATHER = false>
DI void gemm_phase_i8(LAS unsigned char* lds, const Gemm g, const Sched& S, const Epi& E, const int* etok = nullptr, const LAS int* tpt = nullptr) {
    int tid = threadIdx.x; asm volatile("" : "+v"(tid));
    const int wid = __builtin_amdgcn_readfirstlane(tid >> 6), lane = tid & 63, wr = wid >> 2, wc = wid & 3, fr = lane & 15, fq = lane >> 4;
    int K = g.K; asm volatile("" : "+s"(K));
    const int nt = K / BK;
    unsigned voffA[2], voffB[2], gC[2]; int gR[2];
#pragma unroll
    for (int i = 0; i < 2; ++i) { int R, C; stage_rc(tid * 16 + i * 8192, R, C); const int Rb = Epi::PERM ? ((R & ~31) + perm32(R & 31)) : R;
        voffA[i] = (unsigned)(R * K + C) * 2u; voffB[i] = (unsigned)(Rb * K + C) * 2u; gR[i] = R; gC[i] = (unsigned)C * 2u; }
    const size_t kstep = (size_t)(BK * 2);
    const size_t hstep = (size_t)HALF * K * 2;
    const size_t tstep = 2 * hstep;
    const unsigned ldsw = (unsigned)wid * 1024u;
    const int aoff = lds_byte(wr * 64 + fr, fq * 8), boff = lds_byte(wc * 32 + fr, fq * 8);
#define PG8_SA(b, h) (((b) * 2 + (h)) * HTB)
#define PG8_SB(b, h) ((4 + (b) * 2 + (h)) * HTB)
#define PG8_STAGE(bufoff, gbase, voff) do { _Pragma("unroll") for (int _i = 0; _i < 2; ++_i) \
        __builtin_amdgcn_global_load_lds((const unsigned*)((const char*)(gbase) + (voff)[_i]), (LAS unsigned*)(lds + (bufoff) + ldsw + _i * 8192), 16, 0, 0); } while (0)
#define PG8_STAGE2(bufoff, gbase, o0, o1) do { \
        __builtin_amdgcn_global_load_lds((const unsigned*)((const char*)(gbase) + (o0)), (LAS unsigned*)(lds + (bufoff) + ldsw), 16, 0, 0); \
        __builtin_amdgcn_global_load_lds((const unsigned*)((const char*)(gbase) + (o1)), (LAS unsigned*)(lds + (bufoff) + ldsw + 8192), 16, 0, 0); } while (0)
#define PG8_GATH(u, v) do { const int e_ = (u).grp, b_ = ((u).pm - tpt[e_]) * 256, c_ = tpt[32 + e_]; const int* et_ = etok + e_ * TT; \
        _Pragma("unroll") for (int h_ = 0; h_ < 2; ++h_) _Pragma("unroll") for (int i_ = 0; i_ < 2; ++i_) { const int s_ = b_ + h_ * 128 + gR[i_]; const int t_ = (s_ < c_) ? et_[s_] : 0; \
            v[h_][i_] = (unsigned)t_ * (unsigned)(K * 2) + gC[i_]; } } while (0)
#define PG8_LDA(dst, b, h) do { _Pragma("unroll") for (int m = 0; m < 4; ++m) _Pragma("unroll") for (int k = 0; k < 2; ++k) dst[m][k] = *(const LAS v4i_t*)(lds + PG8_SA(b, h) + aoff + m * 2048 + k * 1024); } while (0)
#define PG8_LDB(dst, b, h) do { _Pragma("unroll") for (int n = 0; n < 2; ++n) _Pragma("unroll") for (int k = 0; k < 2; ++k) dst[n][k] = *(const LAS v4i_t*)(lds + PG8_SB(b, h) + boff + n * 2048 + k * 1024); } while (0)
#define PG8_MMA(ai, bj, At, Bt) do { __builtin_amdgcn_s_setprio(1); _Pragma("unroll") for (int m = 0; m < 4; ++m) _Pragma("unroll") for (int n = 0; n < 2; ++n) _Pragma("unroll") for (int k = 0; k < 2; ++k) \
        acc[ai][bj][m][n] = __builtin_amdgcn_mfma_i32_16x16x64_i8(Bt[n][k], At[m][k], acc[ai][bj][m][n], 0, 0, 0); __builtin_amdgcn_s_setprio(0); } while (0)
#define PG8_WAIT_V(n) asm volatile("s_waitcnt vmcnt(" #n ")" ::: "memory")
#define PG8_WAIT_L(n) asm volatile("s_waitcnt lgkmcnt(" #n ")" ::: "memory")
#define PG8_BAR __builtin_amdgcn_s_barrier()
#define PG8_SCHED __builtin_amdgcn_sched_barrier(0)
    Unit cur, nxt; int ui = 0;
    if (!S.next(0, cur)) return;
    cur.pm = __builtin_amdgcn_readfirstlane(cur.pm); cur.pn = __builtin_amdgcn_readfirstlane(cur.pn); cur.grp = __builtin_amdgcn_readfirstlane(cur.grp);
    v4i_t acc[2][2][4][2];
#pragma unroll
    for (int a = 0; a < 2; ++a)
#pragma unroll
        for (int b = 0; b < 2; ++b)
#pragma unroll
            for (int m = 0; m < 4; ++m)
#pragma unroll
                for (int n = 0; n < 2; ++n) acc[a][b][m][n] = (v4i_t){0, 0, 0, 0};
    v4i_t At[4][2], B0[2][2], B1[2][2];
    const char* cA = GATHER ? (const char*)g.A : (const char*)g.A + (size_t)cur.grp * g.gsA + (size_t)cur.pm * tstep; const char* cB = (const char*)g.Bt + (size_t)cur.grp * g.gsB + (size_t)cur.pn * tstep;
    unsigned cv[2][2] = {{voffA[0], voffA[1]}, {voffA[0], voffA[1]}}, nv[2][2] = {{voffA[0], voffA[1]}, {voffA[0], voffA[1]}};
    if (GATHER) PG8_GATH(cur, cv);
    const size_t ahs = GATHER ? (size_t)0 : hstep;
    PG8_STAGE(PG8_SB(0, 0), cB, voffB); PG8_STAGE(PG8_SB(0, 1), cB + hstep, voffB); PG8_STAGE2(PG8_SA(0, 0), cA, cv[0][0], cv[0][1]); PG8_STAGE2(PG8_SA(0, 1), cA + ahs, cv[1][0], cv[1][1]);
    if (wr == 1) PG8_BAR;
    PG8_WAIT_V(2); PG8_BAR;
    PG8_STAGE(PG8_SB(1, 0), cB + kstep, voffB); PG8_STAGE2(PG8_SA(1, 0), cA + kstep, cv[0][0], cv[0][1]); PG8_STAGE(PG8_SB(1, 1), cB + hstep + kstep, voffB);
    PG8_WAIT_V(6); PG8_BAR;
    for (;;) {
        const bool has_next = S.next(ui + 1, nxt);
        nxt.pm = __builtin_amdgcn_readfirstlane(nxt.pm); nxt.pn = __builtin_amdgcn_readfirstlane(nxt.pn); nxt.grp = __builtin_amdgcn_readfirstlane(nxt.grp);
        const char* nA = (has_next && !GATHER) ? (const char*)g.A + (size_t)nxt.grp * g.gsA + (size_t)nxt.pm * tstep : cA; const char* nB = has_next ? (const char*)g.Bt + (size_t)nxt.grp * g.gsB + (size_t)nxt.pn * tstep : cB;
        if (GATHER) { if (has_next) PG8_GATH(nxt, nv); else { nv[0][0] = cv[0][0]; nv[0][1] = cv[0][1]; nv[1][0] = cv[1][0]; nv[1][1] = cv[1][1]; } }
        for (int t = 0; t < nt; t += 2) {
            const bool last = (t == nt - 2);
            const unsigned s00 = (GATHER && last) ? nv[0][0] : cv[0][0], s01 = (GATHER && last) ? nv[0][1] : cv[0][1], s10 = (GATHER && last) ? nv[1][0] : cv[1][0], s11 = (GATHER && last) ? nv[1][1] : cv[1][1];
            const char* a1 = cA + (size_t)(t + 1) * kstep;
            const char* a2 = last ? nA : cA + (size_t)(t + 2) * kstep; const char* b2 = last ? nB : cB + (size_t)(t + 2) * kstep;
            const char* a3 = a2 + kstep; const char* b3 = b2 + kstep;
            PG8_LDB(B0, 0, 0); PG8_LDB(B1, 0, 1); PG8_SCHED; PG8_LDA(At, 0, 0); PG8_STAGE2(PG8_SA(1, 1), a1 + ahs, cv[1][0], cv[1][1]);
            PG8_WAIT_V(8); PG8_WAIT_L(0); PG8_BAR; PG8_MMA(0, 0, At, B0); PG8_MMA(0, 1, At, B1); PG8_BAR; PG8_SCHED;
            PG8_LDA(At, 0, 1); PG8_STAGE(PG8_SB(0, 0), b2, voffB); PG8_STAGE(PG8_SB(0, 1), b2 + hstep, voffB); PG8_STAGE2(PG8_SA(0, 0), a2, s00, s01);
            PG8_WAIT_V(8); PG8_WAIT_L(0); PG8_BAR; PG8_MMA(1, 0, At, B0); PG8_MMA(1, 1, At, B1); PG8_BAR; PG8_SCHED;
            PG8_LDB(B0, 1, 0); PG8_LDB(B1, 1, 1); PG8_SCHED; PG8_LDA(At, 1, 0); PG8_STAGE2(PG8_SA(0, 1), a2 + ahs, s10, s11);
            PG8_WAIT_V(8); PG8_WAIT_L(0); PG8_BAR; PG8_MMA(0, 0, At, B0); PG8_MMA(0, 1, At, B1); PG8_BAR; PG8_SCHED;
            PG8_LDA(At, 1, 1); PG8_STAGE(PG8_SB(1, 0), b3, voffB); PG8_STAGE(PG8_SB(1, 1), b3 + hstep, voffB); PG8_STAGE2(PG8_SA(1, 0), a3, s00, s01);
            PG8_WAIT_V(8); PG8_WAIT_L(0); PG8_BAR; PG8_MMA(1, 0, At, B0); PG8_MMA(1, 1, At, B1); PG8_BAR; PG8_SCHED;
        }
        bool keep = false;
        if (wr == 0) PG8_BAR;
        { Unit eu; eu.pm = __builtin_amdgcn_readfirstlane(cur.pm); eu.pn = __builtin_amdgcn_readfirstlane(cur.pn); eu.grp = __builtin_amdgcn_readfirstlane(cur.grp); asm volatile("" : "+s"(eu.pm), "+s"(eu.pn), "+s"(eu.grp)); keep = E(acc, eu, wr, wc, fr, fq); }
        if (!has_next) break;
        if (!keep) {
#pragma unroll
        for (int a = 0; a < 2; ++a)
#pragma unroll
            for (int b = 0; b < 2; ++b)
#pragma unroll
                for (int m = 0; m < 4; ++m)
#pragma unroll
                    for (int n = 0; n < 2; ++n) acc[a][b][m][n] = (v4i_t){0, 0, 0, 0};
        }
        cur = nxt; cA = nA; cB = nB; ++ui;
        if (GATHER) { cv[0][0] = nv[0][0]; cv[0][1] = nv[0][1]; cv[1][0] = nv[1][0]; cv[1][1] = nv[1][1]; }
        if (wr == 1) PG8_BAR;
    }
    PG8_WAIT_V(0);
    PG8_BAR;
#undef PG8_SA
#undef PG8_SB
#undef PG8_STAGE
#undef PG8_STAGE2
#undef PG8_GATH
#undef PG8_LDA
#undef PG8_LDB
#undef PG8_MMA
#undef PG8_WAIT_V
#undef PG8_WAIT_L
#undef PG8_BAR
#undef PG8_SCHED
}
}

#define XB_TMO      128
#define XB_XCNT(j)  (256  + 64 * (j))
#define XB_XSUB(j)  (1280 + 64 * (j))
#define XB_XGEN(j)  (2304 + 64 * (j))
#define XB_TOP      3328
#define XB_TOPGEN   3392
#define XCD_BAR_WORDS 3456
#define XB_SPIN_CAP (1u << 18)

__device__ __forceinline__ unsigned xb_ld(unsigned* p)              { return __hip_atomic_load(p, __ATOMIC_RELAXED, __HIP_MEMORY_SCOPE_AGENT); }
__device__ __forceinline__ unsigned xb_add(unsigned* p, unsigned v) { return __hip_atomic_fetch_add(p, v, __ATOMIC_RELAXED, __HIP_MEMORY_SCOPE_AGENT); }
__device__ __forceinline__ unsigned xb_xcc_id() { return (unsigned)__builtin_amdgcn_s_getreg((3 << 11) | 20) & 0xFu; }
#define XB_SPIN(cond, bar) do { unsigned _sp = 0; while (cond) { __builtin_amdgcn_s_sleep(1); \
    if ((++_sp & 255u) == 0u) { if (xb_ld(&(bar)[XB_TMO])) break; if (_sp > XB_SPIN_CAP) { atomicAdd(&(bar)[XB_TMO], 1u); break; } } } } while (0)

struct XcdBarrier {
    unsigned* bar; unsigned x;
    volatile LAS unsigned* st;
};

__device__ __forceinline__ XcdBarrier xcd_barrier_post(unsigned* bar, volatile LAS unsigned* st) {
    XcdBarrier b; b.bar = bar; b.x = xb_xcc_id(); b.st = st;
    if (threadIdx.x == 0) (void)xb_add(&bar[XB_XCNT(b.x)], 1u);
    return b;
}
__device__ __forceinline__ void xcd_barrier_complete(unsigned* bar, unsigned x, unsigned& nloc, unsigned& nx) {
    const unsigned G = gridDim.x * gridDim.y * gridDim.z;
    unsigned sum, cnt, mine, sp = 0u;
    for (;;) {
        sum = 0u; cnt = 0u; mine = 0u;
#pragma unroll
        for (unsigned j = 0; j < 16; ++j) { const unsigned c = xb_ld(&bar[XB_XCNT(j)]); sum += c; cnt += (c > 0u) ? 1u : 0u; mine = (j == x) ? c : mine; }
        if (sum == G) break;
        __builtin_amdgcn_s_sleep(1);
        if ((++sp & 255u) == 0u) { if (xb_ld(&bar[XB_TMO])) break; if (sp > XB_SPIN_CAP) { atomicAdd(&bar[XB_TMO], 1u); break; } }
    }
    nloc = mine > 0u ? mine : 1u; nx = cnt > 0u ? cnt : 1u;
}

__device__ __forceinline__ void xcd_barrier(const XcdBarrier& b) {
    asm volatile("s_waitcnt vmcnt(0)" ::: "memory");
    __syncthreads();
    if (threadIdx.x == 0) {
        unsigned* bar = b.bar;
        __builtin_amdgcn_s_waitcnt(0);
        unsigned nloc = b.st[0], nx = b.st[1];
        if (nloc == 0u) { xcd_barrier_complete(bar, b.x, nloc, nx); b.st[0] = nloc; b.st[1] = nx; }
        const unsigned old = xb_add(&bar[XB_XSUB(b.x)], 1u);
        const unsigned gen = old / nloc;
        if (old + 1u == (gen + 1u) * nloc) {
            __builtin_amdgcn_fence(__ATOMIC_RELEASE, "agent");
            asm volatile("s_waitcnt vmcnt(0)" ::: "memory");
            const unsigned og = xb_add(&bar[XB_TOP], 1u);
            const unsigned tg = og / nx;
            if (og + 1u == (tg + 1u) * nx) xb_add(&bar[XB_TOPGEN], 1u);
            else XB_SPIN(xb_ld(&bar[XB_TOPGEN]) == tg, bar);
            __builtin_amdgcn_fence(__ATOMIC_ACQUIRE, "agent");
            xb_add(&bar[XB_XGEN(b.x)], 1u);
            asm volatile("s_waitcnt vmcnt(0)" ::: "memory");
        } else {
            XB_SPIN(xb_ld(&bar[XB_XGEN(b.x)]) == gen, bar);
            __builtin_amdgcn_fence(__ATOMIC_ACQUIRE, "agent");
            asm volatile("s_waitcnt vmcnt(0)" ::: "memory");
        }
    }
    __syncthreads();
}

constexpr size_t MiB = 1u << 20;
constexpr size_t WS_CTL = 0, CTL_ZERO_BYTES = 1 * MiB;
constexpr size_t WS_MOD  = 1 * MiB;
constexpr size_t WS_WIN  = 2 * MiB;
constexpr size_t WS_WUQ  = 210 * MiB;
constexpr size_t WS_WKN  = 213 * MiB;
constexpr size_t WS_WV   = 214 * MiB;
constexpr size_t WS_WBR  = 215 * MiB;
constexpr size_t WS_WMIX = 247 * MiB;
constexpr size_t WS_W1   = 279 * MiB;
constexpr size_t WS_W2   = 535 * MiB;
constexpr size_t WS_X    = 663 * MiB;
constexpr size_t WS_H    = 735 * MiB;
constexpr size_t WS_U    = 771 * MiB;
constexpr size_t WS_CQN  = 1005 * MiB;
constexpr size_t WS_CKVN = 1014 * MiB;
constexpr size_t WS_KRP  = 1019 * MiB;
constexpr size_t WS_Q    = 1021 * MiB;
constexpr size_t WS_KN   = 1035 * MiB;
constexpr size_t WS_VT   = 1044 * MiB;
constexpr size_t WS_ACTS = 1053 * MiB;
constexpr size_t WS_YM   = 1089 * MiB;
constexpr size_t WS_SLOC = 1125 * MiB;
constexpr size_t WS_DEC  = 1161 * MiB;
constexpr size_t WS_SIN  = 1162 * MiB;
constexpr size_t WS_ETOK = 1261 * MiB, WS_ERS = 1262 * MiB, WS_ERW = 1263 * MiB;
constexpr size_t WS_ROUTE= 1180 * MiB;
constexpr size_t WS_HS   = 1181 * MiB;
constexpr size_t WS_ACTM = 1269 * MiB;
constexpr size_t WS_OUTS = 1291 * MiB;
constexpr size_t WS_W8   = 1379 * MiB;
constexpr size_t WS_H8   = 1483 * MiB;
constexpr size_t WS_RA   = 1501 * MiB;
constexpr size_t WS_RB   = 1501 * MiB + 64 * 1024;
constexpr size_t WS_RB1  = 1501 * MiB + 512 * 1024;
constexpr size_t WS_RSORT= 1501 * MiB + 768 * 1024;
constexpr size_t WS_RAF  = 1501 * MiB + 896 * 1024;
constexpr size_t WS_G8   = 1502 * MiB;
constexpr size_t WS_END  = 1574 * MiB;
constexpr int CW_BAR = 4096;
constexpr int CW_CNT = 16384;
constexpr int CW_CMAX = 131072;

constexpr int RING_BYTES = 131072;
constexpr int LDSX_OFF = RING_BYTES;
constexpr int LDS_BYTES = 147456;

struct Params { const float* in[34]; float* out; unsigned char* ws; int ph_lo, ph_hi; };
typedef const __attribute__((address_space(4))) Params* KParams;
enum { I_X = 0, I_C, I_CTX, I_CCTX, I_WMOD, I_BMOD, I_GMIX, I_GFFN, I_WIN, I_GQ, I_WUQ, I_GKV, I_WUKV, I_WMLAO, I_WCFDW, I_BCFDW, I_GCFLN, I_BCFLN, I_WCFO,
       I_WGF, I_BGF, I_WGB, I_BGB, I_GGLAN, I_WGLAO, I_WSCC, I_WSCO, I_WMIXO, I_WROUT, I_BROUT, I_WEG, I_WEU, I_WED, I_GFIN };

struct Frame { LAS unsigned char* lds; int tid, lane, wave, G, bid, gw, NGW; };

#define WSP(T, off) ((T*)(P->ws + (off)))
#define WSQ(T, off) ((T*)(Q->ws + (off)))
DI unsigned* ctl_words(KParams P) { return (unsigned*)(P->ws + WS_CTL); }
DI int mod_row(int row) { return row < TLAT ? (row >> 11) : 4; }

DI void transpose_item(const float* W, int N, bf16_t* WT, int KD, int dest_row0, int k0, int n0, LAS float* scr, int lane) {
#pragma unroll
    for (int i = 0; i < 32; ++i) { const int kk = 2 * i + (lane >> 5); scr[kk * 33 + (lane & 31)] = __builtin_nontemporal_load(W + (size_t)(k0 + kk) * N + n0 + (lane & 31)); }
    LDS_WAIT(); asm volatile("" ::: "memory");
    const int c = lane & 7;
#pragma unroll
    for (int j = 0; j < 4; ++j) { const int n = (lane >> 3) + 8 * j; const LAS float* s = scr + (8 * c) * 33 + n;
        u32x4 o; o.x = pk2(s[0 * 33], s[1 * 33]); o.y = pk2(s[2 * 33], s[3 * 33]); o.z = pk2(s[4 * 33], s[5 * 33]); o.w = pk2(s[6 * 33], s[7 * 33]);
        __builtin_nontemporal_store(o, (u32x4*)(WT + (size_t)(dest_row0 + n) * KD + k0 + 8 * c)); }
    LDS_WAIT(); asm volatile("" ::: "memory");
}
constexpr int SLAB_AUX = LDSX_OFF + 2048;
DI int slab_off(int k, int n) { return k * 64 + ((((n >> 1) ^ ((k >> 3) & 15)) << 2) | ((n & 1) << 1)); }
DI void slab_item(const float* W, int N, int n0, unsigned char* W8, int dest_row0, float* rB, Frame& F) {
    LAS float* wmax = (LAS float*)(F.lds + SLAB_AUX); LAS float* cmax = wmax + 256;
    { const int n = F.lane & 31, kp = F.lane >> 5; float m = 0.f;
#pragma unroll 1
      for (int j = 0; j < 4; ++j) { const int kb0 = (F.wave * 4 + j) * 64; float v[32];
#pragma unroll
          for (int i = 0; i < 32; ++i) v[i] = __builtin_nontemporal_load(W + (size_t)(kb0 + 2 * i + kp) * N + n0 + n);
#pragma unroll
          for (int i = 0; i < 32; ++i) { m = fmaxf(m, fabsf(v[i])); *(LAS bf16_t*)(F.lds + slab_off(kb0 + 2 * i + kp, n)) = f2bf(v[i]); } }
      m = fmaxf(m, __shfl_xor(m, 32)); if (F.lane < 32) wmax[F.wave * 32 + n] = m; }
    __syncthreads();
    if (F.tid < 32) { float c = 0.f;
#pragma unroll
        for (int w2 = 0; w2 < 8; ++w2) c = fmaxf(c, wmax[w2 * 32 + F.tid]);
        cmax[F.tid] = c; rB[dest_row0 + F.tid] = c * (1.f / 127.f); }
    __syncthreads();
    { const int nn = ((F.tid >> 3) & 7) + 8 * (F.wave & 3); const float cm = cmax[nn], sc = cm > 0.f ? 127.f / cm : 0.f;
#pragma unroll 4
      for (int i2 = 0; i2 < 16; ++i2) { const int c = (F.tid & 7) + 8 * i2 + 128 * (F.wave >> 2); unsigned q[8];
#pragma unroll
          for (int j = 0; j < 8; ++j) q[j] = q8(sc * bf2f(*(const LAS bf16_t*)(F.lds + slab_off(8 * c + j, nn))));
          u32x2 o; o.x = q[0] | (q[1] << 8) | (q[2] << 16) | (q[3] << 24); o.y = q[4] | (q[5] << 8) | (q[6] << 16) | (q[7] << 24);
          __builtin_nontemporal_store(o, (u32x2*)(W8 + (size_t)(dest_row0 + nn) * DM + 8 * c)); } }
    __syncthreads();
}
constexpr int NS_WIN = PW / 32, NS_EXP = 16 * 2 * (EFF / 32), NS_ALL = NS_WIN + NS_EXP;
DI void slab_dispatch(KParams P, Frame& F, int l, int sidx) {
    if (sidx < NS_WIN) { slab_item(P->in[I_WIN] + (size_t)l * DM * PW, PW, 32 * sidx, WSP(unsigned char, WS_W8) + (size_t)l * PWP * DM, wcol_dest(32 * sidx), WSP(float, WS_RB) + (size_t)l * PWP, F); return; }
    const int q = sidx - NS_WIN, e = q >> 5, which = (q >> 4) & 1, n0 = (q & 15) * 32, le = l * 16 + e;
    slab_item((which ? P->in[I_WEU] : P->in[I_WEG]) + (size_t)le * DM * EFF, EFF, n0, WSP(unsigned char, WS_W1) + (size_t)le * 1024 * DM, (n0 >> 7) * 256 + which * 128 + (n0 & 127), WSP(float, WS_RB1) + (size_t)le * 1024, F);
}
constexpr int NL_UQ = 8 * 24, NL_UKV = 4 * 32, NL_BR = 4 * 8 * 64, NL_MIX = 32 * 64, NL_ED = 16 * 8 * 64, NL_PAD = PWP - PW;
constexpr int NL_ITEMS = NL_UQ + NL_UKV + NL_BR + NL_MIX + NL_ED + NL_PAD;
constexpr int NL_F1 = (NL_ITEMS * 55) / 100, NL_F2 = (NL_ITEMS * 88) / 100;
DI void conv_item_layer(KParams P, int l, int it, LAS float* scr, int lane) {
    int r = it;
    if (r < NL_UQ) { const int kb = r / 24, nb = r % 24;
        transpose_item(P->in[I_WUQ] + (size_t)l * 512 * 768, 768, WSP(bf16_t, WS_WUQ) + (size_t)l * 768 * 512, 512, 32 * nb, 64 * kb, 32 * nb, scr, lane); return; } r -= NL_UQ;
    if (r < NL_UKV) { const int kb = r / 32, nb = r % 32, n0 = 32 * nb, hh = n0 >> 7, jj = n0 & 127;
        bf16_t* dst = (jj < 64 ? WSP(bf16_t, WS_WKN) : WSP(bf16_t, WS_WV)) + (size_t)l * 512 * 256;
        transpose_item(P->in[I_WUKV] + (size_t)l * 256 * 1024, 1024, dst, 256, hh * 64 + (jj & 63), 64 * kb, n0, scr, lane); return; } r -= NL_UKV;
    if (r < NL_BR) { const int br = r / 512, q = r % 512, kb = q / 64, nb = q % 64;
        const float* src = (br == 0 ? P->in[I_WMLAO] : br == 1 ? P->in[I_WCFO] : br == 2 ? P->in[I_WGLAO] : P->in[I_WSCO]) + (size_t)l * 512 * DM;
        transpose_item(src, DM, WSP(bf16_t, WS_WBR) + (size_t)(l * 4 + br) * DM * 512, 512, 32 * nb, 64 * kb, 32 * nb, scr, lane); return; } r -= NL_BR;
    if (r < NL_MIX) { const int kb = r / 64, nb = r % 64;
        transpose_item(P->in[I_WMIXO] + (size_t)l * DM * DM, DM, WSP(bf16_t, WS_WMIX) + (size_t)l * DM * DM, DM, 32 * nb, 64 * kb, 32 * nb, scr, lane); return; } r -= NL_MIX;
    if (r < NL_ED) { const int e = r / 512, q = r % 512, kb = q / 64, nb = q % 64, le = l * 16 + e;
        transpose_item(P->in[I_WED] + (size_t)le * EFF * DM, DM, WSP(bf16_t, WS_W2) + (size_t)le * DM * EFF, EFF, 32 * nb, 64 * kb, 32 * nb, scr, lane); return; } r -= NL_ED;
    { unsigned char* row = WSP(unsigned char, WS_W8) + ((size_t)l * PWP + O_MG + r) * DM;
#pragma unroll
      for (int j = 0; j < 2; ++j) *(u32x4*)(row + 16 * lane + 1024 * j) = (u32x4){0u, 0u, 0u, 0u};
      if (lane == 0) WSP(float, WS_RB)[(size_t)l * PWP + O_MG + r] = 0.f; }
}
DI void conv_mixed(KParams P, Frame& F, int l, int s_lo, int s_hi, int w_lo, int w_hi, int rank, int nrank) {
    if (rank < 0) return;
    for (int sidx = s_lo + rank; sidx < s_hi; sidx += nrank) slab_dispatch(P, F, l, sidx);
    LAS float* scr = (LAS float*)(F.lds + F.wave * 8448);
    for (int it = w_lo + rank * 8 + F.wave; it < w_hi; it += nrank * 8) conv_item_layer(P, l, it, scr, F.lane);
    __syncthreads();
}
DI void mod_item(KParams P, Frame& F, int it) {
    const int l = it / 192, n0 = (it % 192) * 64;
    const LAS float* sil = (const LAS float*)F.lds;
    LAS float* red = (LAS float*)(F.lds + 40960);
    const int kq = F.lane >> 4, ln = F.lane & 15;
    const float* wp = P->in[I_WMOD] + (size_t)l * DM * (6 * DM) + n0 + 4 * ln;
    f32x4 acc[5];
#pragma unroll
    for (int r = 0; r < 5; ++r) acc[r] = (f32x4){0.f, 0.f, 0.f, 0.f};
    const int kbase = F.wave * 256 + kq;
#pragma unroll 8
    for (int kk = 0; kk < 64; ++kk) { const int k = kbase + 4 * kk; const f32x4 wv = *(const f32x4*)(wp + (size_t)k * (6 * DM));
#pragma unroll
        for (int r = 0; r < 5; ++r) acc[r] = acc[r] + wv * sil[r * DM + k]; }
    const int grp = F.wave * 4 + kq;
#pragma unroll
    for (int r = 0; r < 5; ++r) *(LAS f32x4*)(red + (grp * 5 + r) * 64 + 4 * ln) = acc[r];
    __syncthreads();
    if (F.tid < 320) { const int r = F.tid >> 6, n = F.tid & 63; float s = P->in[I_BMOD][(size_t)l * (6 * DM) + n0 + n];
        for (int g = 0; g < 32; ++g) s += red[(g * 5 + r) * 64 + n];
        WSP(float, WS_MOD)[(size_t)(l * 5 + r) * (6 * DM) + n0 + n] = s; }
    __syncthreads();
}
DI void phase_prologue(KParams P, Frame& F) {
    LAS float* sil = (LAS float*)F.lds;
    for (int i = F.tid; i < 5 * DM; i += 512) { const int r = i >> 11, k = i & (DM - 1); const float c = r < 4 ? P->in[I_C][r * DM + k] : P->in[I_CCTX][k]; sil[i] = c / (1.f + expf(-c)); }
    __syncthreads();
    for (int it = F.bid; it < DEPTH * 192; it += F.G) mod_item(P, F, it);
    __syncthreads();
}

DI void moe_table(KParams P, Frame& F, int l) {
    LAS int* tp = (LAS int*)(F.lds + LDSX_OFF + 64); LAS int* cn = tp + 32;
    if (F.tid == 0) { const unsigned* cnt = ctl_words(P) + CW_CNT + l * 16 * 64; int a = 0;
        for (int e = 0; e < 16; ++e) { const int c = (int)__hip_atomic_load(cnt + e * 64, __ATOMIC_RELAXED, __HIP_MEMORY_SCOPE_AGENT); tp[e] = a; cn[e] = c; a += (c + 255) >> 8; }
        tp[16] = a; }
    __syncthreads();
}
DI void phase_norm1(KParams P, Frame& F, int l, bool dummy) {
    bf16_t* X = WSP(bf16_t, WS_X); bf16_t* XO = dummy ? WSP(bf16_t, WS_HS) : X; bf16_t* H = WSP(bf16_t, WS_H); const float* mod = WSP(float, WS_MOD); const bf16_t* outs = WSP(bf16_t, WS_OUTS);
    const int* rt_e = (const int*)(P->ws + WS_ROUTE); const int* rt_slot = (const int*)(P->ws + WS_ROUTE + 2 * 73728); const LAS int* tp = (const LAS int*)(F.lds + LDSX_OFF + 64);
    if (l > 0) moe_table(P, F, l - 1);
    for (int row = F.gw; row < TT; row += F.NGW) {
        const int r = mod_row(row);
        f32x4 v[8];
        if (l == 0) { const float* src = row < TLAT ? P->in[I_X] + (size_t)row * DM : P->in[I_CTX] + (size_t)(row - TLAT) * DM;
#pragma unroll
            for (int j = 0; j < 8; ++j) v[j] = *(const f32x4*)(src + 4 * F.lane + 256 * j); }
        else {
#pragma unroll
            for (int j = 0; j < 8; ++j) { const u32x2 w = *(const u32x2*)(X + (size_t)row * DM + 4 * F.lane + 256 * j); v[j] = (f32x4){bflo(w.x), bfhi(w.x), bflo(w.y), bfhi(w.y)}; } }
        if (l > 0) { const int p0 = tp[rt_e[2 * row]] * 256 + rt_slot[2 * row], p1 = tp[rt_e[2 * row + 1]] * 256 + rt_slot[2 * row + 1]; const float* gt = mod + (size_t)((l - 1) * 5 + r) * (6 * DM) + 5 * DM;
#pragma unroll
            for (int j = 0; j < 8; ++j) { const int c = 4 * F.lane + 256 * j; const f32x4 g = *(const f32x4*)(gt + c);
                const u32x2 a = *(const u32x2*)(outs + (size_t)p0 * DM + c), b = *(const u32x2*)(outs + (size_t)p1 * DM + c);
                v[j][0] += g[0] * (bflo(a.x) + bflo(b.x)); v[j][1] += g[1] * (bfhi(a.x) + bfhi(b.x)); v[j][2] += g[2] * (bflo(a.y) + bflo(b.y)); v[j][3] += g[3] * (bfhi(a.y) + bfhi(b.y)); } }
        float ss = 0.f;
#pragma unroll
        for (int j = 0; j < 8; ++j) { *(u32x2*)(XO + (size_t)row * DM + 4 * F.lane + 256 * j) = (u32x2){pk2(v[j][0], v[j][1]), pk2(v[j][2], v[j][3])}; ss += (v[j][0] * v[j][0] + v[j][1] * v[j][1]) + (v[j][2] * v[j][2] + v[j][3] * v[j][3]); }
        const float rstd = 1.f / sqrtf(wave_sum(ss) * (1.f / DM) + EPS);
        const float* mp = mod + (size_t)(l * 5 + r) * (6 * DM); const float* gm = P->in[I_GMIX] + (size_t)l * DM; float am = 0.f;
#pragma unroll
        for (int j = 0; j < 8; ++j) { const int c = 4 * F.lane + 256 * j; const f32x4 g = *(const f32x4*)(gm + c), sh = *(const f32x4*)(mp + c), sc = *(const f32x4*)(mp + DM + c);
            v[j] = (v[j] * rstd * g) * (sc + 1.f) + sh; am = fmaxf(fmaxf(am, fmaxf(fabsf(v[j][0]), fabsf(v[j][1]))), fmaxf(fabsf(v[j][2]), fabsf(v[j][3]))); }
#pragma unroll
        for (int o = 1; o < 64; o <<= 1) am = fmaxf(am, __shfl_xor(am, o));
        const float qs = am > 0.f ? 127.f / am : 0.f;
#pragma unroll
        for (int j = 0; j < 8; ++j) { const int c = 4 * F.lane + 256 * j;
            *(unsigned*)(WSP(unsigned char, WS_H8) + (size_t)row * DM + c) = q8(v[j][0] * qs) | (q8(v[j][1] * qs) << 8) | (q8(v[j][2] * qs) << 16) | (q8(v[j][3] * qs) << 24); }
        if (F.lane == 0) WSP(float, WS_RA)[row] = am * (1.f / 127.f);
    }
}
DI void phase_final(KParams P, Frame& F) {
    const bf16_t* X = WSP(bf16_t, WS_X); const float* mod = WSP(float, WS_MOD); const bf16_t* outs = WSP(bf16_t, WS_OUTS);
    const int* rt_e = (const int*)(P->ws + WS_ROUTE); const int* rt_slot = (const int*)(P->ws + WS_ROUTE + 2 * 73728); const LAS int* tp = (const LAS int*)(F.lds + LDSX_OFF + 64);
    moe_table(P, F, DEPTH - 1);
    for (int row = F.gw; row < TLAT; row += F.NGW) {
        const int r = mod_row(row); const int p0 = tp[rt_e[2 * row]] * 256 + rt_slot[2 * row], p1 = tp[rt_e[2 * row + 1]] * 256 + rt_slot[2 * row + 1]; const float* gt = mod + (size_t)((DEPTH - 1) * 5 + r) * (6 * DM) + 5 * DM;
        f32x4 v[8]; float ss = 0.f;
#pragma unroll
        for (int j = 0; j < 8; ++j) { const int c = 4 * F.lane + 256 * j; { const u32x2 w = *(const u32x2*)(X + (size_t)row * DM + c); v[j] = (f32x4){bflo(w.x), bfhi(w.x), bflo(w.y), bfhi(w.y)}; } const f32x4 g = *(const f32x4*)(gt + c);
            const u32x2 a = *(const u32x2*)(outs + (size_t)p0 * DM + c), b = *(const u32x2*)(outs + (size_t)p1 * DM + c);
            v[j][0] += g[0] * (bflo(a.x) + bflo(b.x)); v[j][1] += g[1] * (bfhi(a.x) + bfhi(b.x)); v[j][2] += g[2] * (bflo(a.y) + bflo(b.y)); v[j][3] += g[3] * (bfhi(a.y) + bfhi(b.y));
            ss += (v[j][0] * v[j][0] + v[j][1] * v[j][1]) + (v[j][2] * v[j][2] + v[j][3] * v[j][3]); }
        const float rstd = 1.f / sqrtf(wave_sum(ss) * (1.f / DM) + EPS);
#pragma unroll
        for (int j = 0; j < 8; ++j) { const int c = 4 * F.lane + 256 * j; const f32x4 g = *(const f32x4*)(P->in[I_GFIN] + c); *(f32x4*)(P->out + (size_t)row * DM + c) = v[j] * rstd * g; }
    }
}
DI float ffn_input_row(KParams P, Frame& F, int l, int row, f32x4 (&v)[8]) {
    const bf16_t* X = WSP(bf16_t, WS_X); unsigned char* H8 = WSP(unsigned char, WS_H); const float* mod = WSP(float, WS_MOD);
    const int r = mod_row(row); float ss = 0.f;
#pragma unroll
    for (int j = 0; j < 8; ++j) { { const u32x2 w = *(const u32x2*)(X + (size_t)row * DM + 4 * F.lane + 256 * j); v[j] = (f32x4){bflo(w.x), bfhi(w.x), bflo(w.y), bfhi(w.y)}; } ss += (v[j][0] * v[j][0] + v[j][1] * v[j][1]) + (v[j][2] * v[j][2] + v[j][3] * v[j][3]); }
    const float rstd = 1.f / sqrtf(wave_sum(ss) * (1.f / DM) + EPS);
    const float* mp = mod + (size_t)(l * 5 + r) * (6 * DM); const float* gm = P->in[I_GFFN] + (size_t)l * DM; float am = 0.f;
#pragma unroll
    for (int j = 0; j < 8; ++j) { const int c = 4 * F.lane + 256 * j; const f32x4 g = *(const f32x4*)(gm + c), sh = *(const f32x4*)(mp + 3 * DM + c), sc = *(const f32x4*)(mp + 4 * DM + c);
        v[j] = (v[j] * rstd * g) * (sc + 1.f) + sh; am = fmaxf(fmaxf(am, fmaxf(fabsf(v[j][0]), fabsf(v[j][1]))), fmaxf(fabsf(v[j][2]), fabsf(v[j][3]))); }
#pragma unroll
    for (int o = 1; o < 64; o <<= 1) am = fmaxf(am, __shfl_xor(am, o));
    const float qs = am > 0.f ? 127.f / am : 0.f;
#pragma unroll
    for (int j = 0; j < 8; ++j) { const int c = 4 * F.lane + 256 * j;
        *(unsigned*)(H8 + (size_t)row * DM + c) = q8(v[j][0] * qs) | (q8(v[j][1] * qs) << 8) | (q8(v[j][2] * qs) << 16) | (q8(v[j][3] * qs) << 24); }
    return am * (1.f / 127.f);
}
DI void route_decide(const float (&lg)[16], const float (&br)[16], int& e1, int& e2, float& wa, float& wb) {
    float aff[16], sel[16];
#pragma unroll
    for (int e = 0; e < 16; ++e) { aff[e] = __builtin_amdgcn_rcpf(1.f + expf(-lg[e])); sel[e] = aff[e] + br[e]; }
    int best = 0; float bestv = -INFINITY;
#pragma unroll
    for (int g = 0; g < 4; ++g) { const float a = sel[4 * g], b = sel[4 * g + 1], c = sel[4 * g + 2], d = sel[4 * g + 3];
        const float hi1 = fmaxf(a, b), lo1 = fminf(a, b), hi2 = fmaxf(c, d), lo2 = fminf(c, d);
        const float gs = fmaxf(hi1, hi2) + fmaxf(fminf(hi1, hi2), fmaxf(lo1, lo2));
        if (gs > bestv) { bestv = gs; best = g; } }
    float s4[4] = {0.f, 0.f, 0.f, 0.f}, a4[4] = {0.f, 0.f, 0.f, 0.f};
#pragma unroll
    for (int g = 0; g < 4; ++g)
#pragma unroll
        for (int j = 0; j < 4; ++j) { s4[j] = (best == g) ? sel[4 * g + j] : s4[j]; a4[j] = (best == g) ? aff[4 * g + j] : a4[j]; }
    int i1 = 0; float m1 = s4[0];
#pragma unroll
    for (int j = 1; j < 4; ++j) if (s4[j] > m1) { m1 = s4[j]; i1 = j; }
    int i2 = -1; float m2 = -INFINITY;
#pragma unroll
    for (int j = 0; j < 4; ++j) if (j != i1 && s4[j] > m2) { m2 = s4[j]; i2 = j; }
    float w1 = 0.f, w2 = 0.f;
#pragma unroll
    for (int j = 0; j < 4; ++j) { w1 = (j == i1) ? a4[j] : w1; w2 = (j == i2) ? a4[j] : w2; }
    const float inv = 1.f / (w1 + w2);
    e1 = 4 * best + i1; e2 = 4 * best + i2; wa = w1 * inv; wb = w2 * inv;
}
DI void phase_norm2_route(KParams P, Frame& F, int l, int cbank) {
    int* rt_e = (int*)(P->ws + WS_ROUTE); int* rt_slot = (int*)(P->ws + WS_ROUTE + 2 * 73728);
    int* etok = (int*)(P->ws + WS_ETOK); float* ers = (float*)(P->ws + WS_ERS); float* erw = (float*)(P->ws + WS_ERW);
    unsigned* cnt = ctl_words(P) + CW_CNT + cbank * 16 * 64;
    LAS float* wrT = (LAS float*)F.lds;
    for (int k = F.tid; k < DM; k += 512) { const f32x4* wp = (const f32x4*)(P->in[I_WROUT] + (size_t)k * 16);
#pragma unroll
        for (int q = 0; q < 4; ++q) { const f32x4 w = wp[q]; wrT[(4 * q + 0) * DM + k] = w[0]; wrT[(4 * q + 1) * DM + k] = w[1]; wrT[(4 * q + 2) * DM + k] = w[2]; wrT[(4 * q + 3) * DM + k] = w[3]; } }
    float br[16];
#pragma unroll
    for (int e = 0; e < 16; ++e) br[e] = P->in[I_BROUT][e];
    const int nrows = (l == DEPTH - 1) ? TLAT : TT;
    const int rpb = (nrows + F.G - 1) / F.G, row0 = F.bid * rpb, row1 = (row0 + rpb < nrows) ? row0 + rpb : nrows;
    LAS int* lcnt = (LAS int*)(F.lds + LDSX_OFF + 512); LAS int* lbase = lcnt + 16; LAS int* lre = lcnt + 32; LAS int* lri = lcnt + 112; LAS float* lrw = (LAS float*)(lcnt + 192); LAS float* lrs = (LAS float*)(lcnt + 272);
    if (F.tid < 16) lcnt[F.tid] = 0;
    __syncthreads();
#pragma unroll 1
    for (int lr = 2 * F.wave; row0 + lr < row1; lr += 16) {
        const bool hasB = row0 + lr + 1 < row1; const int rowA = row0 + lr, rowB = hasB ? rowA + 1 : rowA;
        f32x4 va[8], vb[8]; const float sA = ffn_input_row(P, F, l, rowA, va), sB = ffn_input_row(P, F, l, rowB, vb);
        f32x2_t lab[16];
#pragma unroll
        for (int e = 0; e < 16; ++e) lab[e] = (f32x2_t){0.f, 0.f};
#pragma unroll
        for (int j = 0; j < 8; ++j) {
            const f32x2_t x0 = (f32x2_t){va[j][0], vb[j][0]}, x1 = (f32x2_t){va[j][1], vb[j][1]}, x2 = (f32x2_t){va[j][2], vb[j][2]}, x3 = (f32x2_t){va[j][3], vb[j][3]};
#pragma unroll
            for (int e = 0; e < 16; ++e) { const f32x4 w = *(const LAS f32x4*)(wrT + e * DM + 4 * F.lane + 256 * j);
                lab[e] = __builtin_elementwise_fma(x3, (f32x2_t){w[3], w[3]}, __builtin_elementwise_fma(x2, (f32x2_t){w[2], w[2]}, __builtin_elementwise_fma(x1, (f32x2_t){w[1], w[1]}, __builtin_elementwise_fma(x0, (f32x2_t){w[0], w[0]}, lab[e])))); }
            asm volatile("" ::: "memory"); }
        float la[16], lb[16];
#pragma unroll
        for (int e = 0; e < 16; ++e) { la[e] = wave_sum(lab[e][0]); lb[e] = wave_sum(lab[e][1]); }
        int e1, e2, f1, f2; float wa, wb, xa, xb; route_decide(la, br, e1, e2, wa, wb); route_decide(lb, br, f1, f2, xa, xb);
        if (F.lane == 0) {
            const int j1 = __hip_atomic_fetch_add(lcnt + e1, 1, __ATOMIC_RELAXED, __HIP_MEMORY_SCOPE_WORKGROUP), j2 = __hip_atomic_fetch_add(lcnt + e2, 1, __ATOMIC_RELAXED, __HIP_MEMORY_SCOPE_WORKGROUP);
            lre[2 * lr] = e1; lre[2 * lr + 1] = e2; lri[2 * lr] = j1; lri[2 * lr + 1] = j2;
            rt_e[2 * rowA] = e1; rt_e[2 * rowA + 1] = e2; lrw[2 * lr] = wa; lrw[2 * lr + 1] = wb; lrs[lr] = sA;
            if (hasB) { const int k1 = __hip_atomic_fetch_add(lcnt + f1, 1, __ATOMIC_RELAXED, __HIP_MEMORY_SCOPE_WORKGROUP), k2 = __hip_atomic_fetch_add(lcnt + f2, 1, __ATOMIC_RELAXED, __HIP_MEMORY_SCOPE_WORKGROUP);
                lre[2 * lr + 2] = f1; lre[2 * lr + 3] = f2; lri[2 * lr + 2] = k1; lri[2 * lr + 3] = k2;
                rt_e[2 * rowB] = f1; rt_e[2 * rowB + 1] = f2; lrw[2 * lr + 2] = xa; lrw[2 * lr + 3] = xb; lrs[lr + 1] = sB; } }
    }
    __syncthreads();
    if (F.tid < 16) lbase[F.tid] = (int)atomicAdd(cnt + F.tid * 64, (unsigned)lcnt[F.tid]);
    __syncthreads();
    if (F.tid < 2 * (row1 - row0)) { const int e = lre[F.tid], sl = lbase[e] + lri[F.tid]; rt_slot[2 * row0 + F.tid] = sl;
        etok[e * TT + sl] = row0 + (F.tid >> 1); ers[e * TT + sl] = lrs[F.tid >> 1]; erw[e * TT + sl] = lrw[F.tid]; }
    __syncthreads();
}
DI float rope_freq(int i) { return __expf(-1.1512925465f * (float)i); }
DI void mla_prep_rows(KParams P, Frame& F, int l) {
    const bf16_t* U = WSP(bf16_t, WS_U); bf16_t* cqn = WSP(bf16_t, WS_CQN); bf16_t* ckvn = WSP(bf16_t, WS_CKVN); bf16_t* krp = WSP(bf16_t, WS_KRP);
    for (int row = F.gw; row < TT; row += F.NGW) {
        const bf16_t* up = U + (size_t)row * PWP;
        { const u32x4 a = *(const u32x4*)(up + O_CQ + 8 * F.lane); float f[8] = {bflo(a.x), bfhi(a.x), bflo(a.y), bfhi(a.y), bflo(a.z), bfhi(a.z), bflo(a.w), bfhi(a.w)};
          float ss = 0.f;
#pragma unroll
          for (int i = 0; i < 8; ++i) ss += f[i] * f[i];
          const float rstd = 1.f / sqrtf(wave_sum(ss) * (1.f / 512.f) + EPS); const float* g = P->in[I_GQ] + l * 512 + 8 * F.lane;
          u32x4 o; o.x = pk2(f[0] * rstd * g[0], f[1] * rstd * g[1]); o.y = pk2(f[2] * rstd * g[2], f[3] * rstd * g[3]); o.z = pk2(f[4] * rstd * g[4], f[5] * rstd * g[5]); o.w = pk2(f[6] * rstd * g[6], f[7] * rstd * g[7]);
          *(u32x4*)(cqn + (size_t)row * 512 + 8 * F.lane) = o; }
        { const u32x2 a = *(const u32x2*)(up + O_CKV + 4 * F.lane); float f[4] = {bflo(a.x), bfhi(a.x), bflo(a.y), bfhi(a.y)};
          const float ss = (f[0] * f[0] + f[1] * f[1]) + (f[2] * f[2] + f[3] * f[3]);
          const float rstd = 1.f / sqrtf(wave_sum(ss) * (1.f / 256.f) + EPS); const float* g = P->in[I_GKV] + l * 256 + 4 * F.lane;
          u32x2 o; o.x = pk2(f[0] * rstd * g[0], f[1] * rstd * g[1]); o.y = pk2(f[2] * rstd * g[2], f[3] * rstd * g[3]);
          *(u32x2*)(ckvn + (size_t)row * 256 + 4 * F.lane) = o; }
        { const int e = F.lane; float val = 0.f;
          if (row < TLAT) { if (e < 32) { const int pos = row & (SEQ - 1), part = e >> 4, idx = e & 15, i = idx & 7, second = idx >> 3;
                  const float t1 = bf2f(up[O_KR + 16 * part + i]), t2 = bf2f(up[O_KR + 16 * part + 8 + i]);
                  const float ang = (float)(part ? (pos & 63) : (pos >> 6)) * rope_freq(i); const float sn = __sinf(ang), cs = __cosf(ang);
                  val = second ? (t1 * sn + t2 * cs) : (t1 * cs - t2 * sn); } }
          else { if (e >= 32) val = bf2f(up[O_KR + e - 32]); }
          krp[(size_t)row * 64 + e] = f2bf(val); }
    }
}
DI void cf_sc_tile(KParams P, Frame& F, int l, int ti) {
    const bf16_t* U = WSP(bf16_t, WS_U); bf16_t* acts = WSP(bf16_t, WS_ACTS);
    const int row0 = ti * 32; int seg_lo, seg_hi;
    if (row0 < TLAT) { seg_lo = row0 & ~(SEQ - 1); seg_hi = seg_lo + SEQ; } else { seg_lo = TLAT + ((row0 - TLAT) & ~(CTXL - 1)); seg_hi = seg_lo + CTXL; }
    LAS bf16_t* gl = (LAS bf16_t*)F.lds;
    LAS float* co = (LAS float*)(F.lds + 63488);
    const int c2 = F.tid & 255, th = F.tid >> 8;
    { const bf16_t* ub = U + O_SC + 2 * c2; const float* wp = P->in[I_WSCC] + (size_t)l * 3 * 512 + 2 * c2;
      const float w0a = wp[0], w0b = wp[1], w1a = wp[512], w1b = wp[513], w2a = wp[1024], w2b = wp[1025];
      unsigned pc[18], ph[18], gb[16];
#pragma unroll
      for (int k = 0; k < 18; ++k) { const int rr = row0 + 16 * th - 1 + k; const bool ok = rr >= seg_lo && rr < seg_hi;
          pc[k] = ok ? *(const unsigned*)(ub + (size_t)rr * PWP + 512) : 0u; ph[k] = ok ? *(const unsigned*)(ub + (size_t)rr * PWP + 1024) : 0u; }
#pragma unroll
      for (int k = 0; k < 16; ++k) gb[k] = *(const unsigned*)(ub + (size_t)(row0 + 16 * th + k) * PWP);
      float pa[18], pb[18];
#pragma unroll
      for (int k = 0; k < 18; ++k) { pa[k] = bflo(pc[k]) * bflo(ph[k]); pb[k] = bfhi(pc[k]) * bfhi(ph[k]); }
#pragma unroll
      for (int k = 0; k < 16; ++k) *(unsigned*)(acts + ((size_t)3 * TT + row0 + 16 * th + k) * 512 + 2 * c2) =
          pk2(bflo(gb[k]) * (w0a * pa[k] + w1a * pa[k + 1] + w2a * pa[k + 2]), bfhi(gb[k]) * (w0b * pb[k] + w1b * pb[k + 1] + w2b * pb[k + 2])); }
    { const int cg = F.tid & 63, ri = F.tid >> 6; u32x4 ga[8], gbv[8];
#pragma unroll
      for (int pass = 0; pass < 8; ++pass) { const int i = pass * 8 + ri, rr = row0 - 15 + i; const bool ok = i < 62 && rr >= seg_lo && rr < seg_hi;
          const bf16_t* up = U + (size_t)(ok ? rr : row0) * PWP + O_CF + 8 * cg; ga[pass] = *(const u32x4*)up; gbv[pass] = *(const u32x4*)(up + 512); }
#pragma unroll
      for (int pass = 0; pass < 8; ++pass) { const int i = pass * 8 + ri, rr = row0 - 15 + i; const bool ok = rr >= seg_lo && rr < seg_hi;
          if (i < 62) { const u32x4 a = ga[pass], b = gbv[pass]; u32x4 o;
              o.x = pk2(bflo(a.x) * sigm(bflo(b.x)), bfhi(a.x) * sigm(bfhi(b.x))); o.y = pk2(bflo(a.y) * sigm(bflo(b.y)), bfhi(a.y) * sigm(bfhi(b.y)));
              o.z = pk2(bflo(a.z) * sigm(bflo(b.z)), bfhi(a.z) * sigm(bfhi(b.z))); o.w = pk2(bflo(a.w) * sigm(bflo(b.w)), bfhi(a.w) * sigm(bfhi(b.w)));
              if (!ok) o = (u32x4){0u, 0u, 0u, 0u};
              *(LAS u32x4*)(gl + i * 512 + 8 * cg) = o; } } }
    asm volatile("" ::: "memory");
    float wva[31], wvb[31];
#pragma unroll
    for (int j = 0; j < 31; ++j) { const f32x2_t w = *(const f32x2_t*)(P->in[I_WCFDW] + (size_t)(l * 31 + j) * 512 + 2 * c2); wva[j] = w[0]; wvb[j] = w[1]; }
    const f32x2_t bias = *(const f32x2_t*)(P->in[I_BCFDW] + l * 512 + 2 * c2);
    __syncthreads();
#pragma unroll 1
    for (int hb = 0; hb < 2; ++hb) { const LAS unsigned* gp = (const LAS unsigned*)(gl + (16 * th + 8 * hb) * 512 + 2 * c2); f32x2_t xin[38];
#pragma unroll
      for (int i = 0; i < 38; ++i) { const unsigned x = gp[i * 256]; xin[i] = (f32x2_t){bflo(x), bfhi(x)}; }
#pragma unroll
      for (int t = 0; t < 8; ++t) { f32x2_t a = bias;
#pragma unroll
          for (int j = 0; j < 31; ++j) a = __builtin_elementwise_fma((f32x2_t){wva[j], wvb[j]}, xin[t + j], a);
          *(LAS f32x2_t*)(co + (16 * th + 8 * hb + t) * 512 + 2 * c2) = a; } }
    __syncthreads();
#pragma unroll 1
    for (int tt = 0; tt < 4; ++tt) { const int t = F.wave * 4 + tt; const LAS float* cr = co + t * 512 + 8 * F.lane;
        const f32x4 a = *(const LAS f32x4*)cr, b = *(const LAS f32x4*)(cr + 4);
        float x[8] = {a[0], a[1], a[2], a[3], b[0], b[1], b[2], b[3]}; float s = 0.f;
#pragma unroll
        for (int i = 0; i < 8; ++i) s += x[i];
        const float mean = wave_sum(s) * (1.f / 512.f); float q = 0.f;
#pragma unroll
        for (int i = 0; i < 8; ++i) { x[i] -= mean; q += x[i] * x[i]; }
        const float rstd = 1.f / sqrtf(wave_sum(q) * (1.f / 512.f) + EPS);
        const float* g = P->in[I_GCFLN] + l * 512 + 8 * F.lane; const float* bb = P->in[I_BCFLN] + l * 512 + 8 * F.lane; float y[8];
#pragma unroll
        for (int i = 0; i < 8; ++i) y[i] = siluf(x[i] * rstd * g[i] + bb[i]);
        u32x4 o; o.x = pk2(y[0], y[1]); o.y = pk2(y[2], y[3]); o.z = pk2(y[4], y[5]); o.w = pk2(y[6], y[7]);
        *(u32x4*)(acts + ((size_t)1 * TT + row0 + t) * 512 + 8 * F.lane) = o; }
    __syncthreads();
}

constexpr int GPD = 72;
constexpr int GL_LOW = 0, GL_GSUM = 8192, GL_VT = 10240, GL_A0 = 28672, GL_KD = 37888, GL_QI = 47104, GL_ST = 56320, GL_PP = 74752, GL_OB = 83968;
DI void gla_chunk_decode(int ci, int& b, int& row0, int& jf, int& jb) {
    if (ci < 128) { b = ci >> 5; const int c = ci & 31; row0 = b * SEQ + c * 64; jf = 4 + c; jb = 4 + (31 - c); }
    else { const int cc = ci - 128; b = cc >> 2; const int c = cc & 3; row0 = TLAT + b * CTXL + c * 64; jf = c; jb = 3 - c; }
}
DI int gla_cidx(int b, int hh, int dir, int j) { return ((b * 4 + hh) * 2 + dir) * NCHAIN + j; }
DI void lds_mma_nt(f32x16& acc, const LAS bf16_t* A, int a_row0, const LAS bf16_t* B, int b_row0, int r, int h) {
#pragma unroll
    for (int k0 = 0; k0 < 64; k0 += 16) {
        const bf16x8 a = *(const LAS bf16x8*)(A + (a_row0 + r) * GPD + k0 + 8 * h);
        const bf16x8 b = *(const LAS bf16x8*)(B + (b_row0 + r) * GPD + k0 + 8 * h);
        acc = __builtin_amdgcn_mfma_f32_32x32x16_bf16(a, b, acc, 0, 0, 0);
    }
}
DI float logsig(float z) { return fminf(z, 0.f) - __logf(1.f + __expf(-fabsf(z))); }
DI void gla_decay(Frame& F, int dir, const float (&w2v)[16], float b2, float (&cs)[8], float& off, float& total, float& mid) {
    const LAS float* low = (const LAS float*)(F.lds + GL_LOW); LAS float* gsum = (LAS float*)(F.lds + GL_GSUM);
    const int d = F.tid & 63, tg = F.tid >> 6;
    float la[8];
#pragma unroll
    for (int i = 0; i < 8; ++i) { const LAS float* lp = low + (tg * 8 + i) * 32 + dir * 16; float z = b2;
#pragma unroll
        for (int j = 0; j < 16; ++j) z += lp[j] * w2v[j];
        la[i] = logsig(z) * (1.f / 16.f); }
    if (dir == 0) { cs[0] = la[0];
#pragma unroll
        for (int i = 1; i < 8; ++i) cs[i] = cs[i - 1] + la[i];
        gsum[tg * 64 + d] = cs[7]; }
    else { cs[7] = la[7];
#pragma unroll
        for (int i = 6; i >= 0; --i) cs[i] = cs[i + 1] + la[i];
        gsum[tg * 64 + d] = cs[0]; }
    __syncthreads();
    float g[8];
#pragma unroll
    for (int q = 0; q < 8; ++q) g[q] = gsum[q * 64 + d];
    total = 0.f; off = 0.f; mid = 0.f;
#pragma unroll
    for (int q = 0; q < 8; ++q) { total += g[q]; if (dir == 0) { off += (q < tg) ? g[q] : 0.f; mid += (q <= 3) ? g[q] : 0.f; } else { off += (q > tg) ? g[q] : 0.f; mid += (q >= 4) ? g[q] : 0.f; } }
}
#define GLA_PRELOAD() \
    const int d = F.tid & 63, tg = F.tid >> 6, dcol = hh * 64 + d; \
    const u32x2 loww = *(const u32x2*)(U + (size_t)(row0 + (F.tid >> 3)) * PWP + O_GF + (F.tid & 7) * 4); \
    const u32x4 vva = *(const u32x4*)(U + (size_t)(row0 + (F.tid >> 3)) * PWP + O_GV + hh * 128 + (F.tid & 7) * 16), vvb = *(const u32x4*)(U + (size_t)(row0 + (F.tid >> 3)) * PWP + O_GV + hh * 128 + (F.tid & 7) * 16 + 8); \
    float w2f[16], w2b[16]; \
    _Pragma("unroll") for (int j = 0; j < 16; ++j) { w2f[j] = P->in[I_WGF][(size_t)l * 16 * 256 + j * 256 + dcol]; w2b[j] = P->in[I_WGB][(size_t)l * 16 * 256 + j * 256 + dcol]; } \
    const float b2f = P->in[I_BGF][l * 256 + dcol], b2b = P->in[I_BGB][l * 256 + dcol]; \
    float kraw[8]; \
    _Pragma("unroll") for (int i = 0; i < 8; ++i) kraw[i] = bf2f(U[(size_t)(row0 + tg * 8 + i) * PWP + O_GK + hh * 64 + d]);
#define GLA_STAGE_LOW_VT() do { LAS float* low_ = (LAS float*)(F.lds + GL_LOW); const int t_ = F.tid >> 3, j4_ = (F.tid & 7) * 4, v16_ = (F.tid & 7) * 16; \
    low_[t_ * 32 + j4_] = bflo(loww.x); low_[t_ * 32 + j4_ + 1] = bfhi(loww.x); low_[t_ * 32 + j4_ + 2] = bflo(loww.y); low_[t_ * 32 + j4_ + 3] = bfhi(loww.y); \
    const unsigned w_[8] = {vva.x, vva.y, vva.z, vva.w, vvb.x, vvb.y, vvb.z, vvb.w}; \
    _Pragma("unroll") for (int i = 0; i < 8; ++i) { VT[(v16_ + 2 * i) * GPD + t_] = (bf16_t)(w_[i] & 0xffffu); VT[(v16_ + 2 * i + 1) * GPD + t_] = (bf16_t)(w_[i] >> 16); } } while (0)
DI void gla_a_item(KParams P, Frame& F, int l, int ci, int hh) {
    const bf16_t* U = WSP(bf16_t, WS_U); bf16_t* Sloc = WSP(bf16_t, WS_SLOC); float* dec = WSP(float, WS_DEC);
    int b, row0, jf, jb; gla_chunk_decode(ci, b, row0, jf, jb);
    LAS bf16_t* VT = (LAS bf16_t*)(F.lds + GL_VT); LAS bf16_t* KET = (LAS bf16_t*)(F.lds + GL_A0);
    const int r = F.lane & 31, h = F.lane >> 5, mb = F.wave & 1, nb = F.wave >> 1;
    GLA_PRELOAD();
    GLA_STAGE_LOW_VT();
    __syncthreads();
#pragma unroll
    for (int dir = 0; dir < 2; ++dir) {
        float cs[8], off, total, mid; gla_decay(F, dir, dir ? w2b : w2f, dir ? b2b : b2f, cs, off, total, mid);
        const int cidx = gla_cidx(b, hh, dir, dir ? jb : jf);
#pragma unroll
        for (int i = 0; i < 8; ++i) KET[d * GPD + tg * 8 + i] = f2bf(kraw[i] * __expf(total - (off + cs[i])));
        if (tg == 0) dec[(size_t)cidx * 64 + d] = __expf(total);
        __syncthreads();
        f32x16 acc;
#pragma unroll
        for (int i = 0; i < 16; ++i) acc[i] = 0.f;
        lds_mma_nt(acc, KET, 32 * mb, VT, 32 * nb, r, h);
        bf16_t* sp = Sloc + ((size_t)cidx * 128 + 32 * nb + r) * 64 + 32 * mb + 4 * h;
#pragma unroll
        for (int g = 0; g < 4; ++g) *(u32x2*)(sp + 8 * g) = (u32x2){pk2(acc[4 * g], acc[4 * g + 1]), pk2(acc[4 * g + 2], acc[4 * g + 3])};
        __syncthreads();
    }
}
DI void gla_scan(KParams P, Frame& F) {
    const bf16_t* Sloc = WSP(bf16_t, WS_SLOC); const float* dec = WSP(float, WS_DEC); bf16_t* Sin = WSP(bf16_t, WS_SIN);
    for (int e = F.bid * 512 + F.tid; e < 32 * 4096; e += F.G * 512) { const int chain = e >> 12, vd = (e & 4095) * 2, d = vd & 63; float S0 = 0.f, S1 = 0.f;
#pragma unroll 1
        for (int j0 = 0; j0 < NCHAIN; j0 += 12) { f32x2_t sl[12], dc[12];
#pragma unroll
            for (int j = 0; j < 12; ++j) { const size_t idx = (size_t)chain * NCHAIN + j0 + j; { const unsigned w = *(const unsigned*)(Sloc + idx * 8192 + vd); sl[j] = (f32x2_t){bflo(w), bfhi(w)}; } dc[j] = *(const f32x2_t*)(dec + idx * 64 + d); }
#pragma unroll
            for (int j = 0; j < 12; ++j) { const size_t idx = (size_t)chain * NCHAIN + j0 + j; *(unsigned*)(Sin + idx * 8192 + vd) = pk2(S0, S1); S0 = dc[j][0] * S0 + sl[j][0]; S1 = dc[j][1] * S1 + sl[j][1]; } } }
}
DI void gla_b_item(KParams P, Frame& F, int l, int ci, int hh) {
    const bf16_t* U = WSP(bf16_t, WS_U); const bf16_t* Sin = WSP(bf16_t, WS_SIN); bf16_t* acts = WSP(bf16_t, WS_ACTS);
    int b, row0, jf, jb; gla_chunk_decode(ci, b, row0, jf, jb);
    LAS bf16_t* VT = (LAS bf16_t*)(F.lds + GL_VT); LAS bf16_t* QD = (LAS bf16_t*)(F.lds + GL_A0); LAS bf16_t* KD = (LAS bf16_t*)(F.lds + GL_KD); LAS bf16_t* QI = (LAS bf16_t*)(F.lds + GL_QI);
    LAS bf16_t* ST = (LAS bf16_t*)(F.lds + GL_ST); LAS bf16_t* PP = (LAS bf16_t*)(F.lds + GL_PP); LAS float* OB = (LAS float*)(F.lds + GL_OB);
    const int r = F.lane & 31, h = F.lane >> 5, tb = F.wave & 1, vb = F.wave >> 1;
    GLA_PRELOAD();
    float qraw[8];
#pragma unroll
    for (int i = 0; i < 8; ++i) qraw[i] = bf2f(U[(size_t)(row0 + tg * 8 + i) * PWP + O_GQ + hh * 64 + d]) * 0.125f;
    const int sv = F.tid >> 2, sd16 = (F.tid & 3) * 16;
    const bf16_t* spf = Sin + ((size_t)gla_cidx(b, hh, 0, jf) * 128 + sv) * 64 + sd16; const bf16_t* spb = Sin + ((size_t)gla_cidx(b, hh, 1, jb) * 128 + sv) * 64 + sd16;
    const u32x4 sf0 = *(const u32x4*)spf, sf1 = *(const u32x4*)(spf + 8), sb0 = *(const u32x4*)spb, sb1 = *(const u32x4*)(spb + 8);
    const int ot = F.tid >> 3, ov0 = (F.tid & 7) * 16;
    const bf16_t* rp = U + (size_t)(row0 + ot) * PWP + O_GR + hh * 128 + ov0; const u32x4 r0 = *(const u32x4*)rp, r1 = *(const u32x4*)(rp + 8);
    GLA_STAGE_LOW_VT();
    __syncthreads();
    f32x16 acc;
#pragma unroll
    for (int i = 0; i < 16; ++i) acc[i] = 0.f;
#pragma unroll
    for (int dir = 0; dir < 2; ++dir) {
        float cs[8], off, total, mid; gla_decay(F, dir, dir ? w2b : w2f, dir ? b2b : b2f, cs, off, total, mid);
#pragma unroll
        for (int i = 0; i < 8; ++i) { const int t = tg * 8 + i; const float bc = off + cs[i];
            QD[t * GPD + d] = f2bf(qraw[i] * __expf(bc - mid)); KD[t * GPD + d] = f2bf(kraw[i] * __expf(mid - bc)); QI[t * GPD + d] = f2bf(qraw[i] * __expf(bc)); }
        *(LAS u32x4*)(ST + sv * GPD + sd16) = dir ? sb0 : sf0; *(LAS u32x4*)(ST + sv * GPD + sd16 + 8) = dir ? sb1 : sf1;
        __syncthreads();
        if (F.wave < 4) { const int tb2 = F.wave & 1, sb = F.wave >> 1; f32x16 a;
#pragma unroll
            for (int i = 0; i < 16; ++i) a[i] = 0.f;
            lds_mma_nt(a, QD, 32 * tb2, KD, 32 * sb, r, h);
#pragma unroll
            for (int i = 0; i < 16; ++i) { const int t = 32 * tb2 + (i & 3) + 8 * (i >> 2) + 4 * h, s2 = 32 * sb + r; const bool keep = dir ? (s2 >= t) : (s2 <= t);
                PP[t * GPD + s2] = f2bf(keep ? a[i] : 0.f); } }
        __syncthreads();
        lds_mma_nt(acc, PP, 32 * tb, VT, 32 * vb, r, h);
        lds_mma_nt(acc, QI, 32 * tb, ST, 32 * vb, r, h);
        __syncthreads();
    }
#pragma unroll
    for (int i = 0; i < 16; ++i) OB[(32 * tb + (i & 3) + 8 * (i >> 2) + 4 * h) * 128 + 32 * vb + r] = acc[i];
    __syncthreads();
    { float x[16]; float ss = 0.f;
#pragma unroll
      for (int q = 0; q < 4; ++q) { const f32x4 o = *(const LAS f32x4*)(OB + ot * 128 + ov0 + 4 * q); x[4 * q] = o[0]; x[4 * q + 1] = o[1]; x[4 * q + 2] = o[2]; x[4 * q + 3] = o[3]; }
#pragma unroll
      for (int i = 0; i < 16; ++i) ss += x[i] * x[i];
      ss += __shfl_xor(ss, 1); ss += __shfl_xor(ss, 2); ss += __shfl_xor(ss, 4);
      const float rstd = 1.f / sqrtf(ss * (1.f / 128.f) + EPS);
      const unsigned rw[8] = {r0.x, r0.y, r0.z, r0.w, r1.x, r1.y, r1.z, r1.w}; const float* gn = P->in[I_GGLAN] + l * 128 + ov0; unsigned ow[8];
#pragma unroll
      for (int i = 0; i < 8; ++i) ow[i] = pk2(x[2 * i] * rstd * gn[2 * i] * siluf(bflo(rw[i])), x[2 * i + 1] * rstd * gn[2 * i + 1] * siluf(bfhi(rw[i])));
      bf16_t* op = acts + ((size_t)2 * TT + row0 + ot) * 512 + hh * 128 + ov0;
      *(u32x4*)op = (u32x4){ow[0], ow[1], ow[2], ow[3]}; *(u32x4*)(op + 8) = (u32x4){ow[4], ow[5], ow[6], ow[7]}; }
    __syncthreads();
}
DI float at_max2(float a, float b) { return __builtin_amdgcn_fmed3f(a, b, INFINITY); }
constexpr int AT_KC = 1040, AT_VG = 520;
constexpr int AT_K0 = 0, AT_K1 = 16 * AT_KC, AT_V0 = 32 * AT_KC, AT_V1 = 32 * AT_KC + 16 * AT_VG;
DI void attn_unit(KParams P, Frame& F, int b, int hh, int qrow0, int nlat) {
    const bf16_t* Q = WSP(bf16_t, WS_Q); const bf16_t* KN = WSP(bf16_t, WS_KN); const bf16_t* KRP = WSP(bf16_t, WS_KRP); const bf16_t* VT = WSP(bf16_t, WS_VT); bf16_t* acts = WSP(bf16_t, WS_ACTS);
    const int ntile = nlat + 4; const int r = F.lane & 31, h = F.lane >> 5;
    const int kvi = F.tid >> 3, kc = F.tid & 7;
    const float C = 0.10206207261596577f * 1.4426950408889634f;
    const int qrow = qrow0 + 32 * F.wave + r; const bf16_t* qp = Q + (size_t)qrow * 768 + hh * 96;
    bf16x8 qf[8];
#pragma unroll
    for (int s = 0; s < 4; ++s) { const u32x4 a = *(const u32x4*)(qp + 16 * s + 8 * h);
        u32x4 o; o.x = pk2(C * bflo(a.x), C * bfhi(a.x)); o.y = pk2(C * bflo(a.y), C * bfhi(a.y)); o.z = pk2(C * bflo(a.z), C * bfhi(a.z)); o.w = pk2(C * bflo(a.w), C * bfhi(a.w)); qf[s] = __builtin_bit_cast(bf16x8, o); }
    { const u32x4 a1 = *(const u32x4*)(qp + 64), a2 = *(const u32x4*)(qp + 72), c1 = *(const u32x4*)(qp + 80), c2 = *(const u32x4*)(qp + 88);
      const float ra1[8] = {bflo(a1.x), bfhi(a1.x), bflo(a1.y), bfhi(a1.y), bflo(a1.z), bfhi(a1.z), bflo(a1.w), bfhi(a1.w)}, ra2[8] = {bflo(a2.x), bfhi(a2.x), bflo(a2.y), bfhi(a2.y), bflo(a2.z), bfhi(a2.z), bflo(a2.w), bfhi(a2.w)};
      const float rc1[8] = {bflo(c1.x), bfhi(c1.x), bflo(c1.y), bfhi(c1.y), bflo(c1.z), bfhi(c1.z), bflo(c1.w), bfhi(c1.w)}, rc2[8] = {bflo(c2.x), bfhi(c2.x), bflo(c2.y), bfhi(c2.y), bflo(c2.z), bfhi(c2.z), bflo(c2.w), bfhi(c2.w)};
      float ur[8], uc[8], xr[8], xc[8];
      const int pos = qrow & (SEQ - 1); const float prow = (float)(pos >> 6), pcol = (float)(pos & 63);
#pragma unroll
      for (int i = 0; i < 8; ++i) { ur[i] = C * (h ? ra2[i] : ra1[i]); uc[i] = C * (h ? rc2[i] : rc1[i]);
          if (nlat > 0) { const float f = rope_freq(i); float sn = __sinf(prow * f), cs = __cosf(prow * f); xr[i] = C * (h ? (ra1[i] * sn + ra2[i] * cs) : (ra1[i] * cs - ra2[i] * sn));
              sn = __sinf(pcol * f); cs = __cosf(pcol * f); xc[i] = C * (h ? (rc1[i] * sn + rc2[i] * cs) : (rc1[i] * cs - rc2[i] * sn)); }
          else { xr[i] = 0.f; xc[i] = 0.f; } }
      u32x4 o;
      o.x = pk2(xr[0], xr[1]); o.y = pk2(xr[2], xr[3]); o.z = pk2(xr[4], xr[5]); o.w = pk2(xr[6], xr[7]); qf[4] = __builtin_bit_cast(bf16x8, o);
      o.x = pk2(xc[0], xc[1]); o.y = pk2(xc[2], xc[3]); o.z = pk2(xc[4], xc[5]); o.w = pk2(xc[6], xc[7]); qf[5] = __builtin_bit_cast(bf16x8, o);
      o.x = pk2(ur[0], ur[1]); o.y = pk2(ur[2], ur[3]); o.z = pk2(ur[4], ur[5]); o.w = pk2(ur[6], ur[7]); qf[6] = __builtin_bit_cast(bf16x8, o);
      o.x = pk2(uc[0], uc[1]); o.y = pk2(uc[2], uc[3]); o.z = pk2(uc[4], uc[5]); o.w = pk2(uc[6], uc[7]); qf[7] = __builtin_bit_cast(bf16x8, o); }
    u32x4 kA0, kA1, vA, kB0, kB1, vB;
#define AT_KROW(tl) (((tl) < nlat) ? (b * SEQ + (tl) * 64) : (TLAT + b * CTXL + ((tl) - nlat) * 64))
#define AT_LOADK(tl, R0, R1) do { const int krow0_ = AT_KROW(tl); R0 = *(const u32x4*)(KN + (size_t)(krow0_ + kvi) * 512 + hh * 64 + kc * 8); R1 = *(const u32x4*)(KRP + (size_t)(krow0_ + kvi) * 64 + kc * 8); } while (0)
#define AT_LOADV(tl, R) do { const int krow0_ = AT_KROW(tl); R = *(const u32x4*)(VT + (size_t)(hh * 64 + kvi) * TT + krow0_ + kc * 8); } while (0)
#define AT_STOREK(buf, R0, R1) do { LAS unsigned char* kb_ = F.lds + ((buf) ? AT_K1 : AT_K0); *(LAS u32x4*)(kb_ + kc * AT_KC + kvi * 16) = R0; *(LAS u32x4*)(kb_ + (8 + kc) * AT_KC + kvi * 16) = R1; } while (0)
#define AT_STOREV(buf, R) do { LAS unsigned char* vb_ = F.lds + ((buf) ? AT_V1 : AT_V0); *(LAS u32x2*)(vb_ + (kc & ~1) * AT_KC + kvi * 16 + (kc & 1) * 8) = (u32x2){R.x, R.y}; *(LAS u32x2*)(vb_ + ((kc & ~1) + 1) * AT_KC + kvi * 16 + (kc & 1) * 8) = (u32x2){R.z, R.w}; } while (0)
#define AT_QK(P0, P1, buf, LAT) do { const LAS unsigned char* kb_ = F.lds + ((buf) ? AT_K1 : AT_K0); \
        _Pragma("unroll") for (int i = 0; i < 16; ++i) { P0[i] = 0.f; P1[i] = 0.f; } \
        _Pragma("unroll") for (int s = 0; s < 8; ++s) if ((LAT) ? (s < 6) : (s < 4 || s >= 6)) { const bf16x8 ka0 = *(const LAS bf16x8*)(kb_ + (2 * s + h) * AT_KC + r * 16), ka1 = *(const LAS bf16x8*)(kb_ + (2 * s + h) * AT_KC + (32 + r) * 16); \
            P0 = __builtin_amdgcn_mfma_f32_32x32x16_bf16(ka0, qf[s], P0, 0, 0, 0); P1 = __builtin_amdgcn_mfma_f32_32x32x16_bf16(ka1, qf[s], P1, 0, 0, 0); } } while (0)
#define AT_COMPUTE(tl, LAT) do { const int cur = (tl) & 1; f32x16 pc0, pc1; \
        AT_QK(pc0, pc1, cur, LAT);                                                 \
        const LAS unsigned char* vb = F.lds + (cur ? AT_V1 : AT_V0); \
        float mxa = at_max2(pc0[0], pc0[1]), mxb = at_max2(pc1[0], pc1[1]); \
        _Pragma("unroll") for (int i = 2; i < 16; ++i) { mxa = at_max2(mxa, pc0[i]); mxb = at_max2(mxb, pc1[i]); } \
        float mx = at_max2(mxa, mxb); mx = at_max2(mx, __shfl_xor(mx, 32)); \
        const float mnew = at_max2(m_run, mx), alpha = __builtin_amdgcn_exp2f(m_run - mnew); m_run = mnew; \
        const f32x2_t nm2 = (f32x2_t){-mnew, -mnew}; f32x2_t ps2 = (f32x2_t){0.f, 0.f};                  \
        _Pragma("unroll") for (int i = 0; i < 8; ++i) { \
            f32x2_t ta = (f32x2_t){pc0[2 * i], pc0[2 * i + 1]} + nm2, tb = (f32x2_t){pc1[2 * i], pc1[2 * i + 1]} + nm2; \
            ta[0] = __builtin_amdgcn_exp2f(ta[0]); ta[1] = __builtin_amdgcn_exp2f(ta[1]); tb[0] = __builtin_amdgcn_exp2f(tb[0]); tb[1] = __builtin_amdgcn_exp2f(tb[1]); \
            ps2 = ps2 + (ta + tb); pc0[2 * i] = ta[0]; pc0[2 * i + 1] = ta[1]; pc1[2 * i] = tb[0]; pc1[2 * i + 1] = tb[1]; } \
        const float psum = ps2[0] + ps2[1]; \
        l_run = l_run * alpha + psum; \
        _Pragma("unroll") for (int i = 0; i < 16; ++i) { o0[i] *= alpha; o1[i] *= alpha; } \
        bf16x8 pf[4]; \
        { u32x4 w; \
          w.x = pk2(pc0[0], pc0[1]); w.y = pk2(pc0[2], pc0[3]); w.z = pk2(pc0[4], pc0[5]); w.w = pk2(pc0[6], pc0[7]); pf[0] = __builtin_bit_cast(bf16x8, w); \
          w.x = pk2(pc0[8], pc0[9]); w.y = pk2(pc0[10], pc0[11]); w.z = pk2(pc0[12], pc0[13]); w.w = pk2(pc0[14], pc0[15]); pf[1] = __builtin_bit_cast(bf16x8, w); \
          w.x = pk2(pc1[0], pc1[1]); w.y = pk2(pc1[2], pc1[3]); w.z = pk2(pc1[4], pc1[5]); w.w = pk2(pc1[6], pc1[7]); pf[2] = __builtin_bit_cast(bf16x8, w); \
          w.x = pk2(pc1[8], pc1[9]); w.y = pk2(pc1[10], pc1[11]); w.z = pk2(pc1[12], pc1[13]); w.w = pk2(pc1[14], pc1[15]); pf[3] = __builtin_bit_cast(bf16x8, w); } \
        _Pragma("unroll") for (int s = 0; s < 4; ++s) { \
            const u32x4 va0 = *(const LAS u32x4*)(vb + (2 * s + h) * AT_KC + r * 16), va1 = *(const LAS u32x4*)(vb + (2 * s + h) * AT_KC + (32 + r) * 16); \
            o0 = __builtin_amdgcn_mfma_f32_32x32x16_bf16(__builtin_bit_cast(bf16x8, va0), pf[s], o0, 0, 0, 0); \
            o1 = __builtin_amdgcn_mfma_f32_32x32x16_bf16(__builtin_bit_cast(bf16x8, va1), pf[s], o1, 0, 0, 0); } } while (0)
#define AT_ITER(tl, LAT, LK0, LK1, LV, SK0, SK1, SV) do { \
        if ((tl) + 2 < ntile) { AT_LOADK((tl) + 2, LK0, LK1); AT_LOADV((tl) + 2, LV); } \
        AT_COMPUTE(tl, LAT); \
        if ((tl) + 1 < ntile) { AT_STOREK(((tl) & 1) ^ 1, SK0, SK1); AT_STOREV(((tl) & 1) ^ 1, SV); } \
        __syncthreads(); } while (0)
    float m_run = -INFINITY, l_run = 0.f; f32x16 o0, o1;
#pragma unroll
    for (int i = 0; i < 16; ++i) { o0[i] = 0.f; o1[i] = 0.f; }
    AT_LOADK(0, kA0, kA1); AT_LOADV(0, vA); AT_LOADK(1, kB0, kB1); AT_LOADV(1, vB);
    AT_STOREK(0, kA0, kA1); AT_STOREV(0, vA);
    __syncthreads();
#pragma unroll 1
    for (int tl = 0; tl < nlat; tl += 2) {
        AT_ITER(tl, true, kA0, kA1, vA, kB0, kB1, vB);
        AT_ITER(tl + 1, true, kB0, kB1, vB, kA0, kA1, vA);
    }
#pragma unroll 1
    for (int tl = nlat; tl < ntile; tl += 2) {
        AT_ITER(tl, false, kA0, kA1, vA, kB0, kB1, vB);
        AT_ITER(tl + 1, false, kB0, kB1, vB, kA0, kA1, vA);
    }
#undef AT_COMPUTE
#undef AT_ITER
#undef AT_KROW
#undef AT_LOADK
#undef AT_LOADV
#undef AT_STOREK
#undef AT_STOREV
#undef AT_QK
    const float inv = 1.f / (l_run + __shfl_xor(l_run, 32));
    bf16_t* op = acts + (size_t)qrow * 512 + hh * 64 + 4 * h;
#pragma unroll
    for (int g = 0; g < 4; ++g) { u32x2 w; w.x = pk2(o0[4 * g] * inv, o0[4 * g + 1] * inv); w.y = pk2(o0[4 * g + 2] * inv, o0[4 * g + 3] * inv); *(u32x2*)(op + 8 * g) = w;
        w.x = pk2(o1[4 * g] * inv, o1[4 * g + 1] * inv); w.y = pk2(o1[4 * g + 2] * inv, o1[4 * g + 3] * inv); *(u32x2*)(op + 32 + 8 * g) = w; }
}

DI KParams load_params() { KParams kp = (KParams)__builtin_amdgcn_kernarg_segment_ptr(); asm volatile("" : "+s"(kp)); return kp; }
DI Frame phase_frame(const Frame& F0) { Frame F = F0; int t = F0.tid; asm volatile("" : "+v"(t)); { int b = F0.bid, g = F0.G; asm volatile("" : "+s"(b), "+s"(g)); F.bid = b; F.G = g; F.NGW = g * 8; } F.tid = t; F.lane = t & 63; F.wave = __builtin_amdgcn_readfirstlane(t >> 6); F.gw = F.bid * 8 + F.wave; return F; }
constexpr int PH_PER_LAYER = 10, NPHASE = 1 + DEPTH * PH_PER_LAYER + 1;
__global__ void __launch_bounds__(512, 2) hybrid_trunk_fwd(Params P) {
    extern __shared__ __attribute__((aligned(16))) unsigned char lds_raw[];
    Frame F; F.lds = (LAS unsigned char*)lds_raw; F.tid = threadIdx.x; F.lane = F.tid & 63; F.wave = __builtin_amdgcn_readfirstlane(F.tid >> 6);
    F.G = gridDim.x; F.bid = blockIdx.x; F.gw = F.bid * 8 + F.wave; F.NGW = F.G * 8;
    const int vcu = (F.G % 8 == 0) ? (F.bid % 8) * (F.G / 8) + F.bid / 8 : F.bid;
    for (int u = F.tid; u < (LDS_BYTES - LDSX_OFF) / 4; u += 512) ((LAS unsigned*)(F.lds + LDSX_OFF))[u] = 0u;
    __syncthreads();
    const int lo = P.ph_lo, hi = P.ph_hi;
    XcdBarrier bar; bar.bar = (unsigned*)(P.ws + WS_CTL) + CW_BAR; bar.x = 0; bar.st = (volatile LAS unsigned*)(F.lds + LDSX_OFF);
    if (hi - lo > 1) bar = xcd_barrier_post((unsigned*)(P.ws + WS_CTL) + CW_BAR, (volatile LAS unsigned*)(F.lds + LDSX_OFF));
#ifndef PH_MASK
#define PH_MASK 0xffff
#endif
#define PHM(b) ((PH_MASK >> (b)) & 1)
#ifndef DUP_MASK
#define DUP_MASK 0
#endif
#define REP(b) (1 + ((DUP_MASK >> (b)) & 1))
#define IN(k) (lo <= (k) && (k) < hi)
#ifndef DUP_BAR
#define DUP_BAR 0
#endif
#define SEAM(k) do { if (IN(k) && IN((k) + 1)) { xcd_barrier(bar); if (DUP_BAR) xcd_barrier(bar); } } while (0)
    if (PHM(0) && IN(0)) for (int rep_ = 0; rep_ < REP(0); ++rep_) { KParams Q = load_params(); Frame Fp = phase_frame(F); phase_prologue(Q, Fp);
        conv_mixed(Q, Fp, 0, 0, NS_ALL, 0, NL_ITEMS, Fp.bid, Fp.G); }
    SEAM(0);
    for (int l = 0; l < DEPTH; ++l) {
        const int pb = 1 + PH_PER_LAYER * l;
        if (PHM(1) && IN(pb + 0)) for (int rep_ = 0; rep_ < REP(1); ++rep_) { KParams Q = load_params(); Frame Fp = phase_frame(F); phase_norm1(Q, Fp, l, rep_ + 1 < REP(1)); }
        SEAM(pb + 0);
        if (PHM(2) && IN(pb + 1)) for (int rep_ = 0; rep_ < REP(2); ++rep_) { KParams Q = load_params(); Frame Fp = phase_frame(F);
            const bool lastl = (l == DEPTH - 1); const int nM1 = lastl ? TLAT / 256 : TT / 256;
            pg8::Gemm g8{(const bf16_t*)(Q->ws + WS_H8), (const bf16_t*)(Q->ws + WS_W8 + (size_t)l * PWP * DM), DM / 2, 0, 0};
            pg8::TrimOrder S8{nM1, PWP / 256, nM1 * (PWP / 256), lastl ? (TCTX / 256) * 6 : 0, Fp.G, Fp.bid};
            pg8::EpiStoreQ E8{(bf16_t*)(Q->ws + WS_U), PWP, (const float*)(Q->ws + WS_RA), (const float*)(Q->ws + WS_RB) + (size_t)l * PWP, Q->ws + WS_G8};
            pg8::gemm_phase_i8<pg8::EpiStoreQ, pg8::TrimOrder>(Fp.lds, g8, S8, E8); }
        SEAM(pb + 1);
        if (PHM(3) && IN(pb + 2)) for (int rep_ = 0; rep_ < REP(3); ++rep_) { KParams Q = load_params(); Frame Fp = phase_frame(F); bf16_t* U = (bf16_t*)(Q->ws + WS_U); (void)U; mla_prep_rows(Q, Fp, l);
            const int ncf = (l == DEPTH - 1) ? TLAT / 32 : TT / 32;
            for (int it = vcu; it < ncf; it += Fp.G) cf_sc_tile(Q, Fp, l, it);
            { const int extra = ncf > Fp.G ? ncf - Fp.G : 0;
              if (vcu >= extra) for (int it = vcu - extra; it < 144 * 4; it += Fp.G - extra) gla_a_item(Q, Fp, l, it >> 2, it & 3); } }
        SEAM(pb + 2);
        if (PHM(4) && IN(pb + 3)) for (int rep_ = 0; rep_ < REP(4); ++rep_) { KParams Q = load_params(); Frame Fp = phase_frame(F); bf16_t* U = (bf16_t*)(Q->ws + WS_U); (void)U;
            const int nq = ((l == DEPTH - 1) ? TLAT / 256 : TT / 256) * 3;
            { pg8::Gemm g{WSQ(bf16_t, WS_CQN), WSQ(bf16_t, WS_WUQ) + (size_t)l * 768 * 512, 512, 0, 0}; pg8::RangeOrder S{0, nq, 3, Fp.G, Fp.bid}; pg8::EpiStore E{WSQ(bf16_t, WS_Q), 768};
              pg8::gemm_phase<pg8::EpiStore, pg8::RangeOrder>(Fp.lds, g, S, E); }
            { const bf16_t* ckvn = WSQ(bf16_t, WS_CKVN); const bf16_t* wkn = WSQ(bf16_t, WS_WKN) + (size_t)l * 512 * 256; const bf16_t* wv = WSQ(bf16_t, WS_WV) + (size_t)l * 512 * 256;
              pg8::Gemm g{ckvn, wkn, 256, (size_t)((const char*)wv - (const char*)ckvn), (size_t)((const char*)ckvn - (const char*)wkn)};
              pg8::Range2Order S{nq, 72, 2, 72, 36, Fp.G, Fp.bid}; pg8::EpiStore2 E{WSQ(bf16_t, WS_KN), 512, WSQ(bf16_t, WS_VT), TT};
              pg8::gemm_phase<pg8::EpiStore2, pg8::Range2Order>(Fp.lds, g, S, E); }
            gla_scan(Q, Fp); }
        SEAM(pb + 3);
        if (PHM(5) && IN(pb + 4)) for (int rep_ = 0; rep_ < REP(5); ++rep_) { KParams Q = load_params(); Frame Fp = phase_frame(F); bf16_t* U = (bf16_t*)(Q->ws + WS_U); (void)U;
            for (int u = vcu; u < 256; u += Fp.G) attn_unit(Q, Fp, u >> 6, (u >> 3) & 7, (u >> 6) * SEQ + (u & 7) * 256, 32);
            const bool lastl = (l == DEPTH - 1);
            if (!lastl) for (int u = vcu; u < 32; u += Fp.G) attn_unit(Q, Fp, u >> 3, u & 7, TLAT + (u >> 3) * CTXL, 0);
            for (int it = vcu; it < (lastl ? 128 : 144) * 4; it += Fp.G) gla_b_item(Q, Fp, l, it >> 2, it & 3); }
        SEAM(pb + 4);
        if (PHM(6) && IN(pb + 5)) for (int rep_ = 0; rep_ < REP(6); ++rep_) { KParams Q = load_params(); Frame Fp = phase_frame(F); bf16_t* U = (bf16_t*)(Q->ws + WS_U); (void)U; pg8::Gemm g{WSQ(bf16_t, WS_ACTS), WSQ(bf16_t, WS_WBR) + (size_t)l * 4 * DM * 512, 512, (size_t)TT * 512 * 2, (size_t)DM * 512 * 2}; pg8::MergeOrder S; S.init((l == DEPTH - 1) ? TLAT : TT, DM, Fp.G, Fp.bid);
            LAS float* gtab = (LAS float*)(Fp.lds + LDSX_OFF + 4096);
            if (Fp.tid < 256) { const float x = (float)(Fp.tid - 128) * (GATE_CLIP / 127.f), e = expf(-x); gtab[Fp.tid] = 1.f / (1.f + e); gtab[256 + Fp.tid] = 1.f + e; }
            __syncthreads();
            pg8::EpiMerge E{WSQ(bf16_t, WS_YM), (const unsigned char*)(Q->ws + WS_G8), gtab}; pg8::gemm_phase<pg8::EpiMerge, pg8::MergeOrder>(Fp.lds, g, S, E);
            if (l + 1 < DEPTH && rep_ == 0) { KParams Q2 = load_params(); Frame F2 = phase_frame(F); const int extra = (TT / 256) * (DM / 256) % F2.G; conv_mixed(Q2, F2, l + 1, 0, 600, 0, NL_F1, extra ? F2.bid - extra : F2.bid, extra ? F2.G - extra : F2.G); } }
        SEAM(pb + 5);
        if (PHM(7) && IN(pb + 6)) for (int rep_ = 0; rep_ < REP(7); ++rep_) { KParams Q = load_params(); Frame Fp = phase_frame(F); bf16_t* U = (bf16_t*)(Q->ws + WS_U); (void)U; pg8::Gemm g{WSQ(bf16_t, WS_YM), WSQ(bf16_t, WS_WMIX) + (size_t)l * DM * DM, DM, 0, 0}; pg8::StaticOrder S; S.init((l == DEPTH - 1) ? TLAT : TT, DM, Fp.G, Fp.bid);
            pg8::EpiResid E{WSQ(bf16_t, WS_X), WSQ(float, WS_MOD) + (size_t)l * 5 * (6 * DM) + 2 * DM, (rep_ + 1 < REP(7)) ? WSQ(bf16_t, WS_OUTS) : WSQ(bf16_t, WS_X)}; pg8::gemm_phase<pg8::EpiResid, pg8::StaticOrder>(Fp.lds, g, S, E);
            if (l + 1 < DEPTH && rep_ == 0) { KParams Q2 = load_params(); Frame F2 = phase_frame(F); const int extra = (TT / 256) * (DM / 256) % F2.G; conv_mixed(Q2, F2, l + 1, 600, 870, NL_F1, NL_F2, extra ? F2.bid - extra : F2.bid, extra ? F2.G - extra : F2.G); } }
        SEAM(pb + 6);
        if (PHM(8) && IN(pb + 7)) for (int rep_ = 0; rep_ < REP(8); ++rep_) { KParams Q = load_params(); Frame Fp = phase_frame(F); phase_norm2_route(Q, Fp, l, (rep_ + 1 < REP(8)) ? l + 4 : l); }
        SEAM(pb + 7);
        if (PHM(10) && IN(pb + 8)) for (int rep_ = 0; rep_ < REP(10); ++rep_) { KParams Q = load_params(); Frame Fp = phase_frame(F); bf16_t* U = (bf16_t*)(Q->ws + WS_U); (void)U; moe_table(Q, Fp, l);
            const LAS int* tpt = (const LAS int*)(Fp.lds + LDSX_OFF + 64);
            pg8::Gemm g{WSQ(bf16_t, WS_H), (const bf16_t*)(Q->ws + WS_W1 + (size_t)l * 16 * 1024 * DM), DM / 2, 0, (size_t)1024 * DM}; pg8::MoeOrder S{tpt, 4, Fp.G, Fp.bid};
            pg8::EpiSwiGLUQG E{WSQ(bf16_t, WS_ACTM), (const float*)(Q->ws + WS_ERW), (const float*)(Q->ws + WS_ERS), (const float*)(Q->ws + WS_RB1) + (size_t)l * 16 * 1024, tpt};
            pg8::gemm_phase_i8<pg8::EpiSwiGLUQG, pg8::MoeOrder, true>(Fp.lds, g, S, E, (const int*)(Q->ws + WS_ETOK), tpt);
            if (l + 1 < DEPTH && rep_ == 0) { KParams Q2 = load_params(); Frame F2 = phase_frame(F); const int nun = ((const LAS int*)(F2.lds + LDSX_OFF + 64))[16] * 4, extra = nun % F2.G;
                conv_mixed(Q2, F2, l + 1, 870, NS_ALL, NL_F2, NL_ITEMS, extra ? F2.bid - extra : F2.bid, extra ? F2.G - extra : F2.G); } }
        SEAM(pb + 8);
        if (PHM(11) && IN(pb + 9)) for (int rep_ = 0; rep_ < REP(11); ++rep_) { KParams Q = load_params(); Frame Fp = phase_frame(F); bf16_t* U = (bf16_t*)(Q->ws + WS_U); (void)U; moe_table(Q, Fp, l);
            pg8::Gemm g{WSQ(bf16_t, WS_ACTM), WSQ(bf16_t, WS_W2) + (size_t)l * 16 * DM * EFF, EFF, 0, (size_t)DM * EFF * 2}; pg8::MoeOrder S{(const LAS int*)(Fp.lds + LDSX_OFF + 64), 8, Fp.G, Fp.bid};
            pg8::EpiStore E{WSQ(bf16_t, WS_OUTS), DM}; pg8::gemm_phase<pg8::EpiStore, pg8::MoeOrder>(Fp.lds, g, S, E); }
        SEAM(pb + 9);
    }
    if (PHM(12) && IN(NPHASE - 1)) for (int rep_ = 0; rep_ < REP(12); ++rep_) { KParams Q = load_params(); Frame Fp = phase_frame(F); phase_final(Q, Fp); }
#undef IN
#undef SEAM
}

#ifndef MK_ONE_LAUNCH
#define MK_ONE_LAUNCH 1
#endif
extern "C" void kernel_launch(void* const* d_in, const int* in_sizes, int n_in, void* d_out, int out_size, void* d_ws, size_t ws_size, hipStream_t stream) {
    static int grid = 0;
    if (grid == 0) {
        if (n_in != 34 || out_size != TLAT * DM || ws_size < WS_END) { fprintf(stderr, "kernel_launch: unexpected problem: n_in %d out %d ws %zu (need %zu)\n", n_in, out_size, ws_size, (size_t)WS_END); grid = -1; return; }
        int dev = 0, cus = 0, per_cu = 0;
        if (hipGetDevice(&dev) != hipSuccess || hipDeviceGetAttribute(&cus, hipDeviceAttributeMultiprocessorCount, dev) != hipSuccess) { grid = -1; return; }
        if (hipFuncSetAttribute((const void*)hybrid_trunk_fwd, hipFuncAttributeMaxDynamicSharedMemorySize, LDS_BYTES) != hipSuccess) { fprintf(stderr, "kernel_launch: hipFuncSetAttribute failed\n"); grid = -1; return; }
        if (hipOccupancyMaxActiveBlocksPerMultiprocessor(&per_cu, (const void*)hybrid_trunk_fwd, 512, LDS_BYTES) != hipSuccess || per_cu < 1) { fprintf(stderr, "kernel_launch: occupancy query says %d\n", per_cu); }
        (void)hipGetLastError();
        grid = cus;
    }
    if (grid < 0) return;
    (void)hipMemsetAsync((char*)d_ws + WS_CTL, 0, CTL_ZERO_BYTES, stream);
    Params p{};
    for (int i = 0; i < 34; ++i) p.in[i] = (const float*)d_in[i];
    p.out = (float*)d_out; p.ws = (unsigned char*)d_ws;
#if MK_ONE_LAUNCH
    p.ph_lo = 0; p.ph_hi = NPHASE;
    hipLaunchKernelGGL(hybrid_trunk_fwd, dim3(grid), dim3(512), LDS_BYTES, stream, p);
#else
    for (int k = 0; k < NPHASE; ++k) { p.ph_lo = k; p.ph_hi = k + 1; hipLaunchKernelGGL(hybrid_trunk_fwd, dim3(grid), dim3(512), LDS_BYTES, stream, p); }
#endif
}
```

```cpp
#include <hip/hip_runtime.h>
#include <cstdio>
#include <cstdint>

#define DI __device__ __forceinline__
#define LAS __attribute__((address_space(3)))
typedef unsigned short bf16_t;
typedef short bf16x8 __attribute__((ext_vector_type(8)));
typedef short s16x4 __attribute__((ext_vector_type(4)));
typedef float f32x4 __attribute__((ext_vector_type(4)));
typedef float f32x16 __attribute__((ext_vector_type(16)));
typedef unsigned u32x4 __attribute__((ext_vector_type(4)));
typedef unsigned u32x2 __attribute__((ext_vector_type(2)));
typedef float f32x2_t __attribute__((ext_vector_type(2)));
typedef __bf16 bf16x2_t __attribute__((ext_vector_type(2)));
typedef int v4i_t __attribute__((ext_vector_type(4)));

constexpr int DM = 2048, NB = 4, SEQ = 2048, DEPTH = 4, CTXL = 256;
constexpr int TLAT = NB * SEQ, TCTX = NB * CTXL, TT = TLAT + TCTX;
constexpr int PW = 13120, PWP = 13312;
constexpr int O_CQ = 0, O_CKV = 512, O_KR = 768, O_CF = 800, O_GQ = 1824, O_GK = 2080, O_GV = 2336, O_GF = 2848, O_GB = 2864, O_GR = 2880, O_SC = 3392, O_MG = 4928;
constexpr int GCOL0 = 5120; constexpr float GATE_CLIP = 8.f;
DI int wcol_dest(int n0) { return n0 < O_MG ? n0 : n0 + (GCOL0 - O_MG); }
constexpr int NEXP = 16, EFF = 512, MOE_ROWS = 22528;
constexpr float EPS = 1e-6f;
constexpr int NCHAIN = 36;

DI float bflo(unsigned w) { return __uint_as_float(w << 16); }
DI float bfhi(unsigned w) { return __uint_as_float(w & 0xffff0000u); }
DI float bf2f(bf16_t v) { return __uint_as_float(((unsigned)v) << 16); }
DI unsigned pk2(float lo, float hi) { f32x2_t v = {lo, hi}; bf16x2_t b = __builtin_convertvector(v, bf16x2_t); return __builtin_bit_cast(unsigned, b); }
DI bf16_t f2bf(float f) { return (bf16_t)(pk2(f, 0.f) & 0xffffu); }
DI unsigned q8(float v) { int q = __float2int_rn(v); q = q > 127 ? 127 : q; q = q < -127 ? -127 : q; return (unsigned)q & 255u; }
DI float dpp_f(float v, int ctrl_sel) {
    const int x = __float_as_int(v); int r;
    switch (ctrl_sel) { case 0: r = __builtin_amdgcn_mov_dpp(x, 0xB1, 0xF, 0xF, true); break;
                        case 1: r = __builtin_amdgcn_mov_dpp(x, 0x4E, 0xF, 0xF, true); break;
                        case 2: r = __builtin_amdgcn_mov_dpp(x, 0x141, 0xF, 0xF, true); break;
                        default: r = __builtin_amdgcn_mov_dpp(x, 0x140, 0xF, 0xF, true); break; }
    return __int_as_float(r);
}
DI float wave_sum(float v) {
    v += dpp_f(v, 0); v += dpp_f(v, 1); v += dpp_f(v, 2); v += dpp_f(v, 3);
    { const auto r = __builtin_amdgcn_permlane16_swap(__float_as_uint(v), __float_as_uint(v), false, false); v = __uint_as_float(r[0]) + __uint_as_float(r[1]); }
    { const auto r = __builtin_amdgcn_permlane32_swap(__float_as_uint(v), __float_as_uint(v), false, false); v = __uint_as_float(r[0]) + __uint_as_float(r[1]); }
    return v;
}
DI float sigm(float x) { return __builtin_amdgcn_rcpf(1.f + __expf(-x)); }
DI float siluf(float x) { return x * __builtin_amdgcn_rcpf(1.f + __expf(-x)); }
#define LDS_WAIT() asm volatile("s_waitcnt lgkmcnt(0)" ::: "memory")
#define VM_WAIT() asm volatile("s_waitcnt vmcnt(0)" ::: "memory")

namespace pg8 {
constexpr int BM = 256, BK = 64, HALF = 128, HTB = HALF * BK * 2, STAGE_BYTES = 8 * HTB, NXCD = 8, WGM = 8;
DI int lds_byte(int r, int c) { const int st = (r >> 4) * 2 + (c >> 5), rr = r & 15, cc = c & 31, ob = rr * 64 + cc * 2; return st * 1024 + (ob ^ (((ob >> 9) & 1) << 5)); }
DI void stage_rc(int b, int& R, int& C) { const int st = b / 1024, sb = b % 1024, swz = sb ^ (((sb >> 9) & 1) << 5); R = (st >> 1) * 16 + swz / 64; C = (st & 1) * 32 + (swz % 64) / 2; }
DI int perm32(int rho) { const int n = rho >> 4, i = rho & 15; return 8 * (i >> 2) + 4 * n + (i & 3); }

struct Unit { int pm, pn, grp; };
struct Gemm { const bf16_t* A; const bf16_t* Bt; int K; size_t gsA, gsB; };

DI void tile_of(int wgid0, int nM, int nN, int& pm, int& pn) {
    const int nwg = nM * nN; int wgid = wgid0;
    { const int q = nwg / NXCD, r = nwg % NXCD, xcd = wgid % NXCD, off = wgid / NXCD; wgid = (xcd < r ? xcd * (q + 1) : r * (q + 1) + (xcd - r) * q) + off; }
    const int nig = WGM * nN, gid = wgid / nig, fm = gid * WGM, gsz = (nM - fm) < WGM ? (nM - fm) : WGM;
    pm = fm + ((wgid % nig) % gsz); pn = (wgid % nig) / gsz;
}
struct StaticOrder {
    int nM, nN, nwg, G, c;
    DI void init(int M, int N, int G_, int c_) { nM = M / BM; nN = N / BM; nwg = nM * nN; G = G_; c = c_; }
    DI bool next(int i, Unit& u) const { const int L = i * G + c; if (L >= nwg) return false; tile_of(L, nM, nN, u.pm, u.pn); u.grp = 0; return true; }
};
struct TrimOrder {
    int nM1, nN, n1, nctx, G, c;
    DI bool next(int i, Unit& u) const { const int L = i * G + c; u.grp = 0;
        if (L < n1) { tile_of(L, nM1, nN, u.pm, u.pn); return true; }
        const int q = L - n1; if (q >= nctx) return false; const int j = q % 6; u.pm = nM1 + q / 6; u.pn = j < 2 ? 2 + j : 6 + j; return true; }
};
struct RangeOrder {
    int first, count, nN, G, c;
    DI bool next(int i, Unit& u) const { const int L = i * G + c - first; if (L < 0 || L >= count) return false; u.pm = L / nN; u.pn = L % nN; u.grp = 0; return true; }
};
struct Range2Order {
    int first, count0, nN0, count1, nN1, G, c;
    DI bool next(int i, Unit& u) const { int L = i * G + c - first; if (L < 0) return false;
        if (L < count0) { u.pm = L / nN0; u.pn = L % nN0; u.grp = 0; return true; }
        L -= count0; if (L >= count1) return false; u.pm = L / nN1; u.pn = L % nN1; u.grp = 1; return true; }
};
struct MergeOrder {
    int nM, nN, nwg, G, c;
    DI void init(int M, int N, int G_, int c_) { nM = M / BM; nN = N / BM; nwg = nM * nN; G = G_; c = c_; }
    DI bool next(int i, Unit& u) const { const int L = (i >> 2) * G + c; if (L >= nwg) return false; tile_of(L, nM, nN, u.pm, u.pn); u.grp = i & 3; return true; }
};
struct MoeOrder {
    const LAS int* tp; int ncol, G, c;
    DI bool next(int i, Unit& u) const {
        const int L = i * G + c, ntile = tp[16]; if (L >= ntile * ncol) return false;
        const int rt = L / ncol; int e = 0;
#pragma unroll
        for (int j = 1; j < 16; ++j) e += (rt >= tp[j]) ? 1 : 0;
        u.pm = rt; u.pn = L % ncol; u.grp = e; return true;
    }
};

struct EpiStore {
    static constexpr bool PERM = true;
    bf16_t* O; int ldc;
    DI bool operator()(f32x4 (&acc)[2][2][4][2], const Unit& u, int wr, int wc, int fr, int fq) const {
        const int row0 = u.pm * BM + wr * 64 + fr, col0 = u.pn * BM + wc * 32 + 8 * fq;
#pragma unroll
        for (int ai = 0; ai < 2; ++ai)
#pragma unroll
            for (int m = 0; m < 4; ++m) { bf16_t* rowp = O + (size_t)(row0 + ai * HALF + m * 16) * ldc + col0;
#pragma unroll
                for (int bj = 0; bj < 2; ++bj) { const f32x4 v0 = acc[ai][bj][m][0], v1 = acc[ai][bj][m][1];
                    u32x4 w; w.x = pk2(v0[0], v0[1]); w.y = pk2(v0[2], v0[3]); w.z = pk2(v1[0], v1[1]); w.w = pk2(v1[2], v1[3]);
                    *(u32x4*)(rowp + bj * HALF) = w; } }
        return false;
    }
};
struct EpiStoreQ {
    static constexpr bool PERM = true;
    bf16_t* O; int ldc; const float* rA; const float* rB; unsigned char* G8;
    DI bool operator()(v4i_t (&acc)[2][2][4][2], const Unit& u, int wr, int wc, int fr, int fq) const {
        const int row0 = u.pm * BM + wr * 64 + fr, col0 = u.pn * BM + wc * 32 + 8 * fq;
        f32x4 cb[2][2];
#pragma unroll
        for (int bj = 0; bj < 2; ++bj) { cb[bj][0] = *(const f32x4*)(rB + col0 + bj * HALF); cb[bj][1] = *(const f32x4*)(rB + col0 + bj * HALF + 4); }
        if (col0 >= GCOL0) {
            const float qs = 127.f / GATE_CLIP;
#pragma unroll
            for (int ai = 0; ai < 2; ++ai)
#pragma unroll
                for (int m = 0; m < 4; ++m) { const int row = row0 + ai * HALF + m * 16; const float ra = rA[row] * qs;
                    unsigned char* rowp = G8 + (size_t)(u.pm * 32 + (u.pn - GCOL0 / BM)) * 65536 + (((wr * 4 + wc) * 16 + (ai * 4 + m) * 2) * 64 + fr + 16 * fq) * 8;
#pragma unroll
                    for (int bj = 0; bj < 2; ++bj) { const v4i_t a0 = acc[ai][bj][m][0], a1 = acc[ai][bj][m][1]; const f32x4 c0 = cb[bj][0] * ra, c1 = cb[bj][1] * ra;
                        unsigned w0 = 0u, w1 = 0u;
#pragma unroll
                        for (int j = 0; j < 4; ++j) { w0 = __builtin_amdgcn_cvt_pk_u8_f32((float)a0[j] * c0[j] + 128.0f, j, w0); w1 = __builtin_amdgcn_cvt_pk_u8_f32((float)a1[j] * c1[j] + 128.0f, j, w1); }
                        *(u32x2*)(rowp + bj * 512) = (u32x2){w0, w1}; } }
            return false;
        }
#pragma unroll
        for (int ai = 0; ai < 2; ++ai)
#pragma unroll
            for (int m = 0; m < 4; ++m) { const int row = row0 + ai * HALF + m * 16; const float ra = rA[row]; bf16_t* rowp = O + (size_t)row * ldc + col0;
#pragma unroll
                for (int bj = 0; bj < 2; ++bj) { const v4i_t a0 = acc[ai][bj][m][0], a1 = acc[ai][bj][m][1]; const f32x4 c0 = cb[bj][0] * ra, c1 = cb[bj][1] * ra;
                    u32x4 w; w.x = pk2((float)a0[0] * c0[0], (float)a0[1] * c0[1]); w.y = pk2((float)a0[2] * c0[2], (float)a0[3] * c0[3]);
                    w.z = pk2((float)a1[0] * c1[0], (float)a1[1] * c1[1]); w.w = pk2((float)a1[2] * c1[2], (float)a1[3] * c1[3]);
                    *(u32x4*)(rowp + bj * HALF) = w; } }
        return false;
    }
};
struct EpiStore2 {
    static constexpr bool PERM = true;
    bf16_t* O0; int ldc0; bf16_t* O1; int ldc1;
    DI bool operator()(f32x4 (&acc)[2][2][4][2], const Unit& u, int wr, int wc, int fr, int fq) const {
        const EpiStore E{u.grp ? O1 : O0, u.grp ? ldc1 : ldc0}; return E(acc, u, wr, wc, fr, fq);
    }
};
struct EpiMerge {
    static constexpr bool PERM = true;
    bf16_t* Y; const unsigned char* G8;
    const LAS float* tab;
    DI static int qi(unsigned w, int i) { return (int)((w >> (8 * i)) & 255u); }
    DI bool operator()(f32x4 (&acc)[2][2][4][2], const Unit& u, int wr, int wc, int fr, int fq) const {
        const int row0 = u.pm * BM + wr * 64 + fr, col0 = u.pn * BM + wc * 32 + 8 * fq; const int grp = u.grp;
        if (grp < 3) {
#pragma unroll
            for (int ai = 0; ai < 2; ++ai)
#pragma unroll
                for (int m = 0; m < 4; ++m) { const unsigned char* gp = G8 + (size_t)(u.pm * 32 + grp * 8 + u.pn) * 65536 + (((wr * 4 + wc) * 16 + (ai * 4 + m) * 2) * 64 + fr + 16 * fq) * 8;
#pragma unroll
                    for (int bj = 0; bj < 2; ++bj) { const u32x2 a = *(const u32x2*)(gp + bj * 512), b = *(const u32x2*)(gp + 8 * 65536 + bj * 512);
                        f32x4& a0 = acc[ai][bj][m][0]; f32x4& a1 = acc[ai][bj][m][1];
#pragma unroll
                        for (int j = 0; j < 4; ++j) { a0[j] *= tab[qi(a.x, j)] * tab[256 + qi(b.x, j)]; a1[j] *= tab[qi(a.y, j)] * tab[256 + qi(b.y, j)]; } } }
            return true;
        }
#pragma unroll
        for (int ai = 0; ai < 2; ++ai)
#pragma unroll
            for (int m = 0; m < 4; ++m) { const int row = row0 + ai * HALF + m * 16;
                bf16_t* yp = Y + (size_t)row * DM + col0; const unsigned char* gp = G8 + (size_t)(u.pm * 32 + 3 * 8 + u.pn) * 65536 + (((wr * 4 + wc) * 16 + (ai * 4 + m) * 2) * 64 + fr + 16 * fq) * 8;
#pragma unroll
                for (int bj = 0; bj < 2; ++bj) { const u32x2 g = *(const u32x2*)(gp + bj * 512); const f32x4 a0 = acc[ai][bj][m][0], a1 = acc[ai][bj][m][1];
                    u32x4 w; w.x = pk2(a0[0] * tab[qi(g.x, 0)], a0[1] * tab[qi(g.x, 1)]); w.y = pk2(a0[2] * tab[qi(g.x, 2)], a0[3] * tab[qi(g.x, 3)]);
                    w.z = pk2(a1[0] * tab[qi(g.y, 0)], a1[1] * tab[qi(g.y, 1)]); w.w = pk2(a1[2] * tab[qi(g.y, 2)], a1[3] * tab[qi(g.y, 3)]);
                    *(u32x4*)(yp + bj * HALF) = w; } }
        return false;
    }
};
struct EpiResid {
    static constexpr bool PERM = true;
    bf16_t* X; const float* gate; bf16_t* XO;
    DI bool operator()(f32x4 (&acc)[2][2][4][2], const Unit& u, int wr, int wc, int fr, int fq) const {
        const int row0 = u.pm * BM + wr * 64 + fr, col0 = u.pn * BM + wc * 32 + 8 * fq;
        const int r = (u.pm < TLAT / BM) ? (u.pm >> 3) : 4; const float* gp = gate + (size_t)r * (6 * DM) + col0;
        f32x4 gv[2][2];
#pragma unroll
        for (int bj = 0; bj < 2; ++bj)
#pragma unroll
            for (int n = 0; n < 2; ++n) gv[bj][n] = *(const f32x4*)(gp + bj * HALF + n * 4);
#pragma unroll
        for (int ai = 0; ai < 2; ++ai)
#pragma unroll
            for (int m = 0; m < 4; ++m) { const size_t ro = (size_t)(row0 + ai * HALF + m * 16) * DM + col0;
#pragma unroll
                for (int bj = 0; bj < 2; ++bj) { const u32x4 x = *(const u32x4*)(X + ro + bj * HALF); const f32x4 a0 = gv[bj][0] * acc[ai][bj][m][0], a1 = gv[bj][1] * acc[ai][bj][m][1];
                    u32x4 o; o.x = pk2(bflo(x.x) + a0[0], bfhi(x.x) + a0[1]); o.y = pk2(bflo(x.y) + a0[2], bfhi(x.y) + a0[3]); o.z = pk2(bflo(x.z) + a1[0], bfhi(x.z) + a1[1]); o.w = pk2(bflo(x.w) + a1[2], bfhi(x.w) + a1[3]);
                    *(u32x4*)(XO + ro + bj * HALF) = o; } }
        return false;
    }
};
struct EpiSwiGLUQ {
    static constexpr bool PERM = true;
    bf16_t* O; const float* roww; const float* rs; const float* rb1;
    DI bool operator()(v4i_t (&acc)[2][2][4][2], const Unit& u, int wr, int wc, int fr, int fq) const {
        const int row0 = u.pm * BM + wr * 64 + fr, col0 = u.pn * HALF + wc * 32 + 8 * fq; const float* rb = rb1 + (size_t)u.grp * 1024 + u.pn * BM + wc * 32 + 8 * fq;
        const f32x4 bg0 = *(const f32x4*)rb, bg1 = *(const f32x4*)(rb + 4), bu0 = *(const f32x4*)(rb + HALF), bu1 = *(const f32x4*)(rb + HALF + 4);
#pragma unroll
        for (int ai = 0; ai < 2; ++ai)
#pragma unroll
            for (int m = 0; m < 4; ++m) { const int row = row0 + ai * HALF + m * 16; const float w = roww[row], sa = rs[row];
                const v4i_t g0 = acc[ai][0][m][0], g1 = acc[ai][0][m][1], u0 = acc[ai][1][m][0], u1 = acc[ai][1][m][1];
                float v[8];
#pragma unroll
                for (int j = 0; j < 4; ++j) { v[j] = siluf((float)g0[j] * sa * bg0[j]) * ((float)u0[j] * sa * bu0[j]) * w; v[4 + j] = siluf((float)g1[j] * sa * bg1[j]) * ((float)u1[j] * sa * bu1[j]) * w; }
                u32x4 o; o.x = pk2(v[0], v[1]); o.y = pk2(v[2], v[3]); o.z = pk2(v[4], v[5]); o.w = pk2(v[6], v[7]);
                *(u32x4*)(O + (size_t)row * EFF + col0) = o; }
        return false;
    }
};
struct EpiSwiGLUQG {
    static constexpr bool PERM = true;
    bf16_t* O; const float* erw; const float* ers; const float* rb1; const LAS int* tpt;
    DI bool operator()(v4i_t (&acc)[2][2][4][2], const Unit& u, int wr, int wc, int fr, int fq) const {
        const int row0 = u.pm * BM + wr * 64 + fr, col0 = u.pn * HALF + wc * 32 + 8 * fq; const float* rb = rb1 + (size_t)u.grp * 1024 + u.pn * BM + wc * 32 + 8 * fq;
        const int s0 = (u.pm - tpt[u.grp]) * 256 + wr * 64 + fr, cn = tpt[32 + u.grp]; const float* pw = erw + u.grp * TT; const float* ps = ers + u.grp * TT;
        const f32x4 bg0 = *(const f32x4*)rb, bg1 = *(const f32x4*)(rb + 4), bu0 = *(const f32x4*)(rb + HALF), bu1 = *(const f32x4*)(rb + HALF + 4);
#pragma unroll
        for (int ai = 0; ai < 2; ++ai)
#pragma unroll
            for (int m = 0; m < 4; ++m) { const int row = row0 + ai * HALF + m * 16, sl = s0 + ai * HALF + m * 16; const bool ok = sl < cn; const float w = ok ? pw[ok ? sl : 0] : 0.f, sa = ok ? ps[ok ? sl : 0] : 0.f;
                const v4i_t g0 = acc[ai][0][m][0], g1 = acc[ai][0][m][1], u0 = acc[ai][1][m][0], u1 = acc[ai][1][m][1];
                float v[8];
#pragma unroll
                for (int j = 0; j < 4; ++j) { v[j] = siluf((float)g0[j] * sa * bg0[j]) * ((float)u0[j] * sa * bu0[j]) * w; v[4 + j] = siluf((float)g1[j] * sa * bg1[j]) * ((float)u1[j] * sa * bu1[j]) * w; }
                u32x4 o; o.x = pk2(v[0], v[1]); o.y = pk2(v[2], v[3]); o.z = pk2(v[4], v[5]); o.w = pk2(v[6], v[7]);
                *(u32x4*)(O + (size_t)row * EFF + col0) = o; }
        return false;
    }
};
struct EpiSwiGLU {
    static constexpr bool PERM = true;
    bf16_t* O; const float* roww;
    DI bool operator()(f32x4 (&acc)[2][2][4][2], const Unit& u, int wr, int wc, int fr, int fq) const {
        const int row0 = u.pm * BM + wr * 64 + fr, col0 = u.pn * HALF + wc * 32 + 8 * fq;
#pragma unroll
        for (int ai = 0; ai < 2; ++ai)
#pragma unroll
            for (int m = 0; m < 4; ++m) { const int row = row0 + ai * HALF + m * 16; const float w = roww[row];
                const f32x4 g0 = acc[ai][0][m][0], g1 = acc[ai][0][m][1], u0 = acc[ai][1][m][0], u1 = acc[ai][1][m][1];
                float v[8];
#pragma unroll
                for (int j = 0; j < 4; ++j) { v[j] = siluf(g0[j]) * u0[j] * w; v[4 + j] = siluf(g1[j]) * u1[j] * w; }
                u32x4 o; o.x = pk2(v[0], v[1]); o.y = pk2(v[2], v[3]); o.z = pk2(v[4], v[5]); o.w = pk2(v[6], v[7]);
                *(u32x4*)(O + (size_t)row * EFF + col0) = o; }
        return false;
    }
};

template <class Epi, class Sched>
DI void gemm_phase(LAS unsigned char* lds, const Gemm g, const Sched& S, const Epi& E) {
    int tid = threadIdx.x; asm volatile("" : "+v"(tid));
    const int wid = __builtin_amdgcn_readfirstlane(tid >> 6), lane = tid & 63, wr = wid >> 2, wc = wid & 3, fr = lane & 15, fq = lane >> 4;
    int K = g.K; asm volatile("" : "+s"(K));
    const int nt = K / BK;
    unsigned voffA[2], voffB[2], gC[2]; int gR[2];
#pragma unroll
    for (int i = 0; i < 2; ++i) { int R, C; stage_rc(tid * 16 + i * 8192, R, C); const int Rb = Epi::PERM ? ((R & ~31) + perm32(R & 31)) : R;
        voffA[i] = (unsigned)(R * K + C) * 2u; voffB[i] = (unsigned)(Rb * K + C) * 2u; gR[i] = R; gC[i] = (unsigned)C * 2u; }
    const size_t kstep = (size_t)(BK * 2);
    const size_t hstep = (size_t)HALF * K * 2;
    const size_t tstep = 2 * hstep;
    const unsigned ldsw = (unsigned)wid * 1024u;
    const int aoff = lds_byte(wr * 64 + fr, fq * 8), boff = lds_byte(wc * 32 + fr, fq * 8);
#define PG8_SA(b, h) (((b) * 2 + (h)) * HTB)
#define PG8_SB(b, h) ((4 + (b) * 2 + (h)) * HTB)
#define PG8_STAGE(bufoff, gbase, voff) do { _Pragma("unroll") for (int _i = 0; _i < 2; ++_i) \
        __builtin_amdgcn_global_load_lds((const unsigned*)((const char*)(gbase) + (voff)[_i]), (LAS unsigned*)(lds + (bufoff) + ldsw + _i * 8192), 16, 0, 0); } while (0)
#define PG8_STAGE2(bufoff, gbase, o0, o1) do { \
        __builtin_amdgcn_global_load_lds((const unsigned*)((const char*)(gbase) + (o0)), (LAS unsigned*)(lds + (bufoff) + ldsw), 16, 0, 0); \
        __builtin_amdgcn_global_load_lds((const unsigned*)((const char*)(gbase) + (o1)), (LAS unsigned*)(lds + (bufoff) + ldsw + 8192), 16, 0, 0); } while (0)
#define PG8_GATH(u, v) do { const int e_ = (u).grp, b_ = ((u).pm - tpt[e_]) * 256, c_ = tpt[32 + e_]; const int* et_ = etok + e_ * TT; \
        _Pragma("unroll") for (int h_ = 0; h_ < 2; ++h_) _Pragma("unroll") for (int i_ = 0; i_ < 2; ++i_) { const int s_ = b_ + h_ * 128 + gR[i_]; const int t_ = (s_ < c_) ? et_[s_] : 0; \
            v[h_][i_] = (unsigned)t_ * (unsigned)(K * 2) + gC[i_]; } } while (0)
#define PG8_LDA(dst, b, h) do { _Pragma("unroll") for (int m = 0; m < 4; ++m) _Pragma("unroll") for (int k = 0; k < 2; ++k) dst[m][k] = *(const LAS bf16x8*)(lds + PG8_SA(b, h) + aoff + m * 2048 + k * 1024); } while (0)
#define PG8_LDB(dst, b, h) do { _Pragma("unroll") for (int n = 0; n < 2; ++n) _Pragma("unroll") for (int k = 0; k < 2; ++k) dst[n][k] = *(const LAS bf16x8*)(lds + PG8_SB(b, h) + boff + n * 2048 + k * 1024); } while (0)
#define PG8_MMA(ai, bj, At, Bt) do { __builtin_amdgcn_s_setprio(1); _Pragma("unroll") for (int m = 0; m < 4; ++m) _Pragma("unroll") for (int n = 0; n < 2; ++n) _Pragma("unroll") for (int k = 0; k < 2; ++k) \
        acc[ai][bj][m][n] = __builtin_amdgcn_mfma_f32_16x16x32_bf16(Bt[n][k], At[m][k], acc[ai][bj][m][n], 0, 0, 0); __builtin_amdgcn_s_setprio(0); } while (0)
#define PG8_WAIT_V(n) asm volatile("s_waitcnt vmcnt(" #n ")" ::: "memory")
#define PG8_WAIT_L(n) asm volatile("s_waitcnt lgkmcnt(" #n ")" ::: "memory")
#define PG8_BAR __builtin_amdgcn_s_barrier()
#define PG8_SCHED __builtin_amdgcn_sched_barrier(0)
    Unit cur, nxt; int ui = 0;
    if (!S.next(0, cur)) return;
    cur.pm = __builtin_amdgcn_readfirstlane(cur.pm); cur.pn = __builtin_amdgcn_readfirstlane(cur.pn); cur.grp = __builtin_amdgcn_readfirstlane(cur.grp);
    f32x4 acc[2][2][4][2];
#pragma unroll
    for (int a = 0; a < 2; ++a)
#pragma unroll
        for (int b = 0; b < 2; ++b)
#pragma unroll
            for (int m = 0; m < 4; ++m)
#pragma unroll
                for (int n = 0; n < 2; ++n) acc[a][b][m][n] = (f32x4){0.f, 0.f, 0.f, 0.f};
    bf16x8 At[4][2], B0[2][2], B1[2][2];
    const char* cA = (const char*)g.A + (size_t)cur.grp * g.gsA + (size_t)cur.pm * tstep; const char* cB = (const char*)g.Bt + (size_t)cur.grp * g.gsB + (size_t)cur.pn * tstep;
    PG8_STAGE(PG8_SB(0, 0), cB, voffB); PG8_STAGE(PG8_SB(0, 1), cB + hstep, voffB); PG8_STAGE(PG8_SA(0, 0), cA, voffA); PG8_STAGE(PG8_SA(0, 1), cA + hstep, voffA);
    if (wr == 1) PG8_BAR;
    PG8_WAIT_V(2); PG8_BAR;
    PG8_STAGE(PG8_SB(1, 0), cB + kstep, voffB); PG8_STAGE(PG8_SA(1, 0), cA + kstep, voffA); PG8_STAGE(PG8_SB(1, 1), cB + hstep + kstep, voffB);
    PG8_WAIT_V(6); PG8_BAR;
    for (;;) {
        const bool has_next = S.next(ui + 1, nxt);
        nxt.pm = __builtin_amdgcn_readfirstlane(nxt.pm); nxt.pn = __builtin_amdgcn_readfirstlane(nxt.pn); nxt.grp = __builtin_amdgcn_readfirstlane(nxt.grp);
        const char* nA = has_next ? (const char*)g.A + (size_t)nxt.grp * g.gsA + (size_t)nxt.pm * tstep : cA; const char* nB = has_next ? (const char*)g.Bt + (size_t)nxt.grp * g.gsB + (size_t)nxt.pn * tstep : cB;
        for (int t = 0; t < nt; t += 2) {
            const bool last = (t == nt - 2);
            const char* a1 = cA + (size_t)(t + 1) * kstep;
            const char* a2 = last ? nA : cA + (size_t)(t + 2) * kstep; const char* b2 = last ? nB : cB + (size_t)(t + 2) * kstep;
            const char* a3 = a2 + kstep; const char* b3 = b2 + kstep;
            PG8_LDB(B0, 0, 0); PG8_LDB(B1, 0, 1); PG8_SCHED; PG8_LDA(At, 0, 0); PG8_STAGE(PG8_SA(1, 1), a1 + hstep, voffA);
            PG8_WAIT_V(8); PG8_WAIT_L(0); PG8_BAR; PG8_MMA(0, 0, At, B0); PG8_MMA(0, 1, At, B1); PG8_BAR; PG8_SCHED;
            PG8_LDA(At, 0, 1); PG8_STAGE(PG8_SB(0, 0), b2, voffB); PG8_STAGE(PG8_SB(0, 1), b2 + hstep, voffB); PG8_STAGE(PG8_SA(0, 0), a2, voffA);
            PG8_WAIT_V(8); PG8_WAIT_L(0); PG8_BAR; PG8_MMA(1, 0, At, B0); PG8_MMA(1, 1, At, B1); PG8_BAR; PG8_SCHED;
            PG8_LDB(B0, 1, 0); PG8_LDB(B1, 1, 1); PG8_SCHED; PG8_LDA(At, 1, 0); PG8_STAGE(PG8_SA(0, 1), a2 + hstep, voffA);
            PG8_WAIT_V(8); PG8_WAIT_L(0); PG8_BAR; PG8_MMA(0, 0, At, B0); PG8_MMA(0, 1, At, B1); PG8_BAR; PG8_SCHED;
            PG8_LDA(At, 1, 1); PG8_STAGE(PG8_SB(1, 0), b3, voffB); PG8_STAGE(PG8_SB(1, 1), b3 + hstep, voffB); PG8_STAGE(PG8_SA(1, 0), a3, voffA);
            PG8_WAIT_V(8); PG8_WAIT_L(0); PG8_BAR; PG8_MMA(1, 0, At, B0); PG8_MMA(1, 1, At, B1); PG8_BAR; PG8_SCHED;
        }
        bool keep = false;
        if (wr == 0) PG8_BAR;
        { Unit eu; eu.pm = __builtin_amdgcn_readfirstlane(cur.pm); eu.pn = __builtin_amdgcn_readfirstlane(cur.pn); eu.grp = __builtin_amdgcn_readfirstlane(cur.grp); asm volatile("" : "+s"(eu.pm), "+s"(eu.pn), "+s"(eu.grp)); keep = E(acc, eu, wr, wc, fr, fq); }
        if (!has_next) break;
        if (!keep) {
#pragma unroll
        for (int a = 0; a < 2; ++a)
#pragma unroll
            for (int b = 0; b < 2; ++b)
#pragma unroll
                for (int m = 0; m < 4; ++m)
#pragma unroll
                    for (int n = 0; n < 2; ++n) acc[a][b][m][n] = (f32x4){0.f, 0.f, 0.f, 0.f};
        }
        cur = nxt; cA = nA; cB = nB; ++ui;
        if (wr == 1) PG8_BAR;
    }
    PG8_WAIT_V(0);
    PG8_BAR;
#undef PG8_SA
#undef PG8_SB
#undef PG8_STAGE
#undef PG8_LDA
#undef PG8_LDB
#undef PG8_MMA
#undef PG8_WAIT_V
#undef PG8_WAIT_L
#undef PG8_BAR
#undef PG8_SCHED
}
template <class Epi, class Sched, bool GATHER = false>
DI void gemm_phase_i8(LAS unsigned char* lds, const Gemm g, const Sched& S, const Epi& E, const int* etok = nullptr, const LAS int* tpt = nullptr) {
    int tid = threadIdx.x; asm volatile("" : "+v"(tid));
    const int wid = __builtin_amdgcn_readfirstlane(tid >> 6), lane = tid & 63, wr = wid >> 2, wc = wid & 3, fr = lane & 15, fq = lane >> 4;
    int K = g.K; asm volatile("" : "+s"(K));
    const int nt = K / BK;
    unsigned voffA[2], voffB[2], gC[2]; int gR[2];
#pragma unroll
    for (int i = 0; i < 2; ++i) { int R, C; stage_rc(tid * 16 + i * 8192, R, C); const int Rb = Epi::PERM ? ((R & ~31) + perm32(R & 31)) : R;
        voffA[i] = (unsigned)(R * K + C) * 2u; voffB[i] = (unsigned)(Rb * K + C) * 2u; gR[i] = R; gC[i] = (unsigned)C * 2u; }
    const size_t kstep = (size_t)(BK * 2);
    const size_t hstep = (size_t)HALF * K * 2;
    const size_t tstep = 2 * hstep;
    const unsigned ldsw = (unsigned)wid * 1024u;
    const int aoff = lds_byte(wr * 64 + fr, fq * 8), boff = lds_byte(wc * 32 + fr, fq * 8);
#define PG8_SA(b, h) (((b) * 2 + (h)) * HTB)
#define PG8_SB(b, h) ((4 + (b) * 2 + (h)) * HTB)
#define PG8_STAGE(bufoff, gbase, voff) do { _Pragma("unroll") for (int _i = 0; _i < 2; ++_i) \
        __builtin_amdgcn_global_load_lds((const unsigned*)((const char*)(gbase) + (voff)[_i]), (LAS unsigned*)(lds + (bufoff) + ldsw + _i * 8192), 16, 0, 0); } while (0)
#define PG8_STAGE2(bufoff, gbase, o0, o1) do { \
        __builtin_amdgcn_global_load_lds((const unsigned*)((const char*)(gbase) + (o0)), (LAS unsigned*)(lds + (bufoff) + ldsw), 16, 0, 0); \
        __builtin_amdgcn_global_load_lds((const unsigned*)((const char*)(gbase) + (o1)), (LAS unsigned*)(lds + (bufoff) + ldsw + 8192), 16, 0, 0); } while (0)
#define PG8_GATH(u, v) do { const int e_ = (u).grp, b_ = ((u).pm - tpt[e_]) * 256, c_ = tpt[32 + e_]; const int* et_ = etok + e_ * TT; \
        _Pragma("unroll") for (int h_ = 0; h_ < 2; ++h_) _Pragma("unroll") for (int i_ = 0; i_ < 2; ++i_) { const int s_ = b_ + h_ * 128 + gR[i_]; const int t_ = (s_ < c_) ? et_[s_] : 0; \
            v[h_][i_] = (unsigned)t_ * (unsigned)(K * 2) + gC[i_]; } } while (0)
#define PG8_LDA(dst, b, h) do { _Pragma("unroll") for (int m = 0; m < 4; ++m) _Pragma("unroll") for (int k = 0; k < 2; ++k) dst[m][k] = *(const LAS v4i_t*)(lds + PG8_SA(b, h) + aoff + m * 2048 + k * 1024); } while (0)
#define PG8_LDB(dst, b, h) do { _Pragma("unroll") for (int n = 0; n < 2; ++n) _Pragma("unroll") for (int k = 0; k < 2; ++k) dst[n][k] = *(const LAS v4i_t*)(lds + PG8_SB(b, h) + boff + n * 2048 + k * 1024); } while (0)
#define PG8_MMA(ai, bj, At, Bt) do { __builtin_amdgcn_s_setprio(1); _Pragma("unroll") for (int m = 0; m < 4; ++m) _Pragma("unroll") for (int n = 0; n < 2; ++n) _Pragma("unroll") for (int k = 0; k < 2; ++k) \
        acc[ai][bj][m][n] = __builtin_amdgcn_mfma_i32_16x16x64_i8(Bt[n][k], At[m][k], acc[ai][bj][m][n], 0, 0, 0); __builtin_amdgcn_s_setprio(0); } while (0)
#define PG8_WAIT_V(n) asm volatile("s_waitcnt vmcnt(" #n ")" ::: "memory")
#define PG8_WAIT_L(n) asm volatile("s_waitcnt lgkmcnt(" #n ")" ::: "memory")
#define PG8_BAR __builtin_amdgcn_s_barrier()
#define PG8_SCHED __builtin_amdgcn_sched_barrier(0)
    Unit cur, nxt; int ui = 0;
    if (!S.next(0, cur)) return;
    cur.pm = __builtin_amdgcn_readfirstlane(cur.pm); cur.pn = __builtin_amdgcn_readfirstlane(cur.pn); cur.grp = __builtin_amdgcn_readfirstlane(cur.grp);
    v4i_t acc[2][2][4][2];
#pragma unroll
    for (int a = 0; a < 2; ++a)
#pragma unroll
        for (int b = 0; b < 2; ++b)
#pragma unroll
            for (int m = 0; m < 4; ++m)
#pragma unroll
                for (int n = 0; n < 2; ++n) acc[a][b][m][n] = (v4i_t){0, 0, 0, 0};
    v4i_t At[4][2], B0[2][2], B1[2][2];
    const char* cA = GATHER ? (const char*)g.A : (const char*)g.A + (size_t)cur.grp * g.gsA + (size_t)cur.pm * tstep; const char* cB = (const char*)g.Bt + (size_t)cur.grp * g.gsB + (size_t)cur.pn * tstep;
    unsigned cv[2][2] = {{voffA[0], voffA[1]}, {voffA[0], voffA[1]}}, nv[2][2] = {{voffA[0], voffA[1]}, {voffA[0], voffA[1]}};
    if (GATHER) PG8_GATH(cur, cv);
    const size_t ahs = GATHER ? (size_t)0 : hstep;
    PG8_STAGE(PG8_SB(0, 0), cB, voffB); PG8_STAGE(PG8_SB(0, 1), cB + hstep, voffB); PG8_STAGE2(PG8_SA(0, 0), cA, cv[0][0], cv[0][1]); PG8_STAGE2(PG8_SA(0, 1), cA + ahs, cv[1][0], cv[1][1]);
    if (wr == 1) PG8_BAR;
    PG8_WAIT_V(2); PG8_BAR;
    PG8_STAGE(PG8_SB(1, 0), cB + kstep, voffB); PG8_STAGE2(PG8_SA(1, 0), cA + kstep, cv[0][0], cv[0][1]); PG8_STAGE(PG8_SB(1, 1), cB + hstep + kstep, voffB);
    PG8_WAIT_V(6); PG8_BAR;
    for (;;) {
        const bool has_next = S.next(ui + 1, nxt);
        nxt.pm = __builtin_amdgcn_readfirstlane(nxt.pm); nxt.pn = __builtin_amdgcn_readfirstlane(nxt.pn); nxt.grp = __builtin_amdgcn_readfirstlane(nxt.grp);
        const char* nA = (has_next && !GATHER) ? (const char*)g.A + (size_t)nxt.grp * g.gsA + (size_t)nxt.pm * tstep : cA; const char* nB = has_next ? (const char*)g.Bt + (size_t)nxt.grp * g.gsB + (size_t)nxt.pn * tstep : cB;
        if (GATHER) { if (has_next) PG8_GATH(nxt, nv); else { nv[0][0] = cv[0][0]; nv[0][1] = cv[0][1]; nv[1][0] = cv[1][0]; nv[1][1] = cv[1][1]; } }
        for (int t = 0; t < nt; t += 2) {
            const bool last = (t == nt - 2);
            const unsigned s00 = (GATHER && last) ? nv[0][0] : cv[0][0], s01 = (GATHER && last) ? nv[0][1] : cv[0][1], s10 = (GATHER && last) ? nv[1][0] : cv[1][0], s11 = (GATHER && last) ? nv[1][1] : cv[1][1];
            const char* a1 = cA + (size_t)(t + 1) * kstep;
            const char* a2 = last ? nA : cA + (size_t)(t + 2) * kstep; const char* b2 = last ? nB : cB + (size_t)(t + 2) * kstep;
            const char* a3 = a2 + kstep; const char* b3 = b2 + kstep;
            PG8_LDB(B0, 0, 0); PG8_LDB(B1, 0, 1); PG8_SCHED; PG8_LDA(At, 0, 0); PG8_STAGE2(PG8_SA(1, 1), a1 + ahs, cv[1][0], cv[1][1]);
            PG8_WAIT_V(8); PG8_WAIT_L(0); PG8_BAR; PG8_MMA(0, 0, At, B0); PG8_MMA(0, 1, At, B1); PG8_BAR; PG8_SCHED;
            PG8_LDA(At, 0, 1); PG8_STAGE(PG8_SB(0, 0), b2, voffB); PG8_STAGE(PG8_SB(0, 1), b2 + hstep, voffB); PG8_STAGE2(PG8_SA(0, 0), a2, s00, s01);
            PG8_WAIT_V(8); PG8_WAIT_L(0); PG8_BAR; PG8_MMA(1, 0, At, B0); PG8_MMA(1, 1, At, B1); PG8_BAR; PG8_SCHED;
            PG8_LDB(B0, 1, 0); PG8_LDB(B1, 1, 1); PG8_SCHED; PG8_LDA(At, 1, 0); PG8_STAGE2(PG8_SA(0, 1), a2 + ahs, s10, s11);
            PG8_WAIT_V(8); PG8_WAIT_L(0); PG8_BAR; PG8_MMA(0, 0, At, B0); PG8_MMA(0, 1, At, B1); PG8_BAR; PG8_SCHED;
            PG8_LDA(At, 1, 1); PG8_STAGE(PG8_SB(1, 0), b3, voffB); PG8_STAGE(PG8_SB(1, 1), b3 + hstep, voffB); PG8_STAGE2(PG8_SA(1, 0), a3, s00, s01);
            PG8_WAIT_V(8); PG8_WAIT_L(0); PG8_BAR; PG8_MMA(1, 0, At, B0); PG8_MMA(1, 1, At, B1); PG8_BAR; PG8_SCHED;
        }
        bool keep = false;
        if (wr == 0) PG8_BAR;
        { Unit eu; eu.pm = __builtin_amdgcn_readfirstlane(cur.pm); eu.pn = __builtin_amdgcn_readfirstlane(cur.pn); eu.grp = __builtin_amdgcn_readfirstlane(cur.grp); asm volatile("" : "+s"(eu.pm), "+s"(eu.pn), "+s"(eu.grp)); keep = E(acc, eu, wr, wc, fr, fq); }
        if (!has_next) break;
        if (!keep) {
#pragma unroll
        for (int a = 0; a < 2; ++a)
#pragma unroll
            for (int b = 0; b < 2; ++b)
#pragma unroll
                for (int m = 0; m < 4; ++m)
#pragma unroll
                    for (int n = 0; n < 2; ++n) acc[a][b][m][n] = (v4i_t){0, 0, 0, 0};
        }
        cur = nxt; cA = nA; cB = nB; ++ui;
        if (GATHER) { cv[0][0] = nv[0][0]; cv[0][1] = nv[0][1]; cv[1][0] = nv[1][0]; cv[1][1] = nv[1][1]; }
        if (wr == 1) PG8_BAR;
    }
    PG8_WAIT_V(0);
    PG8_BAR;
#undef PG8_SA
#undef PG8_SB
#undef PG8_STAGE
#undef PG8_STAGE2
#undef PG8_GATH
#undef PG8_LDA
#undef PG8_LDB
#undef PG8_MMA
#undef PG8_WAIT_V
#undef PG8_WAIT_L
#undef PG8_BAR
#undef PG8_SCHED
}
}

#define XB_TMO      128
#define XB_XCNT(j)  (256  + 64 * (j))
#define XB_XSUB(j)  (1280 + 64 * (j))
#define XB_XGEN(j)  (2304 + 64 * (j))
#define XB_TOP      3328
#define XB_TOPGEN   3392
#define XCD_BAR_WORDS 3456
#define XB_SPIN_CAP (1u << 18)

__device__ __forceinline__ unsigned xb_ld(unsigned* p)              { return __hip_atomic_load(p, __ATOMIC_RELAXED, __HIP_MEMORY_SCOPE_AGENT); }
__device__ __forceinline__ unsigned xb_add(unsigned* p, unsigned v) { return __hip_atomic_fetch_add(p, v, __ATOMIC_RELAXED, __HIP_MEMORY_SCOPE_AGENT); }
__device__ __forceinline__ unsigned xb_xcc_id() { return (unsigned)__builtin_amdgcn_s_getreg((3 << 11) | 20) & 0xFu; }
#define XB_SPIN(cond, bar) do { unsigned _sp = 0; while (cond) { __builtin_amdgcn_s_sleep(1); \
    if ((++_sp & 255u) == 0u) { if (xb_ld(&(bar)[XB_TMO])) break; if (_sp > XB_SPIN_CAP) { atomicAdd(&(bar)[XB_TMO], 1u); break; } } } } while (0)

struct XcdBarrier {
    unsigned* bar; unsigned x;
    volatile LAS unsigned* st;
};

__device__ __forceinline__ XcdBarrier xcd_barrier_post(unsigned* bar, volatile LAS unsigned* st) {
    XcdBarrier b; b.bar = bar; b.x = xb_xcc_id(); b.st = st;
    if (threadIdx.x == 0) (void)xb_add(&bar[XB_XCNT(b.x)], 1u);
    return b;
}
__device__ __forceinline__ void xcd_barrier_complete(unsigned* bar, unsigned x, unsigned& nloc, unsigned& nx) {
    const unsigned G = gridDim.x * gridDim.y * gridDim.z;
    unsigned sum, cnt, mine, sp = 0u;
    for (;;) {
        sum = 0u; cnt = 0u; mine = 0u;
#pragma unroll
        for (unsigned j = 0; j < 16; ++j) { const unsigned c = xb_ld(&bar[XB_XCNT(j)]); sum += c; cnt += (c > 0u) ? 1u : 0u; mine = (j == x) ? c : mine; }
        if (sum == G) break;
        __builtin_amdgcn_s_sleep(1);
        if ((++sp & 255u) == 0u) { if (xb_ld(&bar[XB_TMO])) break; if (sp > XB_SPIN_CAP) { atomicAdd(&bar[XB_TMO], 1u); break; } }
    }
    nloc = mine > 0u ? mine : 1u; nx = cnt > 0u ? cnt : 1u;
}

__device__ __forceinline__ void xcd_barrier(const XcdBarrier& b) {
    asm volatile("s_waitcnt vmcnt(0)" ::: "memory");
    __syncthreads();
    if (threadIdx.x == 0) {
        unsigned* bar = b.bar;
        __builtin_amdgcn_s_waitcnt(0);
        unsigned nloc = b.st[0], nx = b.st[1];
        if (nloc == 0u) { xcd_barrier_complete(bar, b.x, nloc, nx); b.st[0] = nloc; b.st[1] = nx; }
        const unsigned old = xb_add(&bar[XB_XSUB(b.x)], 1u);
        const unsigned gen = old / nloc;
        if (old + 1u == (gen + 1u) * nloc) {
            __builtin_amdgcn_fence(__ATOMIC_RELEASE, "agent");
            asm volatile("s_waitcnt vmcnt(0)" ::: "memory");
            const unsigned og = xb_add(&bar[XB_TOP], 1u);
            const unsigned tg = og / nx;
            if (og + 1u == (tg + 1u) * nx) xb_add(&bar[XB_TOPGEN], 1u);
            else XB_SPIN(xb_ld(&bar[XB_TOPGEN]) == tg, bar);
            __builtin_amdgcn_fence(__ATOMIC_ACQUIRE, "agent");
            xb_add(&bar[XB_XGEN(b.x)], 1u);
            asm volatile("s_waitcnt vmcnt(0)" ::: "memory");
        } else {
            XB_SPIN(xb_ld(&bar[XB_XGEN(b.x)]) == gen, bar);
            __builtin_amdgcn_fence(__ATOMIC_ACQUIRE, "agent");
            asm volatile("s_waitcnt vmcnt(0)" ::: "memory");
        }
    }
    __syncthreads();
}

constexpr size_t MiB = 1u << 20;
constexpr size_t WS_CTL = 0, CTL_ZERO_BYTES = 1 * MiB;
constexpr size_t WS_MOD  = 1 * MiB;
constexpr size_t WS_WIN  = 2 * MiB;
constexpr size_t WS_WUQ  = 210 * MiB;
constexpr size_t WS_WKN  = 213 * MiB;
constexpr size_t WS_WV   = 214 * MiB;
constexpr size_t WS_WBR  = 215 * MiB;
constexpr size_t WS_WMIX = 247 * MiB;
constexpr size_t WS_W1   = 279 * MiB;
constexpr size_t WS_W2   = 535 * MiB;
constexpr size_t WS_X    = 663 * MiB;
constexpr size_t WS_H    = 735 * MiB;
constexpr size_t WS_U    = 771 * MiB;
constexpr size_t WS_CQN  = 1005 * MiB;
constexpr size_t WS_CKVN = 1014 * MiB;
constexpr size_t WS_KRP  = 1019 * MiB;
constexpr size_t WS_Q    = 1021 * MiB;
constexpr size_t WS_KN   = 1035 * MiB;
constexpr size_t WS_VT   = 1044 * MiB;
constexpr size_t WS_ACTS = 1053 * MiB;
constexpr size_t WS_YM   = 1089 * MiB;
constexpr size_t WS_SLOC = 1125 * MiB;
constexpr size_t WS_DEC  = 1161 * MiB;
constexpr size_t WS_SIN  = 1162 * MiB;
constexpr size_t WS_ETOK = 1261 * MiB, WS_ERS = 1262 * MiB, WS_ERW = 1263 * MiB;
constexpr size_t WS_ROUTE= 1180 * MiB;
constexpr size_t WS_HS   = 1181 * MiB;
constexpr size_t WS_ACTM = 1269 * MiB;
constexpr size_t WS_OUTS = 1291 * MiB;
constexpr size_t WS_W8   = 1379 * MiB;
constexpr size_t WS_H8   = 1483 * MiB;
constexpr size_t WS_RA   = 1501 * MiB;
constexpr size_t WS_RB   = 1501 * MiB + 64 * 1024;
constexpr size_t WS_RB1  = 1501 * MiB + 512 * 1024;
constexpr size_t WS_RSORT= 1501 * MiB + 768 * 1024;
constexpr size_t WS_RAF  = 1501 * MiB + 896 * 1024;
constexpr size_t WS_G8   = 1502 * MiB;
constexpr size_t WS_END  = 1574 * MiB;
constexpr int CW_BAR = 4096;
constexpr int CW_CNT = 16384;
constexpr int CW_CMAX = 131072;

constexpr int RING_BYTES = 131072;
constexpr int LDSX_OFF = RING_BYTES;
constexpr int LDS_BYTES = 147456;

struct Params { const float* in[34]; float* out; unsigned char* ws; int ph_lo, ph_hi; };
typedef const __attribute__((address_space(4))) Params* KParams;
enum { I_X = 0, I_C, I_CTX, I_CCTX, I_WMOD, I_BMOD, I_GMIX, I_GFFN, I_WIN, I_GQ, I_WUQ, I_GKV, I_WUKV, I_WMLAO, I_WCFDW, I_BCFDW, I_GCFLN, I_BCFLN, I_WCFO,
       I_WGF, I_BGF, I_WGB, I_BGB, I_GGLAN, I_WGLAO, I_WSCC, I_WSCO, I_WMIXO, I_WROUT, I_BROUT, I_WEG, I_WEU, I_WED, I_GFIN };

struct Frame { LAS unsigned char* lds; int tid, lane, wave, G, bid, gw, NGW; };

#define WSP(T, off) ((T*)(P->ws + (off)))
#define WSQ(T, off) ((T*)(Q->ws + (off)))
DI unsigned* ctl_words(KParams P) { return (unsigned*)(P->ws + WS_CTL); }
DI int mod_row(int row) { return row < TLAT ? (row >> 11) : 4; }

DI void transpose_item(const float* W, int N, bf16_t* WT, int KD, int dest_row0, int k0, int n0, LAS float* scr, int lane) {
#pragma unroll
    for (int i = 0; i < 32; ++i) { const int kk = 2 * i + (lane >> 5); scr[kk * 33 + (lane & 31)] = __builtin_nontemporal_load(W + (size_t)(k0 + kk) * N + n0 + (lane & 31)); }
    LDS_WAIT(); asm volatile("" ::: "memory");
    const int c = lane & 7;
#pragma unroll
    for (int j = 0; j < 4; ++j) { const int n = (lane >> 3) + 8 * j; const LAS float* s = scr + (8 * c) * 33 + n;
        u32x4 o; o.x = pk2(s[0 * 33], s[1 * 33]); o.y = pk2(s[2 * 33], s[3 * 33]); o.z = pk2(s[4 * 33], s[5 * 33]); o.w = pk2(s[6 * 33], s[7 * 33]);
        __builtin_nontemporal_store(o, (u32x4*)(WT + (size_t)(dest_row0 + n) * KD + k0 + 8 * c)); }
    LDS_WAIT(); asm volatile("" ::: "memory");
}
constexpr int SLAB_AUX = LDSX_OFF + 2048;
DI int slab_off(int k, int n) { return k * 64 + ((((n >> 1) ^ ((k >> 3) & 15)) << 2) | ((n & 1) << 1)); }
DI void slab_item(const float* W, int N, int n0, unsigned char* W8, int dest_row0, float* rB, Frame& F) {
    LAS float* wmax = (LAS float*)(F.lds + SLAB_AUX); LAS float* cmax = wmax + 256;
    { const int n = F.lane & 31, kp = F.lane >> 5; float m = 0.f;
#pragma unroll 1
      for (int j = 0; j < 4; ++j) { const int kb0 = (F.wave * 4 + j) * 64; float v[32];
#pragma unroll
          for (int i = 0; i < 32; ++i) v[i] = __builtin_nontemporal_load(W + (size_t)(kb0 + 2 * i + kp) * N + n0 + n);
#pragma unroll
          for (int i = 0; i < 32; ++i) { m = fmaxf(m, fabsf(v[i])); *(LAS bf16_t*)(F.lds + slab_off(kb0 + 2 * i + kp, n)) = f2bf(v[i]); } }
      m = fmaxf(m, __shfl_xor(m, 32)); if (F.lane < 32) wmax[F.wave * 32 + n] = m; }
    __syncthreads();
    if (F.tid < 32) { float c = 0.f;
#pragma unroll
        for (int w2 = 0; w2 < 8; ++w2) c = fmaxf(c, wmax[w2 * 32 + F.tid]);
        cmax[F.tid] = c; rB[dest_row0 + F.tid] = c * (1.f / 127.f); }
    __syncthreads();
    { const int nn = ((F.tid >> 3) & 7) + 8 * (F.wave & 3); const float cm = cmax[nn], sc = cm > 0.f ? 127.f / cm : 0.f;
#pragma unroll 4
      for (int i2 = 0; i2 < 16; ++i2) { const int c = (F.tid & 7) + 8 * i2 + 128 * (F.wave >> 2); unsigned q[8];
#pragma unroll
          for (int j = 0; j < 8; ++j) q[j] = q8(sc * bf2f(*(const LAS bf16_t*)(F.lds + slab_off(8 * c + j, nn))));
          u32x2 o; o.x = q[0] | (q[1] << 8) | (q[2] << 16) | (q[3] << 24); o.y = q[4] | (q[5] << 8) | (q[6] << 16) | (q[7] << 24);
          __builtin_nontemporal_store(o, (u32x2*)(W8 + (size_t)(dest_row0 + nn) * DM + 8 * c)); } }
    __syncthreads();
}
constexpr int NS_WIN = PW / 32, NS_EXP = 16 * 2 * (EFF / 32), NS_ALL = NS_WIN + NS_EXP;
DI void slab_dispatch(KParams P, Frame& F, int l, int sidx) {
    if (sidx < NS_WIN) { slab_item(P->in[I_WIN] + (size_t)l * DM * PW, PW, 32 * sidx, WSP(unsigned char, WS_W8) + (size_t)l * PWP * DM, wcol_dest(32 * sidx), WSP(float, WS_RB) + (size_t)l * PWP, F); return; }
    const int q = sidx - NS_WIN, e = q >> 5, which = (q >> 4) & 1, n0 = (q & 15) * 32, le = l * 16 + e;
    slab_item((which ? P->in[I_WEU] : P->in[I_WEG]) + (size_t)le * DM * EFF, EFF, n0, WSP(unsigned char, WS_W1) + (size_t)le * 1024 * DM, (n0 >> 7) * 256 + which * 128 + (n0 & 127), WSP(float, WS_RB1) + (size_t)le * 1024, F);
}
constexpr int NL_UQ = 8 * 24, NL_UKV = 4 * 32, NL_BR = 4 * 8 * 64, NL_MIX = 32 * 64, NL_ED = 16 * 8 * 64, NL_PAD = PWP - PW;
constexpr int NL_ITEMS = NL_UQ + NL_UKV + NL_BR + NL_MIX + NL_ED + NL_PAD;
constexpr int NL_F1 = (NL_ITEMS * 55) / 100, NL_F2 = (NL_ITEMS * 88) / 100;
DI void conv_item_layer(KParams P, int l, int it, LAS float* scr, int lane) {
    int r = it;
    if (r < NL_UQ) { const int kb = r / 24, nb = r % 24;
        transpose_item(P->in[I_WUQ] + (size_t)l * 512 * 768, 768, WSP(bf16_t, WS_WUQ) + (size_t)l * 768 * 512, 512, 32 * nb, 64 * kb, 32 * nb, scr, lane); return; } r -= NL_UQ;
    if (r < NL_UKV) { const int kb = r / 32, nb = r % 32, n0 = 32 * nb, hh = n0 >> 7, jj = n0 & 127;
        bf16_t* dst = (jj < 64 ? WSP(bf16_t, WS_WKN) : WSP(bf16_t, WS_WV)) + (size_t)l * 512 * 256;
        transpose_item(P->in[I_WUKV] + (size_t)l * 256 * 1024, 1024, dst, 256, hh * 64 + (jj & 63), 64 * kb, n0, scr, lane); return; } r -= NL_UKV;
    if (r < NL_BR) { const int br = r / 512, q = r % 512, kb = q / 64, nb = q % 64;
        const float* src = (br == 0 ? P->in[I_WMLAO] : br == 1 ? P->in[I_WCFO] : br == 2 ? P->in[I_WGLAO] : P->in[I_WSCO]) + (size_t)l * 512 * DM;
        transpose_item(src, DM, WSP(bf16_t, WS_WBR) + (size_t)(l * 4 + br) * DM * 512, 512, 32 * nb, 64 * kb, 32 * nb, scr, lane); return; } r -= NL_BR;
    if (r < NL_MIX) { const int kb = r / 64, nb = r % 64;
        transpose_item(P->in[I_WMIXO] + (size_t)l * DM * DM, DM, WSP(bf16_t, WS_WMIX) + (size_t)l * DM * DM, DM, 32 * nb, 64 * kb, 32 * nb, scr, lane); return; } r -= NL_MIX;
    if (r < NL_ED) { const int e = r / 512, q = r % 512, kb = q / 64, nb = q % 64, le = l * 16 + e;
        transpose_item(P->in[I_WED] + (size_t)le * EFF * DM, DM, WSP(bf16_t, WS_W2) + (size_t)le * DM * EFF, EFF, 32 * nb, 64 * kb, 32 * nb, scr, lane); return; } r -= NL_ED;
    { unsigned char* row = WSP(unsigned char, WS_W8) + ((size_t)l * PWP + O_MG + r) * DM;
#pragma unroll
      for (int j = 0; j < 2; ++j) *(u32x4*)(row + 16 * lane + 1024 * j) = (u32x4){0u, 0u, 0u, 0u};
      if (lane == 0) WSP(float, WS_RB)[(size_t)l * PWP + O_MG + r] = 0.f; }
}
DI void conv_mixed(KParams P, Frame& F, int l, int s_lo, int s_hi, int w_lo, int w_hi, int rank, int nrank) {
    if (rank < 0) return;
    for (int sidx = s_lo + rank; sidx < s_hi; sidx += nrank) slab_dispatch(P, F, l, sidx);
    LAS float* scr = (LAS float*)(F.lds + F.wave * 8448);
    for (int it = w_lo + rank * 8 + F.wave; it < w_hi; it += nrank * 8) conv_item_layer(P, l, it, scr, F.lane);
    __syncthreads();
}
DI void mod_item(KParams P, Frame& F, int it) {
    const int l = it / 192, n0 = (it % 192) * 64;
    const LAS float* sil = (const LAS float*)F.lds;
    LAS float* red = (LAS float*)(F.lds + 40960);
    const int kq = F.lane >> 4, ln = F.lane & 15;
    const float* wp = P->in[I_WMOD] + (size_t)l * DM * (6 * DM) + n0 + 4 * ln;
    f32x4 acc[5];
#pragma unroll
    for (int r = 0; r < 5; ++r) acc[r] = (f32x4){0.f, 0.f, 0.f, 0.f};
    const int kbase = F.wave * 256 + kq;
#pragma unroll 8
    for (int kk = 0; kk < 64; ++kk) { const int k = kbase + 4 * kk; const f32x4 wv = *(const f32x4*)(wp + (size_t)k * (6 * DM));
#pragma unroll
        for (int r = 0; r < 5; ++r) acc[r] = acc[r] + wv * sil[r * DM + k]; }
    const int grp = F.wave * 4 + kq;
#pragma unroll
    for (int r = 0; r < 5; ++r) *(LAS f32x4*)(red + (grp * 5 + r) * 64 + 4 * ln) = acc[r];
    __syncthreads();
    if (F.tid < 320) { const int r = F.tid >> 6, n = F.tid & 63; float s = P->in[I_BMOD][(size_t)l * (6 * DM) + n0 + n];
        for (int g = 0; g < 32; ++g) s += red[(g * 5 + r) * 64 + n];
        WSP(float, WS_MOD)[(size_t)(l * 5 + r) * (6 * DM) + n0 + n] = s; }
    __syncthreads();
}
DI void phase_prologue(KParams P, Frame& F) {
    LAS float* sil = (LAS float*)F.lds;
    for (int i = F.tid; i < 5 * DM; i += 512) { const int r = i >> 11, k = i & (DM - 1); const float c = r < 4 ? P->in[I_C][r * DM + k] : P->in[I_CCTX][k]; sil[i] = c / (1.f + expf(-c)); }
    __syncthreads();
    for (int it = F.bid; it < DEPTH * 192; it += F.G) mod_item(P, F, it);
    __syncthreads();
}

DI void moe_table(KParams P, Frame& F, int l) {
    LAS int* tp = (LAS int*)(F.lds + LDSX_OFF + 64); LAS int* cn = tp + 32;
    if (F.tid == 0) { const unsigned* cnt = ctl_words(P) + CW_CNT + l * 16 * 64; int a = 0;
        for (int e = 0; e < 16; ++e) { const int c = (int)__hip_atomic_load(cnt + e * 64, __ATOMIC_RELAXED, __HIP_MEMORY_SCOPE_AGENT); tp[e] = a; cn[e] = c; a += (c + 255) >> 8; }
        tp[16] = a; }
    __syncthreads();
}
DI void phase_norm1(KParams P, Frame& F, int l, bool dummy) {
    bf16_t* X = WSP(bf16_t, WS_X); bf16_t* XO = dummy ? WSP(bf16_t, WS_HS) : X; bf16_t* H = WSP(bf16_t, WS_H); const float* mod = WSP(float, WS_MOD); const bf16_t* outs = WSP(bf16_t, WS_OUTS);
    const int* rt_e = (const int*)(P->ws + WS_ROUTE); const int* rt_slot = (const int*)(P->ws + WS_ROUTE + 2 * 73728); const LAS int* tp = (const LAS int*)(F.lds + LDSX_OFF + 64);
    if (l > 0) moe_table(P, F, l - 1);
    for (int row = F.gw; row < TT; row += F.NGW) {
        const int r = mod_row(row);
        f32x4 v[8];
        if (l == 0) { const float* src = row < TLAT ? P->in[I_X] + (size_t)row * DM : P->in[I_CTX] + (size_t)(row - TLAT) * DM;
#pragma unroll
            for (int j = 0; j < 8; ++j) v[j] = *(const f32x4*)(src + 4 * F.lane + 256 * j); }
        else {
#pragma unroll
            for (int j = 0; j < 8; ++j) { const u32x2 w = *(const u32x2*)(X + (size_t)row * DM + 4 * F.lane + 256 * j); v[j] = (f32x4){bflo(w.x), bfhi(w.x), bflo(w.y), bfhi(w.y)}; } }
        if (l > 0) { const int p0 = tp[rt_e[2 * row]] * 256 + rt_slot[2 * row], p1 = tp[rt_e[2 * row + 1]] * 256 + rt_slot[2 * row + 1]; const float* gt = mod + (size_t)((l - 1) * 5 + r) * (6 * DM) + 5 * DM;
#pragma unroll
            for (int j = 0; j < 8; ++j) { const int c = 4 * F.lane + 256 * j; const f32x4 g = *(const f32x4*)(gt + c);
                const u32x2 a = *(const u32x2*)(outs + (size_t)p0 * DM + c), b = *(const u32x2*)(outs + (size_t)p1 * DM + c);
                v[j][0] += g[0] * (bflo(a.x) + bflo(b.x)); v[j][1] += g[1] * (bfhi(a.x) + bfhi(b.x)); v[j][2] += g[2] * (bflo(a.y) + bflo(b.y)); v[j][3] += g[3] * (bfhi(a.y) + bfhi(b.y)); } }
        float ss = 0.f;
#pragma unroll
        for (int j = 0; j < 8; ++j) { *(u32x2*)(XO + (size_t)row * DM + 4 * F.lane + 256 * j) = (u32x2){pk2(v[j][0], v[j][1]), pk2(v[j][2], v[j][3])}; ss += (v[j][0] * v[j][0] + v[j][1] * v[j][1]) + (v[j][2] * v[j][2] + v[j][3] * v[j][3]); }
        const float rstd = 1.f / sqrtf(wave_sum(ss) * (1.f / DM) + EPS);
        const float* mp = mod + (size_t)(l * 5 + r) * (6 * DM); const float* gm = P->in[I_GMIX] + (size_t)l * DM; float am = 0.f;
#pragma unroll
        for (int j = 0; j < 8; ++j) { const int c = 4 * F.lane + 256 * j; const f32x4 g = *(const f32x4*)(gm + c), sh = *(const f32x4*)(mp + c), sc = *(const f32x4*)(mp + DM + c);
            v[j] = (v[j] * rstd * g) * (sc + 1.f) + sh; am = fmaxf(fmaxf(am, fmaxf(fabsf(v[j][0]), fabsf(v[j][1]))), fmaxf(fabsf(v[j][2]), fabsf(v[j][3]))); }
#pragma unroll
        for (int o = 1; o < 64; o <<= 1) am = fmaxf(am, __shfl_xor(am, o));
        const float qs = am > 0.f ? 127.f / am : 0.f;
#pragma unroll
        for (int j = 0; j < 8; ++j) { const int c = 4 * F.lane + 256 * j;
            *(unsigned*)(WSP(unsigned char, WS_H8) + (size_t)row * DM + c) = q8(v[j][0] * qs) | (q8(v[j][1] * qs) << 8) | (q8(v[j][2] * qs) << 16) | (q8(v[j][3] * qs) << 24); }
        if (F.lane == 0) WSP(float, WS_RA)[row] = am * (1.f / 127.f);
    }
}
DI void phase_final(KParams P, Frame& F) {
    const bf16_t* X = WSP(bf16_t, WS_X); const float* mod = WSP(float, WS_MOD); const bf16_t* outs = WSP(bf16_t, WS_OUTS);
    const int* rt_e = (const int*)(P->ws + WS_ROUTE); const int* rt_slot = (const int*)(P->ws + WS_ROUTE + 2 * 73728); const LAS int* tp = (const LAS int*)(F.lds + LDSX_OFF + 64);
    moe_table(P, F, DEPTH - 1);
    for (int row = F.gw; row < TLAT; row += F.NGW) {
        const int r = mod_row(row); const int p0 = tp[rt_e[2 * row]] * 256 + rt_slot[2 * row], p1 = tp[rt_e[2 * row + 1]] * 256 + rt_slot[2 * row + 1]; const float* gt = mod + (size_t)((DEPTH - 1) * 5 + r) * (6 * DM) + 5 * DM;
        f32x4 v[8]; float ss = 0.f;
#pragma unroll
        for (int j = 0; j < 8; ++j) { const int c = 4 * F.lane + 256 * j; { const u32x2 w = *(const u32x2*)(X + (size_t)row * DM + c); v[j] = (f32x4){bflo(w.x), bfhi(w.x), bflo(w.y), bfhi(w.y)}; } const f32x4 g = *(const f32x4*)(gt + c);
            const u32x2 a = *(const u32x2*)(outs + (size_t)p0 * DM + c), b = *(const u32x2*)(outs + (size_t)p1 * DM + c);
            v[j][0] += g[0] * (bflo(a.x) + bflo(b.x)); v[j][1] += g[1] * (bfhi(a.x) + bfhi(b.x)); v[j][2] += g[2] * (bflo(a.y) + bflo(b.y)); v[j][3] += g[3] * (bfhi(a.y) + bfhi(b.y));
            ss += (v[j][0] * v[j][0] + v[j][1] * v[j][1]) + (v[j][2] * v[j][2] + v[j][3] * v[j][3]); }
        const float rstd = 1.f / sqrtf(wave_sum(ss) * (1.f / DM) + EPS);
#pragma unroll
        for (int j = 0; j < 8; ++j) { const int c = 4 * F.lane + 256 * j; const f32x4 g = *(const f32x4*)(P->in[I_GFIN] + c); *(f32x4*)(P->out + (size_t)row * DM + c) = v[j] * rstd * g; }
    }
}
DI float ffn_input_row(KParams P, Frame& F, int l, int row, f32x4 (&v)[8]) {
    const bf16_t* X = WSP(bf16_t, WS_X); unsigned char* H8 = WSP(unsigned char, WS_H); const float* mod = WSP(float, WS_MOD);
    const int r = mod_row(row); float ss = 0.f;
#pragma unroll
    for (int j = 0; j < 8; ++j) { { const u32x2 w = *(const u32x2*)(X + (size_t)row * DM + 4 * F.lane + 256 * j); v[j] = (f32x4){bflo(w.x), bfhi(w.x), bflo(w.y), bfhi(w.y)}; } ss += (v[j][0] * v[j][0] + v[j][1] * v[j][1]) + (v[j][2] * v[j][2] + v[j][3] * v[j][3]); }
    const float rstd = 1.f / sqrtf(wave_sum(ss) * (1.f / DM) + EPS);
    const float* mp = mod + (size_t)(l * 5 + r) * (6 * DM); const float* gm = P->in[I_GFFN] + (size_t)l * DM; float am = 0.f;
#pragma unroll
    for (int j = 0; j < 8; ++j) { const int c = 4 * F.lane + 256 * j; const f32x4 g = *(const f32x4*)(gm + c), sh = *(const f32x4*)(mp + 3 * DM + c), sc = *(const f32x4*)(mp + 4 * DM + c);
        v[j] = (v[j] * rstd * g) * (sc + 1.f) + sh; am = fmaxf(fmaxf(am, fmaxf(fabsf(v[j][0]), fabsf(v[j][1]))), fmaxf(fabsf(v[j][2]), fabsf(v[j][3]))); }
#pragma unroll
    for (int o = 1; o < 64; o <<= 1) am = fmaxf(am, __shfl_xor(am, o));
    const float qs = am > 0.f ? 127.f / am : 0.f;
#pragma unroll
    for (int j = 0; j < 8; ++j) { const int c = 4 * F.lane + 256 * j;
        *(unsigned*)(H8 + (size_t)row * DM + c) = q8(v[j][0] * qs) | (q8(v[j][1] * qs) << 8) | (q8(v[j][2] * qs) << 16) | (q8(v[j][3] * qs) << 24); }
    return am * (1.f / 127.f);
}
DI void route_decide(const float (&lg)[16], const float (&br)[16], int& e1, int& e2, float& wa, float& wb) {
    float aff[16], sel[16];
#pragma unroll
    for (int e = 0; e < 16; ++e) { aff[e] = __builtin_amdgcn_rcpf(1.f + expf(-lg[e])); sel[e] = aff[e] + br[e]; }
    int best = 0; float bestv = -INFINITY;
#pragma unroll
    for (int g = 0; g < 4; ++g) { const float a = sel[4 * g], b = sel[4 * g + 1], c = sel[4 * g + 2], d = sel[4 * g + 3];
        const float hi1 = fmaxf(a, b), lo1 = fminf(a, b), hi2 = fmaxf(c, d), lo2 = fminf(c, d);
        const float gs = fmaxf(hi1, hi2) + fmaxf(fminf(hi1, hi2), fmaxf(lo1, lo2));
        if (gs > bestv) { bestv = gs; best = g; } }
    float s4[4] = {0.f, 0.f, 0.f, 0.f}, a4[4] = {0.f, 0.f, 0.f, 0.f};
#pragma unroll
    for (int g = 0; g < 4; ++g)
#pragma unroll
        for (int j = 0; j < 4; ++j) { s4[j] = (best == g) ? sel[4 * g + j] : s4[j]; a4[j] = (best == g) ? aff[4 * g + j] : a4[j]; }
    int i1 = 0; float m1 = s4[0];
#pragma unroll
    for (int j = 1; j < 4; ++j) if (s4[j] > m1) { m1 = s4[j]; i1 = j; }
    int i2 = -1; float m2 = -INFINITY;
#pragma unroll
    for (int j = 0; j < 4; ++j) if (j != i1 && s4[j] > m2) { m2 = s4[j]; i2 = j; }
    float w1 = 0.f, w2 = 0.f;
#pragma unroll
    for (int j = 0; j < 4; ++j) { w1 = (j == i1) ? a4[j] : w1; w2 = (j == i2) ? a4[j] : w2; }
    const float inv = 1.f / (w1 + w2);
    e1 = 4 * best + i1; e2 = 4 * best + i2; wa = w1 * inv; wb = w2 * inv;
}
DI void phase_norm2_route(KParams P, Frame& F, int l, int cbank) {
    int* rt_e = (int*)(P->ws + WS_ROUTE); int* rt_slot = (int*)(P->ws + WS_ROUTE + 2 * 73728);
    int* etok = (int*)(P->ws + WS_ETOK); float* ers = (float*)(P->ws + WS_ERS); float* erw = (float*)(P->ws + WS_ERW);
    unsigned* cnt = ctl_words(P) + CW_CNT + cbank * 16 * 64;
    LAS float* wrT = (LAS float*)F.lds;
    for (int k = F.tid; k < DM; k += 512) { const f32x4* wp = (const f32x4*)(P->in[I_WROUT] + (size_t)k * 16);
#pragma unroll
        for (int q = 0; q < 4; ++q) { const f32x4 w = wp[q]; wrT[(4 * q + 0) * DM + k] = w[0]; wrT[(4 * q + 1) * DM + k] = w[1]; wrT[(4 * q + 2) * DM + k] = w[2]; wrT[(4 * q + 3) * DM + k] = w[3]; } }
    float br[16];
#pragma unroll
    for (int e = 0; e < 16; ++e) br[e] = P->in[I_BROUT][e];
    const int nrows = (l == DEPTH - 1) ? TLAT : TT;
    const int rpb = (nrows + F.G - 1) / F.G, row0 = F.bid * rpb, row1 = (row0 + rpb < nrows) ? row0 + rpb : nrows;
    LAS int* lcnt = (LAS int*)(F.lds + LDSX_OFF + 512); LAS int* lbase = lcnt + 16; LAS int* lre = lcnt + 32; LAS int* lri = lcnt + 112; LAS float* lrw = (LAS float*)(lcnt + 192); LAS float* lrs = (LAS float*)(lcnt + 272);
    if (F.tid < 16) lcnt[F.tid] = 0;
    __syncthreads();
#pragma unroll 1
    for (int lr = 2 * F.wave; row0 + lr < row1; lr += 16) {
        const bool hasB = row0 + lr + 1 < row1; const int rowA = row0 + lr, rowB = hasB ? rowA + 1 : rowA;
        f32x4 va[8], vb[8]; const float sA = ffn_input_row(P, F, l, rowA, va), sB = ffn_input_row(P, F, l, rowB, vb);
        f32x2_t lab[16];
#pragma unroll
        for (int e = 0; e < 16; ++e) lab[e] = (f32x2_t){0.f, 0.f};
#pragma unroll
        for (int j = 0; j < 8; ++j) {
            const f32x2_t x0 = (f32x2_t){va[j][0], vb[j][0]}, x1 = (f32x2_t){va[j][1], vb[j][1]}, x2 = (f32x2_t){va[j][2], vb[j][2]}, x3 = (f32x2_t){va[j][3], vb[j][3]};
#pragma unroll
            for (int e = 0; e < 16; ++e) { const f32x4 w = *(const LAS f32x4*)(wrT + e * DM + 4 * F.lane + 256 * j);
                lab[e] = __builtin_elementwise_fma(x3, (f32x2_t){w[3], w[3]}, __builtin_elementwise_fma(x2, (f32x2_t){w[2], w[2]}, __builtin_elementwise_fma(x1, (f32x2_t){w[1], w[1]}, __builtin_elementwise_fma(x0, (f32x2_t){w[0], w[0]}, lab[e])))); }
            asm volatile("" ::: "memory"); }
        float la[16], lb[16];
#pragma unroll
        for (int e = 0; e < 16; ++e) { la[e] = wave_sum(lab[e][0]); lb[e] = wave_sum(lab[e][1]); }
        int e1, e2, f1, f2; float wa, wb, xa, xb; route_decide(la, br, e1, e2, wa, wb); route_decide(lb, br, f1, f2, xa, xb);
        if (F.lane == 0) {
            const int j1 = __hip_atomic_fetch_add(lcnt + e1, 1, __ATOMIC_RELAXED, __HIP_MEMORY_SCOPE_WORKGROUP), j2 = __hip_atomic_fetch_add(lcnt + e2, 1, __ATOMIC_RELAXED, __HIP_MEMORY_SCOPE_WORKGROUP);
            lre[2 * lr] = e1; lre[2 * lr + 1] = e2; lri[2 * lr] = j1; lri[2 * lr + 1] = j2;
            rt_e[2 * rowA] = e1; rt_e[2 * rowA + 1] = e2; lrw[2 * lr] = wa; lrw[2 * lr + 1] = wb; lrs[lr] = sA;
            if (hasB) { const int k1 = __hip_atomic_fetch_add(lcnt + f1, 1, __ATOMIC_RELAXED, __HIP_MEMORY_SCOPE_WORKGROUP), k2 = __hip_atomic_fetch_add(lcnt + f2, 1, __ATOMIC_RELAXED, __HIP_MEMORY_SCOPE_WORKGROUP);
                lre[2 * lr + 2] = f1; lre[2 * lr + 3] = f2; lri[2 * lr + 2] = k1; lri[2 * lr + 3] = k2;
                rt_e[2 * rowB] = f1; rt_e[2 * rowB + 1] = f2; lrw[2 * lr + 2] = xa; lrw[2 * lr + 3] = xb; lrs[lr + 1] = sB; } }
    }
    __syncthreads();
    if (F.tid < 16) lbase[F.tid] = (int)atomicAdd(cnt + F.tid * 64, (unsigned)lcnt[F.tid]);
    __syncthreads();
    if (F.tid < 2 * (row1 - row0)) { const int e = lre[F.tid], sl = lbase[e] + lri[F.tid]; rt_slot[2 * row0 + F.tid] = sl;
        etok[e * TT + sl] = row0 + (F.tid >> 1); ers[e * TT + sl] = lrs[F.tid >> 1]; erw[e * TT + sl] = lrw[F.tid]; }
    __syncthreads();
}
DI float rope_freq(int i) { return __expf(-1.1512925465f * (float)i); }
DI void mla_prep_rows(KParams P, Frame& F, int l) {
    const bf16_t* U = WSP(bf16_t, WS_U); bf16_t* cqn = WSP(bf16_t, WS_CQN); bf16_t* ckvn = WSP(bf16_t, WS_CKVN); bf16_t* krp = WSP(bf16_t, WS_KRP);
    for (int row = F.gw; row < TT; row += F.NGW) {
        const bf16_t* up = U + (size_t)row * PWP;
        { const u32x4 a = *(const u32x4*)(up + O_CQ + 8 * F.lane); float f[8] = {bflo(a.x), bfhi(a.x), bflo(a.y), bfhi(a.y), bflo(a.z), bfhi(a.z), bflo(a.w), bfhi(a.w)};
          float ss = 0.f;
#pragma unroll
          for (int i = 0; i < 8; ++i) ss += f[i] * f[i];
          const float rstd = 1.f / sqrtf(wave_sum(ss) * (1.f / 512.f) + EPS); const float* g = P->in[I_GQ] + l * 512 + 8 * F.lane;
          u32x4 o; o.x = pk2(f[0] * rstd * g[0], f[1] * rstd * g[1]); o.y = pk2(f[2] * rstd * g[2], f[3] * rstd * g[3]); o.z = pk2(f[4] * rstd * g[4], f[5] * rstd * g[5]); o.w = pk2(f[6] * rstd * g[6], f[7] * rstd * g[7]);
          *(u32x4*)(cqn + (size_t)row * 512 + 8 * F.lane) = o; }
        { const u32x2 a = *(const u32x2*)(up + O_CKV + 4 * F.lane); float f[4] = {bflo(a.x), bfhi(a.x), bflo(a.y), bfhi(a.y)};
          const float ss = (f[0] * f[0] + f[1] * f[1]) + (f[2] * f[2] + f[3] * f[3]);
          const float rstd = 1.f / sqrtf(wave_sum(ss) * (1.f / 256.f) + EPS); const float* g = P->in[I_GKV] + l * 256 + 4 * F.lane;
          u32x2 o; o.x = pk2(f[0] * rstd * g[0], f[1] * rstd * g[1]); o.y = pk2(f[2] * rstd * g[2], f[3] * rstd * g[3]);
          *(u32x2*)(ckvn + (size_t)row * 256 + 4 * F.lane) = o; }
        { const int e = F.lane; float val = 0.f;
          if (row < TLAT) { if (e < 32) { const int pos = row & (SEQ - 1), part = e >> 4, idx = e & 15, i = idx & 7, second = idx >> 3;
                  const float t1 = bf2f(up[O_KR + 16 * part + i]), t2 = bf2f(up[O_KR + 16 * part + 8 + i]);
                  const float ang = (float)(part ? (pos & 63) : (pos >> 6)) * rope_freq(i); const float sn = __sinf(ang), cs = __cosf(ang);
                  val = second ? (t1 * sn + t2 * cs) : (t1 * cs - t2 * sn); } }
          else { if (e >= 32) val = bf2f(up[O_KR + e - 32]); }
          krp[(size_t)row * 64 + e] = f2bf(val); }
    }
}
DI void cf_sc_tile(KParams P, Frame& F, int l, int ti) {
    const bf16_t* U = WSP(bf16_t, WS_U); bf16_t* acts = WSP(bf16_t, WS_ACTS);
    const int row0 = ti * 32; int seg_lo, seg_hi;
    if (row0 < TLAT) { seg_lo = row0 & ~(SEQ - 1); seg_hi = seg_lo + SEQ; } else { seg_lo = TLAT + ((row0 - TLAT) & ~(CTXL - 1)); seg_hi = seg_lo + CTXL; }
    LAS bf16_t* gl = (LAS bf16_t*)F.lds;
    LAS float* co = (LAS float*)(F.lds + 63488);
    const int c2 = F.tid & 255, th = F.tid >> 8;
    { const bf16_t* ub = U + O_SC + 2 * c2; const float* wp = P->in[I_WSCC] + (size_t)l * 3 * 512 + 2 * c2;
      const float w0a = wp[0], w0b = wp[1], w1a = wp[512], w1b = wp[513], w2a = wp[1024], w2b = wp[1025];
      unsigned pc[18], ph[18], gb[16];
#pragma unroll
      for (int k = 0; k < 18; ++k) { const int rr = row0 + 16 * th - 1 + k; const bool ok = rr >= seg_lo && rr < seg_hi;
          pc[k] = ok ? *(const unsigned*)(ub + (size_t)rr * PWP + 512) : 0u; ph[k] = ok ? *(const unsigned*)(ub + (size_t)rr * PWP + 1024) : 0u; }
#pragma unroll
      for (int k = 0; k < 16; ++k) gb[k] = *(const unsigned*)(ub + (size_t)(row0 + 16 * th + k) * PWP);
      float pa[18], pb[18];
#pragma unroll
      for (int k = 0; k < 18; ++k) { pa[k] = bflo(pc[k]) * bflo(ph[k]); pb[k] = bfhi(pc[k]) * bfhi(ph[k]); }
#pragma unroll
      for (int k = 0; k < 16; ++k) *(unsigned*)(acts + ((size_t)3 * TT + row0 + 16 * th + k) * 512 + 2 * c2) =
          pk2(bflo(gb[k]) * (w0a * pa[k] + w1a * pa[k + 1] + w2a * pa[k + 2]), bfhi(gb[k]) * (w0b * pb[k] + w1b * pb[k + 1] + w2b * pb[k + 2])); }
    { const int cg = F.tid & 63, ri = F.tid >> 6; u32x4 ga[8], gbv[8];
#pragma unroll
      for (int pass = 0; pass < 8; ++pass) { const int i = pass * 8 + ri, rr = row0 - 15 + i; const bool ok = i < 62 && rr >= seg_lo && rr < seg_hi;
          const bf16_t* up = U + (size_t)(ok ? rr : row0) * PWP + O_CF + 8 * cg; ga[pass] = *(const u32x4*)up; gbv[pass] = *(const u32x4*)(up + 512); }
#pragma unroll
      for (int pass = 0; pass < 8; ++pass) { const int i = pass * 8 + ri, rr = row0 - 15 + i; const bool ok = rr >= seg_lo && rr < seg_hi;
          if (i < 62) { const u32x4 a = ga[pass], b = gbv[pass]; u32x4 o;
              o.x = pk2(bflo(a.x) * sigm(bflo(b.x)), bfhi(a.x) * sigm(bfhi(b.x))); o.y = pk2(bflo(a.y) * sigm(bflo(b.y)), bfhi(a.y) * sigm(bfhi(b.y)));
              o.z = pk2(bflo(a.z) * sigm(bflo(b.z)), bfhi(a.z) * sigm(bfhi(b.z))); o.w = pk2(bflo(a.w) * sigm(bflo(b.w)), bfhi(a.w) * sigm(bfhi(b.w)));
              if (!ok) o = (u32x4){0u, 0u, 0u, 0u};
              *(LAS u32x4*)(gl + i * 512 + 8 * cg) = o; } } }
    asm volatile("" ::: "memory");
    float wva[31], wvb[31];
#pragma unroll
    for (int j = 0; j < 31; ++j) { const f32x2_t w = *(const f32x2_t*)(P->in[I_WCFDW] + (size_t)(l * 31 + j) * 512 + 2 * c2); wva[j] = w[0]; wvb[j] = w[1]; }
    const f32x2_t bias = *(const f32x2_t*)(P->in[I_BCFDW] + l * 512 + 2 * c2);
    __syncthreads();
#pragma unroll 1
    for (int hb = 0; hb < 2; ++hb) { const LAS unsigned* gp = (const LAS unsigned*)(gl + (16 * th + 8 * hb) * 512 + 2 * c2); f32x2_t xin[38];
#pragma unroll
      for (int i = 0; i < 38; ++i) { const unsigned x = gp[i * 256]; xin[i] = (f32x2_t){bflo(x), bfhi(x)}; }
#pragma unroll
      for (int t = 0; t < 8; ++t) { f32x2_t a = bias;
#pragma unroll
          for (int j = 0; j < 31; ++j) a = __builtin_elementwise_fma((f32x2_t){wva[j], wvb[j]}, xin[t + j], a);
          *(LAS f32x2_t*)(co + (16 * th + 8 * hb + t) * 512 + 2 * c2) = a; } }
    __syncthreads();
#pragma unroll 1
    for (int tt = 0; tt < 4; ++tt) { const int t = F.wave * 4 + tt; const LAS float* cr = co + t * 512 + 8 * F.lane;
        const f32x4 a = *(const LAS f32x4*)cr, b = *(const LAS f32x4*)(cr + 4);
        float x[8] = {a[0], a[1], a[2], a[3], b[0], b[1], b[2], b[3]}; float s = 0.f;
#pragma unroll
        for (int i = 0; i < 8; ++i) s += x[i];
        const float mean = wave_sum(s) * (1.f / 512.f); float q = 0.f;
#pragma unroll
        for (int i = 0; i < 8; ++i) { x[i] -= mean; q += x[i] * x[i]; }
        const float rstd = 1.f / sqrtf(wave_sum(q) * (1.f / 512.f) + EPS);
        const float* g = P->in[I_GCFLN] + l * 512 + 8 * F.lane; const float* bb = P->in[I_BCFLN] + l * 512 + 8 * F.lane; float y[8];
#pragma unroll
        for (int i = 0; i < 8; ++i) y[i] = siluf(x[i] * rstd * g[i] + bb[i]);
        u32x4 o; o.x = pk2(y[0], y[1]); o.y = pk2(y[2], y[3]); o.z = pk2(y[4], y[5]); o.w = pk2(y[6], y[7]);
        *(u32x4*)(acts + ((size_t)1 * TT + row0 + t) * 512 + 8 * F.lane) = o; }
    __syncthreads();
}

constexpr int GPD = 72;
constexpr int GL_LOW = 0, GL_GSUM = 8192, GL_VT = 10240, GL_A0 = 28672, GL_KD = 37888, GL_QI = 47104, GL_ST = 56320, GL_PP = 74752, GL_OB = 83968;
DI void gla_chunk_decode(int ci, int& b, int& row0, int& jf, int& jb) {
    if (ci < 128) { b = ci >> 5; const int c = ci & 31; row0 = b * SEQ + c * 64; jf = 4 + c; jb = 4 + (31 - c); }
    else { const int cc = ci - 128; b = cc >> 2; const int c = cc & 3; row0 = TLAT + b * CTXL + c * 64; jf = c; jb = 3 - c; }
}
DI int gla_cidx(int b, int hh, int dir, int j) { return ((b * 4 + hh) * 2 + dir) * NCHAIN + j; }
DI void lds_mma_nt(f32x16& acc, const LAS bf16_t* A, int a_row0, const LAS bf16_t* B, int b_row0, int r, int h) {
#pragma unroll
    for (int k0 = 0; k0 < 64; k0 += 16) {
        const bf16x8 a = *(const LAS bf16x8*)(A + (a_row0 + r) * GPD + k0 + 8 * h);
        const bf16x8 b = *(const LAS bf16x8*)(B + (b_row0 + r) * GPD + k0 + 8 * h);
        acc = __builtin_amdgcn_mfma_f32_32x32x16_bf16(a, b, acc, 0, 0, 0);
    }
}
DI float logsig(float z) { return fminf(z, 0.f) - __logf(1.f + __expf(-fabsf(z))); }
DI void gla_decay(Frame& F, int dir, const float (&w2v)[16], float b2, float (&cs)[8], float& off, float& total, float& mid) {
    const LAS float* low = (const LAS float*)(F.lds + GL_LOW); LAS float* gsum = (LAS float*)(F.lds + GL_GSUM);
    const int d = F.tid & 63, tg = F.tid >> 6;
    float la[8];
#pragma unroll
    for (int i = 0; i < 8; ++i) { const LAS float* lp = low + (tg * 8 + i) * 32 + dir * 16; float z = b2;
#pragma unroll
        for (int j = 0; j < 16; ++j) z += lp[j] * w2v[j];
        la[i] = logsig(z) * (1.f / 16.f); }
    if (dir == 0) { cs[0] = la[0];
#pragma unroll
        for (int i = 1; i < 8; ++i) cs[i] = cs[i - 1] + la[i];
        gsum[tg * 64 + d] = cs[7]; }
    else { cs[7] = la[7];
#pragma unroll
        for (int i = 6; i >= 0; --i) cs[i] = cs[i + 1] + la[i];
        gsum[tg * 64 + d] = cs[0]; }
    __syncthreads();
    float g[8];
#pragma unroll
    for (int q = 0; q < 8; ++q) g[q] = gsum[q * 64 + d];
    total = 0.f; off = 0.f; mid = 0.f;
#pragma unroll
    for (int q = 0; q < 8; ++q) { total += g[q]; if (dir == 0) { off += (q < tg) ? g[q] : 0.f; mid += (q <= 3) ? g[q] : 0.f; } else { off += (q > tg) ? g[q] : 0.f; mid += (q >= 4) ? g[q] : 0.f; } }
}
#define GLA_PRELOAD() \
    const int d = F.tid & 63, tg = F.tid >> 6, dcol = hh * 64 + d; \
    const u32x2 loww = *(const u32x2*)(U + (size_t)(row0 + (F.tid >> 3)) * PWP + O_GF + (F.tid & 7) * 4); \
    const u32x4 vva = *(const u32x4*)(U + (size_t)(row0 + (F.tid >> 3)) * PWP + O_GV + hh * 128 + (F.tid & 7) * 16), vvb = *(const u32x4*)(U + (size_t)(row0 + (F.tid >> 3)) * PWP + O_GV + hh * 128 + (F.tid & 7) * 16 + 8); \
    float w2f[16], w2b[16]; \
    _Pragma("unroll") for (int j = 0; j < 16; ++j) { w2f[j] = P->in[I_WGF][(size_t)l * 16 * 256 + j * 256 + dcol]; w2b[j] = P->in[I_WGB][(size_t)l * 16 * 256 + j * 256 + dcol]; } \
    const float b2f = P->in[I_BGF][l * 256 + dcol], b2b = P->in[I_BGB][l * 256 + dcol]; \
    float kraw[8]; \
    _Pragma("unroll") for (int i = 0; i < 8; ++i) kraw[i] = bf2f(U[(size_t)(row0 + tg * 8 + i) * PWP + O_GK + hh * 64 + d]);
#define GLA_STAGE_LOW_VT() do { LAS float* low_ = (LAS float*)(F.lds + GL_LOW); const int t_ = F.tid >> 3, j4_ = (F.tid & 7) * 4, v16_ = (F.tid & 7) * 16; \
    low_[t_ * 32 + j4_] = bflo(loww.x); low_[t_ * 32 + j4_ + 1] = bfhi(loww.x); low_[t_ * 32 + j4_ + 2] = bflo(loww.y); low_[t_ * 32 + j4_ + 3] = bfhi(loww.y); \
    const unsigned w_[8] = {vva.x, vva.y, vva.z, vva.w, vvb.x, vvb.y, vvb.z, vvb.w}; \
    _Pragma("unroll") for (int i = 0; i < 8; ++i) { VT[(v16_ + 2 * i) * GPD + t_] = (bf16_t)(w_[i] & 0xffffu); VT[(v16_ + 2 * i + 1) * GPD + t_] = (bf16_t)(w_[i] >> 16); } } while (0)
DI void gla_a_item(KParams P, Frame& F, int l, int ci, int hh) {
    const bf16_t* U = WSP(bf16_t, WS_U); bf16_t* Sloc = WSP(bf16_t, WS_SLOC); float* dec = WSP(float, WS_DEC);
    int b, row0, jf, jb; gla_chunk_decode(ci, b, row0, jf, jb);
    LAS bf16_t* VT = (LAS bf16_t*)(F.lds + GL_VT); LAS bf16_t* KET = (LAS bf16_t*)(F.lds + GL_A0);
    const int r = F.lane & 31, h = F.lane >> 5, mb = F.wave & 1, nb = F.wave >> 1;
    GLA_PRELOAD();
    GLA_STAGE_LOW_VT();
    __syncthreads();
#pragma unroll
    for (int dir = 0; dir < 2; ++dir) {
        float cs[8], off, total, mid; gla_decay(F, dir, dir ? w2b : w2f, dir ? b2b : b2f, cs, off, total, mid);
        const int cidx = gla_cidx(b, hh, dir, dir ? jb : jf);
#pragma unroll
        for (int i = 0; i < 8; ++i) KET[d * GPD + tg * 8 + i] = f2bf(kraw[i] * __expf(total - (off + cs[i])));
        if (tg == 0) dec[(size_t)cidx * 64 + d] = __expf(total);
        __syncthreads();
        f32x16 acc;
#pragma unroll
        for (int i = 0; i < 16; ++i) acc[i] = 0.f;
        lds_mma_nt(acc, KET, 32 * mb, VT, 32 * nb, r, h);
        bf16_t* sp = Sloc + ((size_t)cidx * 128 + 32 * nb + r) * 64 + 32 * mb + 4 * h;
#pragma unroll
        for (int g = 0; g < 4; ++g) *(u32x2*)(sp + 8 * g) = (u32x2){pk2(acc[4 * g], acc[4 * g + 1]), pk2(acc[4 * g + 2], acc[4 * g + 3])};
        __syncthreads();
    }
}
DI void gla_scan(KParams P, Frame& F) {
    const bf16_t* Sloc = WSP(bf16_t, WS_SLOC); const float* dec = WSP(float, WS_DEC); bf16_t* Sin = WSP(bf16_t, WS_SIN);
    for (int e = F.bid * 512 + F.tid; e < 32 * 4096; e += F.G * 512) { const int chain = e >> 12, vd = (e & 4095) * 2, d = vd & 63; float S0 = 0.f, S1 = 0.f;
#pragma unroll 1
        for (int j0 = 0; j0 < NCHAIN; j0 += 12) { f32x2_t sl[12], dc[12];
#pragma unroll
            for (int j = 0; j < 12; ++j) { const size_t idx = (size_t)chain * NCHAIN + j0 + j; { const unsigned w = *(const unsigned*)(Sloc + idx * 8192 + vd); sl[j] = (f32x2_t){bflo(w), bfhi(w)}; } dc[j] = *(const f32x2_t*)(dec + idx * 64 + d); }
#pragma unroll
            for (int j = 0; j < 12; ++j) { const size_t idx = (size_t)chain * NCHAIN + j0 + j; *(unsigned*)(Sin + idx * 8192 + vd) = pk2(S0, S1); S0 = dc[j][0] * S0 + sl[j][0]; S1 = dc[j][1] * S1 + sl[j][1]; } } }
}
DI void gla_b_item(KParams P, Frame& F, int l, int ci, int hh) {
    const bf16_t* U = WSP(bf16_t, WS_U); const bf16_t* Sin = WSP(bf16_t, WS_SIN); bf16_t* acts = WSP(bf16_t, WS_ACTS);
    int b, row0, jf, jb; gla_chunk_decode(ci, b, row0, jf, jb);
    LAS bf16_t* VT = (LAS bf16_t*)(F.lds + GL_VT); LAS bf16_t* QD = (LAS bf16_t*)(F.lds + GL_A0); LAS bf16_t* KD = (LAS bf16_t*)(F.lds + GL_KD); LAS bf16_t* QI = (LAS bf16_t*)(F.lds + GL_QI);
    LAS bf16_t* ST = (LAS bf16_t*)(F.lds + GL_ST); LAS bf16_t* PP = (LAS bf16_t*)(F.lds + GL_PP); LAS float* OB = (LAS float*)(F.lds + GL_OB);
    const int r = F.lane & 31, h = F.lane >> 5, tb = F.wave & 1, vb = F.wave >> 1;
    GLA_PRELOAD();
    float qraw[8];
#pragma unroll
    for (int i = 0; i < 8; ++i) qraw[i] = bf2f(U[(size_t)(row0 + tg * 8 + i) * PWP + O_GQ + hh * 64 + d]) * 0.125f;
    const int sv = F.tid >> 2, sd16 = (F.tid & 3) * 16;
    const bf16_t* spf = Sin + ((size_t)gla_cidx(b, hh, 0, jf) * 128 + sv) * 64 + sd16; const bf16_t* spb = Sin + ((size_t)gla_cidx(b, hh, 1, jb) * 128 + sv) * 64 + sd16;
    const u32x4 sf0 = *(const u32x4*)spf, sf1 = *(const u32x4*)(spf + 8), sb0 = *(const u32x4*)spb, sb1 = *(const u32x4*)(spb + 8);
    const int ot = F.tid >> 3, ov0 = (F.tid & 7) * 16;
    const bf16_t* rp = U + (size_t)(row0 + ot) * PWP + O_GR + hh * 128 + ov0; const u32x4 r0 = *(const u32x4*)rp, r1 = *(const u32x4*)(rp + 8);
    GLA_STAGE_LOW_VT();
    __syncthreads();
    f32x16 acc;
#pragma unroll
    for (int i = 0; i < 16; ++i) acc[i] = 0.f;
#pragma unroll
    for (int dir = 0; dir < 2; ++dir) {
        float cs[8], off, total, mid; gla_decay(F, dir, dir ? w2b : w2f, dir ? b2b : b2f, cs, off, total, mid);
#pragma unroll
        for (int i = 0; i < 8; ++i) { const int t = tg * 8 + i; const float bc = off + cs[i];
            QD[t * GPD + d] = f2bf(qraw[i] * __expf(bc - mid)); KD[t * GPD + d] = f2bf(kraw[i] * __expf(mid - bc)); QI[t * GPD + d] = f2bf(qraw[i] * __expf(bc)); }
        *(LAS u32x4*)(ST + sv * GPD + sd16) = dir ? sb0 : sf0; *(LAS u32x4*)(ST + sv * GPD + sd16 + 8) = dir ? sb1 : sf1;
        __syncthreads();
        if (F.wave < 4) { const int tb2 = F.wave & 1, sb = F.wave >> 1; f32x16 a;
#pragma unroll
            for (int i = 0; i < 16; ++i) a[i] = 0.f;
            lds_mma_nt(a, QD, 32 * tb2, KD, 32 * sb, r, h);
#pragma unroll
            for (int i = 0; i < 16; ++i) { const int t = 32 * tb2 + (i & 3) + 8 * (i >> 2) + 4 * h, s2 = 32 * sb + r; const bool keep = dir ? (s2 >= t) : (s2 <= t);
                PP[t * GPD + s2] = f2bf(keep ? a[i] : 0.f); } }
        __syncthreads();
        lds_mma_nt(acc, PP, 32 * tb, VT, 32 * vb, r, h);
        lds_mma_nt(acc, QI, 32 * tb, ST, 32 * vb, r, h);
        __syncthreads();
    }
#pragma unroll
    for (int i = 0; i < 16; ++i) OB[(32 * tb + (i & 3) + 8 * (i >> 2) + 4 * h) * 128 + 32 * vb + r] = acc[i];
    __syncthreads();
    { float x[16]; float ss = 0.f;
#pragma unroll
      for (int q = 0; q < 4; ++q) { const f32x4 o = *(const LAS f32x4*)(OB + ot * 128 + ov0 + 4 * q); x[4 * q] = o[0]; x[4 * q + 1] = o[1]; x[4 * q + 2] = o[2]; x[4 * q + 3] = o[3]; }
#pragma unroll
      for (int i = 0; i < 16; ++i) ss += x[i] * x[i];
      ss += __shfl_xor(ss, 1); ss += __shfl_xor(ss, 2); ss += __shfl_xor(ss, 4);
      const float rstd = 1.f / sqrtf(ss * (1.f / 128.f) + EPS);
      const unsigned rw[8] = {r0.x, r0.y, r0.z, r0.w, r1.x, r1.y, r1.z, r1.w}; const float* gn = P->in[I_GGLAN] + l * 128 + ov0; unsigned ow[8];
#pragma unroll
      for (int i = 0; i < 8; ++i) ow[i] = pk2(x[2 * i] * rstd * gn[2 * i] * siluf(bflo(rw[i])), x[2 * i + 1] * rstd * gn[2 * i + 1] * siluf(bfhi(rw[i])));
      bf16_t* op = acts + ((size_t)2 * TT + row0 + ot) * 512 + hh * 128 + ov0;
      *(u32x4*)op = (u32x4){ow[0], ow[1], ow[2], ow[3]}; *(u32x4*)(op + 8) = (u32x4){ow[4], ow[5], ow[6], ow[7]}; }
    __syncthreads();
}
DI float at_max2(float a, float b) { return __builtin_amdgcn_fmed3f(a, b, INFINITY); }
constexpr int AT_KC = 1040, AT_VG = 520;
constexpr int AT_K0 = 0, AT_K1 = 16 * AT_KC, AT_V0 = 32 * AT_KC, AT_V1 = 32 * AT_KC + 16 * AT_VG;
DI void attn_unit(KParams P, Frame& F, int b, int hh, int qrow0, int nlat) {
    const bf16_t* Q = WSP(bf16_t, WS_Q); const bf16_t* KN = WSP(bf16_t, WS_KN); const bf16_t* KRP = WSP(bf16_t, WS_KRP); const bf16_t* VT = WSP(bf16_t, WS_VT); bf16_t* acts = WSP(bf16_t, WS_ACTS);
    const int ntile = nlat + 4; const int r = F.lane & 31, h = F.lane >> 5;
    const int kvi = F.tid >> 3, kc = F.tid & 7;
    const float C = 0.10206207261596577f * 1.4426950408889634f;
    const int qrow = qrow0 + 32 * F.wave + r; const bf16_t* qp = Q + (size_t)qrow * 768 + hh * 96;
    bf16x8 qf[8];
#pragma unroll
    for (int s = 0; s < 4; ++s) { const u32x4 a = *(const u32x4*)(qp + 16 * s + 8 * h);
        u32x4 o; o.x = pk2(C * bflo(a.x), C * bfhi(a.x)); o.y = pk2(C * bflo(a.y), C * bfhi(a.y)); o.z = pk2(C * bflo(a.z), C * bfhi(a.z)); o.w = pk2(C * bflo(a.w), C * bfhi(a.w)); qf[s] = __builtin_bit_cast(bf16x8, o); }
    { const u32x4 a1 = *(const u32x4*)(qp + 64), a2 = *(const u32x4*)(qp + 72), c1 = *(const u32x4*)(qp + 80), c2 = *(const u32x4*)(qp + 88);
      const float ra1[8] = {bflo(a1.x), bfhi(a1.x), bflo(a1.y), bfhi(a1.y), bflo(a1.z), bfhi(a1.z), bflo(a1.w), bfhi(a1.w)}, ra2[8] = {bflo(a2.x), bfhi(a2.x), bflo(a2.y), bfhi(a2.y), bflo(a2.z), bfhi(a2.z), bflo(a2.w), bfhi(a2.w)};
      const float rc1[8] = {bflo(c1.x), bfhi(c1.x), bflo(c1.y), bfhi(c1.y), bflo(c1.z), bfhi(c1.z), bflo(c1.w), bfhi(c1.w)}, rc2[8] = {bflo(c2.x), bfhi(c2.x), bflo(c2.y), bfhi(c2.y), bflo(c2.z), bfhi(c2.z), bflo(c2.w), bfhi(c2.w)};
      float ur[8], uc[8], xr[8], xc[8];
      const int pos = qrow & (SEQ - 1); const float prow = (float)(pos >> 6), pcol = (float)(pos & 63);
#pragma unroll
      for (int i = 0; i < 8; ++i) { ur[i] = C * (h ? ra2[i] : ra1[i]); uc[i] = C * (h ? rc2[i] : rc1[i]);
          if (nlat > 0) { const float f = rope_freq(i); float sn = __sinf(prow * f), cs = __cosf(prow * f); xr[i] = C * (h ? (ra1[i] * sn + ra2[i] * cs) : (ra1[i] * cs - ra2[i] * sn));
              sn = __sinf(pcol * f); cs = __cosf(pcol * f); xc[i] = C * (h ? (rc1[i] * sn + rc2[i] * cs) : (rc1[i] * cs - rc2[i] * sn)); }
          else { xr[i] = 0.f; xc[i] = 0.f; } }
      u32x4 o;
      o.x = pk2(xr[0], xr[1]); o.y = pk2(xr[2], xr[3]); o.z = pk2(xr[4], xr[5]); o.w = pk2(xr[6], xr[7]); qf[4] = __builtin_bit_cast(bf16x8, o);
      o.x = pk2(xc[0], xc[1]); o.y = pk2(xc[2], xc[3]); o.z = pk2(xc[4], xc[5]); o.w = pk2(xc[6], xc[7]); qf[5] = __builtin_bit_cast(bf16x8, o);
      o.x = pk2(ur[0], ur[1]); o.y = pk2(ur[2], ur[3]); o.z = pk2(ur[4], ur[5]); o.w = pk2(ur[6], ur[7]); qf[6] = __builtin_bit_cast(bf16x8, o);
      o.x = pk2(uc[0], uc[1]); o.y = pk2(uc[2], uc[3]); o.z = pk2(uc[4], uc[5]); o.w = pk2(uc[6], uc[7]); qf[7] = __builtin_bit_cast(bf16x8, o); }
    u32x4 kA0, kA1, vA, kB0, kB1, vB;
#define AT_KROW(tl) (((tl) < nlat) ? (b * SEQ + (tl) * 64) : (TLAT + b * CTXL + ((tl) - nlat) * 64))
#define AT_LOADK(tl, R0, R1) do { const int krow0_ = AT_KROW(tl); R0 = *(const u32x4*)(KN + (size_t)(krow0_ + kvi) * 512 + hh * 64 + kc * 8); R1 = *(const u32x4*)(KRP + (size_t)(krow0_ + kvi) * 64 + kc * 8); } while (0)
#define AT_LOADV(tl, R) do { const int krow0_ = AT_KROW(tl); R = *(const u32x4*)(VT + (size_t)(hh * 64 + kvi) * TT + krow0_ + kc * 8); } while (0)
#define AT_STOREK(buf, R0, R1) do { LAS unsigned char* kb_ = F.lds + ((buf) ? AT_K1 : AT_K0); *(LAS u32x4*)(kb_ + kc * AT_KC + kvi * 16) = R0; *(LAS u32x4*)(kb_ + (8 + kc) * AT_KC + kvi * 16) = R1; } while (0)
#define AT_STOREV(buf, R) do { LAS unsigned char* vb_ = F.lds + ((buf) ? AT_V1 : AT_V0); *(LAS u32x2*)(vb_ + (kc & ~1) * AT_KC + kvi * 16 + (kc & 1) * 8) = (u32x2){R.x, R.y}; *(LAS u32x2*)(vb_ + ((kc & ~1) + 1) * AT_KC + kvi * 16 + (kc & 1) * 8) = (u32x2){R.z, R.w}; } while (0)
#define AT_QK(P0, P1, buf, LAT) do { const LAS unsigned char* kb_ = F.lds + ((buf) ? AT_K1 : AT_K0); \
        _Pragma("unroll") for (int i = 0; i < 16; ++i) { P0[i] = 0.f; P1[i] = 0.f; } \
        _Pragma("unroll") for (int s = 0; s < 8; ++s) if ((LAT) ? (s < 6) : (s < 4 || s >= 6)) { const bf16x8 ka0 = *(const LAS bf16x8*)(kb_ + (2 * s + h) * AT_KC + r * 16), ka1 = *(const LAS bf16x8*)(kb_ + (2 * s + h) * AT_KC + (32 + r) * 16); \
            P0 = __builtin_amdgcn_mfma_f32_32x32x16_bf16(ka0, qf[s], P0, 0, 0, 0); P1 = __builtin_amdgcn_mfma_f32_32x32x16_bf16(ka1, qf[s], P1, 0, 0, 0); } } while (0)
#define AT_COMPUTE(tl, LAT) do { const int cur = (tl) & 1; f32x16 pc0, pc1; \
        AT_QK(pc0, pc1, cur, LAT);                                                 \
        const LAS unsigned char* vb = F.lds + (cur ? AT_V1 : AT_V0); \
        float mxa = at_max2(pc0[0], pc0[1]), mxb = at_max2(pc1[0], pc1[1]); \
        _Pragma("unroll") for (int i = 2; i < 16; ++i) { mxa = at_max2(mxa, pc0[i]); mxb = at_max2(mxb, pc1[i]); } \
        float mx = at_max2(mxa, mxb); mx = at_max2(mx, __shfl_xor(mx, 32)); \
        const float mnew = at_max2(m_run, mx), alpha = __builtin_amdgcn_exp2f(m_run - mnew); m_run = mnew; \
        const f32x2_t nm2 = (f32x2_t){-mnew, -mnew}; f32x2_t ps2 = (f32x2_t){0.f, 0.f};                  \
        _Pragma("unroll") for (int i = 0; i < 8; ++i) { \
            f32x2_t ta = (f32x2_t){pc0[2 * i], pc0[2 * i + 1]} + nm2, tb = (f32x2_t){pc1[2 * i], pc1[2 * i + 1]} + nm2; \
            ta[0] = __builtin_amdgcn_exp2f(ta[0]); ta[1] = __builtin_amdgcn_exp2f(ta[1]); tb[0] = __builtin_amdgcn_exp2f(tb[0]); tb[1] = __builtin_amdgcn_exp2f(tb[1]); \
            ps2 = ps2 + (ta + tb); pc0[2 * i] = ta[0]; pc0[2 * i + 1] = ta[1]; pc1[2 * i] = tb[0]; pc1[2 * i + 1] = tb[1]; } \
        const float psum = ps2[0] + ps2[1]; \
        l_run = l_run * alpha + psum; \
        _Pragma("unroll") for (int i = 0; i < 16; ++i) { o0[i] *= alpha; o1[i] *= alpha; } \
        bf16x8 pf[4]; \
        { u32x4 w; \
          w.x = pk2(pc0[0], pc0[1]); w.y = pk2(pc0[2], pc0[3]); w.z = pk2(pc0[4], pc0[5]); w.w = pk2(pc0[6], pc0[7]); pf[0] = __builtin_bit_cast(bf16x8, w); \
          w.x = pk2(pc0[8], pc0[9]); w.y = pk2(pc0[10], pc0[11]); w.z = pk2(pc0[12], pc0[13]); w.w = pk2(pc0[14], pc0[15]); pf[1] = __builtin_bit_cast(bf16x8, w); \
          w.x = pk2(pc1[0], pc1[1]); w.y = pk2(pc1[2], pc1[3]); w.z = pk2(pc1[4], pc1[5]); w.w = pk2(pc1[6], pc1[7]); pf[2] = __builtin_bit_cast(bf16x8, w); \
          w.x = pk2(pc1[8], pc1[9]); w.y = pk2(pc1[10], pc1[11]); w.z = pk2(pc1[12], pc1[13]); w.w = pk2(pc1[14], pc1[15]); pf[3] = __builtin_bit_cast(bf16x8, w); } \
        _Pragma("unroll") for (int s = 0; s < 4; ++s) { \
            const u32x4 va0 = *(const LAS u32x4*)(vb + (2 * s + h) * AT_KC + r * 16), va1 = *(const LAS u32x4*)(vb + (2 * s + h) * AT_KC + (32 + r) * 16); \
            o0 = __builtin_amdgcn_mfma_f32_32x32x16_bf16(__builtin_bit_cast(bf16x8, va0), pf[s], o0, 0, 0, 0); \
            o1 = __builtin_amdgcn_mfma_f32_32x32x16_bf16(__builtin_bit_cast(bf16x8, va1), pf[s], o1, 0, 0, 0); } } while (0)
#define AT_ITER(tl, LAT, LK0, LK1, LV, SK0, SK1, SV) do { \
        if ((tl) + 2 < ntile) { AT_LOADK((tl) + 2, LK0, LK1); AT_LOADV((tl) + 2, LV); } \
        AT_COMPUTE(tl, LAT); \
        if ((tl) + 1 < ntile) { AT_STOREK(((tl) & 1) ^ 1, SK0, SK1); AT_STOREV(((tl) & 1) ^ 1, SV); } \
        __syncthreads(); } while (0)
    float m_run = -INFINITY, l_run = 0.f; f32x16 o0, o1;
#pragma unroll
    for (int i = 0; i < 16; ++i) { o0[i] = 0.f; o1[i] = 0.f; }
    AT_LOADK(0, kA0, kA1); AT_LOADV(0, vA); AT_LOADK(1, kB0, kB1); AT_LOADV(1, vB);
    AT_STOREK(0, kA0, kA1); AT_STOREV(0, vA);
    __syncthreads();
#pragma unroll 1
    for (int tl = 0; tl < nlat; tl += 2) {
        AT_ITER(tl, true, kA0, kA1, vA, kB0, kB1, vB);
        AT_ITER(tl + 1, true, kB0, kB1, vB, kA0, kA1, vA);
    }
#pragma unroll 1
    for (int tl = nlat; tl < ntile; tl += 2) {
        AT_ITER(tl, false, kA0, kA1, vA, kB0, kB1, vB);
        AT_ITER(tl + 1, false, kB0, kB1, vB, kA0, kA1, vA);
    }
#undef AT_COMPUTE
#undef AT_ITER
#undef AT_KROW
#undef AT_LOADK
#undef AT_LOADV
#undef AT_STOREK
#undef AT_STOREV
#undef AT_QK
    const float inv = 1.f / (l_run + __shfl_xor(l_run, 32));
    bf16_t* op = acts + (size_t)qrow * 512 + hh * 64 + 4 * h;
#pragma unroll
    for (int g = 0; g < 4; ++g) { u32x2 w; w.x = pk2(o0[4 * g] * inv, o0[4 * g + 1] * inv); w.y = pk2(o0[4 * g + 2] * inv, o0[4 * g + 3] * inv); *(u32x2*)(op + 8 * g) = w;
        w.x = pk2(o1[4 * g] * inv, o1[4 * g + 1] * inv); w.y = pk2(o1[4 * g + 2] * inv, o1[4 * g + 3] * inv); *(u32x2*)(op + 32 + 8 * g) = w; }
}

DI KParams load_params() { KParams kp = (KParams)__builtin_amdgcn_kernarg_segment_ptr(); asm volatile("" : "+s"(kp)); return kp; }
DI Frame phase_frame(const Frame& F0) { Frame F = F0; int t = F0.tid; asm volatile("" : "+v"(t)); { int b = F0.bid, g = F0.G; asm volatile("" : "+s"(b), "+s"(g)); F.bid = b; F.G = g; F.NGW = g * 8; } F.tid = t; F.lane = t & 63; F.wave = __builtin_amdgcn_readfirstlane(t >> 6); F.gw = F.bid * 8 + F.wave; return F; }
constexpr int PH_PER_LAYER = 10, NPHASE = 1 + DEPTH * PH_PER_LAYER + 1;
__global__ void __launch_bounds__(512, 2) hybrid_trunk_fwd(Params P) {
    extern __shared__ __attribute__((aligned(16))) unsigned char lds_raw[];
    Frame F; F.lds = (LAS unsigned char*)lds_raw; F.tid = threadIdx.x; F.lane = F.tid & 63; F.wave = __builtin_amdgcn_readfirstlane(F.tid >> 6);
    F.G = gridDim.x; F.bid = blockIdx.x; F.gw = F.bid * 8 + F.wave; F.NGW = F.G * 8;
    const int vcu = (F.G % 8 == 0) ? (F.bid % 8) * (F.G / 8) + F.bid / 8 : F.bid;
    for (int u = F.tid; u < (LDS_BYTES - LDSX_OFF) / 4; u += 512) ((LAS unsigned*)(F.lds + LDSX_OFF))[u] = 0u;
    __syncthreads();
    const int lo = P.ph_lo, hi = P.ph_hi;
    XcdBarrier bar; bar.bar = (unsigned*)(P.ws + WS_CTL) + CW_BAR; bar.x = 0; bar.st = (volatile LAS unsigned*)(F.lds + LDSX_OFF);
    if (hi - lo > 1) bar = xcd_barrier_post((unsigned*)(P.ws + WS_CTL) + CW_BAR, (volatile LAS unsigned*)(F.lds + LDSX_OFF));
#ifndef PH_MASK
#define PH_MASK 0xffff
#endif
#define PHM(b) ((PH_MASK >> (b)) & 1)
#ifndef DUP_MASK
#define DUP_MASK 0
#endif
#define REP(b) (1 + ((DUP_MASK >> (b)) & 1))
#define IN(k) (lo <= (k) && (k) < hi)
#ifndef DUP_BAR
#define DUP_BAR 0
#endif
#define SEAM(k) do { if (IN(k) && IN((k) + 1)) { xcd_barrier(bar); if (DUP_BAR) xcd_barrier(bar); } } while (0)
    if (PHM(0) && IN(0)) for (int rep_ = 0; rep_ < REP(0); ++rep_) { KParams Q = load_params(); Frame Fp = phase_frame(F); phase_prologue(Q, Fp);
        conv_mixed(Q, Fp, 0, 0, NS_ALL, 0, NL_ITEMS, Fp.bid, Fp.G); }
    SEAM(0);
    for (int l = 0; l < DEPTH; ++l) {
        const int pb = 1 + PH_PER_LAYER * l;
        if (PHM(1) && IN(pb + 0)) for (int rep_ = 0; rep_ < REP(1); ++rep_) { KParams Q = load_params(); Frame Fp = phase_frame(F); phase_norm1(Q, Fp, l, rep_ + 1 < REP(1)); }
        SEAM(pb + 0);
        if (PHM(2) && IN(pb + 1)) for (int rep_ = 0; rep_ < REP(2); ++rep_) { KParams Q = load_params(); Frame Fp = phase_frame(F);
            const bool lastl = (l == DEPTH - 1); const int nM1 = lastl ? TLAT / 256 : TT / 256;
            pg8::Gemm g8{(const bf16_t*)(Q->ws + WS_H8), (const bf16_t*)(Q->ws + WS_W8 + (size_t)l * PWP * DM), DM / 2, 0, 0};
            pg8::TrimOrder S8{nM1, PWP / 256, nM1 * (PWP / 256), lastl ? (TCTX / 256) * 6 : 0, Fp.G, Fp.bid};
            pg8::EpiStoreQ E8{(bf16_t*)(Q->ws + WS_U), PWP, (const float*)(Q->ws + WS_RA), (const float*)(Q->ws + WS_RB) + (size_t)l * PWP, Q->ws + WS_G8};
            pg8::gemm_phase_i8<pg8::EpiStoreQ, pg8::TrimOrder>(Fp.lds, g8, S8, E8); }
        SEAM(pb + 1);
        if (PHM(3) && IN(pb + 2)) for (int rep_ = 0; rep_ < REP(3); ++rep_) { KParams Q = load_params(); Frame Fp = phase_frame(F); bf16_t* U = (bf16_t*)(Q->ws + WS_U); (void)U; mla_prep_rows(Q, Fp, l);
            const int ncf = (l == DEPTH - 1) ? TLAT / 32 : TT / 32;
            for (int it = vcu; it < ncf; it += Fp.G) cf_sc_tile(Q, Fp, l, it);
            { const int extra = ncf > Fp.G ? ncf - Fp.G : 0;
              if (vcu >= extra) for (int it = vcu - extra; it < 144 * 4; it += Fp.G - extra) gla_a_item(Q, Fp, l, it >> 2, it & 3); } }
        SEAM(pb + 2);
        if (PHM(4) && IN(pb + 3)) for (int rep_ = 0; rep_ < REP(4); ++rep_) { KParams Q = load_params(); Frame Fp = phase_frame(F); bf16_t* U = (bf16_t*)(Q->ws + WS_U); (void)U;
            const int nq = ((l == DEPTH - 1) ? TLAT / 256 : TT / 256) * 3;
            { pg8::Gemm g{WSQ(bf16_t, WS_CQN), WSQ(bf16_t, WS_WUQ) + (size_t)l * 768 * 512, 512, 0, 0}; pg8::RangeOrder S{0, nq, 3, Fp.G, Fp.bid}; pg8::EpiStore E{WSQ(bf16_t, WS_Q), 768};
              pg8::gemm_phase<pg8::EpiStore, pg8::RangeOrder>(Fp.lds, g, S, E); }
            { const bf16_t* ckvn = WSQ(bf16_t, WS_CKVN); const bf16_t* wkn = WSQ(bf16_t, WS_WKN) + (size_t)l * 512 * 256; const bf16_t* wv = WSQ(bf16_t, WS_WV) + (size_t)l * 512 * 256;
              pg8::Gemm g{ckvn, wkn, 256, (size_t)((const char*)wv - (const char*)ckvn), (size_t)((const char*)ckvn - (const char*)wkn)};
              pg8::Range2Order S{nq, 72, 2, 72, 36, Fp.G, Fp.bid}; pg8::EpiStore2 E{WSQ(bf16_t, WS_KN), 512, WSQ(bf16_t, WS_VT), TT};
              pg8::gemm_phase<pg8::EpiStore2, pg8::Range2Order>(Fp.lds, g, S, E); }
            gla_scan(Q, Fp); }
        SEAM(pb + 3);
        if (PHM(5) && IN(pb + 4)) for (int rep_ = 0; rep_ < REP(5); ++rep_) { KParams Q = load_params(); Frame Fp = phase_frame(F); bf16_t* U = (bf16_t*)(Q->ws + WS_U); (void)U;
            for (int u = vcu; u < 256; u += Fp.G) attn_unit(Q, Fp, u >> 6, (u >> 3) & 7, (u >> 6) * SEQ + (u & 7) * 256, 32);
            const bool lastl = (l == DEPTH - 1);
            if (!lastl) for (int u = vcu; u < 32; u += Fp.G) attn_unit(Q, Fp, u >> 3, u & 7, TLAT + (u >> 3) * CTXL, 0);
            for (int it = vcu; it < (lastl ? 128 : 144) * 4; it += Fp.G) gla_b_item(Q, Fp, l, it >> 2, it & 3); }
        SEAM(pb + 4);
        if (PHM(6) && IN(pb + 5)) for (int rep_ = 0; rep_ < REP(6); ++rep_) { KParams Q = load_params(); Frame Fp = phase_frame(F); bf16_t* U = (bf16_t*)(Q->ws + WS_U); (void)U; pg8::Gemm g{WSQ(bf16_t, WS_ACTS), WSQ(bf16_t, WS_WBR) + (size_t)l * 4 * DM * 512, 512, (size_t)TT * 512 * 2, (size_t)DM * 512 * 2}; pg8::MergeOrder S; S.init((l == DEPTH - 1) ? TLAT : TT, DM, Fp.G, Fp.bid);
            LAS float* gtab = (LAS float*)(Fp.lds + LDSX_OFF + 4096);
            if (Fp.tid < 256) { const float x = (float)(Fp.tid - 128) * (GATE_CLIP / 127.f), e = expf(-x); gtab[Fp.tid] = 1.f / (1.f + e); gtab[256 + Fp.tid] = 1.f + e; }
            __syncthreads();
            pg8::EpiMerge E{WSQ(bf16_t, WS_YM), (const unsigned char*)(Q->ws + WS_G8), gtab}; pg8::gemm_phase<pg8::EpiMerge, pg8::MergeOrder>(Fp.lds, g, S, E);
            if (l + 1 < DEPTH && rep_ == 0) { KParams Q2 = load_params(); Frame F2 = phase_frame(F); const int extra = (TT / 256) * (DM / 256) % F2.G; conv_mixed(Q2, F2, l + 1, 0, 600, 0, NL_F1, extra ? F2.bid - extra : F2.bid, extra ? F2.G - extra : F2.G); } }
        SEAM(pb + 5);
        if (PHM(7) && IN(pb + 6)) for (int rep_ = 0; rep_ < REP(7); ++rep_) { KParams Q = load_params(); Frame Fp = phase_frame(F); bf16_t* U = (bf16_t*)(Q->ws + WS_U); (void)U; pg8::Gemm g{WSQ(bf16_t, WS_YM), WSQ(bf16_t, WS_WMIX) + (size_t)l * DM * DM, DM, 0, 0}; pg8::StaticOrder S; S.init((l == DEPTH - 1) ? TLAT : TT, DM, Fp.G, Fp.bid);
            pg8::EpiResid E{WSQ(bf16_t, WS_X), WSQ(float, WS_MOD) + (size_t)l * 5 * (6 * DM) + 2 * DM, (rep_ + 1 < REP(7)) ? WSQ(bf16_t, WS_OUTS) : WSQ(bf16_t, WS_X)}; pg8::gemm_phase<pg8::EpiResid, pg8::StaticOrder>(Fp.lds, g, S, E);
            if (l + 1 < DEPTH && rep_ == 0) { KParams Q2 = load_params(); Frame F2 = phase_frame(F); const int extra = (TT / 256) * (DM / 256) % F2.G; conv_mixed(Q2, F2, l + 1, 600, 870, NL_F1, NL_F2, extra ? F2.bid - extra : F2.bid, extra ? F2.G - extra : F2.G); } }
        SEAM(pb + 6);
        if (PHM(8) && IN(pb + 7)) for (int rep_ = 0; rep_ < REP(8); ++rep_) { KParams Q = load_params(); Frame Fp = phase_frame(F); phase_norm2_route(Q, Fp, l, (rep_ + 1 < REP(8)) ? l + 4 : l); }
        SEAM(pb + 7);
        if (PHM(10) && IN(pb + 8)) for (int rep_ = 0; rep_ < REP(10); ++rep_) { KParams Q = load_params(); Frame Fp = phase_frame(F); bf16_t* U = (bf16_t*)(Q->ws + WS_U); (void)U; moe_table(Q, Fp, l);
            const LAS int* tpt = (const LAS int*)(Fp.lds + LDSX_OFF + 64);
            pg8::Gemm g{WSQ(bf16_t, WS_H), (const bf16_t*)(Q->ws + WS_W1 + (size_t)l * 16 * 1024 * DM), DM / 2, 0, (size_t)1024 * DM}; pg8::MoeOrder S{tpt, 4, Fp.G, Fp.bid};
            pg8::EpiSwiGLUQG E{WSQ(bf16_t, WS_ACTM), (const float*)(Q->ws + WS_ERW), (const float*)(Q->ws + WS_ERS), (const float*)(Q->ws + WS_RB1) + (size_t)l * 16 * 1024, tpt};
            pg8::gemm_phase_i8<pg8::EpiSwiGLUQG, pg8::MoeOrder, true>(Fp.lds, g, S, E, (const int*)(Q->ws + WS_ETOK), tpt);
            if (l + 1 < DEPTH && rep_ == 0) { KParams Q2 = load_params(); Frame F2 = phase_frame(F); const int nun = ((const LAS int*)(F2.lds + LDSX_OFF + 64))[16] * 4, extra = nun % F2.G;
                conv_mixed(Q2, F2, l + 1, 870, NS_ALL, NL_F2, NL_ITEMS, extra ? F2.bid - extra : F2.bid, extra ? F2.G - extra : F2.G); } }
        SEAM(pb + 8);
        if (PHM(11) && IN(pb + 9)) for (int rep_ = 0; rep_ < REP(11); ++rep_) { KParams Q = load_params(); Frame Fp = phase_frame(F); bf16_t* U = (bf16_t*)(Q->ws + WS_U); (void)U; moe_table(Q, Fp, l);
            pg8::Gemm g{WSQ(bf16_t, WS_ACTM), WSQ(bf16_t, WS_W2) + (size_t)l * 16 * DM * EFF, EFF, 0, (size_t)DM * EFF * 2}; pg8::MoeOrder S{(const LAS int*)(Fp.lds + LDSX_OFF + 64), 8, Fp.G, Fp.bid};
            pg8::EpiStore E{WSQ(bf16_t, WS_OUTS), DM}; pg8::gemm_phase<pg8::EpiStore, pg8::MoeOrder>(Fp.lds, g, S, E); }
        SEAM(pb + 9);
    }
    if (PHM(12) && IN(NPHASE - 1)) for (int rep_ = 0; rep_ < REP(12); ++rep_) { KParams Q = load_params(); Frame Fp = phase_frame(F); phase_final(Q, Fp); }
#undef IN
#undef SEAM
}

#ifndef MK_ONE_LAUNCH
#define MK_ONE_LAUNCH 1
#endif
extern "C" void kernel_launch(void* const* d_in, const int* in_sizes, int n_in, void* d_out, int out_size, void* d_ws, size_t ws_size, hipStream_t stream) {
    static int grid = 0;
    if (grid == 0) {
        if (n_in != 34 || out_size != TLAT * DM || ws_size < WS_END) { fprintf(stderr, "kernel_launch: unexpected problem: n_in %d out %d ws %zu (need %zu)\n", n_in, out_size, ws_size, (size_t)WS_END); grid = -1; return; }
        int dev = 0, cus = 0, per_cu = 0;
        if (hipGetDevice(&dev) != hipSuccess || hipDeviceGetAttribute(&cus, hipDeviceAttributeMultiprocessorCount, dev) != hipSuccess) { grid = -1; return; }
        if (hipFuncSetAttribute((const void*)hybrid_trunk_fwd, hipFuncAttributeMaxDynamicSharedMemorySize, LDS_BYTES) != hipSuccess) { fprintf(stderr, "kernel_launch: hipFuncSetAttribute failed\n"); grid = -1; return; }
        if (hipOccupancyMaxActiveBlocksPerMultiprocessor(&per_cu, (const void*)hybrid_trunk_fwd, 512, LDS_BYTES) != hipSuccess || per_cu < 1) { fprintf(stderr, "kernel_launch: occupancy query says %d\n", per_cu); }
        (void)hipGetLastError();
        grid = cus;
    }
    if (grid < 0) return;
    (void)hipMemsetAsync((char*)d_ws + WS_CTL, 0, CTL_ZERO_BYTES, stream);
    Params p{};
    for (int i = 0; i < 34; ++i) p.in[i] = (const float*)d_in[i];
    p.out = (float*)d_out; p.ws = (unsigned char*)d_ws;
#if MK_ONE_LAUNCH
    p.ph_lo = 0; p.ph_hi = NPHASE;
    hipLaunchKernelGGL(hybrid_trunk_fwd, dim3(grid), dim3(512), LDS_BYTES, stream, p);
#else
    for (int k = 0; k < NPHASE; ++k) { p.ph_lo = k; p.ph_hi = k + 1; hipLaunchKernelGGL(hybrid_trunk_fwd, dim3(grid), dim3(512), LDS_BYTES, stream, p); }
#endif
}
```

```cpp
#include <hip/hip_runtime.h>
#include <cstdio>
#include <cstdint>

#define DI __device__ __forceinline__
#define LAS __attribute__((address_space(3)))
typedef unsigned short bf16_t;
typedef short bf16x8 __attribute__((ext_vector_type(8)));
typedef short s16x4 __attribute__((ext_vector_type(4)));
typedef float f32x4 __attribute__((ext_vector_type(4)));
typedef float f32x16 __attribute__((ext_vector_type(16)));
typedef unsigned u32x4 __attribute__((ext_vector_type(4)));
typedef unsigned u32x2 __attribute__((ext_vector_type(2)));
typedef float f32x2_t __attribute__((ext_vector_type(2)));
typedef __bf16 bf16x2_t __attribute__((ext_vector_type(2)));
typedef int v4i_t __attribute__((ext_vector_type(4)));

constexpr int DM = 2048, NB = 4, SEQ = 2048, DEPTH = 4, CTXL = 256;
constexpr int TLAT = NB * SEQ, TCTX = NB * CTXL, TT = TLAT + TCTX;
constexpr int PW = 13120, PWP = 13312;
constexpr int O_CQ = 0, O_CKV = 512, O_KR = 768, O_CF = 800, O_GQ = 1824, O_GK = 2080, O_GV = 2336, O_GF = 2848, O_GB = 2864, O_GR = 2880, O_SC = 3392, O_MG = 4928;
constexpr int GCOL0 = 5120; constexpr float GATE_CLIP = 8.f;
DI int wcol_dest(int n0) { return n0 < O_MG ? n0 : n0 + (GCOL0 - O_MG); }
constexpr int NEXP = 16, EFF = 512, MOE_ROWS = 22528;
constexpr float EPS = 1e-6f;
constexpr int NCHAIN = 36;

DI float bflo(unsigned w) { return __uint_as_float(w << 16); }
DI float bfhi(unsigned w) { return __uint_as_float(w & 0xffff0000u); }
DI float bf2f(bf16_t v) { return __uint_as_float(((unsigned)v) << 16); }
DI unsigned pk2(float lo, float hi) { f32x2_t v = {lo, hi}; bf16x2_t b = __builtin_convertvector(v, bf16x2_t); return __builtin_bit_cast(unsigned, b); }
DI bf16_t f2bf(float f) { return (bf16_t)(pk2(f, 0.f) & 0xffffu); }
DI unsigned q8(float v) { int q = __float2int_rn(v); q = q > 127 ? 127 : q; q = q < -127 ? -127 : q; return (unsigned)q & 255u; }
DI float dpp_f(float v, int ctrl_sel) {
    const int x = __float_as_int(v); int r;
    switch (ctrl_sel) { case 0: r = __builtin_amdgcn_mov_dpp(x, 0xB1, 0xF, 0xF, true); break;
                        case 1: r = __builtin_amdgcn_mov_dpp(x, 0x4E, 0xF, 0xF, true); break;
                        case 2: r = __builtin_amdgcn_mov_dpp(x, 0x141, 0xF, 0xF, true); break;
                        default: r = __builtin_amdgcn_mov_dpp(x, 0x140, 0xF, 0xF, true); break; }
    return __int_as_float(r);
}
DI float wave_sum(float v) {
    v += dpp_f(v, 0); v += dpp_f(v, 1); v += dpp_f(v, 2); v += dpp_f(v, 3);
    { const auto r = __builtin_amdgcn_permlane16_swap(__float_as_uint(v), __float_as_uint(v), false, false); v = __uint_as_float(r[0]) + __uint_as_float(r[1]); }
    { const auto r = __builtin_amdgcn_permlane32_swap(__float_as_uint(v), __float_as_uint(v), false, false); v = __uint_as_float(r[0]) + __uint_as_float(r[1]); }
    return v;
}
DI float sigm(float x) { return __builtin_amdgcn_rcpf(1.f + __expf(-x)); }
DI float siluf(float x) { return x * __builtin_amdgcn_rcpf(1.f + __expf(-x)); }
#define LDS_WAIT() asm volatile("s_waitcnt lgkmcnt(0)" ::: "memory")
#define VM_WAIT() asm volatile("s_waitcnt vmcnt(0)" ::: "memory")

namespace pg8 {
constexpr int BM = 256, BK = 64, HALF = 128, HTB = HALF * BK * 2, STAGE_BYTES = 8 * HTB, NXCD = 8, WGM = 8;
DI int lds_byte(int r, int c) { const int st = (r >> 4) * 2 + (c >> 5), rr = r & 15, cc = c & 31, ob = rr * 64 + cc * 2; return st * 1024 + (ob ^ (((ob >> 9) & 1) << 5)); }
DI void stage_rc(int b, int& R, int& C) { const int st = b / 1024, sb = b % 1024, swz = sb ^ (((sb >> 9) & 1) << 5); R = (st >> 1) * 16 + swz / 64; C = (st & 1) * 32 + (swz % 64) / 2; }
DI int perm32(int rho) { const int n = rho >> 4, i = rho & 15; return 8 * (i >> 2) + 4 * n + (i & 3); }

struct Unit { int pm, pn, grp; };
struct Gemm { const bf16_t* A; const bf16_t* Bt; int K; size_t gsA, gsB; };

DI void tile_of(int wgid0, int nM, int nN, int& pm, int& pn) {
    const int nwg = nM * nN; int wgid = wgid0;
    { const int q = nwg / NXCD, r = nwg % NXCD, xcd = wgid % NXCD, off = wgid / NXCD; wgid = (xcd < r ? xcd * (q + 1) : r * (q + 1) + (xcd - r) * q) + off; }
    const int nig = WGM * nN, gid = wgid / nig, fm = gid * WGM, gsz = (nM - fm) < WGM ? (nM - fm) : WGM;
    pm = fm + ((wgid % nig) % gsz); pn = (wgid % nig) / gsz;
}
struct StaticOrder {
    int nM, nN, nwg, G, c;
    DI void init(int M, int N, int G_, int c_) { nM = M / BM; nN = N / BM; nwg = nM * nN; G = G_; c = c_; }
    DI bool next(int i, Unit& u) const { const int L = i * G + c; if (L >= nwg) return false; tile_of(L, nM, nN, u.pm, u.pn); u.grp = 0; return true; }
};
struct TrimOrder {
    int nM1, nN, n1, nctx, G, c;
    DI bool next(int i, Unit& u) const { const int L = i * G + c; u.grp = 0;
        if (L < n1) { tile_of(L, nM1, nN, u.pm, u.pn); return true; }
        const int q = L - n1; if (q >= nctx) return false; const int j = q % 6; u.pm = nM1 + q / 6; u.pn = j < 2 ? 2 + j : 6 + j; return true; }
};
struct RangeOrder {
    int first, count, nN, G, c;
    DI bool next(int i, Unit& u) const { const int L = i * G + c - first; if (L < 0 || L >= count) return false; u.pm = L / nN; u.pn = L % nN; u.grp = 0; return true; }
};
struct Range2Order {
    int first, count0, nN0, count1, nN1, G, c;
    DI bool next(int i, Unit& u) const { int L = i * G + c - first; if (L < 0) return false;
        if (L < count0) { u.pm = L / nN0; u.pn = L % nN0; u.grp = 0; return true; }
        L -= count0; if (L >= count1) return false; u.pm = L / nN1; u.pn = L % nN1; u.grp = 1; return true; }
};
struct MergeOrder {
    int nM, nN, nwg, G, c;
    DI void init(int M, int N, int G_, int c_) { nM = M / BM; nN = N / BM; nwg = nM * nN; G = G_; c = c_; }
    DI bool next(int i, Unit& u) const { const int L = (i >> 2) * G + c; if (L >= nwg) return false; tile_of(L, nM, nN, u.pm, u.pn); u.grp = i & 3; return true; }
};
struct MoeOrder {
    const LAS int* tp; int ncol, G, c;
    DI bool next(int i, Unit& u) const {
        const int L = i * G + c, ntile = tp[16]; if (L >= ntile * ncol) return false;
        const int rt = L / ncol; int e = 0;
#pragma unroll
        for (int j = 1; j < 16; ++j) e += (rt >= tp[j]) ? 1 : 0;
        u.pm = rt; u.pn = L % ncol; u.grp = e; return true;
    }
};

struct EpiStore {
    static constexpr bool PERM = true;
    bf16_t* O; int ldc;
    DI bool operator()(f32x4 (&acc)[2][2][4][2], const Unit& u, int wr, int wc, int fr, int fq) const {
        const int row0 = u.pm * BM + wr * 64 + fr, col0 = u.pn * BM + wc * 32 + 8 * fq;
#pragma unroll
        for (int ai = 0; ai < 2; ++ai)
#pragma unroll
            for (int m = 0; m < 4; ++m) { bf16_t* rowp = O + (size_t)(row0 + ai * HALF + m * 16) * ldc + col0;
#pragma unroll
                for (int bj = 0; bj < 2; ++bj) { const f32x4 v0 = acc[ai][bj][m][0], v1 = acc[ai][bj][m][1];
                    u32x4 w; w.x = pk2(v0[0], v0[1]); w.y = pk2(v0[2], v0[3]); w.z = pk2(v1[0], v1[1]); w.w = pk2(v1[2], v1[3]);
                    *(u32x4*)(rowp + bj * HALF) = w; } }
        return false;
    }
};
struct EpiStoreQ {
    static constexpr bool PERM = true;
    bf16_t* O; int ldc; const float* rA; const float* rB; unsigned char* G8;
    DI bool operator()(v4i_t (&acc)[2][2][4][2], const Unit& u, int wr, int wc, int fr, int fq) const {
        const int row0 = u.pm * BM + wr * 64 + fr, col0 = u.pn * BM + wc * 32 + 8 * fq;
        f32x4 cb[2][2];
#pragma unroll
        for (int bj = 0; bj < 2; ++bj) { cb[bj][0] = *(const f32x4*)(rB + col0 + bj * HALF); cb[bj][1] = *(const f32x4*)(rB + col0 + bj * HALF + 4); }
        if (col0 >= GCOL0) {
            const float qs = 127.f / GATE_CLIP;
#pragma unroll
            for (int ai = 0; ai < 2; ++ai)
#pragma unroll
                for (int m = 0; m < 4; ++m) { const int row = row0 + ai * HALF + m * 16; const float ra = rA[row] * qs;
                    unsigned char* rowp = G8 + (size_t)(u.pm * 32 + (u.pn - GCOL0 / BM)) * 65536 + (((wr * 4 + wc) * 8 + ai * 4 + m) * 64 + fr + 16 * fq) * 16;
                    unsigned ww[4] = {0u, 0u, 0u, 0u};
#pragma unroll
                    for (int bj = 0; bj < 2; ++bj) { const v4i_t a0 = acc[ai][bj][m][0], a1 = acc[ai][bj][m][1]; const f32x4 c0 = cb[bj][0] * ra, c1 = cb[bj][1] * ra;
#pragma unroll
                        for (int j = 0; j < 4; ++j) { ww[2 * bj] = __builtin_amdgcn_cvt_pk_u8_f32((float)a0[j] * c0[j] + 128.0f, j, ww[2 * bj]); ww[2 * bj + 1] = __builtin_amdgcn_cvt_pk_u8_f32((float)a1[j] * c1[j] + 128.0f, j, ww[2 * bj + 1]); } }
                    *(u32x4*)rowp = (u32x4){ww[0], ww[1], ww[2], ww[3]}; }
            return false;
        }
#pragma unroll
        for (int ai = 0; ai < 2; ++ai)
#pragma unroll
            for (int m = 0; m < 4; ++m) { const int row = row0 + ai * HALF + m * 16; const float ra = rA[row]; bf16_t* rowp = O + (size_t)row * ldc + col0;
#pragma unroll
                for (int bj = 0; bj < 2; ++bj) { const v4i_t a0 = acc[ai][bj][m][0], a1 = acc[ai][bj][m][1]; const f32x4 c0 = cb[bj][0] * ra, c1 = cb[bj][1] * ra;
                    u32x4 w; w.x = pk2((float)a0[0] * c0[0], (float)a0[1] * c0[1]); w.y = pk2((float)a0[2] * c0[2], (float)a0[3] * c0[3]);
                    w.z = pk2((float)a1[0] * c1[0], (float)a1[1] * c1[1]); w.w = pk2((float)a1[2] * c1[2], (float)a1[3] * c1[3]);
                    *(u32x4*)(rowp + bj * HALF) = w; } }
        return false;
    }
};
struct EpiStore2 {
    static constexpr bool PERM = true;
    bf16_t* O0; int ldc0; bf16_t* O1; int ldc1;
    DI bool operator()(f32x4 (&acc)[2][2][4][2], const Unit& u, int wr, int wc, int fr, int fq) const {
        const EpiStore E{u.grp ? O1 : O0, u.grp ? ldc1 : ldc0}; return E(acc, u, wr, wc, fr, fq);
    }
};
struct EpiMerge {
    static constexpr bool PERM = true;
    bf16_t* Y; const unsigned char* G8;
    const LAS float* tab;
    DI static int qi(unsigned w, int i) { return (int)((w >> (8 * i)) & 255u); }
    DI bool operator()(f32x4 (&acc)[2][2][4][2], const Unit& u, int wr, int wc, int fr, int fq) const {
        const int row0 = u.pm * BM + wr * 64 + fr, col0 = u.pn * BM + wc * 32 + 8 * fq; const int grp = u.grp;
        const unsigned char* gp = G8 + (size_t)(u.pm * 32 + grp * 8 + u.pn) * 65536 + ((wr * 4 + wc) * 8 * 64 + fr + 16 * fq) * 16;
        if (grp < 3) {
            u32x4 ca[8], cb[8];
#pragma unroll
            for (int q = 0; q < 8; ++q) { ca[q] = *(const u32x4*)(gp + q * 1024); cb[q] = *(const u32x4*)(gp + 8 * 65536 + q * 1024); }
            __builtin_amdgcn_sched_barrier(0);
#pragma unroll
            for (int ai = 0; ai < 2; ++ai)
#pragma unroll
                for (int m = 0; m < 4; ++m) { const u32x4 a = ca[ai * 4 + m], b = cb[ai * 4 + m];
#pragma unroll
                    for (int bj = 0; bj < 2; ++bj) { const unsigned ax = bj ? a.z : a.x, ay = bj ? a.w : a.y, bx = bj ? b.z : b.x, by = bj ? b.w : b.y;
                        f32x4& a0 = acc[ai][bj][m][0]; f32x4& a1 = acc[ai][bj][m][1];
#pragma unroll
                        for (int j = 0; j < 4; ++j) { a0[j] *= tab[qi(ax, j)] * tab[256 + qi(bx, j)]; a1[j] *= tab[qi(ay, j)] * tab[256 + qi(by, j)]; } } }
            return true;
        }
        u32x4 cg[8];
#pragma unroll
        for (int q = 0; q < 8; ++q) cg[q] = *(const u32x4*)(gp + q * 1024);
        __builtin_amdgcn_sched_barrier(0);
#pragma unroll
        for (int ai = 0; ai < 2; ++ai)
#pragma unroll
            for (int m = 0; m < 4; ++m) { const int row = row0 + ai * HALF + m * 16; const u32x4 g4 = cg[ai * 4 + m];
                bf16_t* yp = Y + (size_t)row * DM + col0;
#pragma unroll
                for (int bj = 0; bj < 2; ++bj) { const unsigned gx = bj ? g4.z : g4.x, gy = bj ? g4.w : g4.y; const f32x4 a0 = acc[ai][bj][m][0], a1 = acc[ai][bj][m][1];
                    u32x4 w; w.x = pk2(a0[0] * tab[qi(gx, 0)], a0[1] * tab[qi(gx, 1)]); w.y = pk2(a0[2] * tab[qi(gx, 2)], a0[3] * tab[qi(gx, 3)]);
                    w.z = pk2(a1[0] * tab[qi(gy, 0)], a1[1] * tab[qi(gy, 1)]); w.w = pk2(a1[2] * tab[qi(gy, 2)], a1[3] * tab[qi(gy, 3)]);
                    *(u32x4*)(yp + bj * HALF) = w; } }
        return false;
    }
};
struct EpiResid {
    static constexpr bool PERM = true;
    bf16_t* X; const float* gate; bf16_t* XO;
    DI bool operator()(f32x4 (&acc)[2][2][4][2], const Unit& u, int wr, int wc, int fr, int fq) const {
        const int row0 = u.pm * BM + wr * 64 + fr, col0 = u.pn * BM + wc * 32 + 8 * fq;
        const int r = (u.pm < TLAT / BM) ? (u.pm >> 3) : 4; const float* gp = gate + (size_t)r * (6 * DM) + col0;
        f32x4 gv[2][2];
#pragma unroll
        for (int bj = 0; bj < 2; ++bj)
#pragma unroll
            for (int n = 0; n < 2; ++n) gv[bj][n] = *(const f32x4*)(gp + bj * HALF + n * 4);
#pragma unroll
        for (int ai = 0; ai < 2; ++ai)
#pragma unroll
            for (int m = 0; m < 4; ++m) { const size_t ro = (size_t)(row0 + ai * HALF + m * 16) * DM + col0;
#pragma unroll
                for (int bj = 0; bj < 2; ++bj) { const u32x4 x = *(const u32x4*)(X + ro + bj * HALF); const f32x4 a0 = gv[bj][0] * acc[ai][bj][m][0], a1 = gv[bj][1] * acc[ai][bj][m][1];
                    u32x4 o; o.x = pk2(bflo(x.x) + a0[0], bfhi(x.x) + a0[1]); o.y = pk2(bflo(x.y) + a0[2], bfhi(x.y) + a0[3]); o.z = pk2(bflo(x.z) + a1[0], bfhi(x.z) + a1[1]); o.w = pk2(bflo(x.w) + a1[2], bfhi(x.w) + a1[3]);
                    *(u32x4*)(XO + ro + bj * HALF) = o; } }
        return false;
    }
};
struct EpiSwiGLUQ {
    static constexpr bool PERM = true;
    bf16_t* O; const float* roww; const float* rs; const float* rb1;
    DI bool operator()(v4i_t (&acc)[2][2][4][2], const Unit& u, int wr, int wc, int fr, int fq) const {
        const int row0 = u.pm * BM + wr * 64 + fr, col0 = u.pn * HALF + wc * 32 + 8 * fq; const float* rb = rb1 + (size_t)u.grp * 1024 + u.pn * BM + wc * 32 + 8 * fq;
        const f32x4 bg0 = *(const f32x4*)rb, bg1 = *(const f32x4*)(rb + 4), bu0 = *(const f32x4*)(rb + HALF), bu1 = *(const f32x4*)(rb + HALF + 4);
#pragma unroll
        for (int ai = 0; ai < 2; ++ai)
#pragma unroll
            for (int m = 0; m < 4; ++m) { const int row = row0 + ai * HALF + m * 16; const float w = roww[row], sa = rs[row];
                const v4i_t g0 = acc[ai][0][m][0], g1 = acc[ai][0][m][1], u0 = acc[ai][1][m][0], u1 = acc[ai][1][m][1];
                float v[8];
#pragma unroll
                for (int j = 0; j < 4; ++j) { v[j] = siluf((float)g0[j] * sa * bg0[j]) * ((float)u0[j] * sa * bu0[j]) * w; v[4 + j] = siluf((float)g1[j] * sa * bg1[j]) * ((float)u1[j] * sa * bu1[j]) * w; }
                u32x4 o; o.x = pk2(v[0], v[1]); o.y = pk2(v[2], v[3]); o.z = pk2(v[4], v[5]); o.w = pk2(v[6], v[7]);
                *(u32x4*)(O + (size_t)row * EFF + col0) = o; }
        return false;
    }
};
struct EpiSwiGLUQG {
    static constexpr bool PERM = true;
    bf16_t* O; const float* erw; const float* ers; const float* rb1; const LAS int* tpt;
    DI bool operator()(v4i_t (&acc)[2][2][4][2], const Unit& u, int wr, int wc, int fr, int fq) const {
        const int row0 = u.pm * BM + wr * 64 + fr, col0 = u.pn * HALF + wc * 32 + 8 * fq; const float* rb = rb1 + (size_t)u.grp * 1024 + u.pn * BM + wc * 32 + 8 * fq;
        const int s0 = (u.pm - tpt[u.grp]) * 256 + wr * 64 + fr, cn = tpt[32 + u.grp]; const float* pw = erw + u.grp * TT; const float* ps = ers + u.grp * TT;
        const f32x4 bg0 = *(const f32x4*)rb, bg1 = *(const f32x4*)(rb + 4), bu0 = *(const f32x4*)(rb + HALF), bu1 = *(const f32x4*)(rb + HALF + 4);
#pragma unroll
        for (int ai = 0; ai < 2; ++ai)
#pragma unroll
            for (int m = 0; m < 4; ++m) { const int row = row0 + ai * HALF + m * 16, sl = s0 + ai * HALF + m * 16; const bool ok = sl < cn; const float w = ok ? pw[ok ? sl : 0] : 0.f, sa = ok ? ps[ok ? sl : 0] : 0.f;
                const v4i_t g0 = acc[ai][0][m][0], g1 = acc[ai][0][m][1], u0 = acc[ai][1][m][0], u1 = acc[ai][1][m][1];
                float v[8];
#pragma unroll
                for (int j = 0; j < 4; ++j) { v[j] = siluf((float)g0[j] * sa * bg0[j]) * ((float)u0[j] * sa * bu0[j]) * w; v[4 + j] = siluf((float)g1[j] * sa * bg1[j]) * ((float)u1[j] * sa * bu1[j]) * w; }
                u32x4 o; o.x = pk2(v[0], v[1]); o.y = pk2(v[2], v[3]); o.z = pk2(v[4], v[5]); o.w = pk2(v[6], v[7]);
                *(u32x4*)(O + (size_t)row * EFF + col0) = o; }
        return false;
    }
};
struct EpiSwiGLU {
    static constexpr bool PERM = true;
    bf16_t* O; const float* roww;
    DI bool operator()(f32x4 (&acc)[2][2][4][2], const Unit& u, int wr, int wc, int fr, int fq) const {
        const int row0 = u.pm * BM + wr * 64 + fr, col0 = u.pn * HALF + wc * 32 + 8 * fq;
#pragma unroll
        for (int ai = 0; ai < 2; ++ai)
#pragma unroll
            for (int m = 0; m < 4; ++m) { const int row = row0 + ai * HALF + m * 16; const float w = roww[row];
                const f32x4 g0 = acc[ai][0][m][0], g1 = acc[ai][0][m][1], u0 = acc[ai][1][m][0], u1 = acc[ai][1][m][1];
                float v[8];
#pragma unroll
                for (int j = 0; j < 4; ++j) { v[j] = siluf(g0[j]) * u0[j] * w; v[4 + j] = siluf(g1[j]) * u1[j] * w; }
                u32x4 o; o.x = pk2(v[0], v[1]); o.y = pk2(v[2], v[3]); o.z = pk2(v[4], v[5]); o.w = pk2(v[6], v[7]);
                *(u32x4*)(O + (size_t)row * EFF + col0) = o; }
        return false;
    }
};

template <class Epi, class Sched>
DI void gemm_phase(LAS unsigned char* lds, const Gemm g, const Sched& S, const Epi& E) {
    int tid = threadIdx.x; asm volatile("" : "+v"(tid));
    const int wid = __builtin_amdgcn_readfirstlane(tid >> 6), lane = tid & 63, wr = wid >> 2, wc = wid & 3, fr = lane & 15, fq = lane >> 4;
    int K = g.K; asm volatile("" : "+s"(K));
    const int nt = K / BK;
    unsigned voffA[2], voffB[2], gC[2]; int gR[2];
#pragma unroll
    for (int i = 0; i < 2; ++i) { int R, C; stage_rc(tid * 16 + i * 8192, R, C); const int Rb = Epi::PERM ? ((R & ~31) + perm32(R & 31)) : R;
        voffA[i] = (unsigned)(R * K + C) * 2u; voffB[i] = (unsigned)(Rb * K + C) * 2u; gR[i] = R; gC[i] = (unsigned)C * 2u; }
    const size_t kstep = (size_t)(BK * 2);
    const size_t hstep = (size_t)HALF * K * 2;
    const size_t tstep = 2 * hstep;
    const unsigned ldsw = (unsigned)wid * 1024u;
    const int aoff = lds_byte(wr * 64 + fr, fq * 8), boff = lds_byte(wc * 32 + fr, fq * 8);
#define PG8_SA(b, h) (((b) * 2 + (h)) * HTB)
#define PG8_SB(b, h) ((4 + (b) * 2 + (h)) * HTB)
#define PG8_STAGE(bufoff, gbase, voff) do { _Pragma("unroll") for (int _i = 0; _i < 2; ++_i) \
        __builtin_amdgcn_global_load_lds((const unsigned*)((const char*)(gbase) + (voff)[_i]), (LAS unsigned*)(lds + (bufoff) + ldsw + _i * 8192), 16, 0, 0); } while (0)
#define PG8_STAGE2(bufoff, gbase, o0, o1) do { \
        __builtin_amdgcn_global_load_lds((const unsigned*)((const char*)(gbase) + (o0)), (LAS unsigned*)(lds + (bufoff) + ldsw), 16, 0, 0); \
        __builtin_amdgcn_global_load_lds((const unsigned*)((const char*)(gbase) + (o1)), (LAS unsigned*)(lds + (bufoff) + ldsw + 8192), 16, 0, 0); } while (0)
#define PG8_GATH(u, v) do { const int e_ = (u).grp, b_ = ((u).pm - tpt[e_]) * 256, c_ = tpt[32 + e_]; const int* et_ = etok + e_ * TT; \
        _Pragma("unroll") for (int h_ = 0; h_ < 2; ++h_) _Pragma("unroll") for (int i_ = 0; i_ < 2; ++i_) { const int s_ = b_ + h_ * 128 + gR[i_]; const int t_ = (s_ < c_) ? et_[s_] : 0; \
            v[h_][i_] = (unsigned)t_ * (unsigned)(K * 2) + gC[i_]; } } while (0)
#define PG8_LDA(dst, b, h) do { _Pragma("unroll") for (int m = 0; m < 4; ++m) _Pragma("unroll") for (int k = 0; k < 2; ++k) dst[m][k] = *(const LAS bf16x8*)(lds + PG8_SA(b, h) + aoff + m * 2048 + k * 1024); } while (0)
#define PG8_LDB(dst, b, h) do { _Pragma("unroll") for (int n = 0; n < 2; ++n) _Pragma("unroll") for (int k = 0; k < 2; ++k) dst[n][k] = *(const LAS bf16x8*)(lds + PG8_SB(b, h) + boff + n * 2048 + k * 1024); } while (0)
#define PG8_MMA(ai, bj, At, Bt) do { __builtin_amdgcn_s_setprio(1); _Pragma("unroll") for (int m = 0; m < 4; ++m) _Pragma("unroll") for (int n = 0; n < 2; ++n) _Pragma("unroll") for (int k = 0; k < 2; ++k) \
        acc[ai][bj][m][n] = __builtin_amdgcn_mfma_f32_16x16x32_bf16(Bt[n][k], At[m][k], acc[ai][bj][m][n], 0, 0, 0); __builtin_amdgcn_s_setprio(0); } while (0)
#define PG8_WAIT_V(n) asm volatile("s_waitcnt vmcnt(" #n ")" ::: "memory")
#define PG8_WAIT_L(n) asm volatile("s_waitcnt lgkmcnt(" #n ")" ::: "memory")
#define PG8_BAR __builtin_amdgcn_s_barrier()
#define PG8_SCHED __builtin_amdgcn_sched_barrier(0)
    Unit cur, nxt; int ui = 0;
    if (!S.next(0, cur)) return;
    cur.pm = __builtin_amdgcn_readfirstlane(cur.pm); cur.pn = __builtin_amdgcn_readfirstlane(cur.pn); cur.grp = __builtin_amdgcn_readfirstlane(cur.grp);
    f32x4 acc[2][2][4][2];
#pragma unroll
    for (int a = 0; a < 2; ++a)
#pragma unroll
        for (int b = 0; b < 2; ++b)
#pragma unroll
            for (int m = 0; m < 4; ++m)
#pragma unroll
                for (int n = 0; n < 2; ++n) acc[a][b][m][n] = (f32x4){0.f, 0.f, 0.f, 0.f};
    bf16x8 At[4][2], B0[2][2], B1[2][2];
    const char* cA = (const char*)g.A + (size_t)cur.grp * g.gsA + (size_t)cur.pm * tstep; const char* cB = (const char*)g.Bt + (size_t)cur.grp * g.gsB + (size_t)cur.pn * tstep;
    PG8_STAGE(PG8_SB(0, 0), cB, voffB); PG8_STAGE(PG8_SB(0, 1), cB + hstep, voffB); PG8_STAGE(PG8_SA(0, 0), cA, voffA); PG8_STAGE(PG8_SA(0, 1), cA + hstep, voffA);
    if (wr == 1) PG8_BAR;
    PG8_WAIT_V(2); PG8_BAR;
    PG8_STAGE(PG8_SB(1, 0), cB + kstep, voffB); PG8_STAGE(PG8_SA(1, 0), cA + kstep, voffA); PG8_STAGE(PG8_SB(1, 1), cB + hstep + kstep, voffB);
    PG8_WAIT_V(6); PG8_BAR;
    for (;;) {
        const bool has_next = S.next(ui + 1, nxt);
        nxt.pm = __builtin_amdgcn_readfirstlane(nxt.pm); nxt.pn = __builtin_amdgcn_readfirstlane(nxt.pn); nxt.grp = __builtin_amdgcn_readfirstlane(nxt.grp);
        const char* nA = has_next ? (const char*)g.A + (size_t)nxt.grp * g.gsA + (size_t)nxt.pm * tstep : cA; const char* nB = has_next ? (const char*)g.Bt + (size_t)nxt.grp * g.gsB + (size_t)nxt.pn * tstep : cB;
        for (int t = 0; t < nt; t += 2) {
            const bool last = (t == nt - 2);
            const char* a1 = cA + (size_t)(t + 1) * kstep;
            const char* a2 = last ? nA : cA + (size_t)(t + 2) * kstep; const char* b2 = last ? nB : cB + (size_t)(t + 2) * kstep;
            const char* a3 = a2 + kstep; const char* b3 = b2 + kstep;
            PG8_LDB(B0, 0, 0); PG8_LDB(B1, 0, 1); PG8_SCHED; PG8_LDA(At, 0, 0); PG8_STAGE(PG8_SA(1, 1), a1 + hstep, voffA);
            PG8_WAIT_V(8); PG8_WAIT_L(0); PG8_BAR; PG8_MMA(0, 0, At, B0); PG8_MMA(0, 1, At, B1); PG8_BAR; PG8_SCHED;
            PG8_LDA(At, 0, 1); PG8_STAGE(PG8_SB(0, 0), b2, voffB); PG8_STAGE(PG8_SB(0, 1), b2 + hstep, voffB); PG8_STAGE(PG8_SA(0, 0), a2, voffA);
            PG8_WAIT_V(8); PG8_WAIT_L(0); PG8_BAR; PG8_MMA(1, 0, At, B0); PG8_MMA(1, 1, At, B1); PG8_BAR; PG8_SCHED;
            PG8_LDB(B0, 1, 0); PG8_LDB(B1, 1, 1); PG8_SCHED; PG8_LDA(At, 1, 0); PG8_STAGE(PG8_SA(0, 1), a2 + hstep, voffA);
            PG8_WAIT_V(8); PG8_WAIT_L(0); PG8_BAR; PG8_MMA(0, 0, At, B0); PG8_MMA(0, 1, At, B1); PG8_BAR; PG8_SCHED;
            PG8_LDA(At, 1, 1); PG8_STAGE(PG8_SB(1, 0), b3, voffB); PG8_STAGE(PG8_SB(1, 1), b3 + hstep, voffB); PG8_STAGE(PG8_SA(1, 0), a3, voffA);
            PG8_WAIT_V(8); PG8_WAIT_L(0); PG8_BAR; PG8_MMA(1, 0, At, B0); PG8_MMA(1, 1, At, B1); PG8_BAR; PG8_SCHED;
        }
        bool keep = false;
        if (wr == 0) PG8_BAR;
        { Unit eu; eu.pm = __builtin_amdgcn_readfirstlane(cur.pm); eu.pn = __builtin_amdgcn_readfirstlane(cur.pn); eu.grp = __builtin_amdgcn_readfirstlane(cur.grp); asm volatile("" : "+s"(eu.pm), "+s"(eu.pn), "+s"(eu.grp)); keep = E(acc, eu, wr, wc, fr, fq); }
        if (!has_next) break;
        if (!keep) {
#pragma unroll
        for (int a = 0; a < 2; ++a)
#pragma unroll
            for (int b = 0; b < 2; ++b)
#pragma unroll
                for (int m = 0; m < 4; ++m)
#pragma unroll
                    for (int n = 0; n < 2; ++n) acc[a][b][m][n] = (f32x4){0.f, 0.f, 0.f, 0.f};
        }
        cur = nxt; cA = nA; cB = nB; ++ui;
        if (wr == 1) PG8_BAR;
    }
    PG8_WAIT_V(0);
    PG8_BAR;
#undef PG8_SA
#undef PG8_SB
#undef PG8_STAGE
#undef PG8_LDA
#undef PG8_LDB
#undef PG8_MMA
#undef PG8_WAIT_V
#undef PG8_WAIT_L
#undef PG8_BAR
#undef PG8_SCHED
}
template <class Epi, class Sched, bool GATHER = false>
DI void gemm_phase_i8(LAS unsigned char* lds, const Gemm g, const Sched& S, const Epi& E, const int* etok = nullptr, const LAS int* tpt = nullptr) {
    int tid = threadIdx.x; asm volatile("" : "+v"(tid));
    const int wid = __builtin_amdgcn_readfirstlane(tid >> 6), lane = tid & 63, wr = wid >> 2, wc = wid & 3, fr = lane & 15, fq = lane >> 4;
    int K = g.K; asm volatile("" : "+s"(K));
    const int nt = K / BK;
    unsigned voffA[2], voffB[2], gC[2]; int gR[2];
#pragma unroll
    for (int i = 0; i < 2; ++i) { int R, C; stage_rc(tid * 16 + i * 8192, R, C); const int Rb = Epi::PERM ? ((R & ~31) + perm32(R & 31)) : R;
        voffA[i] = (unsigned)(R * K + C) * 2u; voffB[i] = (unsigned)(Rb * K + C) * 2u; gR[i] = R; gC[i] = (unsigned)C * 2u; }
    const size_t kstep = (size_t)(BK * 2);
    const size_t hstep = (size_t)HALF * K * 2;
    const size_t tstep = 2 * hstep;
    const unsigned ldsw = (unsigned)wid * 1024u;
    const int aoff = lds_byte(wr * 64 + fr, fq * 8), boff = lds_byte(wc * 32 + fr, fq * 8);
#define PG8_SA(b, h) (((b) * 2 + (h)) * HTB)
#define PG8_SB(b, h) ((4 + (b) * 2 + (h)) * HTB)
#define PG8_STAGE(bufoff, gbase, voff) do { _Pragma("unroll") for (int _i = 0; _i < 2; ++_i) \
        __builtin_amdgcn_global_load_lds((const unsigned*)((const char*)(gbase) + (voff)[_i]), (LAS unsigned*)(lds + (bufoff) + ldsw + _i * 8192), 16, 0, 0); } while (0)
#define PG8_STAGE2(bufoff, gbase, o0, o1) do { \
        __builtin_amdgcn_global_load_lds((const unsigned*)((const char*)(gbase) + (o0)), (LAS unsigned*)(lds + (bufoff) + ldsw), 16, 0, 0); \
        __builtin_amdgcn_global_load_lds((const unsigned*)((const char*)(gbase) + (o1)), (LAS unsigned*)(lds + (bufoff) + ldsw + 8192), 16, 0, 0); } while (0)
#define PG8_GATH(u, v) do { const int e_ = (u).grp, b_ = ((u).pm - tpt[e_]) * 256, c_ = tpt[32 + e_]; const int* et_ = etok + e_ * TT; \
        _Pragma("unroll") for (int h_ = 0; h_ < 2; ++h_) _Pragma("unroll") for (int i_ = 0; i_ < 2; ++i_) { const int s_ = b_ + h_ * 128 + gR[i_]; const int t_ = (s_ < c_) ? et_[s_] : 0; \
            v[h_][i_] = (unsigned)t_ * (unsigned)(K * 2) + gC[i_]; } } while (0)
#define PG8_LDA(dst, b, h) do { _Pragma("unroll") for (int m = 0; m < 4; ++m) _Pragma("unroll") for (int k = 0; k < 2; ++k) dst[m][k] = *(const LAS v4i_t*)(lds + PG8_SA(b, h) + aoff + m * 2048 + k * 1024); } while (0)
#define PG8_LDB(dst, b, h) do { _Pragma("unroll") for (int n = 0; n < 2; ++n) _Pragma("unroll") for (int k = 0; k < 2; ++k) dst[n][k] = *(const LAS v4i_t*)(lds + PG8_SB(b, h) + boff + n * 2048 + k * 1024); } while (0)
#define PG8_MMA(ai, bj, At, Bt) do { __builtin_amdgcn_s_setprio(1); _Pragma("unroll") for (int m = 0; m < 4; ++m) _Pragma("unroll") for (int n = 0; n < 2; ++n) _Pragma("unroll") for (int k = 0; k < 2; ++k) \
        acc[ai][bj][m][n] = __builtin_amdgcn_mfma_i32_16x16x64_i8(Bt[n][k], At[m][k], acc[ai][bj][m][n], 0, 0, 0); __builtin_amdgcn_s_setprio(0); } while (0)
#define PG8_WAIT_V(n) asm volatile("s_waitcnt vmcnt(" #n ")" ::: "memory")
#define PG8_WAIT_L(n) asm volatile("s_waitcnt lgkmcnt(" #n ")" ::: "memory")
#define PG8_BAR __builtin_amdgcn_s_barrier()
#define PG8_SCHED __builtin_amdgcn_sched_barrier(0)
    Unit cur, nxt; int ui = 0;
    if (!S.next(0, cur)) return;
    cur.pm = __builtin_amdgcn_readfirstlane(cur.pm); cur.pn = __builtin_amdgcn_readfirstlane(cur.pn); cur.grp = __builtin_amdgcn_readfirstlane(cur.grp);
    v4i_t acc[2][2][4][2];
#pragma unroll
    for (int a = 0; a < 2; ++a)
#pragma unroll
        for (int b = 0; b < 2; ++b)
#pragma unroll
            for (int m = 0; m < 4; ++m)
#pragma unroll
                for (int n = 0; n < 2; ++n) acc[a][b][m][n] = (v4i_t){0, 0, 0, 0};
    v4i_t At[4][2], B0[2][2], B1[2][2];
    const char* cA = GATHER ? (const char*)g.A : (const char*)g.A + (size_t)cur.grp * g.gsA + (size_t)cur.pm * tstep; const char* cB = (const char*)g.Bt + (size_t)cur.grp * g.gsB + (size_t)cur.pn * tstep;
    unsigned cv[2][2] = {{voffA[0], voffA[1]}, {voffA[0], voffA[1]}}, nv[2][2] = {{voffA[0], voffA[1]}, {voffA[0], voffA[1]}};
    if (GATHER) PG8_GATH(cur, cv);
    const size_t ahs = GATHER ? (size_t)0 : hstep;
    PG8_STAGE(PG8_SB(0, 0), cB, voffB); PG8_STAGE(PG8_SB(0, 1), cB + hstep, voffB); PG8_STAGE2(PG8_SA(0, 0), cA, cv[0][0], cv[0][1]); PG8_STAGE2(PG8_SA(0, 1), cA + ahs, cv[1][0], cv[1][1]);
    if (wr == 1) PG8_BAR;
    PG8_WAIT_V(2); PG8_BAR;
    PG8_STAGE(PG8_SB(1, 0), cB + kstep, voffB); PG8_STAGE2(PG8_SA(1, 0), cA + kstep, cv[0][0], cv[0][1]); PG8_STAGE(PG8_SB(1, 1), cB + hstep + kstep, voffB);
    PG8_WAIT_V(6); PG8_BAR;
    for (;;) {
        const bool has_next = S.next(ui + 1, nxt);
        nxt.pm = __builtin_amdgcn_readfirstlane(nxt.pm); nxt.pn = __builtin_amdgcn_readfirstlane(nxt.pn); nxt.grp = __builtin_amdgcn_readfirstlane(nxt.grp);
        const char* nA = (has_next && !GATHER) ? (const char*)g.A + (size_t)nxt.grp * g.gsA + (size_t)nxt.pm * tstep : cA; const char* nB = has_next ? (const char*)g.Bt + (size_t)nxt.grp * g.gsB + (size_t)nxt.pn * tstep : cB;
        if (GATHER) { if (has_next) PG8_GATH(nxt, nv); else { nv[0][0] = cv[0][0]; nv[0][1] = cv[0][1]; nv[1][0] = cv[1][0]; nv[1][1] = cv[1][1]; } }
        for (int t = 0; t < nt; t += 2) {
            const bool last = (t == nt - 2);
            const unsigned s00 = (GATHER && last) ? nv[0][0] : cv[0][0], s01 = (GATHER && last) ? nv[0][1] : cv[0][1], s10 = (GATHER && last) ? nv[1][0] : cv[1][0], s11 = (GATHER && last) ? nv[1][1] : cv[1][1];
            const char* a1 = cA + (size_t)(t + 1) * kstep;
            const char* a2 = last ? nA : cA + (size_t)(t + 2) * kstep; const char* b2 = last ? nB : cB + (size_t)(t + 2) * kstep;
            const char* a3 = a2 + kstep; const char* b3 = b2 + kstep;
            PG8_LDB(B0, 0, 0); PG8_LDB(B1, 0, 1); PG8_SCHED; PG8_LDA(At, 0, 0); PG8_STAGE2(PG8_SA(1, 1), a1 + ahs, cv[1][0], cv[1][1]);
            PG8_WAIT_V(8); PG8_WAIT_L(0); PG8_BAR; PG8_MMA(0, 0, At, B0); PG8_MMA(0, 1, At, B1); PG8_BAR; PG8_SCHED;
            PG8_LDA(At, 0, 1); PG8_STAGE(PG8_SB(0, 0), b2, voffB); PG8_STAGE(PG8_SB(0, 1), b2 + hstep, voffB); PG8_STAGE2(PG8_SA(0, 0), a2, s00, s01);
            PG8_WAIT_V(8); PG8_WAIT_L(0); PG8_BAR; PG8_MMA(1, 0, At, B0); PG8_MMA(1, 1, At, B1); PG8_BAR; PG8_SCHED;
            PG8_LDB(B0, 1, 0); PG8_LDB(B1, 1, 1); PG8_SCHED; PG8_LDA(At, 1, 0); PG8_STAGE2(PG8_SA(0, 1), a2 + ahs, s10, s11);
            PG8_WAIT_V(8); PG8_WAIT_L(0); PG8_BAR; PG8_MMA(0, 0, At, B0); PG8_MMA(0, 1, At, B1); PG8_BAR; PG8_SCHED;
            PG8_LDA(At, 1, 1); PG8_STAGE(PG8_SB(1, 0), b3, voffB); PG8_STAGE(PG8_SB(1, 1), b3 + hstep, voffB); PG8_STAGE2(PG8_SA(1, 0), a3, s00, s01);
            PG8_WAIT_V(8); PG8_WAIT_L(0); PG8_BAR; PG8_MMA(1, 0, At, B0); PG8_MMA(1, 1, At, B1); PG8_BAR; PG8_SCHED;
        }
        bool keep = false;
        if (wr == 0) PG8_BAR;
        { Unit eu; eu.pm = __builtin_amdgcn_readfirstlane(cur.pm); eu.pn = __builtin_amdgcn_readfirstlane(cur.pn); eu.grp = __builtin_amdgcn_readfirstlane(cur.grp); asm volatile("" : "+s"(eu.pm), "+s"(eu.pn), "+s"(eu.grp)); keep = E(acc, eu, wr, wc, fr, fq); }
        if (!has_next) break;
        if (!keep) {
#pragma unroll
        for (int a = 0; a < 2; ++a)
#pragma unroll
            for (int b = 0; b < 2; ++b)
#pragma unroll
                for (int m = 0; m < 4; ++m)
#pragma unroll
                    for (int n = 0; n < 2; ++n) acc[a][b][m][n] = (v4i_t){0, 0, 0, 0};
        }
        cur = nxt; cA = nA; cB = nB; ++ui;
        if (GATHER) { cv[0][0] = nv[0][0]; cv[0][1] = nv[0][1]; cv[1][0] = nv[1][0]; cv[1][1] = nv[1][1]; }
        if (wr == 1) PG8_BAR;
    }
    PG8_WAIT_V(0);
    PG8_BAR;
#undef PG8_SA
#undef PG8_SB
#undef PG8_STAGE
#undef PG8_STAGE2
#undef PG8_GATH
#undef PG8_LDA
#undef PG8_LDB
#undef PG8_MMA
#undef PG8_WAIT_V
#undef PG8_WAIT_L
#undef PG8_BAR
#undef PG8_SCHED
}
}

#define XB_TMO      128
#define XB_XCNT(j)  (256  + 64 * (j))
#define XB_XSUB(j)  (1280 + 64 * (j))
#define XB_XGEN(j)  (2304 + 64 * (j))
#define XB_TOP      3328
#define XB_TOPGEN   3392
#define XCD_BAR_WORDS 3456
#define XB_SPIN_CAP (1u << 18)

__device__ __forceinline__ unsigned xb_ld(unsigned* p)              { return __hip_atomic_load(p, __ATOMIC_RELAXED, __HIP_MEMORY_SCOPE_AGENT); }
__device__ __forceinline__ unsigned xb_add(unsigned* p, unsigned v) { return __hip_atomic_fetch_add(p, v, __ATOMIC_RELAXED, __HIP_MEMORY_SCOPE_AGENT); }
__device__ __forceinline__ unsigned xb_xcc_id() { return (unsigned)__builtin_amdgcn_s_getreg((3 << 11) | 20) & 0xFu; }
#define XB_SPIN(cond, bar) do { unsigned _sp = 0; while (cond) { __builtin_amdgcn_s_sleep(1); \
    if ((++_sp & 255u) == 0u) { if (xb_ld(&(bar)[XB_TMO])) break; if (_sp > XB_SPIN_CAP) { atomicAdd(&(bar)[XB_TMO], 1u); break; } } } } while (0)

struct XcdBarrier {
    unsigned* bar; unsigned x;
    volatile LAS unsigned* st;
};

__device__ __forceinline__ XcdBarrier xcd_barrier_post(unsigned* bar, volatile LAS unsigned* st) {
    XcdBarrier b; b.bar = bar; b.x = xb_xcc_id(); b.st = st;
    if (threadIdx.x == 0) (void)xb_add(&bar[XB_XCNT(b.x)], 1u);
    return b;
}
__device__ __forceinline__ void xcd_barrier_complete(unsigned* bar, unsigned x, unsigned& nloc, unsigned& nx) {
    const unsigned G = gridDim.x * gridDim.y * gridDim.z;
    unsigned sum, cnt, mine, sp = 0u;
    for (;;) {
        sum = 0u; cnt = 0u; mine = 0u;
#pragma unroll
        for (unsigned j = 0; j < 16; ++j) { const unsigned c = xb_ld(&bar[XB_XCNT(j)]); sum += c; cnt += (c > 0u) ? 1u : 0u; mine = (j == x) ? c : mine; }
        if (sum == G) break;
        __builtin_amdgcn_s_sleep(1);
        if ((++sp & 255u) == 0u) { if (xb_ld(&bar[XB_TMO])) break; if (sp > XB_SPIN_CAP) { atomicAdd(&bar[XB_TMO], 1u); break; } }
    }
    nloc = mine > 0u ? mine : 1u; nx = cnt > 0u ? cnt : 1u;
}

__device__ __forceinline__ void xcd_barrier(const XcdBarrier& b) {
    asm volatile("s_waitcnt vmcnt(0)" ::: "memory");
    __syncthreads();
    if (threadIdx.x == 0) {
        unsigned* bar = b.bar;
        __builtin_amdgcn_s_waitcnt(0);
        unsigned nloc = b.st[0], nx = b.st[1];
        if (nloc == 0u) { xcd_barrier_complete(bar, b.x, nloc, nx); b.st[0] = nloc; b.st[1] = nx; }
        const unsigned old = xb_add(&bar[XB_XSUB(b.x)], 1u);
        const unsigned gen = old / nloc;
        if (old + 1u == (gen + 1u) * nloc) {
            __builtin_amdgcn_fence(__ATOMIC_RELEASE, "agent");
            asm volatile("s_waitcnt vmcnt(0)" ::: "memory");
            const unsigned og = xb_add(&bar[XB_TOP], 1u);
            const unsigned tg = og / nx;
            if (og + 1u == (tg + 1u) * nx) xb_add(&bar[XB_TOPGEN], 1u);
            else XB_SPIN(xb_ld(&bar[XB_TOPGEN]) == tg, bar);
            __builtin_amdgcn_fence(__ATOMIC_ACQUIRE, "agent");
            xb_add(&bar[XB_XGEN(b.x)], 1u);
            asm volatile("s_waitcnt vmcnt(0)" ::: "memory");
        } else {
            XB_SPIN(xb_ld(&bar[XB_XGEN(b.x)]) == gen, bar);
            __builtin_amdgcn_fence(__ATOMIC_ACQUIRE, "agent");
            asm volatile("s_waitcnt vmcnt(0)" ::: "memory");
        }
    }
    __syncthreads();
}

constexpr size_t MiB = 1u << 20;
constexpr size_t WS_CTL = 0, CTL_ZERO_BYTES = 1 * MiB;
constexpr size_t WS_MOD  = 1 * MiB;
constexpr size_t WS_WIN  = 2 * MiB;
constexpr size_t WS_WUQ  = 210 * MiB;
constexpr size_t WS_WKN  = 213 * MiB;
constexpr size_t WS_WV   = 214 * MiB;
constexpr size_t WS_WBR  = 215 * MiB;
constexpr size_t WS_WMIX = 247 * MiB;
constexpr size_t WS_W1   = 279 * MiB;
constexpr size_t WS_W2   = 535 * MiB;
constexpr size_t WS_X    = 663 * MiB;
constexpr size_t WS_H    = 735 * MiB;
constexpr size_t WS_U    = 771 * MiB;
constexpr size_t WS_CQN  = 1005 * MiB;
constexpr size_t WS_CKVN = 1014 * MiB;
constexpr size_t WS_KRP  = 1019 * MiB;
constexpr size_t WS_Q    = 1021 * MiB;
constexpr size_t WS_KN   = 1035 * MiB;
constexpr size_t WS_VT   = 1044 * MiB;
constexpr size_t WS_ACTS = 1053 * MiB;
constexpr size_t WS_YM   = 1089 * MiB;
constexpr size_t WS_SLOC = 1125 * MiB;
constexpr size_t WS_DEC  = 1161 * MiB;
constexpr size_t WS_SIN  = 1162 * MiB;
constexpr size_t WS_ETOK = 1261 * MiB, WS_ERS = 1262 * MiB, WS_ERW = 1263 * MiB;
constexpr size_t WS_ROUTE= 1180 * MiB;
constexpr size_t WS_HS   = 1181 * MiB;
constexpr size_t WS_ACTM = 1269 * MiB;
constexpr size_t WS_OUTS = 1291 * MiB;
constexpr size_t WS_W8   = 1379 * MiB;
constexpr size_t WS_H8   = 1483 * MiB;
constexpr size_t WS_RA   = 1501 * MiB;
constexpr size_t WS_RB   = 1501 * MiB + 64 * 1024;
constexpr size_t WS_RB1  = 1501 * MiB + 512 * 1024;
constexpr size_t WS_RSORT= 1501 * MiB + 768 * 1024;
constexpr size_t WS_RAF  = 1501 * MiB + 896 * 1024;
constexpr size_t WS_G8   = 1502 * MiB;
constexpr size_t WS_END  = 1574 * MiB;
constexpr int CW_BAR = 4096;
constexpr int CW_CNT = 16384;
constexpr int CW_CMAX = 131072;

constexpr int RING_BYTES = 131072;
constexpr int LDSX_OFF = RING_BYTES;
constexpr int LDS_BYTES = 147456;

struct Params { const float* in[34]; float* out; unsigned char* ws; int ph_lo, ph_hi; };
typedef const __attribute__((address_space(4))) Params* KParams;
enum { I_X = 0, I_C, I_CTX, I_CCTX, I_WMOD, I_BMOD, I_GMIX, I_GFFN, I_WIN, I_GQ, I_WUQ, I_GKV, I_WUKV, I_WMLAO, I_WCFDW, I_BCFDW, I_GCFLN, I_BCFLN, I_WCFO,
       I_WGF, I_BGF, I_WGB, I_BGB, I_GGLAN, I_WGLAO, I_WSCC, I_WSCO, I_WMIXO, I_WROUT, I_BROUT, I_WEG, I_WEU, I_WED, I_GFIN };

struct Frame { LAS unsigned char* lds; int tid, lane, wave, G, bid, gw, NGW; };

#define WSP(T, off) ((T*)(P->ws + (off)))
#define WSQ(T, off) ((T*)(Q->ws + (off)))
DI unsigned* ctl_words(KParams P) { return (unsigned*)(P->ws + WS_CTL); }
DI int mod_row(int row) { return row < TLAT ? (row >> 11) : 4; }

DI void transpose_item(const float* W, int N, bf16_t* WT, int KD, int dest_row0, int k0, int n0, LAS float* scr, int lane) {
#pragma unroll
    for (int i = 0; i < 32; ++i) { const int kk = 2 * i + (lane >> 5); scr[kk * 33 + (lane & 31)] = __builtin_nontemporal_load(W + (size_t)(k0 + kk) * N + n0 + (lane & 31)); }
    LDS_WAIT(); asm volatile("" ::: "memory");
    const int c = lane & 7;
#pragma unroll
    for (int j = 0; j < 4; ++j) { const int n = (lane >> 3) + 8 * j; const LAS float* s = scr + (8 * c) * 33 + n;
        u32x4 o; o.x = pk2(s[0 * 33], s[1 * 33]); o.y = pk2(s[2 * 33], s[3 * 33]); o.z = pk2(s[4 * 33], s[5 * 33]); o.w = pk2(s[6 * 33], s[7 * 33]);
        __builtin_nontemporal_store(o, (u32x4*)(WT + (size_t)(dest_row0 + n) * KD + k0 + 8 * c)); }
    LDS_WAIT(); asm volatile("" ::: "memory");
}
constexpr int SLAB_AUX = LDSX_OFF + 2048;
DI int slab_off(int k, int n) { return k * 64 + ((((n >> 1) ^ ((k >> 3) & 15)) << 2) | ((n & 1) << 1)); }
DI void slab_item(const float* W, int N, int n0, unsigned char* W8, int dest_row0, float* rB, Frame& F) {
    LAS float* wmax = (LAS float*)(F.lds + SLAB_AUX); LAS float* cmax = wmax + 256;
    { const int n = F.lane & 31, kp = F.lane >> 5; float m = 0.f;
#pragma unroll 1
      for (int j = 0; j < 4; ++j) { const int kb0 = (F.wave * 4 + j) * 64; float v[32];
#pragma unroll
          for (int i = 0; i < 32; ++i) v[i] = __builtin_nontemporal_load(W + (size_t)(kb0 + 2 * i + kp) * N + n0 + n);
#pragma unroll
          for (int i = 0; i < 32; ++i) { m = fmaxf(m, fabsf(v[i])); *(LAS bf16_t*)(F.lds + slab_off(kb0 + 2 * i + kp, n)) = f2bf(v[i]); } }
      m = fmaxf(m, __shfl_xor(m, 32)); if (F.lane < 32) wmax[F.wave * 32 + n] = m; }
    __syncthreads();
    if (F.tid < 32) { float c = 0.f;
#pragma unroll
        for (int w2 = 0; w2 < 8; ++w2) c = fmaxf(c, wmax[w2 * 32 + F.tid]);
        cmax[F.tid] = c; rB[dest_row0 + F.tid] = c * (1.f / 127.f); }
    __syncthreads();
    { const int nn = ((F.tid >> 3) & 7) + 8 * (F.wave & 3); const float cm = cmax[nn], sc = cm > 0.f ? 127.f / cm : 0.f;
#pragma unroll 4
      for (int i2 = 0; i2 < 16; ++i2) { const int c = (F.tid & 7) + 8 * i2 + 128 * (F.wave >> 2); unsigned q[8];
#pragma unroll
          for (int j = 0; j < 8; ++j) q[j] = q8(sc * bf2f(*(const LAS bf16_t*)(F.lds + slab_off(8 * c + j, nn))));
          u32x2 o; o.x = q[0] | (q[1] << 8) | (q[2] << 16) | (q[3] << 24); o.y = q[4] | (q[5] << 8) | (q[6] << 16) | (q[7] << 24);
          __builtin_nontemporal_store(o, (u32x2*)(W8 + (size_t)(dest_row0 + nn) * DM + 8 * c)); } }
    __syncthreads();
}
constexpr int NS_WIN = PW / 32, NS_EXP = 16 * 2 * (EFF / 32), NS_ALL = NS_WIN + NS_EXP;
DI void slab_dispatch(KParams P, Frame& F, int l, int sidx) {
    if (sidx < NS_WIN) { slab_item(P->in[I_WIN] + (size_t)l * DM * PW, PW, 32 * sidx, WSP(unsigned char, WS_W8) + (size_t)l * PWP * DM, wcol_dest(32 * sidx), WSP(float, WS_RB) + (size_t)l * PWP, F); return; }
    const int q = sidx - NS_WIN, e = q >> 5, which = (q >> 4) & 1, n0 = (q & 15) * 32, le = l * 16 + e;
    slab_item((which ? P->in[I_WEU] : P->in[I_WEG]) + (size_t)le * DM * EFF, EFF, n0, WSP(unsigned char, WS_W1) + (size_t)le * 1024 * DM, (n0 >> 7) * 256 + which * 128 + (n0 & 127), WSP(float, WS_RB1) + (size_t)le * 1024, F);
}
constexpr int NL_UQ = 8 * 24, NL_UKV = 4 * 32, NL_BR = 4 * 8 * 64, NL_MIX = 32 * 64, NL_ED = 16 * 8 * 64, NL_PAD = PWP - PW;
constexpr int NL_ITEMS = NL_UQ + NL_UKV + NL_BR + NL_MIX + NL_ED + NL_PAD;
constexpr int NL_F1 = (NL_ITEMS * 55) / 100, NL_F2 = (NL_ITEMS * 88) / 100;
DI void conv_item_layer(KParams P, int l, int it, LAS float* scr, int lane) {
    int r = it;
    if (r < NL_UQ) { const int kb = r / 24, nb = r % 24;
        transpose_item(P->in[I_WUQ] + (size_t)l * 512 * 768, 768, WSP(bf16_t, WS_WUQ) + (size_t)l * 768 * 512, 512, 32 * nb, 64 * kb, 32 * nb, scr, lane); return; } r -= NL_UQ;
    if (r < NL_UKV) { const int kb = r / 32, nb = r % 32, n0 = 32 * nb, hh = n0 >> 7, jj = n0 & 127;
        bf16_t* dst = (jj < 64 ? WSP(bf16_t, WS_WKN) : WSP(bf16_t, WS_WV)) + (size_t)l * 512 * 256;
        transpose_item(P->in[I_WUKV] + (size_t)l * 256 * 1024, 1024, dst, 256, hh * 64 + (jj & 63), 64 * kb, n0, scr, lane); return; } r -= NL_UKV;
    if (r < NL_BR) { const int br = r / 512, q = r % 512, kb = q / 64, nb = q % 64;
        const float* src = (br == 0 ? P->in[I_WMLAO] : br == 1 ? P->in[I_WCFO] : br == 2 ? P->in[I_WGLAO] : P->in[I_WSCO]) + (size_t)l * 512 * DM;
        transpose_item(src, DM, WSP(bf16_t, WS_WBR) + (size_t)(l * 4 + br) * DM * 512, 512, 32 * nb, 64 * kb, 32 * nb, scr, lane); return; } r -= NL_BR;
    if (r < NL_MIX) { const int kb = r / 64, nb = r % 64;
        transpose_item(P->in[I_WMIXO] + (size_t)l * DM * DM, DM, WSP(bf16_t, WS_WMIX) + (size_t)l * DM * DM, DM, 32 * nb, 64 * kb, 32 * nb, scr, lane); return; } r -= NL_MIX;
    if (r < NL_ED) { const int e = r / 512, q = r % 512, kb = q / 64, nb = q % 64, le = l * 16 + e;
        transpose_item(P->in[I_WED] + (size_t)le * EFF * DM, DM, WSP(bf16_t, WS_W2) + (size_t)le * DM * EFF, EFF, 32 * nb, 64 * kb, 32 * nb, scr, lane); return; } r -= NL_ED;
    { unsigned char* row = WSP(unsigned char, WS_W8) + ((size_t)l * PWP + O_MG + r) * DM;
#pragma unroll
      for (int j = 0; j < 2; ++j) *(u32x4*)(row + 16 * lane + 1024 * j) = (u32x4){0u, 0u, 0u, 0u};
      if (lane == 0) WSP(float, WS_RB)[(size_t)l * PWP + O_MG + r] = 0.f; }
}
DI void conv_mixed(KParams P, Frame& F, int l, int s_lo, int s_hi, int w_lo, int w_hi, int rank, int nrank) {
    if (rank < 0) return;
    for (int sidx = s_lo + rank; sidx < s_hi; sidx += nrank) slab_dispatch(P, F, l, sidx);
    LAS float* scr = (LAS float*)(F.lds + F.wave * 8448);
    for (int it = w_lo + rank * 8 + F.wave; it < w_hi; it += nrank * 8) conv_item_layer(P, l, it, scr, F.lane);
    __syncthreads();
}
DI void mod_item(KParams P, Frame& F, int it) {
    const int l = it / 192, n0 = (it % 192) * 64;
    const LAS float* sil = (const LAS float*)F.lds;
    LAS float* red = (LAS float*)(F.lds + 40960);
    const int kq = F.lane >> 4, ln = F.lane & 15;
    const float* wp = P->in[I_WMOD] + (size_t)l * DM * (6 * DM) + n0 + 4 * ln;
    f32x4 acc[5];
#pragma unroll
    for (int r = 0; r < 5; ++r) acc[r] = (f32x4){0.f, 0.f, 0.f, 0.f};
    const int kbase = F.wave * 256 + kq;
#pragma unroll 8
    for (int kk = 0; kk < 64; ++kk) { const int k = kbase + 4 * kk; const f32x4 wv = *(const f32x4*)(wp + (size_t)k * (6 * DM));
#pragma unroll
        for (int r = 0; r < 5; ++r) acc[r] = acc[r] + wv * sil[r * DM + k]; }
    const int grp = F.wave * 4 + kq;
#pragma unroll
    for (int r = 0; r < 5; ++r) *(LAS f32x4*)(red + (grp * 5 + r) * 64 + 4 * ln) = acc[r];
    __syncthreads();
    if (F.tid < 320) { const int r = F.tid >> 6, n = F.tid & 63; float s = P->in[I_BMOD][(size_t)l * (6 * DM) + n0 + n];
        for (int g = 0; g < 32; ++g) s += red[(g * 5 + r) * 64 + n];
        WSP(float, WS_MOD)[(size_t)(l * 5 + r) * (6 * DM) + n0 + n] = s; }
    __syncthreads();
}
DI void phase_prologue(KParams P, Frame& F) {
    LAS float* sil = (LAS float*)F.lds;
    for (int i = F.tid; i < 5 * DM; i += 512) { const int r = i >> 11, k = i & (DM - 1); const float c = r < 4 ? P->in[I_C][r * DM + k] : P->in[I_CCTX][k]; sil[i] = c / (1.f + expf(-c)); }
    __syncthreads();
    for (int it = F.bid; it < DEPTH * 192; it += F.G) mod_item(P, F, it);
    __syncthreads();
}

DI void moe_table(KParams P, Frame& F, int l) {
    LAS int* tp = (LAS int*)(F.lds + LDSX_OFF + 64); LAS int* cn = tp + 32;
    if (F.tid == 0) { const unsigned* cnt = ctl_words(P) + CW_CNT + l * 16 * 64; int a = 0;
        for (int e = 0; e < 16; ++e) { const int c = (int)__hip_atomic_load(cnt + e * 64, __ATOMIC_RELAXED, __HIP_MEMORY_SCOPE_AGENT); tp[e] = a; cn[e] = c; a += (c + 255) >> 8; }
        tp[16] = a; }
    __syncthreads();
}
DI void phase_norm1(KParams P, Frame& F, int l, bool dummy) {
    bf16_t* X = WSP(bf16_t, WS_X); bf16_t* XO = dummy ? WSP(bf16_t, WS_HS) : X; bf16_t* H = WSP(bf16_t, WS_H); const float* mod = WSP(float, WS_MOD); const bf16_t* outs = WSP(bf16_t, WS_OUTS);
    const int* rt_e = (const int*)(P->ws + WS_ROUTE); const int* rt_slot = (const int*)(P->ws + WS_ROUTE + 2 * 73728); const LAS int* tp = (const LAS int*)(F.lds + LDSX_OFF + 64);
    if (l > 0) moe_table(P, F, l - 1);
    for (int row = F.gw; row < TT; row += F.NGW) {
        const int r = mod_row(row);
        f32x4 v[8];
        if (l == 0) { const float* src = row < TLAT ? P->in[I_X] + (size_t)row * DM : P->in[I_CTX] + (size_t)(row - TLAT) * DM;
#pragma unroll
            for (int j = 0; j < 8; ++j) v[j] = *(const f32x4*)(src + 4 * F.lane + 256 * j); }
        else {
#pragma unroll
            for (int j = 0; j < 8; ++j) { const u32x2 w = *(const u32x2*)(X + (size_t)row * DM + 4 * F.lane + 256 * j); v[j] = (f32x4){bflo(w.x), bfhi(w.x), bflo(w.y), bfhi(w.y)}; } }
        if (l > 0) { const int p0 = tp[rt_e[2 * row]] * 256 + rt_slot[2 * row], p1 = tp[rt_e[2 * row + 1]] * 256 + rt_slot[2 * row + 1]; const float* gt = mod + (size_t)((l - 1) * 5 + r) * (6 * DM) + 5 * DM;
#pragma unroll
            for (int j = 0; j < 8; ++j) { const int c = 4 * F.lane + 256 * j; const f32x4 g = *(const f32x4*)(gt + c);
                const u32x2 a = *(const u32x2*)(outs + (size_t)p0 * DM + c), b = *(const u32x2*)(outs + (size_t)p1 * DM + c);
                v[j][0] += g[0] * (bflo(a.x) + bflo(b.x)); v[j][1] += g[1] * (bfhi(a.x) + bfhi(b.x)); v[j][2] += g[2] * (bflo(a.y) + bflo(b.y)); v[j][3] += g[3] * (bfhi(a.y) + bfhi(b.y)); } }
        float ss = 0.f;
#pragma unroll
        for (int j = 0; j < 8; ++j) { *(u32x2*)(XO + (size_t)row * DM + 4 * F.lane + 256 * j) = (u32x2){pk2(v[j][0], v[j][1]), pk2(v[j][2], v[j][3])}; ss += (v[j][0] * v[j][0] + v[j][1] * v[j][1]) + (v[j][2] * v[j][2] + v[j][3] * v[j][3]); }
        const float rstd = 1.f / sqrtf(wave_sum(ss) * (1.f / DM) + EPS);
        const float* mp = mod + (size_t)(l * 5 + r) * (6 * DM); const float* gm = P->in[I_GMIX] + (size_t)l * DM; float am = 0.f;
#pragma unroll
        for (int j = 0; j < 8; ++j) { const int c = 4 * F.lane + 256 * j; const f32x4 g = *(const f32x4*)(gm + c), sh = *(const f32x4*)(mp + c), sc = *(const f32x4*)(mp + DM + c);
            v[j] = (v[j] * rstd * g) * (sc + 1.f) + sh; am = fmaxf(fmaxf(am, fmaxf(fabsf(v[j][0]), fabsf(v[j][1]))), fmaxf(fabsf(v[j][2]), fabsf(v[j][3]))); }
#pragma unroll
        for (int o = 1; o < 64; o <<= 1) am = fmaxf(am, __shfl_xor(am, o));
        const float qs = am > 0.f ? 127.f / am : 0.f;
#pragma unroll
        for (int j = 0; j < 8; ++j) { const int c = 4 * F.lane + 256 * j;
            *(unsigned*)(WSP(unsigned char, WS_H8) + (size_t)row * DM + c) = q8(v[j][0] * qs) | (q8(v[j][1] * qs) << 8) | (q8(v[j][2] * qs) << 16) | (q8(v[j][3] * qs) << 24); }
        if (F.lane == 0) WSP(float, WS_RA)[row] = am * (1.f / 127.f);
    }
}
DI void phase_final(KParams P, Frame& F) {
    const bf16_t* X = WSP(bf16_t, WS_X); const float* mod = WSP(float, WS_MOD); const bf16_t* outs = WSP(bf16_t, WS_OUTS);
    const int* rt_e = (const int*)(P->ws + WS_ROUTE); const int* rt_slot = (const int*)(P->ws + WS_ROUTE + 2 * 73728); const LAS int* tp = (const LAS int*)(F.lds + LDSX_OFF + 64);
    moe_table(P, F, DEPTH - 1);
    for (int row = F.gw; row < TLAT; row += F.NGW) {
        const int r = mod_row(row); const int p0 = tp[rt_e[2 * row]] * 256 + rt_slot[2 * row], p1 = tp[rt_e[2 * row + 1]] * 256 + rt_slot[2 * row + 1]; const float* gt = mod + (size_t)((DEPTH - 1) * 5 + r) * (6 * DM) + 5 * DM;
        f32x4 v[8]; float ss = 0.f;
#pragma unroll
        for (int j = 0; j < 8; ++j) { const int c = 4 * F.lane + 256 * j; { const u32x2 w = *(const u32x2*)(X + (size_t)row * DM + c); v[j] = (f32x4){bflo(w.x), bfhi(w.x), bflo(w.y), bfhi(w.y)}; } const f32x4 g = *(const f32x4*)(gt + c);
            const u32x2 a = *(const u32x2*)(outs + (size_t)p0 * DM + c), b = *(const u32x2*)(outs + (size_t)p1 * DM + c);
            v[j][0] += g[0] * (bflo(a.x) + bflo(b.x)); v[j][1] += g[1] * (bfhi(a.x) + bfhi(b.x)); v[j][2] += g[2] * (bflo(a.y) + bflo(b.y)); v[j][3] += g[3] * (bfhi(a.y) + bfhi(b.y));
            ss += (v[j][0] * v[j][0] + v[j][1] * v[j][1]) + (v[j][2] * v[j][2] + v[j][3] * v[j][3]); }
        const float rstd = 1.f / sqrtf(wave_sum(ss) * (1.f / DM) + EPS);
#pragma unroll
        for (int j = 0; j < 8; ++j) { const int c = 4 * F.lane + 256 * j; const f32x4 g = *(const f32x4*)(P->in[I_GFIN] + c); *(f32x4*)(P->out + (size_t)row * DM + c) = v[j] * rstd * g; }
    }
}
DI float ffn_input_row(KParams P, Frame& F, int l, int row, f32x4 (&v)[8]) {
    const bf16_t* X = WSP(bf16_t, WS_X); unsigned char* H8 = WSP(unsigned char, WS_H); const float* mod = WSP(float, WS_MOD);
    const int r = mod_row(row); float ss = 0.f;
#pragma unroll
    for (int j = 0; j < 8; ++j) { { const u32x2 w = *(const u32x2*)(X + (size_t)row * DM + 4 * F.lane + 256 * j); v[j] = (f32x4){bflo(w.x), bfhi(w.x), bflo(w.y), bfhi(w.y)}; } ss += (v[j][0] * v[j][0] + v[j][1] * v[j][1]) + (v[j][2] * v[j][2] + v[j][3] * v[j][3]); }
    const float rstd = 1.f / sqrtf(wave_sum(ss) * (1.f / DM) + EPS);
    const float* mp = mod + (size_t)(l * 5 + r) * (6 * DM); const float* gm = P->in[I_GFFN] + (size_t)l * DM; float am = 0.f;
#pragma unroll
    for (int j = 0; j < 8; ++j) { const int c = 4 * F.lane + 256 * j; const f32x4 g = *(const f32x4*)(gm + c), sh = *(const f32x4*)(mp + 3 * DM + c), sc = *(const f32x4*)(mp + 4 * DM + c);
        v[j] = (v[j] * rstd * g) * (sc + 1.f) + sh; am = fmaxf(fmaxf(am, fmaxf(fabsf(v[j][0]), fabsf(v[j][1]))), fmaxf(fabsf(v[j][2]), fabsf(v[j][3]))); }
#pragma unroll
    for (int o = 1; o < 64; o <<= 1) am = fmaxf(am, __shfl_xor(am, o));
    const float qs = am > 0.f ? 127.f / am : 0.f;
#pragma unroll
    for (int j = 0; j < 8; ++j) { const int c = 4 * F.lane + 256 * j;
        *(unsigned*)(H8 + (size_t)row * DM + c) = q8(v[j][0] * qs) | (q8(v[j][1] * qs) << 8) | (q8(v[j][2] * qs) << 16) | (q8(v[j][3] * qs) << 24); }
    return am * (1.f / 127.f);
}
DI void route_decide(const float (&lg)[16], const float (&br)[16], int& e1, int& e2, float& wa, float& wb) {
    float aff[16], sel[16];
#pragma unroll
    for (int e = 0; e < 16; ++e) { aff[e] = __builtin_amdgcn_rcpf(1.f + expf(-lg[e])); sel[e] = aff[e] + br[e]; }
    int best = 0; float bestv = -INFINITY;
#pragma unroll
    for (int g = 0; g < 4; ++g) { const float a = sel[4 * g], b = sel[4 * g + 1], c = sel[4 * g + 2], d = sel[4 * g + 3];
        const float hi1 = fmaxf(a, b), lo1 = fminf(a, b), hi2 = fmaxf(c, d), lo2 = fminf(c, d);
        const float gs = fmaxf(hi1, hi2) + fmaxf(fminf(hi1, hi2), fmaxf(lo1, lo2));
        if (gs > bestv) { bestv = gs; best = g; } }
    float s4[4] = {0.f, 0.f, 0.f, 0.f}, a4[4] = {0.f, 0.f, 0.f, 0.f};
#pragma unroll
    for (int g = 0; g < 4; ++g)
#pragma unroll
        for (int j = 0; j < 4; ++j) { s4[j] = (best == g) ? sel[4 * g + j] : s4[j]; a4[j] = (best == g) ? aff[4 * g + j] : a4[j]; }
    int i1 = 0; float m1 = s4[0];
#pragma unroll
    for (int j = 1; j < 4; ++j) if (s4[j] > m1) { m1 = s4[j]; i1 = j; }
    int i2 = -1; float m2 = -INFINITY;
#pragma unroll
    for (int j = 0; j < 4; ++j) if (j != i1 && s4[j] > m2) { m2 = s4[j]; i2 = j; }
    float w1 = 0.f, w2 = 0.f;
#pragma unroll
    for (int j = 0; j < 4; ++j) { w1 = (j == i1) ? a4[j] : w1; w2 = (j == i2) ? a4[j] : w2; }
    const float inv = 1.f / (w1 + w2);
    e1 = 4 * best + i1; e2 = 4 * best + i2; wa = w1 * inv; wb = w2 * inv;
}
DI void phase_norm2_route(KParams P, Frame& F, int l, int cbank) {
    int* rt_e = (int*)(P->ws + WS_ROUTE); int* rt_slot = (int*)(P->ws + WS_ROUTE + 2 * 73728);
    int* etok = (int*)(P->ws + WS_ETOK); float* ers = (float*)(P->ws + WS_ERS); float* erw = (float*)(P->ws + WS_ERW);
    unsigned* cnt = ctl_words(P) + CW_CNT + cbank * 16 * 64;
    LAS float* wrT = (LAS float*)F.lds;
    for (int k = F.tid; k < DM; k += 512) { const f32x4* wp = (const f32x4*)(P->in[I_WROUT] + (size_t)k * 16);
#pragma unroll
        for (int q = 0; q < 4; ++q) { const f32x4 w = wp[q]; wrT[(4 * q + 0) * DM + k] = w[0]; wrT[(4 * q + 1) * DM + k] = w[1]; wrT[(4 * q + 2) * DM + k] = w[2]; wrT[(4 * q + 3) * DM + k] = w[3]; } }
    float br[16];
#pragma unroll
    for (int e = 0; e < 16; ++e) br[e] = P->in[I_BROUT][e];
    const int nrows = (l == DEPTH - 1) ? TLAT : TT;
    const int rpb = (nrows + F.G - 1) / F.G, row0 = F.bid * rpb, row1 = (row0 + rpb < nrows) ? row0 + rpb : nrows;
    LAS int* lcnt = (LAS int*)(F.lds + LDSX_OFF + 512); LAS int* lbase = lcnt + 16; LAS int* lre = lcnt + 32; LAS int* lri = lcnt + 112; LAS float* lrw = (LAS float*)(lcnt + 192); LAS float* lrs = (LAS float*)(lcnt + 272);
    if (F.tid < 16) lcnt[F.tid] = 0;
    __syncthreads();
#pragma unroll 1
    for (int lr = 2 * F.wave; row0 + lr < row1; lr += 16) {
        const bool hasB = row0 + lr + 1 < row1; const int rowA = row0 + lr, rowB = hasB ? rowA + 1 : rowA;
        f32x4 va[8], vb[8]; const float sA = ffn_input_row(P, F, l, rowA, va), sB = ffn_input_row(P, F, l, rowB, vb);
        f32x2_t lab[16];
#pragma unroll
        for (int e = 0; e < 16; ++e) lab[e] = (f32x2_t){0.f, 0.f};
#pragma unroll
        for (int j = 0; j < 8; ++j) {
            const f32x2_t x0 = (f32x2_t){va[j][0], vb[j][0]}, x1 = (f32x2_t){va[j][1], vb[j][1]}, x2 = (f32x2_t){va[j][2], vb[j][2]}, x3 = (f32x2_t){va[j][3], vb[j][3]};
#pragma unroll
            for (int e = 0; e < 16; ++e) { const f32x4 w = *(const LAS f32x4*)(wrT + e * DM + 4 * F.lane + 256 * j);
                lab[e] = __builtin_elementwise_fma(x3, (f32x2_t){w[3], w[3]}, __builtin_elementwise_fma(x2, (f32x2_t){w[2], w[2]}, __builtin_elementwise_fma(x1, (f32x2_t){w[1], w[1]}, __builtin_elementwise_fma(x0, (f32x2_t){w[0], w[0]}, lab[e])))); }
            asm volatile("" ::: "memory"); }
        float la[16], lb[16];
#pragma unroll
        for (int e = 0; e < 16; ++e) { la[e] = wave_sum(lab[e][0]); lb[e] = wave_sum(lab[e][1]); }
        int e1, e2, f1, f2; float wa, wb, xa, xb; route_decide(la, br, e1, e2, wa, wb); route_decide(lb, br, f1, f2, xa, xb);
        if (F.lane == 0) {
            const int j1 = __hip_atomic_fetch_add(lcnt + e1, 1, __ATOMIC_RELAXED, __HIP_MEMORY_SCOPE_WORKGROUP), j2 = __hip_atomic_fetch_add(lcnt + e2, 1, __ATOMIC_RELAXED, __HIP_MEMORY_SCOPE_WORKGROUP);
            lre[2 * lr] = e1; lre[2 * lr + 1] = e2; lri[2 * lr] = j1; lri[2 * lr + 1] = j2;
            rt_e[2 * rowA] = e1; rt_e[2 * rowA + 1] = e2; lrw[2 * lr] = wa; lrw[2 * lr + 1] = wb; lrs[lr] = sA;
            if (hasB) { const int k1 = __hip_atomic_fetch_add(lcnt + f1, 1, __ATOMIC_RELAXED, __HIP_MEMORY_SCOPE_WORKGROUP), k2 = __hip_atomic_fetch_add(lcnt + f2, 1, __ATOMIC_RELAXED, __HIP_MEMORY_SCOPE_WORKGROUP);
                lre[2 * lr + 2] = f1; lre[2 * lr + 3] = f2; lri[2 * lr + 2] = k1; lri[2 * lr + 3] = k2;
                rt_e[2 * rowB] = f1; rt_e[2 * rowB + 1] = f2; lrw[2 * lr + 2] = xa; lrw[2 * lr + 3] = xb; lrs[lr + 1] = sB; } }
    }
    __syncthreads();
    if (F.tid < 16) lbase[F.tid] = (int)atomicAdd(cnt + F.tid * 64, (unsigned)lcnt[F.tid]);
    __syncthreads();
    if (F.tid < 2 * (row1 - row0)) { const int e = lre[F.tid], sl = lbase[e] + lri[F.tid]; rt_slot[2 * row0 + F.tid] = sl;
        etok[e * TT + sl] = row0 + (F.tid >> 1); ers[e * TT + sl] = lrs[F.tid >> 1]; erw[e * TT + sl] = lrw[F.tid]; }
    __syncthreads();
}
DI float rope_freq(int i) { return __expf(-1.1512925465f * (float)i); }
DI void mla_prep_rows(KParams P, Frame& F, int l) {
    const bf16_t* U = WSP(bf16_t, WS_U); bf16_t* cqn = WSP(bf16_t, WS_CQN); bf16_t* ckvn = WSP(bf16_t, WS_CKVN); bf16_t* krp = WSP(bf16_t, WS_KRP);
    for (int row = F.gw; row < TT; row += F.NGW) {
        const bf16_t* up = U + (size_t)row * PWP;
        { const u32x4 a = *(const u32x4*)(up + O_CQ + 8 * F.lane); float f[8] = {bflo(a.x), bfhi(a.x), bflo(a.y), bfhi(a.y), bflo(a.z), bfhi(a.z), bflo(a.w), bfhi(a.w)};
          float ss = 0.f;
#pragma unroll
          for (int i = 0; i < 8; ++i) ss += f[i] * f[i];
          const float rstd = 1.f / sqrtf(wave_sum(ss) * (1.f / 512.f) + EPS); const float* g = P->in[I_GQ] + l * 512 + 8 * F.lane;
          u32x4 o; o.x = pk2(f[0] * rstd * g[0], f[1] * rstd * g[1]); o.y = pk2(f[2] * rstd * g[2], f[3] * rstd * g[3]); o.z = pk2(f[4] * rstd * g[4], f[5] * rstd * g[5]); o.w = pk2(f[6] * rstd * g[6], f[7] * rstd * g[7]);
          *(u32x4*)(cqn + (size_t)row * 512 + 8 * F.lane) = o; }
        { const u32x2 a = *(const u32x2*)(up + O_CKV + 4 * F.lane); float f[4] = {bflo(a.x), bfhi(a.x), bflo(a.y), bfhi(a.y)};
          const float ss = (f[0] * f[0] + f[1] * f[1]) + (f[2] * f[2] + f[3] * f[3]);
          const float rstd = 1.f / sqrtf(wave_sum(ss) * (1.f / 256.f) + EPS); const float* g = P->in[I_GKV] + l * 256 + 4 * F.lane;
          u32x2 o; o.x = pk2(f[0] * rstd * g[0], f[1] * rstd * g[1]); o.y = pk2(f[2] * rstd * g[2], f[3] * rstd * g[3]);
          *(u32x2*)(ckvn + (size_t)row * 256 + 4 * F.lane) = o; }
        { const int e = F.lane; float val = 0.f;
          if (row < TLAT) { if (e < 32) { const int pos = row & (SEQ - 1), part = e >> 4, idx = e & 15, i = idx & 7, second = idx >> 3;
                  const float t1 = bf2f(up[O_KR + 16 * part + i]), t2 = bf2f(up[O_KR + 16 * part + 8 + i]);
                  const float ang = (float)(part ? (pos & 63) : (pos >> 6)) * rope_freq(i); const float sn = __sinf(ang), cs = __cosf(ang);
                  val = second ? (t1 * sn + t2 * cs) : (t1 * cs - t2 * sn); } }
          else { if (e >= 32) val = bf2f(up[O_KR + e - 32]); }
          krp[(size_t)row * 64 + e] = f2bf(val); }
    }
}
DI void cf_sc_tile(KParams P, Frame& F, int l, int ti) {
    const bf16_t* U = WSP(bf16_t, WS_U); bf16_t* acts = WSP(bf16_t, WS_ACTS);
    const int row0 = ti * 32; int seg_lo, seg_hi;
    if (row0 < TLAT) { seg_lo = row0 & ~(SEQ - 1); seg_hi = seg_lo + SEQ; } else { seg_lo = TLAT + ((row0 - TLAT) & ~(CTXL - 1)); seg_hi = seg_lo + CTXL; }
    LAS bf16_t* gl = (LAS bf16_t*)F.lds;
    LAS float* co = (LAS float*)(F.lds + 63488);
    const int c2 = F.tid & 255, th = F.tid >> 8;
    { const bf16_t* ub = U + O_SC + 2 * c2; const float* wp = P->in[I_WSCC] + (size_t)l * 3 * 512 + 2 * c2;
      const float w0a = wp[0], w0b = wp[1], w1a = wp[512], w1b = wp[513], w2a = wp[1024], w2b = wp[1025];
      unsigned pc[18], ph[18], gb[16];
#pragma unroll
      for (int k = 0; k < 18; ++k) { const int rr = row0 + 16 * th - 1 + k; const bool ok = rr >= seg_lo && rr < seg_hi;
          pc[k] = ok ? *(const unsigned*)(ub + (size_t)rr * PWP + 512) : 0u; ph[k] = ok ? *(const unsigned*)(ub + (size_t)rr * PWP + 1024) : 0u; }
#pragma unroll
      for (int k = 0; k < 16; ++k) gb[k] = *(const unsigned*)(ub + (size_t)(row0 + 16 * th + k) * PWP);
      float pa[18], pb[18];
#pragma unroll
      for (int k = 0; k < 18; ++k) { pa[k] = bflo(pc[k]) * bflo(ph[k]); pb[k] = bfhi(pc[k]) * bfhi(ph[k]); }
#pragma unroll
      for (int k = 0; k < 16; ++k) *(unsigned*)(acts + ((size_t)3 * TT + row0 + 16 * th + k) * 512 + 2 * c2) =
          pk2(bflo(gb[k]) * (w0a * pa[k] + w1a * pa[k + 1] + w2a * pa[k + 2]), bfhi(gb[k]) * (w0b * pb[k] + w1b * pb[k + 1] + w2b * pb[k + 2])); }
    { const int cg = F.tid & 63, ri = F.tid >> 6; u32x4 ga[8], gbv[8];
#pragma unroll
      for (int pass = 0; pass < 8; ++pass) { const int i = pass * 8 + ri, rr = row0 - 15 + i; const bool ok = i < 62 && rr >= seg_lo && rr < seg_hi;
          const bf16_t* up = U + (size_t)(ok ? rr : row0) * PWP + O_CF + 8 * cg; ga[pass] = *(const u32x4*)up; gbv[pass] = *(const u32x4*)(up + 512); }
#pragma unroll
      for (int pass = 0; pass < 8; ++pass) { const int i = pass * 8 + ri, rr = row0 - 15 + i; const bool ok = rr >= seg_lo && rr < seg_hi;
          if (i < 62) { const u32x4 a = ga[pass], b = gbv[pass]; u32x4 o;
              o.x = pk2(bflo(a.x) * sigm(bflo(b.x)), bfhi(a.x) * sigm(bfhi(b.x))); o.y = pk2(bflo(a.y) * sigm(bflo(b.y)), bfhi(a.y) * sigm(bfhi(b.y)));
              o.z = pk2(bflo(a.z) * sigm(bflo(b.z)), bfhi(a.z) * sigm(bfhi(b.z))); o.w = pk2(bflo(a.w) * sigm(bflo(b.w)), bfhi(a.w) * sigm(bfhi(b.w)));
              if (!ok) o = (u32x4){0u, 0u, 0u, 0u};
              *(LAS u32x4*)(gl + i * 512 + 8 * cg) = o; } } }
    asm volatile("" ::: "memory");
    float wva[31], wvb[31];
#pragma unroll
    for (int j = 0; j < 31; ++j) { const f32x2_t w = *(const f32x2_t*)(P->in[I_WCFDW] + (size_t)(l * 31 + j) * 512 + 2 * c2); wva[j] = w[0]; wvb[j] = w[1]; }
    const f32x2_t bias = *(const f32x2_t*)(P->in[I_BCFDW] + l * 512 + 2 * c2);
    __syncthreads();
#pragma unroll 1
    for (int hb = 0; hb < 2; ++hb) { const LAS unsigned* gp = (const LAS unsigned*)(gl + (16 * th + 8 * hb) * 512 + 2 * c2); f32x2_t xin[38];
#pragma unroll
      for (int i = 0; i < 38; ++i) { const unsigned x = gp[i * 256]; xin[i] = (f32x2_t){bflo(x), bfhi(x)}; }
#pragma unroll
      for (int t = 0; t < 8; ++t) { f32x2_t a = bias;
#pragma unroll
          for (int j = 0; j < 31; ++j) a = __builtin_elementwise_fma((f32x2_t){wva[j], wvb[j]}, xin[t + j], a);
          *(LAS f32x2_t*)(co + (16 * th + 8 * hb + t) * 512 + 2 * c2) = a; } }
    __syncthreads();
#pragma unroll 1
    for (int tt = 0; tt < 4; ++tt) { const int t = F.wave * 4 + tt; const LAS float* cr = co + t * 512 + 8 * F.lane;
        const f32x4 a = *(const LAS f32x4*)cr, b = *(const LAS f32x4*)(cr + 4);
        float x[8] = {a[0], a[1], a[2], a[3], b[0], b[1], b[2], b[3]}; float s = 0.f;
#pragma unroll
        for (int i = 0; i < 8; ++i) s += x[i];
        const float mean = wave_sum(s) * (1.f / 512.f); float q = 0.f;
#pragma unroll
        for (int i = 0; i < 8; ++i) { x[i] -= mean; q += x[i] * x[i]; }
        const float rstd = 1.f / sqrtf(wave_sum(q) * (1.f / 512.f) + EPS);
        const float* g = P->in[I_GCFLN] + l * 512 + 8 * F.lane; const float* bb = P->in[I_BCFLN] + l * 512 + 8 * F.lane; float y[8];
#pragma unroll
        for (int i = 0; i < 8; ++i) y[i] = siluf(x[i] * rstd * g[i] + bb[i]);
        u32x4 o; o.x = pk2(y[0], y[1]); o.y = pk2(y[2], y[3]); o.z = pk2(y[4], y[5]); o.w = pk2(y[6], y[7]);
        *(u32x4*)(acts + ((size_t)1 * TT + row0 + t) * 512 + 8 * F.lane) = o; }
    __syncthreads();
}

constexpr int GPD = 72;
constexpr int GL_LOW = 0, GL_GSUM = 8192, GL_VT = 10240, GL_A0 = 28672, GL_KD = 37888, GL_QI = 47104, GL_ST = 56320, GL_PP = 74752, GL_OB = 83968;
DI void gla_chunk_decode(int ci, int& b, int& row0, int& jf, int& jb) {
    if (ci < 128) { b = ci >> 5; const int c = ci & 31; row0 = b * SEQ + c * 64; jf = 4 + c; jb = 4 + (31 - c); }
    else { const int cc = ci - 128; b = cc >> 2; const int c = cc & 3; row0 = TLAT + b * CTXL + c * 64; jf = c; jb = 3 - c; }
}
DI int gla_cidx(int b, int hh, int dir, int j) { return ((b * 4 + hh) * 2 + dir) * NCHAIN + j; }
DI void lds_mma_nt(f32x16& acc, const LAS bf16_t* A, int a_row0, const LAS bf16_t* B, int b_row0, int r, int h) {
#pragma unroll
    for (int k0 = 0; k0 < 64; k0 += 16) {
        const bf16x8 a = *(const LAS bf16x8*)(A + (a_row0 + r) * GPD + k0 + 8 * h);
        const bf16x8 b = *(const LAS bf16x8*)(B + (b_row0 + r) * GPD + k0 + 8 * h);
        acc = __builtin_amdgcn_mfma_f32_32x32x16_bf16(a, b, acc, 0, 0, 0);
    }
}
DI float logsig(float z) { return fminf(z, 0.f) - __logf(1.f + __expf(-fabsf(z))); }
DI void gla_decay(Frame& F, int dir, const float (&w2v)[16], float b2, float (&cs)[8], float& off, float& total, float& mid) {
    const LAS float* low = (const LAS float*)(F.lds + GL_LOW); LAS float* gsum = (LAS float*)(F.lds + GL_GSUM);
    const int d = F.tid & 63, tg = F.tid >> 6;
    float la[8];
#pragma unroll
    for (int i = 0; i < 8; ++i) { const LAS float* lp = low + (tg * 8 + i) * 32 + dir * 16; float z = b2;
#pragma unroll
        for (int j = 0; j < 16; ++j) z += lp[j] * w2v[j];
        la[i] = logsig(z) * (1.f / 16.f); }
    if (dir == 0) { cs[0] = la[0];
#pragma unroll
        for (int i = 1; i < 8; ++i) cs[i] = cs[i - 1] + la[i];
        gsum[tg * 64 + d] = cs[7]; }
    else { cs[7] = la[7];
#pragma unroll
        for (int i = 6; i >= 0; --i) cs[i] = cs[i + 1] + la[i];
        gsum[tg * 64 + d] = cs[0]; }
    __syncthreads();
    float g[8];
#pragma unroll
    for (int q = 0; q < 8; ++q) g[q] = gsum[q * 64 + d];
    total = 0.f; off = 0.f; mid = 0.f;
#pragma unroll
    for (int q = 0; q < 8; ++q) { total += g[q]; if (dir == 0) { off += (q < tg) ? g[q] : 0.f; mid += (q <= 3) ? g[q] : 0.f; } else { off += (q > tg) ? g[q] : 0.f; mid += (q >= 4) ? g[q] : 0.f; } }
}
#define GLA_PRELOAD() \
    const int d = F.tid & 63, tg = F.tid >> 6, dcol = hh * 64 + d; \
    const u32x2 loww = *(const u32x2*)(U + (size_t)(row0 + (F.tid >> 3)) * PWP + O_GF + (F.tid & 7) * 4); \
    const u32x4 vva = *(const u32x4*)(U + (size_t)(row0 + (F.tid >> 3)) * PWP + O_GV + hh * 128 + (F.tid & 7) * 16), vvb = *(const u32x4*)(U + (size_t)(row0 + (F.tid >> 3)) * PWP + O_GV + hh * 128 + (F.tid & 7) * 16 + 8); \
    float w2f[16], w2b[16]; \
    _Pragma("unroll") for (int j = 0; j < 16; ++j) { w2f[j] = P->in[I_WGF][(size_t)l * 16 * 256 + j * 256 + dcol]; w2b[j] = P->in[I_WGB][(size_t)l * 16 * 256 + j * 256 + dcol]; } \
    const float b2f = P->in[I_BGF][l * 256 + dcol], b2b = P->in[I_BGB][l * 256 + dcol]; \
    float kraw[8]; \
    _Pragma("unroll") for (int i = 0; i < 8; ++i) kraw[i] = bf2f(U[(size_t)(row0 + tg * 8 + i) * PWP + O_GK + hh * 64 + d]);
#define GLA_STAGE_LOW_VT() do { LAS float* low_ = (LAS float*)(F.lds + GL_LOW); const int t_ = F.tid >> 3, j4_ = (F.tid & 7) * 4, v16_ = (F.tid & 7) * 16; \
    low_[t_ * 32 + j4_] = bflo(loww.x); low_[t_ * 32 + j4_ + 1] = bfhi(loww.x); low_[t_ * 32 + j4_ + 2] = bflo(loww.y); low_[t_ * 32 + j4_ + 3] = bfhi(loww.y); \
    const unsigned w_[8] = {vva.x, vva.y, vva.z, vva.w, vvb.x, vvb.y, vvb.z, vvb.w}; \
    _Pragma("unroll") for (int i = 0; i < 8; ++i) { VT[(v16_ + 2 * i) * GPD + t_] = (bf16_t)(w_[i] & 0xffffu); VT[(v16_ + 2 * i + 1) * GPD + t_] = (bf16_t)(w_[i] >> 16); } } while (0)
DI void gla_a_item(KParams P, Frame& F, int l, int ci, int hh) {
    const bf16_t* U = WSP(bf16_t, WS_U); bf16_t* Sloc = WSP(bf16_t, WS_SLOC); float* dec = WSP(float, WS_DEC);
    int b, row0, jf, jb; gla_chunk_decode(ci, b, row0, jf, jb);
    LAS bf16_t* VT = (LAS bf16_t*)(F.lds + GL_VT); LAS bf16_t* KET = (LAS bf16_t*)(F.lds + GL_A0);
    const int r = F.lane & 31, h = F.lane >> 5, mb = F.wave & 1, nb = F.wave >> 1;
    GLA_PRELOAD();
    GLA_STAGE_LOW_VT();
    __syncthreads();
#pragma unroll
    for (int dir = 0; dir < 2; ++dir) {
        float cs[8], off, total, mid; gla_decay(F, dir, dir ? w2b : w2f, dir ? b2b : b2f, cs, off, total, mid);
        const int cidx = gla_cidx(b, hh, dir, dir ? jb : jf);
#pragma unroll
        for (int i = 0; i < 8; ++i) KET[d * GPD + tg * 8 + i] = f2bf(kraw[i] * __expf(total - (off + cs[i])));
        if (tg == 0) dec[(size_t)cidx * 64 + d] = __expf(total);
        __syncthreads();
        f32x16 acc;
#pragma unroll
        for (int i = 0; i < 16; ++i) acc[i] = 0.f;
        lds_mma_nt(acc, KET, 32 * mb, VT, 32 * nb, r, h);
        bf16_t* sp = Sloc + ((size_t)cidx * 128 + 32 * nb + r) * 64 + 32 * mb + 4 * h;
#pragma unroll
        for (int g = 0; g < 4; ++g) *(u32x2*)(sp + 8 * g) = (u32x2){pk2(acc[4 * g], acc[4 * g + 1]), pk2(acc[4 * g + 2], acc[4 * g + 3])};
        __syncthreads();
    }
}
DI void gla_scan(KParams P, Frame& F) {
    const bf16_t* Sloc = WSP(bf16_t, WS_SLOC); const float* dec = WSP(float, WS_DEC); bf16_t* Sin = WSP(bf16_t, WS_SIN);
    for (int e = F.bid * 512 + F.tid; e < 32 * 4096; e += F.G * 512) { const int chain = e >> 12, vd = (e & 4095) * 2, d = vd & 63; float S0 = 0.f, S1 = 0.f;
#pragma unroll 1
        for (int j0 = 0; j0 < NCHAIN; j0 += 12) { f32x2_t sl[12], dc[12];
#pragma unroll
            for (int j = 0; j < 12; ++j) { const size_t idx = (size_t)chain * NCHAIN + j0 + j; { const unsigned w = *(const unsigned*)(Sloc + idx * 8192 + vd); sl[j] = (f32x2_t){bflo(w), bfhi(w)}; } dc[j] = *(const f32x2_t*)(dec + idx * 64 + d); }
#pragma unroll
            for (int j = 0; j < 12; ++j) { const size_t idx = (size_t)chain * NCHAIN + j0 + j; *(unsigned*)(Sin + idx * 8192 + vd) = pk2(S0, S1); S0 = dc[j][0] * S0 + sl[j][0]; S1 = dc[j][1] * S1 + sl[j][1]; } } }
}
DI void gla_b_item(KParams P, Frame& F, int l, int ci, int hh) {
    const bf16_t* U = WSP(bf16_t, WS_U); const bf16_t* Sin = WSP(bf16_t, WS_SIN); bf16_t* acts = WSP(bf16_t, WS_ACTS);
    int b, row0, jf, jb; gla_chunk_decode(ci, b, row0, jf, jb);
    LAS bf16_t* VT = (LAS bf16_t*)(F.lds + GL_VT); LAS bf16_t* QD = (LAS bf16_t*)(F.lds + GL_A0); LAS bf16_t* KD = (LAS bf16_t*)(F.lds + GL_KD); LAS bf16_t* QI = (LAS bf16_t*)(F.lds + GL_QI);
    LAS bf16_t* ST = (LAS bf16_t*)(F.lds + GL_ST); LAS bf16_t* PP = (LAS bf16_t*)(F.lds + GL_PP); LAS float* OB = (LAS float*)(F.lds + GL_OB);
    const int r = F.lane & 31, h = F.lane >> 5, tb = F.wave & 1, vb = F.wave >> 1;
    GLA_PRELOAD();
    float qraw[8];
#pragma unroll
    for (int i = 0; i < 8; ++i) qraw[i] = bf2f(U[(size_t)(row0 + tg * 8 + i) * PWP + O_GQ + hh * 64 + d]) * 0.125f;
    const int sv = F.tid >> 2, sd16 = (F.tid & 3) * 16;
    const bf16_t* spf = Sin + ((size_t)gla_cidx(b, hh, 0, jf) * 128 + sv) * 64 + sd16; const bf16_t* spb = Sin + ((size_t)gla_cidx(b, hh, 1, jb) * 128 + sv) * 64 + sd16;
    const u32x4 sf0 = *(const u32x4*)spf, sf1 = *(const u32x4*)(spf + 8), sb0 = *(const u32x4*)spb, sb1 = *(const u32x4*)(spb + 8);
    const int ot = F.tid >> 3, ov0 = (F.tid & 7) * 16;
    const bf16_t* rp = U + (size_t)(row0 + ot) * PWP + O_GR + hh * 128 + ov0; const u32x4 r0 = *(const u32x4*)rp, r1 = *(const u32x4*)(rp + 8);
    GLA_STAGE_LOW_VT();
    __syncthreads();
    f32x16 acc;
#pragma unroll
    for (int i = 0; i < 16; ++i) acc[i] = 0.f;
#pragma unroll
    for (int dir = 0; dir < 2; ++dir) {
        float cs[8], off, total, mid; gla_decay(F, dir, dir ? w2b : w2f, dir ? b2b : b2f, cs, off, total, mid);
#pragma unroll
        for (int i = 0; i < 8; ++i) { const int t = tg * 8 + i; const float bc = off + cs[i];
            QD[t * GPD + d] = f2bf(qraw[i] * __expf(bc - mid)); KD[t * GPD + d] = f2bf(kraw[i] * __expf(mid - bc)); QI[t * GPD + d] = f2bf(qraw[i] * __expf(bc)); }
        *(LAS u32x4*)(ST + sv * GPD + sd16) = dir ? sb0 : sf0; *(LAS u32x4*)(ST + sv * GPD + sd16 + 8) = dir ? sb1 : sf1;
        __syncthreads();
        if (F.wave < 4) { const int tb2 = F.wave & 1, sb = F.wave >> 1; f32x16 a;
#pragma unroll
            for (int i = 0; i < 16; ++i) a[i] = 0.f;
            lds_mma_nt(a, QD, 32 * tb2, KD, 32 * sb, r, h);
#pragma unroll
            for (int i = 0; i < 16; ++i) { const int t = 32 * tb2 + (i & 3) + 8 * (i >> 2) + 4 * h, s2 = 32 * sb + r; const bool keep = dir ? (s2 >= t) : (s2 <= t);
                PP[t * GPD + s2] = f2bf(keep ? a[i] : 0.f); } }
        __syncthreads();
        lds_mma_nt(acc, PP, 32 * tb, VT, 32 * vb, r, h);
        lds_mma_nt(acc, QI, 32 * tb, ST, 32 * vb, r, h);
        __syncthreads();
    }
#pragma unroll
    for (int i = 0; i < 16; ++i) OB[(32 * tb + (i & 3) + 8 * (i >> 2) + 4 * h) * 128 + 32 * vb + r] = acc[i];
    __syncthreads();
    { float x[16]; float ss = 0.f;
#pragma unroll
      for (int q = 0; q < 4; ++q) { const f32x4 o = *(const LAS f32x4*)(OB + ot * 128 + ov0 + 4 * q); x[4 * q] = o[0]; x[4 * q + 1] = o[1]; x[4 * q + 2] = o[2]; x[4 * q + 3] = o[3]; }
#pragma unroll
      for (int i = 0; i < 16; ++i) ss += x[i] * x[i];
      ss += __shfl_xor(ss, 1); ss += __shfl_xor(ss, 2); ss += __shfl_xor(ss, 4);
      const float rstd = 1.f / sqrtf(ss * (1.f / 128.f) + EPS);
      const unsigned rw[8] = {r0.x, r0.y, r0.z, r0.w, r1.x, r1.y, r1.z, r1.w}; const float* gn = P->in[I_GGLAN] + l * 128 + ov0; unsigned ow[8];
#pragma unroll
      for (int i = 0; i < 8; ++i) ow[i] = pk2(x[2 * i] * rstd * gn[2 * i] * siluf(bflo(rw[i])), x[2 * i + 1] * rstd * gn[2 * i + 1] * siluf(bfhi(rw[i])));
      bf16_t* op = acts + ((size_t)2 * TT + row0 + ot) * 512 + hh * 128 + ov0;
      *(u32x4*)op = (u32x4){ow[0], ow[1], ow[2], ow[3]}; *(u32x4*)(op + 8) = (u32x4){ow[4], ow[5], ow[6], ow[7]}; }
    __syncthreads();
}
DI float at_max2(float a, float b) { return __builtin_amdgcn_fmed3f(a, b, INFINITY); }
constexpr int AT_KC = 1040, AT_VG = 520;
constexpr int AT_K0 = 0, AT_K1 = 16 * AT_KC, AT_V0 = 32 * AT_KC, AT_V1 = 32 * AT_KC + 16 * AT_VG;
DI void attn_unit(KParams P, Frame& F, int b, int hh, int qrow0, int nlat) {
    const bf16_t* Q = WSP(bf16_t, WS_Q); const bf16_t* KN = WSP(bf16_t, WS_KN); const bf16_t* KRP = WSP(bf16_t, WS_KRP); const bf16_t* VT = WSP(bf16_t, WS_VT); bf16_t* acts = WSP(bf16_t, WS_ACTS);
    const int ntile = nlat + 4; const int r = F.lane & 31, h = F.lane >> 5;
    const int kvi = F.tid >> 3, kc = F.tid & 7;
    const float C = 0.10206207261596577f * 1.4426950408889634f;
    const int qrow = qrow0 + 32 * F.wave + r; const bf16_t* qp = Q + (size_t)qrow * 768 + hh * 96;
    bf16x8 qf[8];
#pragma unroll
    for (int s = 0; s < 4; ++s) { const u32x4 a = *(const u32x4*)(qp + 16 * s + 8 * h);
        u32x4 o; o.x = pk2(C * bflo(a.x), C * bfhi(a.x)); o.y = pk2(C * bflo(a.y), C * bfhi(a.y)); o.z = pk2(C * bflo(a.z), C * bfhi(a.z)); o.w = pk2(C * bflo(a.w), C * bfhi(a.w)); qf[s] = __builtin_bit_cast(bf16x8, o); }
    { const u32x4 a1 = *(const u32x4*)(qp + 64), a2 = *(const u32x4*)(qp + 72), c1 = *(const u32x4*)(qp + 80), c2 = *(const u32x4*)(qp + 88);
      const float ra1[8] = {bflo(a1.x), bfhi(a1.x), bflo(a1.y), bfhi(a1.y), bflo(a1.z), bfhi(a1.z), bflo(a1.w), bfhi(a1.w)}, ra2[8] = {bflo(a2.x), bfhi(a2.x), bflo(a2.y), bfhi(a2.y), bflo(a2.z), bfhi(a2.z), bflo(a2.w), bfhi(a2.w)};
      const float rc1[8] = {bflo(c1.x), bfhi(c1.x), bflo(c1.y), bfhi(c1.y), bflo(c1.z), bfhi(c1.z), bflo(c1.w), bfhi(c1.w)}, rc2[8] = {bflo(c2.x), bfhi(c2.x), bflo(c2.y), bfhi(c2.y), bflo(c2.z), bfhi(c2.z), bflo(c2.w), bfhi(c2.w)};
      float ur[8], uc[8], xr[8], xc[8];
      const int pos = qrow & (SEQ - 1); const float prow = (float)(pos >> 6), pcol = (float)(pos & 63);
#pragma unroll
      for (int i = 0; i < 8; ++i) { ur[i] = C * (h ? ra2[i] : ra1[i]); uc[i] = C * (h ? rc2[i] : rc1[i]);
          if (nlat > 0) { const float f = rope_freq(i); float sn = __sinf(prow * f), cs = __cosf(prow * f); xr[i] = C * (h ? (ra1[i] * sn + ra2[i] * cs) : (ra1[i] * cs - ra2[i] * sn));
              sn = __sinf(pcol * f); cs = __cosf(pcol * f); xc[i] = C * (h ? (rc1[i] * sn + rc2[i] * cs) : (rc1[i] * cs - rc2[i] * sn)); }
          else { xr[i] = 0.f; xc[i] = 0.f; } }
      u32x4 o;
      o.x = pk2(xr[0], xr[1]); o.y = pk2(xr[2], xr[3]); o.z = pk2(xr[4], xr[5]); o.w = pk2(xr[6], xr[7]); qf[4] = __builtin_bit_cast(bf16x8, o);
      o.x = pk2(xc[0], xc[1]); o.y = pk2(xc[2], xc[3]); o.z = pk2(xc[4], xc[5]); o.w = pk2(xc[6], xc[7]); qf[5] = __builtin_bit_cast(bf16x8, o);
      o.x = pk2(ur[0], ur[1]); o.y = pk2(ur[2], ur[3]); o.z = pk2(ur[4], ur[5]); o.w = pk2(ur[6], ur[7]); qf[6] = __builtin_bit_cast(bf16x8, o);
      o.x = pk2(uc[0], uc[1]); o.y = pk2(uc[2], uc[3]); o.z = pk2(uc[4], uc[5]); o.w = pk2(uc[6], uc[7]); qf[7] = __builtin_bit_cast(bf16x8, o); }
    u32x4 kA0, kA1, vA, kB0, kB1, vB;
#define AT_KROW(tl) (((tl) < nlat) ? (b * SEQ + (tl) * 64) : (TLAT + b * CTXL + ((tl) - nlat) * 64))
#define AT_LOADK(tl, R0, R1) do { const int krow0_ = AT_KROW(tl); R0 = *(const u32x4*)(KN + (size_t)(krow0_ + kvi) * 512 + hh * 64 + kc * 8); R1 = *(const u32x4*)(KRP + (size_t)(krow0_ + kvi) * 64 + kc * 8); } while (0)
#define AT_LOADV(tl, R) do { const int krow0_ = AT_KROW(tl); R = *(const u32x4*)(VT + (size_t)(hh * 64 + kvi) * TT + krow0_ + kc * 8); } while (0)
#define AT_STOREK(buf, R0, R1) do { LAS unsigned char* kb_ = F.lds + ((buf) ? AT_K1 : AT_K0); *(LAS u32x4*)(kb_ + kc * AT_KC + kvi * 16) = R0; *(LAS u32x4*)(kb_ + (8 + kc) * AT_KC + kvi * 16) = R1; } while (0)
#define AT_STOREV(buf, R) do { LAS unsigned char* vb_ = F.lds + ((buf) ? AT_V1 : AT_V0); *(LAS u32x2*)(vb_ + (kc & ~1) * AT_KC + kvi * 16 + (kc & 1) * 8) = (u32x2){R.x, R.y}; *(LAS u32x2*)(vb_ + ((kc & ~1) + 1) * AT_KC + kvi * 16 + (kc & 1) * 8) = (u32x2){R.z, R.w}; } while (0)
#define AT_QK(P0, P1, buf, LAT) do { const LAS unsigned char* kb_ = F.lds + ((buf) ? AT_K1 : AT_K0); \
        _Pragma("unroll") for (int i = 0; i < 16; ++i) { P0[i] = 0.f; P1[i] = 0.f; } \
        _Pragma("unroll") for (int s = 0; s < 8; ++s) if ((LAT) ? (s < 6) : (s < 4 || s >= 6)) { const bf16x8 ka0 = *(const LAS bf16x8*)(kb_ + (2 * s + h) * AT_KC + r * 16), ka1 = *(const LAS bf16x8*)(kb_ + (2 * s + h) * AT_KC + (32 + r) * 16); \
            P0 = __builtin_amdgcn_mfma_f32_32x32x16_bf16(ka0, qf[s], P0, 0, 0, 0); P1 = __builtin_amdgcn_mfma_f32_32x32x16_bf16(ka1, qf[s], P1, 0, 0, 0); } } while (0)
#define AT_COMPUTE(tl, LAT) do { const int cur = (tl) & 1; f32x16 pc0, pc1; \
        AT_QK(pc0, pc1, cur, LAT);                                                 \
        const LAS unsigned char* vb = F.lds + (cur ? AT_V1 : AT_V0); \
        float mxa = at_max2(pc0[0], pc0[1]), mxb = at_max2(pc1[0], pc1[1]); \
        _Pragma("unroll") for (int i = 2; i < 16; ++i) { mxa = at_max2(mxa, pc0[i]); mxb = at_max2(mxb, pc1[i]); } \
        float mx = at_max2(mxa, mxb); mx = at_max2(mx, __shfl_xor(mx, 32)); \
        const float mnew = at_max2(m_run, mx), alpha = __builtin_amdgcn_exp2f(m_run - mnew); m_run = mnew; \
        const f32x2_t nm2 = (f32x2_t){-mnew, -mnew}; f32x2_t ps2 = (f32x2_t){0.f, 0.f};                  \
        _Pragma("unroll") for (int i = 0; i < 8; ++i) { \
            f32x2_t ta = (f32x2_t){pc0[2 * i], pc0[2 * i + 1]} + nm2, tb = (f32x2_t){pc1[2 * i], pc1[2 * i + 1]} + nm2; \
            ta[0] = __builtin_amdgcn_exp2f(ta[0]); ta[1] = __builtin_amdgcn_exp2f(ta[1]); tb[0] = __builtin_amdgcn_exp2f(tb[0]); tb[1] = __builtin_amdgcn_exp2f(tb[1]); \
            ps2 = ps2 + (ta + tb); pc0[2 * i] = ta[0]; pc0[2 * i + 1] = ta[1]; pc1[2 * i] = tb[0]; pc1[2 * i + 1] = tb[1]; } \
        const float psum = ps2[0] + ps2[1]; \
        l_run = l_run * alpha + psum; \
        _Pragma("unroll") for (int i = 0; i < 16; ++i) { o0[i] *= alpha; o1[i] *= alpha; } \
        bf16x8 pf[4]; \
        { u32x4 w; \
          w.x = pk2(pc0[0], pc0[1]); w.y = pk2(pc0[2], pc0[3]); w.z = pk2(pc0[4], pc0[5]); w.w = pk2(pc0[6], pc0[7]); pf[0] = __builtin_bit_cast(bf16x8, w); \
          w.x = pk2(pc0[8], pc0[9]); w.y = pk2(pc0[10], pc0[11]); w.z = pk2(pc0[12], pc0[13]); w.w = pk2(pc0[14], pc0[15]); pf[1] = __builtin_bit_cast(bf16x8, w); \
          w.x = pk2(pc1[0], pc1[1]); w.y = pk2(pc1[2], pc1[3]); w.z = pk2(pc1[4], pc1[5]); w.w = pk2(pc1[6], pc1[7]); pf[2] = __builtin_bit_cast(bf16x8, w); \
          w.x = pk2(pc1[8], pc1[9]); w.y = pk2(pc1[10], pc1[11]); w.z = pk2(pc1[12], pc1[13]); w.w = pk2(pc1[14], pc1[15]); pf[3] = __builtin_bit_cast(bf16x8, w); } \
        _Pragma("unroll") for (int s = 0; s < 4; ++s) { \
            const u32x4 va0 = *(const LAS u32x4*)(vb + (2 * s + h) * AT_KC + r * 16), va1 = *(const LAS u32x4*)(vb + (2 * s + h) * AT_KC + (32 + r) * 16); \
            o0 = __builtin_amdgcn_mfma_f32_32x32x16_bf16(__builtin_bit_cast(bf16x8, va0), pf[s], o0, 0, 0, 0); \
            o1 = __builtin_amdgcn_mfma_f32_32x32x16_bf16(__builtin_bit_cast(bf16x8, va1), pf[s], o1, 0, 0, 0); } } while (0)
#define AT_ITER(tl, LAT, LK0, LK1, LV, SK0, SK1, SV) do { \
        if ((tl) + 2 < ntile) { AT_LOADK((tl) + 2, LK0, LK1); AT_LOADV((tl) + 2, LV); } \
        AT_COMPUTE(tl, LAT); \
        if ((tl) + 1 < ntile) { AT_STOREK(((tl) & 1) ^ 1, SK0, SK1); AT_STOREV(((tl) & 1) ^ 1, SV); } \
        __syncthreads(); } while (0)
    float m_run = -INFINITY, l_run = 0.f; f32x16 o0, o1;
#pragma unroll
    for (int i = 0; i < 16; ++i) { o0[i] = 0.f; o1[i] = 0.f; }
    AT_LOADK(0, kA0, kA1); AT_LOADV(0, vA); AT_LOADK(1, kB0, kB1); AT_LOADV(1, vB);
    AT_STOREK(0, kA0, kA1); AT_STOREV(0, vA);
    __syncthreads();
#pragma unroll 1
    for (int tl = 0; tl < nlat; tl += 2) {
        AT_ITER(tl, true, kA0, kA1, vA, kB0, kB1, vB);
        AT_ITER(tl + 1, true, kB0, kB1, vB, kA0, kA1, vA);
    }
#pragma unroll 1
    for (int tl = nlat; tl < ntile; tl += 2) {
        AT_ITER(tl, false, kA0, kA1, vA, kB0, kB1, vB);
        AT_ITER(tl + 1, false, kB0, kB1, vB, kA0, kA1, vA);
    }
#undef AT_COMPUTE
#undef AT_ITER
#undef AT_KROW
#undef AT_LOADK
#undef AT_LOADV
#undef AT_STOREK
#undef AT_STOREV
#undef AT_QK
    const float inv = 1.f / (l_run + __shfl_xor(l_run, 32));
    bf16_t* op = acts + (size_t)qrow * 512 + hh * 64 + 4 * h;
#pragma unroll
    for (int g = 0; g < 4; ++g) { u32x2 w; w.x = pk2(o0[4 * g] * inv, o0[4 * g + 1] * inv); w.y = pk2(o0[4 * g + 2] * inv, o0[4 * g + 3] * inv); *(u32x2*)(op + 8 * g) = w;
        w.x = pk2(o1[4 * g] * inv, o1[4 * g + 1] * inv); w.y = pk2(o1[4 * g + 2] * inv, o1[4 * g + 3] * inv); *(u32x2*)(op + 32 + 8 * g) = w; }
}

DI KParams load_params() { KParams kp = (KParams)__builtin_amdgcn_kernarg_segment_ptr(); asm volatile("" : "+s"(kp)); return kp; }
DI Frame phase_frame(const Frame& F0) { Frame F = F0; int t = F0.tid; asm volatile("" : "+v"(t)); { int b = F0.bid, g = F0.G; asm volatile("" : "+s"(b), "+s"(g)); F.bid = b; F.G = g; F.NGW = g * 8; } F.tid = t; F.lane = t & 63; F.wave = __builtin_amdgcn_readfirstlane(t >> 6); F.gw = F.bid * 8 + F.wave; return F; }
constexpr int PH_PER_LAYER = 10, NPHASE = 1 + DEPTH * PH_PER_LAYER + 1;
__global__ void __launch_bounds__(512, 2) hybrid_trunk_fwd(Params P) {
    extern __shared__ __attribute__((aligned(16))) unsigned char lds_raw[];
    Frame F; F.lds = (LAS unsigned char*)lds_raw; F.tid = threadIdx.x; F.lane = F.tid & 63; F.wave = __builtin_amdgcn_readfirstlane(F.tid >> 6);
    F.G = gridDim.x; F.bid = blockIdx.x; F.gw = F.bid * 8 + F.wave; F.NGW = F.G * 8;
    const int vcu = (F.G % 8 == 0) ? (F.bid % 8) * (F.G / 8) + F.bid / 8 : F.bid;
    for (int u = F.tid; u < (LDS_BYTES - LDSX_OFF) / 4; u += 512) ((LAS unsigned*)(F.lds + LDSX_OFF))[u] = 0u;
    __syncthreads();
    const int lo = P.ph_lo, hi = P.ph_hi;
    XcdBarrier bar; bar.bar = (unsigned*)(P.ws + WS_CTL) + CW_BAR; bar.x = 0; bar.st = (volatile LAS unsigned*)(F.lds + LDSX_OFF);
    if (hi - lo > 1) bar = xcd_barrier_post((unsigned*)(P.ws + WS_CTL) + CW_BAR, (volatile LAS unsigned*)(F.lds + LDSX_OFF));
#ifndef PH_MASK
#define PH_MASK 0xffff
#endif
#define PHM(b) ((PH_MASK >> (b)) & 1)
#ifndef DUP_MASK
#define DUP_MASK 0
#endif
#define REP(b) (1 + ((DUP_MASK >> (b)) & 1))
#define IN(k) (lo <= (k) && (k) < hi)
#ifndef DUP_BAR
#define DUP_BAR 0
#endif
#define SEAM(k) do { if (IN(k) && IN((k) + 1)) { xcd_barrier(bar); if (DUP_BAR) xcd_barrier(bar); } } while (0)
    if (PHM(0) && IN(0)) for (int rep_ = 0; rep_ < REP(0); ++rep_) { KParams Q = load_params(); Frame Fp = phase_frame(F); phase_prologue(Q, Fp);
        conv_mixed(Q, Fp, 0, 0, NS_ALL, 0, NL_ITEMS, Fp.bid, Fp.G); }
    SEAM(0);
    for (int l = 0; l < DEPTH; ++l) {
        const int pb = 1 + PH_PER_LAYER * l;
        if (PHM(1) && IN(pb + 0)) for (int rep_ = 0; rep_ < REP(1); ++rep_) { KParams Q = load_params(); Frame Fp = phase_frame(F); phase_norm1(Q, Fp, l, rep_ + 1 < REP(1)); }
        SEAM(pb + 0);
        if (PHM(2) && IN(pb + 1)) for (int rep_ = 0; rep_ < REP(2); ++rep_) { KParams Q = load_params(); Frame Fp = phase_frame(F);
            const bool lastl = (l == DEPTH - 1); const int nM1 = lastl ? TLAT / 256 : TT / 256;
            pg8::Gemm g8{(const bf16_t*)(Q->ws + WS_H8), (const bf16_t*)(Q->ws + WS_W8 + (size_t)l * PWP * DM), DM / 2, 0, 0};
            pg8::TrimOrder S8{nM1, PWP / 256, nM1 * (PWP / 256), lastl ? (TCTX / 256) * 6 : 0, Fp.G, Fp.bid};
            pg8::EpiStoreQ E8{(bf16_t*)(Q->ws + WS_U), PWP, (const float*)(Q->ws + WS_RA), (const float*)(Q->ws + WS_RB) + (size_t)l * PWP, Q->ws + WS_G8};
            pg8::gemm_phase_i8<pg8::EpiStoreQ, pg8::TrimOrder>(Fp.lds, g8, S8, E8); }
        SEAM(pb + 1);
        if (PHM(3) && IN(pb + 2)) for (int rep_ = 0; rep_ < REP(3); ++rep_) { KParams Q = load_params(); Frame Fp = phase_frame(F); bf16_t* U = (bf16_t*)(Q->ws + WS_U); (void)U; mla_prep_rows(Q, Fp, l);
            const int ncf = (l == DEPTH - 1) ? TLAT / 32 : TT / 32;
            for (int it = vcu; it < ncf; it += Fp.G) cf_sc_tile(Q, Fp, l, it);
            { const int extra = ncf > Fp.G ? ncf - Fp.G : 0;
              if (vcu >= extra) for (int it = vcu - extra; it < 144 * 4; it += Fp.G - extra) gla_a_item(Q, Fp, l, it >> 2, it & 3); } }
        SEAM(pb + 2);
        if (PHM(4) && IN(pb + 3)) for (int rep_ = 0; rep_ < REP(4); ++rep_) { KParams Q = load_params(); Frame Fp = phase_frame(F); bf16_t* U = (bf16_t*)(Q->ws + WS_U); (void)U;
            const int nq = ((l == DEPTH - 1) ? TLAT / 256 : TT / 256) * 3;
            { pg8::Gemm g{WSQ(bf16_t, WS_CQN), WSQ(bf16_t, WS_WUQ) + (size_t)l * 768 * 512, 512, 0, 0}; pg8::RangeOrder S{0, nq, 3, Fp.G, Fp.bid}; pg8::EpiStore E{WSQ(bf16_t, WS_Q), 768};
              pg8::gemm_phase<pg8::EpiStore, pg8::RangeOrder>(Fp.lds, g, S, E); }
            { const bf16_t* ckvn = WSQ(bf16_t, WS_CKVN); const bf16_t* wkn = WSQ(bf16_t, WS_WKN) + (size_t)l * 512 * 256; const bf16_t* wv = WSQ(bf16_t, WS_WV) + (size_t)l * 512 * 256;
              pg8::Gemm g{ckvn, wkn, 256, (size_t)((const char*)wv - (const char*)ckvn), (size_t)((const char*)ckvn - (const char*)wkn)};
              pg8::Range2Order S{nq, 72, 2, 72, 36, Fp.G, Fp.bid}; pg8::EpiStore2 E{WSQ(bf16_t, WS_KN), 512, WSQ(bf16_t, WS_VT), TT};
              pg8::gemm_phase<pg8::EpiStore2, pg8::Range2Order>(Fp.lds, g, S, E); }
            gla_scan(Q, Fp); }
        SEAM(pb + 3);
        if (PHM(5) && IN(pb + 4)) for (int rep_ = 0; rep_ < REP(5); ++rep_) { KParams Q = load_params(); Frame Fp = phase_frame(F); bf16_t* U = (bf16_t*)(Q->ws + WS_U); (void)U;
            for (int u = vcu; u < 256; u += Fp.G) attn_unit(Q, Fp, u >> 6, (u >> 3) & 7, (u >> 6) * SEQ + (u & 7) * 256, 32);
            const bool lastl = (l == DEPTH - 1);
            if (!lastl) for (int u = vcu; u < 32; u += Fp.G) attn_unit(Q, Fp, u >> 3, u & 7, TLAT + (u >> 3) * CTXL, 0);
            for (int it = vcu; it < (lastl ? 128 : 144) * 4; it += Fp.G) gla_b_item(Q, Fp, l, it >> 2, it & 3); }
        SEAM(pb + 4);
        if (PHM(6) && IN(pb + 5)) for (int rep_ = 0; rep_ < REP(6); ++rep_) { KParams Q = load_params(); Frame Fp = phase_frame(F); bf16_t* U = (bf16_t*)(Q->ws + WS_U); (void)U; pg8::Gemm g{WSQ(bf16_t, WS_ACTS), WSQ(bf16_t, WS_WBR) + (size_t)l * 4 * DM * 512, 512, (size_t)TT * 512 * 2, (size_t)DM * 512 * 2}; pg8::MergeOrder S; S.init((l == DEPTH - 1) ? TLAT : TT, DM, Fp.G, Fp.bid);
            LAS float* gtab = (LAS float*)(Fp.lds + LDSX_OFF + 4096);
            if (Fp.tid < 256) { const float x = (float)(Fp.tid - 128) * (GATE_CLIP / 127.f), e = expf(-x); gtab[Fp.tid] = 1.f / (1.f + e); gtab[256 + Fp.tid] = 1.f + e; }
            __syncthreads();
            pg8::EpiMerge E{WSQ(bf16_t, WS_YM), (const unsigned char*)(Q->ws + WS_G8), gtab}; pg8::gemm_phase<pg8::EpiMerge, pg8::MergeOrder>(Fp.lds, g, S, E);
            if (l + 1 < DEPTH && rep_ == 0) { KParams Q2 = load_params(); Frame F2 = phase_frame(F); const int extra = (TT / 256) * (DM / 256) % F2.G; conv_mixed(Q2, F2, l + 1, 0, 600, 0, NL_F1, extra ? F2.bid - extra : F2.bid, extra ? F2.G - extra : F2.G); } }
        SEAM(pb + 5);
        if (PHM(7) && IN(pb + 6)) for (int rep_ = 0; rep_ < REP(7); ++rep_) { KParams Q = load_params(); Frame Fp = phase_frame(F); bf16_t* U = (bf16_t*)(Q->ws + WS_U); (void)U; pg8::Gemm g{WSQ(bf16_t, WS_YM), WSQ(bf16_t, WS_WMIX) + (size_t)l * DM * DM, DM, 0, 0}; pg8::StaticOrder S; S.init((l == DEPTH - 1) ? TLAT : TT, DM, Fp.G, Fp.bid);
            pg8::EpiResid E{WSQ(bf16_t, WS_X), WSQ(float, WS_MOD) + (size_t)l * 5 * (6 * DM) + 2 * DM, (rep_ + 1 < REP(7)) ? WSQ(bf16_t, WS_OUTS) : WSQ(bf16_t, WS_X)}; pg8::gemm_phase<pg8::EpiResid, pg8::StaticOrder>(Fp.lds, g, S, E);
            if (l + 1 < DEPTH && rep_ == 0) { KParams Q2 = load_params(); Frame F2 = phase_frame(F); const int extra = (TT / 256) * (DM / 256) % F2.G; conv_mixed(Q2, F2, l + 1, 600, 870, NL_F1, NL_F2, extra ? F2.bid - extra : F2.bid, extra ? F2.G - extra : F2.G); } }
        SEAM(pb + 6);
        if (PHM(8) && IN(pb + 7)) for (int rep_ = 0; rep_ < REP(8); ++rep_) { KParams Q = load_params(); Frame Fp = phase_frame(F); phase_norm2_route(Q, Fp, l, (rep_ + 1 < REP(8)) ? l + 4 : l); }
        SEAM(pb + 7);
        if (PHM(10) && IN(pb + 8)) for (int rep_ = 0; rep_ < REP(10); ++rep_) { KParams Q = load_params(); Frame Fp = phase_frame(F); bf16_t* U = (bf16_t*)(Q->ws + WS_U); (void)U; moe_table(Q, Fp, l);
            const LAS int* tpt = (const LAS int*)(Fp.lds + LDSX_OFF + 64);
            pg8::Gemm g{WSQ(bf16_t, WS_H), (const bf16_t*)(Q->ws + WS_W1 + (size_t)l * 16 * 1024 * DM), DM / 2, 0, (size_t)1024 * DM}; pg8::MoeOrder S{tpt, 4, Fp.G, Fp.bid};
            pg8::EpiSwiGLUQG E{WSQ(bf16_t, WS_ACTM), (const float*)(Q->ws + WS_ERW), (const float*)(Q->ws + WS_ERS), (const float*)(Q->ws + WS_RB1) + (size_t)l * 16 * 1024, tpt};
            pg8::gemm_phase_i8<pg8::EpiSwiGLUQG, pg8::MoeOrder, true>(Fp.lds, g, S, E, (const int*)(Q->ws + WS_ETOK), tpt);
            if (l + 1 < DEPTH && rep_ == 0) { KParams Q2 = load_params(); Frame F2 = phase_frame(F); const int nun = ((const LAS int*)(F2.lds + LDSX_OFF + 64))[16] * 4, extra = nun % F2.G;
                conv_mixed(Q2, F2, l + 1, 870, NS_ALL, NL_F2, NL_ITEMS, extra ? F2.bid - extra : F2.bid, extra ? F2.G - extra : F2.G); } }
        SEAM(pb + 8);
        if (PHM(11) && IN(pb + 9)) for (int rep_ = 0; rep_ < REP(11); ++rep_) { KParams Q = load_params(); Frame Fp = phase_frame(F); bf16_t* U = (bf16_t*)(Q->ws + WS_U); (void)U; moe_table(Q, Fp, l);
            pg8::Gemm g{WSQ(bf16_t, WS_ACTM), WSQ(bf16_t, WS_W2) + (size_t)l * 16 * DM * EFF, EFF, 0, (size_t)DM * EFF * 2}; pg8::MoeOrder S{(const LAS int*)(Fp.lds + LDSX_OFF + 64), 8, Fp.G, Fp.bid};
            pg8::EpiStore E{WSQ(bf16_t, WS_OUTS), DM}; pg8::gemm_phase<pg8::EpiStore, pg8::MoeOrder>(Fp.lds, g, S, E); }
        SEAM(pb + 9);
    }
    if (PHM(12) && IN(NPHASE - 1)) for (int rep_ = 0; rep_ < REP(12); ++rep_) { KParams Q = load_params(); Frame Fp = phase_frame(F); phase_final(Q, Fp); }
#undef IN
#undef SEAM
}

#ifndef MK_ONE_LAUNCH
#define MK_ONE_LAUNCH 1
#endif
extern "C" void kernel_launch(void* const* d_in, const int* in_sizes, int n_in, void* d_out, int out_size, void* d_ws, size_t ws_size, hipStream_t stream) {
    static int grid = 0;
    if (grid == 0) {
        if (n_in != 34 || out_size != TLAT * DM || ws_size < WS_END) { fprintf(stderr, "kernel_launch: unexpected problem: n_in %d out %d ws %zu (need %zu)\n", n_in, out_size, ws_size, (size_t)WS_END); grid = -1; return; }
        int dev = 0, cus = 0, per_cu = 0;
        if (hipGetDevice(&dev) != hipSuccess || hipDeviceGetAttribute(&cus, hipDeviceAttributeMultiprocessorCount, dev) != hipSuccess) { grid = -1; return; }
        if (hipFuncSetAttribute((const void*)hybrid_trunk_fwd, hipFuncAttributeMaxDynamicSharedMemorySize, LDS_BYTES) != hipSuccess) { fprintf(stderr, "kernel_launch: hipFuncSetAttribute failed\n"); grid = -1; return; }
        if (hipOccupancyMaxActiveBlocksPerMultiprocessor(&per_cu, (const void*)hybrid_trunk_fwd, 512, LDS_BYTES) != hipSuccess || per_cu < 1) { fprintf(stderr, "kernel_launch: occupancy query says %d\n", per_cu); }
        (void)hipGetLastError();
        grid = cus;
    }
    if (grid < 0) return;
    (void)hipMemsetAsync((char*)d_ws + WS_CTL, 0, CTL_ZERO_BYTES, stream);
    Params p{};
    for (int i = 0; i < 34; ++i) p.in[i] = (const float*)d_in[i];
    p.out = (float*)d_out; p.ws = (unsigned char*)d_ws;
#if MK_ONE_LAUNCH
    p.ph_lo = 0; p.ph_hi = NPHASE;
    hipLaunchKernelGGL(hybrid_trunk_fwd, dim3(grid), dim3(512), LDS_BYTES, stream, p);
#else
    for (int k = 0; k < NPHASE; ++k) { p.ph_lo = k; p.ph_hi = k + 1; hipLaunchKernelGGL(hybrid_trunk_fwd, dim3(grid), dim3(512), LDS_BYTES, stream, p); }
#endif
}
```

```cpp
#include <hip/hip_runtime.h>
#include <cstdio>
#include <cstdint>

#define DI __device__ __forceinline__
#define LAS __attribute__((address_space(3)))
typedef unsigned short bf16_t;
typedef short bf16x8 __attribute__((ext_vector_type(8)));
typedef short s16x4 __attribute__((ext_vector_type(4)));
typedef float f32x4 __attribute__((ext_vector_type(4)));
typedef float f32x16 __attribute__((ext_vector_type(16)));
typedef unsigned u32x4 __attribute__((ext_vector_type(4)));
typedef unsigned u32x2 __attribute__((ext_vector_type(2)));
typedef float f32x2_t __attribute__((ext_vector_type(2)));
typedef __bf16 bf16x2_t __attribute__((ext_vector_type(2)));
typedef int v4i_t __attribute__((ext_vector_type(4)));

constexpr int DM = 2048, NB = 4, SEQ = 2048, DEPTH = 4, CTXL = 256;
constexpr int TLAT = NB * SEQ, TCTX = NB * CTXL, TT = TLAT + TCTX;
constexpr int PW = 13120, PWP = 13312;
constexpr int O_CQ = 0, O_CKV = 512, O_KR = 768, O_CF = 800, O_GQ = 1824, O_GK = 2080, O_GV = 2336, O_GF = 2848, O_GB = 2864, O_GR = 2880, O_SC = 3392, O_MG = 4928;
constexpr int GCOL0 = 5120; constexpr float GATE_CLIP = 8.f;
DI int wcol_dest(int n0) { return n0 < O_MG ? n0 : n0 + (GCOL0 - O_MG); }
constexpr int NEXP = 16, EFF = 512, MOE_ROWS = 22528;
constexpr float EPS = 1e-6f;
constexpr int NCHAIN = 36;

DI float bflo(unsigned w) { return __uint_as_float(w << 16); }
DI float bfhi(unsigned w) { return __uint_as_float(w & 0xffff0000u); }
DI float bf2f(bf16_t v) { return __uint_as_float(((unsigned)v) << 16); }
DI unsigned pk2(float lo, float hi) { f32x2_t v = {lo, hi}; bf16x2_t b = __builtin_convertvector(v, bf16x2_t); return __builtin_bit_cast(unsigned, b); }
DI bf16_t f2bf(float f) { return (bf16_t)(pk2(f, 0.f) & 0xffffu); }
DI unsigned q8(float v) { int q = __float2int_rn(v); q = q > 127 ? 127 : q; q = q < -127 ? -127 : q; return (unsigned)q & 255u; }
DI float dpp_f(float v, int ctrl_sel) {
    const int x = __float_as_int(v); int r;
    switch (ctrl_sel) { case 0: r = __builtin_amdgcn_mov_dpp(x, 0xB1, 0xF, 0xF, true); break;
                        case 1: r = __builtin_amdgcn_mov_dpp(x, 0x4E, 0xF, 0xF, true); break;
                        case 2: r = __builtin_amdgcn_mov_dpp(x, 0x141, 0xF, 0xF, true); break;
                        default: r = __builtin_amdgcn_mov_dpp(x, 0x140, 0xF, 0xF, true); break; }
    return __int_as_float(r);
}
DI float wave_sum(float v) {
    v += dpp_f(v, 0); v += dpp_f(v, 1); v += dpp_f(v, 2); v += dpp_f(v, 3);
    { const auto r = __builtin_amdgcn_permlane16_swap(__float_as_uint(v), __float_as_uint(v), false, false); v = __uint_as_float(r[0]) + __uint_as_float(r[1]); }
    { const auto r = __builtin_amdgcn_permlane32_swap(__float_as_uint(v), __float_as_uint(v), false, false); v = __uint_as_float(r[0]) + __uint_as_float(r[1]); }
    return v;
}
DI float sigm(float x) { return __builtin_amdgcn_rcpf(1.f + __expf(-x)); }
DI float siluf(float x) { return x * __builtin_amdgcn_rcpf(1.f + __expf(-x)); }
#define LDS_WAIT() asm volatile("s_waitcnt lgkmcnt(0)" ::: "memory")
#define VM_WAIT() asm volatile("s_waitcnt vmcnt(0)" ::: "memory")

namespace pg8 {
constexpr int BM = 256, BK = 64, HALF = 128, HTB = HALF * BK * 2, STAGE_BYTES = 8 * HTB, NXCD = 8, WGM = 8;
DI int lds_byte(int r, int c) { const int st = (r >> 4) * 2 + (c >> 5), rr = r & 15, cc = c & 31, ob = rr * 64 + cc * 2; return st * 1024 + (ob ^ (((ob >> 9) & 1) << 5)); }
DI void stage_rc(int b, int& R, int& C) { const int st = b / 1024, sb = b % 1024, swz = sb ^ (((sb >> 9) & 1) << 5); R = (st >> 1) * 16 + swz / 64; C = (st & 1) * 32 + (swz % 64) / 2; }
DI int perm32(int rho) { const int n = rho >> 4, i = rho & 15; return 8 * (i >> 2) + 4 * n + (i & 3); }

struct Unit { int pm, pn, grp; };
struct Gemm { const bf16_t* A; const bf16_t* Bt; int K; size_t gsA, gsB; };

DI void tile_of(int wgid0, int nM, int nN, int& pm, int& pn) {
    const int nwg = nM * nN; int wgid = wgid0;
    { const int q = nwg / NXCD, r = nwg % NXCD, xcd = wgid % NXCD, off = wgid / NXCD; wgid = (xcd < r ? xcd * (q + 1) : r * (q + 1) + (xcd - r) * q) + off; }
    const int nig = WGM * nN, gid = wgid / nig, fm = gid * WGM, gsz = (nM - fm) < WGM ? (nM - fm) : WGM;
    pm = fm + ((wgid % nig) % gsz); pn = (wgid % nig) / gsz;
}
struct StaticOrder {
    int nM, nN, nwg, G, c;
    DI void init(int M, int N, int G_, int c_) { nM = M / BM; nN = N / BM; nwg = nM * nN; G = G_; c = c_; }
    DI bool next(int i, Unit& u) const { const int L = i * G + c; if (L >= nwg) return false; tile_of(L, nM, nN, u.pm, u.pn); u.grp = 0; return true; }
};
struct TrimOrder {
    int nM1, nN, n1, nctx, G, c;
    DI bool next(int i, Unit& u) const { const int L = i * G + c; u.grp = 0;
        if (L < n1) { tile_of(L, nM1, nN, u.pm, u.pn); return true; }
        const int q = L - n1; if (q >= nctx) return false; const int j = q % 6; u.pm = nM1 + q / 6; u.pn = j < 2 ? 2 + j : 6 + j; return true; }
};
struct RangeOrder {
    int first, count, nN, G, c;
    DI bool next(int i, Unit& u) const { const int L = i * G + c - first; if (L < 0 || L >= count) return false; u.pm = L / nN; u.pn = L % nN; u.grp = 0; return true; }
};
struct Range2Order {
    int first, count0, nN0, count1, nN1, G, c;
    DI bool next(int i, Unit& u) const { int L = i * G + c - first; if (L < 0) return false;
        if (L < count0) { u.pm = L / nN0; u.pn = L % nN0; u.grp = 0; return true; }
        L -= count0; if (L >= count1) return false; u.pm = L / nN1; u.pn = L % nN1; u.grp = 1; return true; }
};
struct MergeOrder {
    int nM, nN, nwg, G, c;
    DI void init(int M, int N, int G_, int c_) { nM = M / BM; nN = N / BM; nwg = nM * nN; G = G_; c = c_; }
    DI bool next(int i, Unit& u) const { const int L = (i >> 2) * G + c; if (L >= nwg) return false; tile_of(L, nM, nN, u.pm, u.pn); u.grp = i & 3; return true; }
};
struct MoeOrder {
    const LAS int* tp; int ncol, G, c;
    DI bool next(int i, Unit& u) const {
        const int L = i * G + c, ntile = tp[16]; if (L >= ntile * ncol) return false;
        const int rt = L / ncol; int e = 0;
#pragma unroll
        for (int j = 1; j < 16; ++j) e += (rt >= tp[j]) ? 1 : 0;
        u.pm = rt; u.pn = L % ncol; u.grp = e; return true;
    }
};

struct EpiStore {
    static constexpr bool PERM = true;
    bf16_t* O; int ldc;
    DI bool operator()(f32x4 (&acc)[2][2][4][2], const Unit& u, int wr, int wc, int fr, int fq) const {
        const int row0 = u.pm * BM + wr * 64 + fr, col0 = u.pn * BM + wc * 32 + 8 * fq;
#pragma unroll
        for (int ai = 0; ai < 2; ++ai)
#pragma unroll
            for (int m = 0; m < 4; ++m) { bf16_t* rowp = O + (size_t)(row0 + ai * HALF + m * 16) * ldc + col0;
#pragma unroll
                for (int bj = 0; bj < 2; ++bj) { const f32x4 v0 = acc[ai][bj][m][0], v1 = acc[ai][bj][m][1];
                    u32x4 w; w.x = pk2(v0[0], v0[1]); w.y = pk2(v0[2], v0[3]); w.z = pk2(v1[0], v1[1]); w.w = pk2(v1[2], v1[3]);
                    *(u32x4*)(rowp + bj * HALF) = w; } }
        return false;
    }
};
struct EpiStoreQ {
    static constexpr bool PERM = true;
    bf16_t* O; int ldc; const float* rA; const float* rB; unsigned char* G8;
    DI bool operator()(v4i_t (&acc)[2][2][4][2], const Unit& u, int wr, int wc, int fr, int fq) const {
        const int row0 = u.pm * BM + wr * 64 + fr, col0 = u.pn * BM + wc * 32 + 8 * fq;
        f32x4 cb[2][2];
#pragma unroll
        for (int bj = 0; bj < 2; ++bj) { cb[bj][0] = *(const f32x4*)(rB + col0 + bj * HALF); cb[bj][1] = *(const f32x4*)(rB + col0 + bj * HALF + 4); }
        float rav[2][4];
#pragma unroll
        for (int ai = 0; ai < 2; ++ai)
#pragma unroll
            for (int m = 0; m < 4; ++m) rav[ai][m] = rA[row0 + ai * HALF + m * 16];
        __builtin_amdgcn_sched_barrier(0);
        if (col0 >= GCOL0) {
            const float qs = 127.f / GATE_CLIP;
#pragma unroll
            for (int ai = 0; ai < 2; ++ai)
#pragma unroll
                for (int m = 0; m < 4; ++m) { const float ra = rav[ai][m] * qs;
                    unsigned char* rowp = G8 + (size_t)(u.pm * 32 + (u.pn - GCOL0 / BM)) * 65536 + (((wr * 4 + wc) * 8 + ai * 4 + m) * 64 + fr + 16 * fq) * 16;
                    unsigned ww[4] = {0u, 0u, 0u, 0u};
#pragma unroll
                    for (int bj = 0; bj < 2; ++bj) { const v4i_t a0 = acc[ai][bj][m][0], a1 = acc[ai][bj][m][1]; const f32x4 c0 = cb[bj][0] * ra, c1 = cb[bj][1] * ra;
#pragma unroll
                        for (int j = 0; j < 4; ++j) { ww[2 * bj] = __builtin_amdgcn_cvt_pk_u8_f32((float)a0[j] * c0[j] + 128.0f, j, ww[2 * bj]); ww[2 * bj + 1] = __builtin_amdgcn_cvt_pk_u8_f32((float)a1[j] * c1[j] + 128.0f, j, ww[2 * bj + 1]); } }
                    *(u32x4*)rowp = (u32x4){ww[0], ww[1], ww[2], ww[3]}; }
            return false;
        }
#pragma unroll
        for (int ai = 0; ai < 2; ++ai)
#pragma unroll
            for (int m = 0; m < 4; ++m) { const int row = row0 + ai * HALF + m * 16; const float ra = rav[ai][m]; bf16_t* rowp = O + (size_t)row * ldc + col0;
#pragma unroll
                for (int bj = 0; bj < 2; ++bj) { const v4i_t a0 = acc[ai][bj][m][0], a1 = acc[ai][bj][m][1]; const f32x4 c0 = cb[bj][0] * ra, c1 = cb[bj][1] * ra;
                    u32x4 w; w.x = pk2((float)a0[0] * c0[0], (float)a0[1] * c0[1]); w.y = pk2((float)a0[2] * c0[2], (float)a0[3] * c0[3]);
                    w.z = pk2((float)a1[0] * c1[0], (float)a1[1] * c1[1]); w.w = pk2((float)a1[2] * c1[2], (float)a1[3] * c1[3]);
                    *(u32x4*)(rowp + bj * HALF) = w; } }
        return false;
    }
};
struct EpiStore2 {
    static constexpr bool PERM = true;
    bf16_t* O0; int ldc0; bf16_t* O1; int ldc1;
    DI bool operator()(f32x4 (&acc)[2][2][4][2], const Unit& u, int wr, int wc, int fr, int fq) const {
        const EpiStore E{u.grp ? O1 : O0, u.grp ? ldc1 : ldc0}; return E(acc, u, wr, wc, fr, fq);
    }
};
struct EpiMerge {
    static constexpr bool PERM = true;
    bf16_t* Y; const unsigned char* G8;
    const LAS float* tab;
    DI static int qi(unsigned w, int i) { return (int)((w >> (8 * i)) & 255u); }
    DI bool operator()(f32x4 (&acc)[2][2][4][2], const Unit& u, int wr, int wc, int fr, int fq) const {
        const int row0 = u.pm * BM + wr * 64 + fr, col0 = u.pn * BM + wc * 32 + 8 * fq; const int grp = u.grp;
        const unsigned char* gp = G8 + (size_t)(u.pm * 32 + grp * 8 + u.pn) * 65536 + ((wr * 4 + wc) * 8 * 64 + fr + 16 * fq) * 16;
        if (grp < 3) {
            u32x4 ca[8], cb[8];
#pragma unroll
            for (int q = 0; q < 8; ++q) { ca[q] = *(const u32x4*)(gp + q * 1024); cb[q] = *(const u32x4*)(gp + 8 * 65536 + q * 1024); }
            __builtin_amdgcn_sched_barrier(0);
#pragma unroll
            for (int ai = 0; ai < 2; ++ai)
#pragma unroll
                for (int m = 0; m < 4; ++m) { const u32x4 a = ca[ai * 4 + m], b = cb[ai * 4 + m];
#pragma unroll
                    for (int bj = 0; bj < 2; ++bj) { const unsigned ax = bj ? a.z : a.x, ay = bj ? a.w : a.y, bx = bj ? b.z : b.x, by = bj ? b.w : b.y;
                        f32x4& a0 = acc[ai][bj][m][0]; f32x4& a1 = acc[ai][bj][m][1];
#pragma unroll
                        for (int j = 0; j < 4; ++j) { a0[j] *= tab[qi(ax, j)] * tab[256 + qi(bx, j)]; a1[j] *= tab[qi(ay, j)] * tab[256 + qi(by, j)]; } } }
            return true;
        }
        u32x4 cg[8];
#pragma unroll
        for (int q = 0; q < 8; ++q) cg[q] = *(const u32x4*)(gp + q * 1024);
        __builtin_amdgcn_sched_barrier(0);
#pragma unroll
        for (int ai = 0; ai < 2; ++ai)
#pragma unroll
            for (int m = 0; m < 4; ++m) { const int row = row0 + ai * HALF + m * 16; const u32x4 g4 = cg[ai * 4 + m];
                bf16_t* yp = Y + (size_t)row * DM + col0;
#pragma unroll
                for (int bj = 0; bj < 2; ++bj) { const unsigned gx = bj ? g4.z : g4.x, gy = bj ? g4.w : g4.y; const f32x4 a0 = acc[ai][bj][m][0], a1 = acc[ai][bj][m][1];
                    u32x4 w; w.x = pk2(a0[0] * tab[qi(gx, 0)], a0[1] * tab[qi(gx, 1)]); w.y = pk2(a0[2] * tab[qi(gx, 2)], a0[3] * tab[qi(gx, 3)]);
                    w.z = pk2(a1[0] * tab[qi(gy, 0)], a1[1] * tab[qi(gy, 1)]); w.w = pk2(a1[2] * tab[qi(gy, 2)], a1[3] * tab[qi(gy, 3)]);
                    *(u32x4*)(yp + bj * HALF) = w; } }
        return false;
    }
};
struct EpiResid {
    static constexpr bool PERM = true;
    bf16_t* X; const float* gate; bf16_t* XO;
    DI bool operator()(f32x4 (&acc)[2][2][4][2], const Unit& u, int wr, int wc, int fr, int fq) const {
        const int row0 = u.pm * BM + wr * 64 + fr, col0 = u.pn * BM + wc * 32 + 8 * fq;
        const int r = (u.pm < TLAT / BM) ? (u.pm >> 3) : 4; const float* gp = gate + (size_t)r * (6 * DM) + col0;
        f32x4 gv[2][2];
#pragma unroll
        for (int bj = 0; bj < 2; ++bj)
#pragma unroll
            for (int n = 0; n < 2; ++n) gv[bj][n] = *(const f32x4*)(gp + bj * HALF + n * 4);
        u32x4 xv[2][4][2];
        const unsigned ob = (unsigned)(row0 * DM + col0) * 2u;
#pragma unroll
        for (int ai = 0; ai < 2; ++ai)
#pragma unroll
            for (int m = 0; m < 4; ++m)
#pragma unroll
                for (int bj = 0; bj < 2; ++bj) xv[ai][m][bj] = *(const u32x4*)((const char*)X + (ob + (unsigned)((ai * HALF + m * 16) * DM + bj * HALF) * 2u));
        __builtin_amdgcn_sched_barrier(0);
#pragma unroll
        for (int ai = 0; ai < 2; ++ai)
#pragma unroll
            for (int m = 0; m < 4; ++m) {
#pragma unroll
                for (int bj = 0; bj < 2; ++bj) { const u32x4 x = xv[ai][m][bj]; const f32x4 a0 = gv[bj][0] * acc[ai][bj][m][0], a1 = gv[bj][1] * acc[ai][bj][m][1];
                    u32x4 o; o.x = pk2(bflo(x.x) + a0[0], bfhi(x.x) + a0[1]); o.y = pk2(bflo(x.y) + a0[2], bfhi(x.y) + a0[3]); o.z = pk2(bflo(x.z) + a1[0], bfhi(x.z) + a1[1]); o.w = pk2(bflo(x.w) + a1[2], bfhi(x.w) + a1[3]);
                    *(u32x4*)((char*)XO + (ob + (unsigned)((ai * HALF + m * 16) * DM + bj * HALF) * 2u)) = o; }
                __builtin_amdgcn_sched_barrier(0); }
        return false;
    }
};
struct EpiSwiGLUQ {
    static constexpr bool PERM = true;
    bf16_t* O; const float* roww; const float* rs; const float* rb1;
    DI bool operator()(v4i_t (&acc)[2][2][4][2], const Unit& u, int wr, int wc, int fr, int fq) const {
        const int row0 = u.pm * BM + wr * 64 + fr, col0 = u.pn * HALF + wc * 32 + 8 * fq; const float* rb = rb1 + (size_t)u.grp * 1024 + u.pn * BM + wc * 32 + 8 * fq;
        const f32x4 bg0 = *(const f32x4*)rb, bg1 = *(const f32x4*)(rb + 4), bu0 = *(const f32x4*)(rb + HALF), bu1 = *(const f32x4*)(rb + HALF + 4);
#pragma unroll
        for (int ai = 0; ai < 2; ++ai)
#pragma unroll
            for (int m = 0; m < 4; ++m) { const int row = row0 + ai * HALF + m * 16; const float w = roww[row], sa = rs[row];
                const v4i_t g0 = acc[ai][0][m][0], g1 = acc[ai][0][m][1], u0 = acc[ai][1][m][0], u1 = acc[ai][1][m][1];
                float v[8];
#pragma unroll
                for (int j = 0; j < 4; ++j) { v[j] = siluf((float)g0[j] * sa * bg0[j]) * ((float)u0[j] * sa * bu0[j]) * w; v[4 + j] = siluf((float)g1[j] * sa * bg1[j]) * ((float)u1[j] * sa * bu1[j]) * w; }
                u32x4 o; o.x = pk2(v[0], v[1]); o.y = pk2(v[2], v[3]); o.z = pk2(v[4], v[5]); o.w = pk2(v[6], v[7]);
                *(u32x4*)(O + (size_t)row * EFF + col0) = o; }
        return false;
    }
};
struct EpiSwiGLUQG {
    static constexpr bool PERM = true;
    bf16_t* O; const float* erw; const float* ers; const float* rb1; const LAS int* tpt;
    DI bool operator()(v4i_t (&acc)[2][2][4][2], const Unit& u, int wr, int wc, int fr, int fq) const {
        const int row0 = u.pm * BM + wr * 64 + fr, col0 = u.pn * HALF + wc * 32 + 8 * fq; const float* rb = rb1 + (size_t)u.grp * 1024 + u.pn * BM + wc * 32 + 8 * fq;
        const int s0 = (u.pm - tpt[u.grp]) * 256 + wr * 64 + fr, cn = tpt[32 + u.grp]; const float* pw = erw + u.grp * TT; const float* ps = ers + u.grp * TT;
        const f32x4 bg0 = *(const f32x4*)rb, bg1 = *(const f32x4*)(rb + 4), bu0 = *(const f32x4*)(rb + HALF), bu1 = *(const f32x4*)(rb + HALF + 4);
        float wv_[2][4], sv_[2][4];
#pragma unroll
        for (int ai = 0; ai < 2; ++ai)
#pragma unroll
            for (int m = 0; m < 4; ++m) { const int sl = s0 + ai * HALF + m * 16; const bool ok = sl < cn; wv_[ai][m] = ok ? pw[ok ? sl : 0] : 0.f; sv_[ai][m] = ok ? ps[ok ? sl : 0] : 0.f; }
        __builtin_amdgcn_sched_barrier(0);
#pragma unroll
        for (int ai = 0; ai < 2; ++ai)
#pragma unroll
            for (int m = 0; m < 4; ++m) { const int row = row0 + ai * HALF + m * 16; const float w = wv_[ai][m], sa = sv_[ai][m];
                const v4i_t g0 = acc[ai][0][m][0], g1 = acc[ai][0][m][1], u0 = acc[ai][1][m][0], u1 = acc[ai][1][m][1];
                float v[8];
#pragma unroll
                for (int j = 0; j < 4; ++j) { v[j] = siluf((float)g0[j] * sa * bg0[j]) * ((float)u0[j] * sa * bu0[j]) * w; v[4 + j] = siluf((float)g1[j] * sa * bg1[j]) * ((float)u1[j] * sa * bu1[j]) * w; }
                u32x4 o; o.x = pk2(v[0], v[1]); o.y = pk2(v[2], v[3]); o.z = pk2(v[4], v[5]); o.w = pk2(v[6], v[7]);
                *(u32x4*)(O + (size_t)row * EFF + col0) = o; }
        return false;
    }
};
struct EpiSwiGLU {
    static constexpr bool PERM = true;
    bf16_t* O; const float* roww;
    DI bool operator()(f32x4 (&acc)[2][2][4][2], const Unit& u, int wr, int wc, int fr, int fq) const {
        const int row0 = u.pm * BM + wr * 64 + fr, col0 = u.pn * HALF + wc * 32 + 8 * fq;
#pragma unroll
        for (int ai = 0; ai < 2; ++ai)
#pragma unroll
            for (int m = 0; m < 4; ++m) { const int row = row0 + ai * HALF + m * 16; const float w = roww[row];
                const f32x4 g0 = acc[ai][0][m][0], g1 = acc[ai][0][m][1], u0 = acc[ai][1][m][0], u1 = acc[ai][1][m][1];
                float v[8];
#pragma unroll
                for (int j = 0; j < 4; ++j) { v[j] = siluf(g0[j]) * u0[j] * w; v[4 + j] = siluf(g1[j]) * u1[j] * w; }
                u32x4 o; o.x = pk2(v[0], v[1]); o.y = pk2(v[2], v[3]); o.z = pk2(v[4], v[5]); o.w = pk2(v[6], v[7]);
                *(u32x4*)(O + (size_t)row * EFF + col0) = o; }
        return false;
    }
};

template <class Epi, class Sched>
DI void gemm_phase(LAS unsigned char* lds, const Gemm g, const Sched& S, const Epi& E) {
    int tid = threadIdx.x; asm volatile("" : "+v"(tid));
    const int wid = __builtin_amdgcn_readfirstlane(tid >> 6), lane = tid & 63, wr = wid >> 2, wc = wid & 3, fr = lane & 15, fq = lane >> 4;
    int K = g.K; asm volatile("" : "+s"(K));
    const int nt = K / BK;
    unsigned voffA[2], voffB[2], gC[2]; int gR[2];
#pragma unroll
    for (int i = 0; i < 2; ++i) { int R, C; stage_rc(tid * 16 + i * 8192, R, C); const int Rb = Epi::PERM ? ((R & ~31) + perm32(R & 31)) : R;
        voffA[i] = (unsigned)(R * K + C) * 2u; voffB[i] = (unsigned)(Rb * K + C) * 2u; gR[i] = R; gC[i] = (unsigned)C * 2u; }
    const size_t kstep = (size_t)(BK * 2);
    const size_t hstep = (size_t)HALF * K * 2;
    const size_t tstep = 2 * hstep;
    const unsigned ldsw = (unsigned)wid * 1024u;
    const int aoff = lds_byte(wr * 64 + fr, fq * 8), boff = lds_byte(wc * 32 + fr, fq * 8);
#define PG8_SA(b, h) (((b) * 2 + (h)) * HTB)
#define PG8_SB(b, h) ((4 + (b) * 2 + (h)) * HTB)
#define PG8_STAGE(bufoff, gbase, voff) do { _Pragma("unroll") for (int _i = 0; _i < 2; ++_i) \
        __builtin_amdgcn_global_load_lds((const unsigned*)((const char*)(gbase) + (voff)[_i]), (LAS unsigned*)(lds + (bufoff) + ldsw + _i * 8192), 16, 0, 0); } while (0)
#define PG8_STAGE2(bufoff, gbase, o0, o1) do { \
        __builtin_amdgcn_global_load_lds((const unsigned*)((const char*)(gbase) + (o0)), (LAS unsigned*)(lds + (bufoff) + ldsw), 16, 0, 0); \
        __builtin_amdgcn_global_load_lds((const unsigned*)((const char*)(gbase) + (o1)), (LAS unsigned*)(lds + (bufoff) + ldsw + 8192), 16, 0, 0); } while (0)
#define PG8_GATH(u, v) do { const int e_ = (u).grp, b_ = ((u).pm - tpt[e_]) * 256, c_ = tpt[32 + e_]; const int* et_ = etok + e_ * TT; \
        _Pragma("unroll") for (int h_ = 0; h_ < 2; ++h_) _Pragma("unroll") for (int i_ = 0; i_ < 2; ++i_) { const int s_ = b_ + h_ * 128 + gR[i_]; const int t_ = (s_ < c_) ? et_[s_] : 0; \
            v[h_][i_] = (unsigned)t_ * (unsigned)(K * 2) + gC[i_]; } } while (0)
#define PG8_LDA(dst, b, h) do { _Pragma("unroll") for (int m = 0; m < 4; ++m) _Pragma("unroll") for (int k = 0; k < 2; ++k) dst[m][k] = *(const LAS bf16x8*)(lds + PG8_SA(b, h) + aoff + m * 2048 + k * 1024); } while (0)
#define PG8_LDB(dst, b, h) do { _Pragma("unroll") for (int n = 0; n < 2; ++n) _Pragma("unroll") for (int k = 0; k < 2; ++k) dst[n][k] = *(const LAS bf16x8*)(lds + PG8_SB(b, h) + boff + n * 2048 + k * 1024); } while (0)
#define PG8_MMA(ai, bj, At, Bt) do { __builtin_amdgcn_s_setprio(1); _Pragma("unroll") for (int m = 0; m < 4; ++m) _Pragma("unroll") for (int n = 0; n < 2; ++n) _Pragma("unroll") for (int k = 0; k < 2; ++k) \
        acc[ai][bj][m][n] = __builtin_amdgcn_mfma_f32_16x16x32_bf16(Bt[n][k], At[m][k], acc[ai][bj][m][n], 0, 0, 0); __builtin_amdgcn_s_setprio(0); } while (0)
#define PG8_WAIT_V(n) asm volatile("s_waitcnt vmcnt(" #n ")" ::: "memory")
#define PG8_WAIT_L(n) asm volatile("s_waitcnt lgkmcnt(" #n ")" ::: "memory")
#define PG8_BAR __builtin_amdgcn_s_barrier()
#define PG8_SCHED __builtin_amdgcn_sched_barrier(0)
    Unit cur, nxt; int ui = 0;
    if (!S.next(0, cur)) return;
    cur.pm = __builtin_amdgcn_readfirstlane(cur.pm); cur.pn = __builtin_amdgcn_readfirstlane(cur.pn); cur.grp = __builtin_amdgcn_readfirstlane(cur.grp);
    f32x4 acc[2][2][4][2];
#pragma unroll
    for (int a = 0; a < 2; ++a)
#pragma unroll
        for (int b = 0; b < 2; ++b)
#pragma unroll
            for (int m = 0; m < 4; ++m)
#pragma unroll
                for (int n = 0; n < 2; ++n) acc[a][b][m][n] = (f32x4){0.f, 0.f, 0.f, 0.f};
    bf16x8 At[4][2], B0[2][2], B1[2][2];
    const char* cA = (const char*)g.A + (size_t)cur.grp * g.gsA + (size_t)cur.pm * tstep; const char* cB = (const char*)g.Bt + (size_t)cur.grp * g.gsB + (size_t)cur.pn * tstep;
    PG8_STAGE(PG8_SB(0, 0), cB, voffB); PG8_STAGE(PG8_SB(0, 1), cB + hstep, voffB); PG8_STAGE(PG8_SA(0, 0), cA, voffA); PG8_STAGE(PG8_SA(0, 1), cA + hstep, voffA);
    if (wr == 1) PG8_BAR;
    PG8_WAIT_V(2); PG8_BAR;
    PG8_STAGE(PG8_SB(1, 0), cB + kstep, voffB); PG8_STAGE(PG8_SA(1, 0), cA + kstep, voffA); PG8_STAGE(PG8_SB(1, 1), cB + hstep + kstep, voffB);
    PG8_WAIT_V(6); PG8_BAR;
    for (;;) {
        const bool has_next = S.next(ui + 1, nxt);
        nxt.pm = __builtin_amdgcn_readfirstlane(nxt.pm); nxt.pn = __builtin_amdgcn_readfirstlane(nxt.pn); nxt.grp = __builtin_amdgcn_readfirstlane(nxt.grp);
        const char* nA = has_next ? (const char*)g.A + (size_t)nxt.grp * g.gsA + (size_t)nxt.pm * tstep : cA; const char* nB = has_next ? (const char*)g.Bt + (size_t)nxt.grp * g.gsB + (size_t)nxt.pn * tstep : cB;
        for (int t = 0; t < nt; t += 2) {
            const bool last = (t == nt - 2);
            const char* a1 = cA + (size_t)(t + 1) * kstep;
            const char* a2 = last ? nA : cA + (size_t)(t + 2) * kstep; const char* b2 = last ? nB : cB + (size_t)(t + 2) * kstep;
            const char* a3 = a2 + kstep; const char* b3 = b2 + kstep;
            PG8_LDB(B0, 0, 0); PG8_LDB(B1, 0, 1); PG8_SCHED; PG8_LDA(At, 0, 0); PG8_STAGE(PG8_SA(1, 1), a1 + hstep, voffA);
            PG8_WAIT_V(8); PG8_WAIT_L(0); PG8_BAR; PG8_MMA(0, 0, At, B0); PG8_MMA(0, 1, At, B1); PG8_BAR; PG8_SCHED;
            PG8_LDA(At, 0, 1); PG8_STAGE(PG8_SB(0, 0), b2, voffB); PG8_STAGE(PG8_SB(0, 1), b2 + hstep, voffB); PG8_STAGE(PG8_SA(0, 0), a2, voffA);
            PG8_WAIT_V(8); PG8_WAIT_L(0); PG8_BAR; PG8_MMA(1, 0, At, B0); PG8_MMA(1, 1, At, B1); PG8_BAR; PG8_SCHED;
            PG8_LDB(B0, 1, 0); PG8_LDB(B1, 1, 1); PG8_SCHED; PG8_LDA(At, 1, 0); PG8_STAGE(PG8_SA(0, 1), a2 + hstep, voffA);
            PG8_WAIT_V(8); PG8_WAIT_L(0); PG8_BAR; PG8_MMA(0, 0, At, B0); PG8_MMA(0, 1, At, B1); PG8_BAR; PG8_SCHED;
            PG8_LDA(At, 1, 1); PG8_STAGE(PG8_SB(1, 0), b3, voffB); PG8_STAGE(PG8_SB(1, 1), b3 + hstep, voffB); PG8_STAGE(PG8_SA(1, 0), a3, voffA);
            PG8_WAIT_V(8); PG8_WAIT_L(0); PG8_BAR; PG8_MMA(1, 0, At, B0); PG8_MMA(1, 1, At, B1); PG8_BAR; PG8_SCHED;
        }
        bool keep = false;
        if (wr == 0) PG8_BAR;
        { Unit eu; eu.pm = __builtin_amdgcn_readfirstlane(cur.pm); eu.pn = __builtin_amdgcn_readfirstlane(cur.pn); eu.grp = __builtin_amdgcn_readfirstlane(cur.grp); asm volatile("" : "+s"(eu.pm), "+s"(eu.pn), "+s"(eu.grp)); keep = E(acc, eu, wr, wc, fr, fq); }
        if (!has_next) break;
        if (!keep) {
#pragma unroll
        for (int a = 0; a < 2; ++a)
#pragma unroll
            for (int b = 0; b < 2; ++b)
#pragma unroll
                for (int m = 0; m < 4; ++m)
#pragma unroll
                    for (int n = 0; n < 2; ++n) acc[a][b][m][n] = (f32x4){0.f, 0.f, 0.f, 0.f};
        }
        cur = nxt; cA = nA; cB = nB; ++ui;
        if (wr == 1) PG8_BAR;
    }
    PG8_WAIT_V(0);
    PG8_BAR;
#undef PG8_SA
#undef PG8_SB
#undef PG8_STAGE
#undef PG8_LDA
#undef PG8_LDB
#undef PG8_MMA
#undef PG8_WAIT_V
#undef PG8_WAIT_L
#undef PG8_BAR
#undef PG8_SCHED
}
template <class Epi, class Sched, bool GATHER = false>
DI void gemm_phase_i8(LAS unsigned char* lds, const Gemm g, const Sched& S, const Epi& E, const int* etok = nullptr, const LAS int* tpt = nullptr) {
    int tid = threadIdx.x; asm volatile("" : "+v"(tid));
    const int wid = __builtin_amdgcn_readfirstlane(tid >> 6), lane = tid & 63, wr = wid >> 2, wc = wid & 3, fr = lane & 15, fq = lane >> 4;
    int K = g.K; asm volatile("" : "+s"(K));
    const int nt = K / BK;
    unsigned voffA[2], voffB[2], gC[2]; int gR[2];
#pragma unroll
    for (int i = 0; i < 2; ++i) { int R, C; stage_rc(tid * 16 + i * 8192, R, C); const int Rb = Epi::PERM ? ((R & ~31) + perm32(R & 31)) : R;
        voffA[i] = (unsigned)(R * K + C) * 2u; voffB[i] = (unsigned)(Rb * K + C) * 2u; gR[i] = R; gC[i] = (unsigned)C * 2u; }
    const size_t kstep = (size_t)(BK * 2);
    const size_t hstep = (size_t)HALF * K * 2;
    const size_t tstep = 2 * hstep;
    const unsigned ldsw = (unsigned)wid * 1024u;
    const int aoff = lds_byte(wr * 64 + fr, fq * 8), boff = lds_byte(wc * 32 + fr, fq * 8);
#define PG8_SA(b, h) (((b) * 2 + (h)) * HTB)
#define PG8_SB(b, h) ((4 + (b) * 2 + (h)) * HTB)
#define PG8_STAGE(bufoff, gbase, voff) do { _Pragma("unroll") for (int _i = 0; _i < 2; ++_i) \
        __builtin_amdgcn_global_load_lds((const unsigned*)((const char*)(gbase) + (voff)[_i]), (LAS unsigned*)(lds + (bufoff) + ldsw + _i * 8192), 16, 0, 0); } while (0)
#define PG8_STAGE2(bufoff, gbase, o0, o1) do { \
        __builtin_amdgcn_global_load_lds((const unsigned*)((const char*)(gbase) + (o0)), (LAS unsigned*)(lds + (bufoff) + ldsw), 16, 0, 0); \
        __builtin_amdgcn_global_load_lds((const unsigned*)((const char*)(gbase) + (o1)), (LAS unsigned*)(lds + (bufoff) + ldsw + 8192), 16, 0, 0); } while (0)
#define PG8_GATH(u, v) do { const int e_ = (u).grp, b_ = ((u).pm - tpt[e_]) * 256, c_ = tpt[32 + e_]; const int* et_ = etok + e_ * TT; \
        _Pragma("unroll") for (int h_ = 0; h_ < 2; ++h_) _Pragma("unroll") for (int i_ = 0; i_ < 2; ++i_) { const int s_ = b_ + h_ * 128 + gR[i_]; const int t_ = (s_ < c_) ? et_[s_] : 0; \
            v[h_][i_] = (unsigned)t_ * (unsigned)(K * 2) + gC[i_]; } } while (0)
#define PG8_LDA(dst, b, h) do { _Pragma("unroll") for (int m = 0; m < 4; ++m) _Pragma("unroll") for (int k = 0; k < 2; ++k) dst[m][k] = *(const LAS v4i_t*)(lds + PG8_SA(b, h) + aoff + m * 2048 + k * 1024); } while (0)
#define PG8_LDB(dst, b, h) do { _Pragma("unroll") for (int n = 0; n < 2; ++n) _Pragma("unroll") for (int k = 0; k < 2; ++k) dst[n][k] = *(const LAS v4i_t*)(lds + PG8_SB(b, h) + boff + n * 2048 + k * 1024); } while (0)
#define PG8_MMA(ai, bj, At, Bt) do { __builtin_amdgcn_s_setprio(1); _Pragma("unroll") for (int m = 0; m < 4; ++m) _Pragma("unroll") for (int n = 0; n < 2; ++n) _Pragma("unroll") for (int k = 0; k < 2; ++k) \
        acc[ai][bj][m][n] = __builtin_amdgcn_mfma_i32_16x16x64_i8(Bt[n][k], At[m][k], acc[ai][bj][m][n], 0, 0, 0); __builtin_amdgcn_s_setprio(0); } while (0)
#define PG8_WAIT_V(n) asm volatile("s_waitcnt vmcnt(" #n ")" ::: "memory")
#define PG8_WAIT_L(n) asm volatile("s_waitcnt lgkmcnt(" #n ")" ::: "memory")
#define PG8_BAR __builtin_amdgcn_s_barrier()
#define PG8_SCHED __builtin_amdgcn_sched_barrier(0)
    Unit cur, nxt; int ui = 0;
    if (!S.next(0, cur)) return;
    cur.pm = __builtin_amdgcn_readfirstlane(cur.pm); cur.pn = __builtin_amdgcn_readfirstlane(cur.pn); cur.grp = __builtin_amdgcn_readfirstlane(cur.grp);
    v4i_t acc[2][2][4][2];
#pragma unroll
    for (int a = 0; a < 2; ++a)
#pragma unroll
        for (int b = 0; b < 2; ++b)
#pragma unroll
            for (int m = 0; m < 4; ++m)
#pragma unroll
                for (int n = 0; n < 2; ++n) acc[a][b][m][n] = (v4i_t){0, 0, 0, 0};
    v4i_t At[4][2], B0[2][2], B1[2][2];
    const char* cA = GATHER ? (const char*)g.A : (const char*)g.A + (size_t)cur.grp * g.gsA + (size_t)cur.pm * tstep; const char* cB = (const char*)g.Bt + (size_t)cur.grp * g.gsB + (size_t)cur.pn * tstep;
    unsigned cv[2][2] = {{voffA[0], voffA[1]}, {voffA[0], voffA[1]}}, nv[2][2] = {{voffA[0], voffA[1]}, {voffA[0], voffA[1]}};
    if (GATHER) PG8_GATH(cur, cv);
    const size_t ahs = GATHER ? (size_t)0 : hstep;
    PG8_STAGE(PG8_SB(0, 0), cB, voffB); PG8_STAGE(PG8_SB(0, 1), cB + hstep, voffB); PG8_STAGE2(PG8_SA(0, 0), cA, cv[0][0], cv[0][1]); PG8_STAGE2(PG8_SA(0, 1), cA + ahs, cv[1][0], cv[1][1]);
    if (wr == 1) PG8_BAR;
    PG8_WAIT_V(2); PG8_BAR;
    PG8_STAGE(PG8_SB(1, 0), cB + kstep, voffB); PG8_STAGE2(PG8_SA(1, 0), cA + kstep, cv[0][0], cv[0][1]); PG8_STAGE(PG8_SB(1, 1), cB + hstep + kstep, voffB);
    PG8_WAIT_V(6); PG8_BAR;
    for (;;) {
        const bool has_next = S.next(ui + 1, nxt);
        nxt.pm = __builtin_amdgcn_readfirstlane(nxt.pm); nxt.pn = __builtin_amdgcn_readfirstlane(nxt.pn); nxt.grp = __builtin_amdgcn_readfirstlane(nxt.grp);
        const char* nA = (has_next && !GATHER) ? (const char*)g.A + (size_t)nxt.grp * g.gsA + (size_t)nxt.pm * tstep : cA; const char* nB = has_next ? (const char*)g.Bt + (size_t)nxt.grp * g.gsB + (size_t)nxt.pn * tstep : cB;
        if (GATHER) { if (has_next) PG8_GATH(nxt, nv); else { nv[0][0] = cv[0][0]; nv[0][1] = cv[0][1]; nv[1][0] = cv[1][0]; nv[1][1] = cv[1][1]; } }
        for (int t = 0; t < nt; t += 2) {
            const bool last = (t == nt - 2);
            const unsigned s00 = (GATHER && last) ? nv[0][0] : cv[0][0], s01 = (GATHER && last) ? nv[0][1] : cv[0][1], s10 = (GATHER && last) ? nv[1][0] : cv[1][0], s11 = (GATHER && last) ? nv[1][1] : cv[1][1];
            const char* a1 = cA + (size_t)(t + 1) * kstep;
            const char* a2 = last ? nA : cA + (size_t)(t + 2) * kstep; const char* b2 = last ? nB : cB + (size_t)(t + 2) * kstep;
            const char* a3 = a2 + kstep; const char* b3 = b2 + kstep;
            PG8_LDB(B0, 0, 0); PG8_LDB(B1, 0, 1); PG8_SCHED; PG8_LDA(At, 0, 0); PG8_STAGE2(PG8_SA(1, 1), a1 + ahs, cv[1][0], cv[1][1]);
            PG8_WAIT_V(8); PG8_WAIT_L(0); PG8_BAR; PG8_MMA(0, 0, At, B0); PG8_MMA(0, 1, At, B1); PG8_BAR; PG8_SCHED;
            PG8_LDA(At, 0, 1); PG8_STAGE(PG8_SB(0, 0), b2, voffB); PG8_STAGE(PG8_SB(0, 1), b2 + hstep, voffB); PG8_STAGE2(PG8_SA(0, 0), a2, s00, s01);
            PG8_WAIT_V(8); PG8_WAIT_L(0); PG8_BAR; PG8_MMA(1, 0, At, B0); PG8_MMA(1, 1, At, B1); PG8_BAR; PG8_SCHED;
            PG8_LDB(B0, 1, 0); PG8_LDB(B1, 1, 1); PG8_SCHED; PG8_LDA(At, 1, 0); PG8_STAGE2(PG8_SA(0, 1), a2 + ahs, s10, s11);
            PG8_WAIT_V(8); PG8_WAIT_L(0); PG8_BAR; PG8_MMA(0, 0, At, B0); PG8_MMA(0, 1, At, B1); PG8_BAR; PG8_SCHED;
            PG8_LDA(At, 1, 1); PG8_STAGE(PG8_SB(1, 0), b3, voffB); PG8_STAGE(PG8_SB(1, 1), b3 + hstep, voffB); PG8_STAGE2(PG8_SA(1, 0), a3, s00, s01);
            PG8_WAIT_V(8); PG8_WAIT_L(0); PG8_BAR; PG8_MMA(1, 0, At, B0); PG8_MMA(1, 1, At, B1); PG8_BAR; PG8_SCHED;
        }
        bool keep = false;
        if (wr == 0) PG8_BAR;
        { Unit eu; eu.pm = __builtin_amdgcn_readfirstlane(cur.pm); eu.pn = __builtin_amdgcn_readfirstlane(cur.pn); eu.grp = __builtin_amdgcn_readfirstlane(cur.grp); asm volatile("" : "+s"(eu.pm), "+s"(eu.pn), "+s"(eu.grp)); keep = E(acc, eu, wr, wc, fr, fq); }
        if (!has_next) break;
        if (!keep) {
#pragma unroll
        for (int a = 0; a < 2; ++a)
#pragma unroll
            for (int b = 0; b < 2; ++b)
#pragma unroll
                for (int m = 0; m < 4; ++m)
#pragma unroll
                    for (int n = 0; n < 2; ++n) acc[a][b][m][n] = (v4i_t){0, 0, 0, 0};
        }
        cur = nxt; cA = nA; cB = nB; ++ui;
        if (GATHER) { cv[0][0] = nv[0][0]; cv[0][1] = nv[0][1]; cv[1][0] = nv[1][0]; cv[1][1] = nv[1][1]; }
        if (wr == 1) PG8_BAR;
    }
    PG8_WAIT_V(0);
    PG8_BAR;
#undef PG8_SA
#undef PG8_SB
#undef PG8_STAGE
#undef PG8_STAGE2
#undef PG8_GATH
#undef PG8_LDA
#undef PG8_LDB
#undef PG8_MMA
#undef PG8_WAIT_V
#undef PG8_WAIT_L
#undef PG8_BAR
#undef PG8_SCHED
}
}

#define XB_TMO      128
#define XB_XCNT(j)  (256  + 64 * (j))
#define XB_XSUB(j)  (1280 + 64 * (j))
#define XB_XGEN(j)  (2304 + 64 * (j))
#define XB_TOP      3328
#define XB_TOPGEN   3392
#define XCD_BAR_WORDS 3456
#define XB_SPIN_CAP (1u << 18)

__device__ __forceinline__ unsigned xb_ld(unsigned* p)              { return __hip_atomic_load(p, __ATOMIC_RELAXED, __HIP_MEMORY_SCOPE_AGENT); }
__device__ __forceinline__ unsigned xb_add(unsigned* p, unsigned v) { return __hip_atomic_fetch_add(p, v, __ATOMIC_RELAXED, __HIP_MEMORY_SCOPE_AGENT); }
__device__ __forceinline__ unsigned xb_xcc_id() { return (unsigned)__builtin_amdgcn_s_getreg((3 << 11) | 20) & 0xFu; }
#define XB_SPIN(cond, bar) do { unsigned _sp = 0; while (cond) { __builtin_amdgcn_s_sleep(1); \
    if ((++_sp & 255u) == 0u) { if (xb_ld(&(bar)[XB_TMO])) break; if (_sp > XB_SPIN_CAP) { atomicAdd(&(bar)[XB_TMO], 1u); break; } } } } while (0)

struct XcdBarrier {
    unsigned* bar; unsigned x;
    volatile LAS unsigned* st;
};

__device__ __forceinline__ XcdBarrier xcd_barrier_post(unsigned* bar, volatile LAS unsigned* st) {
    XcdBarrier b; b.bar = bar; b.x = xb_xcc_id(); b.st = st;
    if (threadIdx.x == 0) (void)xb_add(&bar[XB_XCNT(b.x)], 1u);
    return b;
}
__device__ __forceinline__ void xcd_barrier_complete(unsigned* bar, unsigned x, unsigned& nloc, unsigned& nx) {
    const unsigned G = gridDim.x * gridDim.y * gridDim.z;
    unsigned sum, cnt, mine, sp = 0u;
    for (;;) {
        sum = 0u; cnt = 0u; mine = 0u;
#pragma unroll
        for (unsigned j = 0; j < 16; ++j) { const unsigned c = xb_ld(&bar[XB_XCNT(j)]); sum += c; cnt += (c > 0u) ? 1u : 0u; mine = (j == x) ? c : mine; }
        if (sum == G) break;
        __builtin_amdgcn_s_sleep(1);
        if ((++sp & 255u) == 0u) { if (xb_ld(&bar[XB_TMO])) break; if (sp > XB_SPIN_CAP) { atomicAdd(&bar[XB_TMO], 1u); break; } }
    }
    nloc = mine > 0u ? mine : 1u; nx = cnt > 0u ? cnt : 1u;
}

__device__ __forceinline__ void xcd_barrier(const XcdBarrier& b) {
    asm volatile("s_waitcnt vmcnt(0)" ::: "memory");
    __syncthreads();
    if (threadIdx.x == 0) {
        unsigned* bar = b.bar;
        __builtin_amdgcn_s_waitcnt(0);
        unsigned nloc = b.st[0], nx = b.st[1];
        if (nloc == 0u) { xcd_barrier_complete(bar, b.x, nloc, nx); b.st[0] = nloc; b.st[1] = nx; }
        const unsigned old = xb_add(&bar[XB_XSUB(b.x)], 1u);
        const unsigned gen = old / nloc;
        if (old + 1u == (gen + 1u) * nloc) {
            __builtin_amdgcn_fence(__ATOMIC_RELEASE, "agent");
            asm volatile("s_waitcnt vmcnt(0)" ::: "memory");
            const unsigned og = xb_add(&bar[XB_TOP], 1u);
            const unsigned tg = og / nx;
            if (og + 1u == (tg + 1u) * nx) xb_add(&bar[XB_TOPGEN], 1u);
            else XB_SPIN(xb_ld(&bar[XB_TOPGEN]) == tg, bar);
            __builtin_amdgcn_fence(__ATOMIC_ACQUIRE, "agent");
            xb_add(&bar[XB_XGEN(b.x)], 1u);
            asm volatile("s_waitcnt vmcnt(0)" ::: "memory");
        } else {
            XB_SPIN(xb_ld(&bar[XB_XGEN(b.x)]) == gen, bar);
            __builtin_amdgcn_fence(__ATOMIC_ACQUIRE, "agent");
            asm volatile("s_waitcnt vmcnt(0)" ::: "memory");
        }
    }
    __syncthreads();
}

constexpr size_t MiB = 1u << 20;
constexpr size_t WS_CTL = 0, CTL_ZERO_BYTES = 1 * MiB;
constexpr size_t WS_MOD  = 1 * MiB;
constexpr size_t WS_WIN  = 2 * MiB;
constexpr size_t WS_WUQ  = 210 * MiB;
constexpr size_t WS_WKN  = 213 * MiB;
constexpr size_t WS_WV   = 214 * MiB;
constexpr size_t WS_WBR  = 215 * MiB;
constexpr size_t WS_WMIX = 247 * MiB;
constexpr size_t WS_W1   = 279 * MiB;
constexpr size_t WS_W2   = 535 * MiB;
constexpr size_t WS_X    = 663 * MiB;
constexpr size_t WS_H    = 735 * MiB;
constexpr size_t WS_U    = 771 * MiB;
constexpr size_t WS_CQN  = 1005 * MiB;
constexpr size_t WS_CKVN = 1014 * MiB;
constexpr size_t WS_KRP  = 1019 * MiB;
constexpr size_t WS_Q    = 1021 * MiB;
constexpr size_t WS_KN   = 1035 * MiB;
constexpr size_t WS_VT   = 1044 * MiB;
constexpr size_t WS_ACTS = 1053 * MiB;
constexpr size_t WS_YM   = 1089 * MiB;
constexpr size_t WS_SLOC = 1125 * MiB;
constexpr size_t WS_DEC  = 1161 * MiB;
constexpr size_t WS_SIN  = 1162 * MiB;
constexpr size_t WS_ETOK = 1261 * MiB, WS_ERS = 1262 * MiB, WS_ERW = 1263 * MiB;
constexpr size_t WS_ROUTE= 1180 * MiB;
constexpr size_t WS_HS   = 1181 * MiB;
constexpr size_t WS_ACTM = 1269 * MiB;
constexpr size_t WS_OUTS = 1291 * MiB;
constexpr size_t WS_W8   = 1379 * MiB;
constexpr size_t WS_H8   = 1483 * MiB;
constexpr size_t WS_RA   = 1501 * MiB;
constexpr size_t WS_RB   = 1501 * MiB + 64 * 1024;
constexpr size_t WS_RB1  = 1501 * MiB + 512 * 1024;
constexpr size_t WS_RSORT= 1501 * MiB + 768 * 1024;
constexpr size_t WS_RAF  = 1501 * MiB + 896 * 1024;
constexpr size_t WS_G8   = 1502 * MiB;
constexpr size_t WS_END  = 1574 * MiB;
constexpr int CW_BAR = 4096;
constexpr int CW_CNT = 16384;
constexpr int CW_CMAX = 131072;

constexpr int RING_BYTES = 131072;
constexpr int LDSX_OFF = RING_BYTES;
constexpr int LDS_BYTES = 147456;

struct Params { const float* in[34]; float* out; unsigned char* ws; int ph_lo, ph_hi; };
typedef const __attribute__((address_space(4))) Params* KParams;
enum { I_X = 0, I_C, I_CTX, I_CCTX, I_WMOD, I_BMOD, I_GMIX, I_GFFN, I_WIN, I_GQ, I_WUQ, I_GKV, I_WUKV, I_WMLAO, I_WCFDW, I_BCFDW, I_GCFLN, I_BCFLN, I_WCFO,
       I_WGF, I_BGF, I_WGB, I_BGB, I_GGLAN, I_WGLAO, I_WSCC, I_WSCO, I_WMIXO, I_WROUT, I_BROUT, I_WEG, I_WEU, I_WED, I_GFIN };

struct Frame { LAS unsigned char* lds; int tid, lane, wave, G, bid, gw, NGW; };

#define WSP(T, off) ((T*)(P->ws + (off)))
#define WSQ(T, off) ((T*)(Q->ws + (off)))
DI unsigned* ctl_words(KParams P) { return (unsigned*)(P->ws + WS_CTL); }
DI int mod_row(int row) { return row < TLAT ? (row >> 11) : 4; }

DI void transpose_item(const float* W, int N, bf16_t* WT, int KD, int dest_row0, int k0, int n0, LAS float* scr, int lane) {
#pragma unroll
    for (int i = 0; i < 32; ++i) { const int kk = 2 * i + (lane >> 5); scr[kk * 33 + (lane & 31)] = __builtin_nontemporal_load(W + (size_t)(k0 + kk) * N + n0 + (lane & 31)); }
    LDS_WAIT(); asm volatile("" ::: "memory");
    const int c = lane & 7;
#pragma unroll
    for (int j = 0; j < 4; ++j) { const int n = (lane >> 3) + 8 * j; const LAS float* s = scr + (8 * c) * 33 + n;
        u32x4 o; o.x = pk2(s[0 * 33], s[1 * 33]); o.y = pk2(s[2 * 33], s[3 * 33]); o.z = pk2(s[4 * 33], s[5 * 33]); o.w = pk2(s[6 * 33], s[7 * 33]);
        __builtin_nontemporal_store(o, (u32x4*)(WT + (size_t)(dest_row0 + n) * KD + k0 + 8 * c)); }
    LDS_WAIT(); asm volatile("" ::: "memory");
}
constexpr int SLAB_AUX = LDSX_OFF + 2048;
DI int slab_off(int k, int n) { return k * 64 + ((((n >> 1) ^ ((k >> 3) & 15)) << 2) | ((n & 1) << 1)); }
DI void slab_item(const float* W, int N, int n0, unsigned char* W8, int dest_row0, float* rB, Frame& F) {
    LAS float* wmax = (LAS float*)(F.lds + SLAB_AUX); LAS float* cmax = wmax + 256;
    { const int n = F.lane & 31, kp = F.lane >> 5; float m = 0.f;
#pragma unroll 1
      for (int j = 0; j < 4; ++j) { const int kb0 = (F.wave * 4 + j) * 64; float v[32];
#pragma unroll
          for (int i = 0; i < 32; ++i) v[i] = __builtin_nontemporal_load(W + (size_t)(kb0 + 2 * i + kp) * N + n0 + n);
#pragma unroll
          for (int i = 0; i < 32; ++i) { m = fmaxf(m, fabsf(v[i])); *(LAS bf16_t*)(F.lds + slab_off(kb0 + 2 * i + kp, n)) = f2bf(v[i]); } }
      m = fmaxf(m, __shfl_xor(m, 32)); if (F.lane < 32) wmax[F.wave * 32 + n] = m; }
    __syncthreads();
    if (F.tid < 32) { float c = 0.f;
#pragma unroll
        for (int w2 = 0; w2 < 8; ++w2) c = fmaxf(c, wmax[w2 * 32 + F.tid]);
        cmax[F.tid] = c; rB[dest_row0 + F.tid] = c * (1.f / 127.f); }
    __syncthreads();
    { const int nn = ((F.tid >> 3) & 7) + 8 * (F.wave & 3); const float cm = cmax[nn], sc = cm > 0.f ? 127.f / cm : 0.f;
#pragma unroll 4
      for (int i2 = 0; i2 < 16; ++i2) { const int c = (F.tid & 7) + 8 * i2 + 128 * (F.wave >> 2); unsigned q[8];
#pragma unroll
          for (int j = 0; j < 8; ++j) q[j] = q8(sc * bf2f(*(const LAS bf16_t*)(F.lds + slab_off(8 * c + j, nn))));
          u32x2 o; o.x = q[0] | (q[1] << 8) | (q[2] << 16) | (q[3] << 24); o.y = q[4] | (q[5] << 8) | (q[6] << 16) | (q[7] << 24);
          __builtin_nontemporal_store(o, (u32x2*)(W8 + (size_t)(dest_row0 + nn) * DM + 8 * c)); } }
    __syncthreads();
}
constexpr int NS_WIN = PW / 32, NS_EXP = 16 * 2 * (EFF / 32), NS_ALL = NS_WIN + NS_EXP;
DI void slab_dispatch(KParams P, Frame& F, int l, int sidx) {
    if (sidx < NS_WIN) { slab_item(P->in[I_WIN] + (size_t)l * DM * PW, PW, 32 * sidx, WSP(unsigned char, WS_W8) + (size_t)l * PWP * DM, wcol_dest(32 * sidx), WSP(float, WS_RB) + (size_t)l * PWP, F); return; }
    const int q = sidx - NS_WIN, e = q >> 5, which = (q >> 4) & 1, n0 = (q & 15) * 32, le = l * 16 + e;
    slab_item((which ? P->in[I_WEU] : P->in[I_WEG]) + (size_t)le * DM * EFF, EFF, n0, WSP(unsigned char, WS_W1) + (size_t)le * 1024 * DM, (n0 >> 7) * 256 + which * 128 + (n0 & 127), WSP(float, WS_RB1) + (size_t)le * 1024, F);
}
constexpr int NL_UQ = 8 * 24, NL_UKV = 4 * 32, NL_BR = 4 * 8 * 64, NL_MIX = 32 * 64, NL_ED = 16 * 8 * 64, NL_PAD = PWP - PW;
constexpr int NL_ITEMS = NL_UQ + NL_UKV + NL_BR + NL_MIX + NL_ED + NL_PAD;
constexpr int NL_F1 = (NL_ITEMS * 55) / 100, NL_F2 = (NL_ITEMS * 88) / 100;
DI void conv_item_layer(KParams P, int l, int it, LAS float* scr, int lane) {
    int r = it;
    if (r < NL_UQ) { const int kb = r / 24, nb = r % 24;
        transpose_item(P->in[I_WUQ] + (size_t)l * 512 * 768, 768, WSP(bf16_t, WS_WUQ) + (size_t)l * 768 * 512, 512, 32 * nb, 64 * kb, 32 * nb, scr, lane); return; } r -= NL_UQ;
    if (r < NL_UKV) { const int kb = r / 32, nb = r % 32, n0 = 32 * nb, hh = n0 >> 7, jj = n0 & 127;
        bf16_t* dst = (jj < 64 ? WSP(bf16_t, WS_WKN) : WSP(bf16_t, WS_WV)) + (size_t)l * 512 * 256;
        transpose_item(P->in[I_WUKV] + (size_t)l * 256 * 1024, 1024, dst, 256, hh * 64 + (jj & 63), 64 * kb, n0, scr, lane); return; } r -= NL_UKV;
    if (r < NL_BR) { const int br = r / 512, q = r % 512, kb = q / 64, nb = q % 64;
        const float* src = (br == 0 ? P->in[I_WMLAO] : br == 1 ? P->in[I_WCFO] : br == 2 ? P->in[I_WGLAO] : P->in[I_WSCO]) + (size_t)l * 512 * DM;
        transpose_item(src, DM, WSP(bf16_t, WS_WBR) + (size_t)(l * 4 + br) * DM * 512, 512, 32 * nb, 64 * kb, 32 * nb, scr, lane); return; } r -= NL_BR;
    if (r < NL_MIX) { const int kb = r / 64, nb = r % 64;
        transpose_item(P->in[I_WMIXO] + (size_t)l * DM * DM, DM, WSP(bf16_t, WS_WMIX) + (size_t)l * DM * DM, DM, 32 * nb, 64 * kb, 32 * nb, scr, lane); return; } r -= NL_MIX;
    if (r < NL_ED) { const int e = r / 512, q = r % 512, kb = q / 64, nb = q % 64, le = l * 16 + e;
        transpose_item(P->in[I_WED] + (size_t)le * EFF * DM, DM, WSP(bf16_t, WS_W2) + (size_t)le * DM * EFF, EFF, 32 * nb, 64 * kb, 32 * nb, scr, lane); return; } r -= NL_ED;
    { unsigned char* row = WSP(unsigned char, WS_W8) + ((size_t)l * PWP + O_MG + r) * DM;
#pragma unroll
      for (int j = 0; j < 2; ++j) *(u32x4*)(row + 16 * lane + 1024 * j) = (u32x4){0u, 0u, 0u, 0u};
      if (lane == 0) WSP(float, WS_RB)[(size_t)l * PWP + O_MG + r] = 0.f; }
}
DI void conv_mixed(KParams P, Frame& F, int l, int s_lo, int s_hi, int w_lo, int w_hi, int rank, int nrank) {
    if (rank < 0) return;
    for (int sidx = s_lo + rank; sidx < s_hi; sidx += nrank) slab_dispatch(P, F, l, sidx);
    LAS float* scr = (LAS float*)(F.lds + F.wave * 8448);
    for (int it = w_lo + rank * 8 + F.wave; it < w_hi; it += nrank * 8) conv_item_layer(P, l, it, scr, F.lane);
    __syncthreads();
}
DI void mod_item(KParams P, Frame& F, int it) {
    const int l = it / 192, n0 = (it % 192) * 64;
    const LAS float* sil = (const LAS float*)F.lds;
    LAS float* red = (LAS float*)(F.lds + 40960);
    const int kq = F.lane >> 4, ln = F.lane & 15;
    const float* wp = P->in[I_WMOD] + (size_t)l * DM * (6 * DM) + n0 + 4 * ln;
    f32x4 acc[5];
#pragma unroll
    for (int r = 0; r < 5; ++r) acc[r] = (f32x4){0.f, 0.f, 0.f, 0.f};
    const int kbase = F.wave * 256 + kq;
#pragma unroll 8
    for (int kk = 0; kk < 64; ++kk) { const int k = kbase + 4 * kk; const f32x4 wv = *(const f32x4*)(wp + (size_t)k * (6 * DM));
#pragma unroll
        for (int r = 0; r < 5; ++r) acc[r] = acc[r] + wv * sil[r * DM + k]; }
    const int grp = F.wave * 4 + kq;
#pragma unroll
    for (int r = 0; r < 5; ++r) *(LAS f32x4*)(red + (grp * 5 + r) * 64 + 4 * ln) = acc[r];
    __syncthreads();
    if (F.tid < 320) { const int r = F.tid >> 6, n = F.tid & 63; float s = P->in[I_BMOD][(size_t)l * (6 * DM) + n0 + n];
        for (int g = 0; g < 32; ++g) s += red[(g * 5 + r) * 64 + n];
        WSP(float, WS_MOD)[(size_t)(l * 5 + r) * (6 * DM) + n0 + n] = s; }
    __syncthreads();
}
DI void phase_prologue(KParams P, Frame& F) {
    LAS float* sil = (LAS float*)F.lds;
    for (int i = F.tid; i < 5 * DM; i += 512) { const int r = i >> 11, k = i & (DM - 1); const float c = r < 4 ? P->in[I_C][r * DM + k] : P->in[I_CCTX][k]; sil[i] = c / (1.f + expf(-c)); }
    __syncthreads();
    for (int it = F.bid; it < DEPTH * 192; it += F.G) mod_item(P, F, it);
    __syncthreads();
}

DI void moe_table(KParams P, Frame& F, int l) {
    LAS int* tp = (LAS int*)(F.lds + LDSX_OFF + 64); LAS int* cn = tp + 32;
    if (F.tid == 0) { const unsigned* cnt = ctl_words(P) + CW_CNT + l * 16 * 64; int a = 0;
        for (int e = 0; e < 16; ++e) { const int c = (int)__hip_atomic_load(cnt + e * 64, __ATOMIC_RELAXED, __HIP_MEMORY_SCOPE_AGENT); tp[e] = a; cn[e] = c; a += (c + 255) >> 8; }
        tp[16] = a; }
    __syncthreads();
}
DI void phase_norm1(KParams P, Frame& F, int l, bool dummy) {
    bf16_t* X = WSP(bf16_t, WS_X); bf16_t* XO = dummy ? WSP(bf16_t, WS_HS) : X; bf16_t* H = WSP(bf16_t, WS_H); const float* mod = WSP(float, WS_MOD); const bf16_t* outs = WSP(bf16_t, WS_OUTS);
    const int* rt_e = (const int*)(P->ws + WS_ROUTE); const int* rt_slot = (const int*)(P->ws + WS_ROUTE + 2 * 73728); const LAS int* tp = (const LAS int*)(F.lds + LDSX_OFF + 64);
    if (l > 0) moe_table(P, F, l - 1);
    for (int row = F.gw; row < TT; row += F.NGW) {
        const int r = mod_row(row);
        f32x4 v[8];
        if (l == 0) { const float* src = row < TLAT ? P->in[I_X] + (size_t)row * DM : P->in[I_CTX] + (size_t)(row - TLAT) * DM;
#pragma unroll
            for (int j = 0; j < 8; ++j) v[j] = *(const f32x4*)(src + 4 * F.lane + 256 * j); }
        else {
#pragma unroll
            for (int j = 0; j < 8; ++j) { const u32x2 w = *(const u32x2*)(X + (size_t)row * DM + 4 * F.lane + 256 * j); v[j] = (f32x4){bflo(w.x), bfhi(w.x), bflo(w.y), bfhi(w.y)}; } }
        if (l > 0) { const int p0 = tp[rt_e[2 * row]] * 256 + rt_slot[2 * row], p1 = tp[rt_e[2 * row + 1]] * 256 + rt_slot[2 * row + 1]; const float* gt = mod + (size_t)((l - 1) * 5 + r) * (6 * DM) + 5 * DM;
#pragma unroll
            for (int j = 0; j < 8; ++j) { const int c = 4 * F.lane + 256 * j; const f32x4 g = *(const f32x4*)(gt + c);
                const u32x2 a = *(const u32x2*)(outs + (size_t)p0 * DM + c), b = *(const u32x2*)(outs + (size_t)p1 * DM + c);
                v[j][0] += g[0] * (bflo(a.x) + bflo(b.x)); v[j][1] += g[1] * (bfhi(a.x) + bfhi(b.x)); v[j][2] += g[2] * (bflo(a.y) + bflo(b.y)); v[j][3] += g[3] * (bfhi(a.y) + bfhi(b.y)); } }
        float ss = 0.f;
#pragma unroll
        for (int j = 0; j < 8; ++j) { *(u32x2*)(XO + (size_t)row * DM + 4 * F.lane + 256 * j) = (u32x2){pk2(v[j][0], v[j][1]), pk2(v[j][2], v[j][3])}; ss += (v[j][0] * v[j][0] + v[j][1] * v[j][1]) + (v[j][2] * v[j][2] + v[j][3] * v[j][3]); }
        const float rstd = 1.f / sqrtf(wave_sum(ss) * (1.f / DM) + EPS);
        const float* mp = mod + (size_t)(l * 5 + r) * (6 * DM); const float* gm = P->in[I_GMIX] + (size_t)l * DM; float am = 0.f;
#pragma unroll
        for (int j = 0; j < 8; ++j) { const int c = 4 * F.lane + 256 * j; const f32x4 g = *(const f32x4*)(gm + c), sh = *(const f32x4*)(mp + c), sc = *(const f32x4*)(mp + DM + c);
            v[j] = (v[j] * rstd * g) * (sc + 1.f) + sh; am = fmaxf(fmaxf(am, fmaxf(fabsf(v[j][0]), fabsf(v[j][1]))), fmaxf(fabsf(v[j][2]), fabsf(v[j][3]))); }
#pragma unroll
        for (int o = 1; o < 64; o <<= 1) am = fmaxf(am, __shfl_xor(am, o));
        const float qs = am > 0.f ? 127.f / am : 0.f;
#pragma unroll
        for (int j = 0; j < 8; ++j) { const int c = 4 * F.lane + 256 * j;
            *(unsigned*)(WSP(unsigned char, WS_H8) + (size_t)row * DM + c) = q8(v[j][0] * qs) | (q8(v[j][1] * qs) << 8) | (q8(v[j][2] * qs) << 16) | (q8(v[j][3] * qs) << 24); }
        if (F.lane == 0) WSP(float, WS_RA)[row] = am * (1.f / 127.f);
    }
}
DI void phase_final(KParams P, Frame& F) {
    const bf16_t* X = WSP(bf16_t, WS_X); const float* mod = WSP(float, WS_MOD); const bf16_t* outs = WSP(bf16_t, WS_OUTS);
    const int* rt_e = (const int*)(P->ws + WS_ROUTE); const int* rt_slot = (const int*)(P->ws + WS_ROUTE + 2 * 73728); const LAS int* tp = (const LAS int*)(F.lds + LDSX_OFF + 64);
    moe_table(P, F, DEPTH - 1);
    for (int row = F.gw; row < TLAT; row += F.NGW) {
        const int r = mod_row(row); const int p0 = tp[rt_e[2 * row]] * 256 + rt_slot[2 * row], p1 = tp[rt_e[2 * row + 1]] * 256 + rt_slot[2 * row + 1]; const float* gt = mod + (size_t)((DEPTH - 1) * 5 + r) * (6 * DM) + 5 * DM;
        f32x4 v[8]; float ss = 0.f;
#pragma unroll
        for (int j = 0; j < 8; ++j) { const int c = 4 * F.lane + 256 * j; { const u32x2 w = *(const u32x2*)(X + (size_t)row * DM + c); v[j] = (f32x4){bflo(w.x), bfhi(w.x), bflo(w.y), bfhi(w.y)}; } const f32x4 g = *(const f32x4*)(gt + c);
            const u32x2 a = *(const u32x2*)(outs + (size_t)p0 * DM + c), b = *(const u32x2*)(outs + (size_t)p1 * DM + c);
            v[j][0] += g[0] * (bflo(a.x) + bflo(b.x)); v[j][1] += g[1] * (bfhi(a.x) + bfhi(b.x)); v[j][2] += g[2] * (bflo(a.y) + bflo(b.y)); v[j][3] += g[3] * (bfhi(a.y) + bfhi(b.y));
            ss += (v[j][0] * v[j][0] + v[j][1] * v[j][1]) + (v[j][2] * v[j][2] + v[j][3] * v[j][3]); }
        const float rstd = 1.f / sqrtf(wave_sum(ss) * (1.f / DM) + EPS);
#pragma unroll
        for (int j = 0; j < 8; ++j) { const int c = 4 * F.lane + 256 * j; const f32x4 g = *(const f32x4*)(P->in[I_GFIN] + c); *(f32x4*)(P->out + (size_t)row * DM + c) = v[j] * rstd * g; }
    }
}
DI float ffn_input_row(KParams P, Frame& F, int l, int row, f32x4 (&v)[8]) {
    const bf16_t* X = WSP(bf16_t, WS_X); unsigned char* H8 = WSP(unsigned char, WS_H); const float* mod = WSP(float, WS_MOD);
    const int r = mod_row(row); float ss = 0.f;
#pragma unroll
    for (int j = 0; j < 8; ++j) { { const u32x2 w = *(const u32x2*)(X + (size_t)row * DM + 4 * F.lane + 256 * j); v[j] = (f32x4){bflo(w.x), bfhi(w.x), bflo(w.y), bfhi(w.y)}; } ss += (v[j][0] * v[j][0] + v[j][1] * v[j][1]) + (v[j][2] * v[j][2] + v[j][3] * v[j][3]); }
    const float rstd = 1.f / sqrtf(wave_sum(ss) * (1.f / DM) + EPS);
    const float* mp = mod + (size_t)(l * 5 + r) * (6 * DM); const float* gm = P->in[I_GFFN] + (size_t)l * DM; float am = 0.f;
#pragma unroll
    for (int j = 0; j < 8; ++j) { const int c = 4 * F.lane + 256 * j; const f32x4 g = *(const f32x4*)(gm + c), sh = *(const f32x4*)(mp + 3 * DM + c), sc = *(const f32x4*)(mp + 4 * DM + c);
        v[j] = (v[j] * rstd * g) * (sc + 1.f) + sh; am = fmaxf(fmaxf(am, fmaxf(fabsf(v[j][0]), fabsf(v[j][1]))), fmaxf(fabsf(v[j][2]), fabsf(v[j][3]))); }
#pragma unroll
    for (int o = 1; o < 64; o <<= 1) am = fmaxf(am, __shfl_xor(am, o));
    const float qs = am > 0.f ? 127.f / am : 0.f;
#pragma unroll
    for (int j = 0; j < 8; ++j) { const int c = 4 * F.lane + 256 * j;
        *(unsigned*)(H8 + (size_t)row * DM + c) = q8(v[j][0] * qs) | (q8(v[j][1] * qs) << 8) | (q8(v[j][2] * qs) << 16) | (q8(v[j][3] * qs) << 24); }
    return am * (1.f / 127.f);
}
DI void route_decide(const float (&lg)[16], const float (&br)[16], int& e1, int& e2, float& wa, float& wb) {
    float aff[16], sel[16];
#pragma unroll
    for (int e = 0; e < 16; ++e) { aff[e] = __builtin_amdgcn_rcpf(1.f + expf(-lg[e])); sel[e] = aff[e] + br[e]; }
    int best = 0; float bestv = -INFINITY;
#pragma unroll
    for (int g = 0; g < 4; ++g) { const float a = sel[4 * g], b = sel[4 * g + 1], c = sel[4 * g + 2], d = sel[4 * g + 3];
        const float hi1 = fmaxf(a, b), lo1 = fminf(a, b), hi2 = fmaxf(c, d), lo2 = fminf(c, d);
        const float gs = fmaxf(hi1, hi2) + fmaxf(fminf(hi1, hi2), fmaxf(lo1, lo2));
        if (gs > bestv) { bestv = gs; best = g; } }
    float s4[4] = {0.f, 0.f, 0.f, 0.f}, a4[4] = {0.f, 0.f, 0.f, 0.f};
#pragma unroll
    for (int g = 0; g < 4; ++g)
#pragma unroll
        for (int j = 0; j < 4; ++j) { s4[j] = (best == g) ? sel[4 * g + j] : s4[j]; a4[j] = (best == g) ? aff[4 * g + j] : a4[j]; }
    int i1 = 0; float m1 = s4[0];
#pragma unroll
    for (int j = 1; j < 4; ++j) if (s4[j] > m1) { m1 = s4[j]; i1 = j; }
    int i2 = -1; float m2 = -INFINITY;
#pragma unroll
    for (int j = 0; j < 4; ++j) if (j != i1 && s4[j] > m2) { m2 = s4[j]; i2 = j; }
    float w1 = 0.f, w2 = 0.f;
#pragma unroll
    for (int j = 0; j < 4; ++j) { w1 = (j == i1) ? a4[j] : w1; w2 = (j == i2) ? a4[j] : w2; }
    const float inv = 1.f / (w1 + w2);
    e1 = 4 * best + i1; e2 = 4 * best + i2; wa = w1 * inv; wb = w2 * inv;
}
DI void phase_norm2_route(KParams P, Frame& F, int l, int cbank) {
    int* rt_e = (int*)(P->ws + WS_ROUTE); int* rt_slot = (int*)(P->ws + WS_ROUTE + 2 * 73728);
    int* etok = (int*)(P->ws + WS_ETOK); float* ers = (float*)(P->ws + WS_ERS); float* erw = (float*)(P->ws + WS_ERW);
    unsigned* cnt = ctl_words(P) + CW_CNT + cbank * 16 * 64;
    LAS float* wrT = (LAS float*)F.lds;
    for (int k = F.tid; k < DM; k += 512) { const f32x4* wp = (const f32x4*)(P->in[I_WROUT] + (size_t)k * 16);
#pragma unroll
        for (int q = 0; q < 4; ++q) { const f32x4 w = wp[q]; wrT[(4 * q + 0) * DM + k] = w[0]; wrT[(4 * q + 1) * DM + k] = w[1]; wrT[(4 * q + 2) * DM + k] = w[2]; wrT[(4 * q + 3) * DM + k] = w[3]; } }
    float br[16];
#pragma unroll
    for (int e = 0; e < 16; ++e) br[e] = P->in[I_BROUT][e];
    const int nrows = (l == DEPTH - 1) ? TLAT : TT;
    const int rpb = (nrows + F.G - 1) / F.G, row0 = F.bid * rpb, row1 = (row0 + rpb < nrows) ? row0 + rpb : nrows;
    LAS int* lcnt = (LAS int*)(F.lds + LDSX_OFF + 512); LAS int* lbase = lcnt + 16; LAS int* lre = lcnt + 32; LAS int* lri = lcnt + 112; LAS float* lrw = (LAS float*)(lcnt + 192); LAS float* lrs = (LAS float*)(lcnt + 272);
    if (F.tid < 16) lcnt[F.tid] = 0;
    __syncthreads();
#pragma unroll 1
    for (int lr = 2 * F.wave; row0 + lr < row1; lr += 16) {
        const bool hasB = row0 + lr + 1 < row1; const int rowA = row0 + lr, rowB = hasB ? rowA + 1 : rowA;
        f32x4 va[8], vb[8]; const float sA = ffn_input_row(P, F, l, rowA, va), sB = ffn_input_row(P, F, l, rowB, vb);
        f32x2_t lab[16];
#pragma unroll
        for (int e = 0; e < 16; ++e) lab[e] = (f32x2_t){0.f, 0.f};
#pragma unroll
        for (int j = 0; j < 8; ++j) {
            const f32x2_t x0 = (f32x2_t){va[j][0], vb[j][0]}, x1 = (f32x2_t){va[j][1], vb[j][1]}, x2 = (f32x2_t){va[j][2], vb[j][2]}, x3 = (f32x2_t){va[j][3], vb[j][3]};
#pragma unroll
            for (int e = 0; e < 16; ++e) { const f32x4 w = *(const LAS f32x4*)(wrT + e * DM + 4 * F.lane + 256 * j);
                lab[e] = __builtin_elementwise_fma(x3, (f32x2_t){w[3], w[3]}, __builtin_elementwise_fma(x2, (f32x2_t){w[2], w[2]}, __builtin_elementwise_fma(x1, (f32x2_t){w[1], w[1]}, __builtin_elementwise_fma(x0, (f32x2_t){w[0], w[0]}, lab[e])))); }
            asm volatile("" ::: "memory"); }
        float la[16], lb[16];
#pragma unroll
        for (int e = 0; e < 16; ++e) { la[e] = wave_sum(lab[e][0]); lb[e] = wave_sum(lab[e][1]); }
        int e1, e2, f1, f2; float wa, wb, xa, xb; route_decide(la, br, e1, e2, wa, wb); route_decide(lb, br, f1, f2, xa, xb);
        if (F.lane == 0) {
            const int j1 = __hip_atomic_fetch_add(lcnt + e1, 1, __ATOMIC_RELAXED, __HIP_MEMORY_SCOPE_WORKGROUP), j2 = __hip_atomic_fetch_add(lcnt + e2, 1, __ATOMIC_RELAXED, __HIP_MEMORY_SCOPE_WORKGROUP);
            lre[2 * lr] = e1; lre[2 * lr + 1] = e2; lri[2 * lr] = j1; lri[2 * lr + 1] = j2;
            rt_e[2 * rowA] = e1; rt_e[2 * rowA + 1] = e2; lrw[2 * lr] = wa; lrw[2 * lr + 1] = wb; lrs[lr] = sA;
            if (hasB) { const int k1 = __hip_atomic_fetch_add(lcnt + f1, 1, __ATOMIC_RELAXED, __HIP_MEMORY_SCOPE_WORKGROUP), k2 = __hip_atomic_fetch_add(lcnt + f2, 1, __ATOMIC_RELAXED, __HIP_MEMORY_SCOPE_WORKGROUP);
                lre[2 * lr + 2] = f1; lre[2 * lr + 3] = f2; lri[2 * lr + 2] = k1; lri[2 * lr + 3] = k2;
                rt_e[2 * rowB] = f1; rt_e[2 * rowB + 1] = f2; lrw[2 * lr + 2] = xa; lrw[2 * lr + 3] = xb; lrs[lr + 1] = sB; } }
    }
    __syncthreads();
    if (F.tid < 16) lbase[F.tid] = (int)atomicAdd(cnt + F.tid * 64, (unsigned)lcnt[F.tid]);
    __syncthreads();
    if (F.tid < 2 * (row1 - row0)) { const int e = lre[F.tid], sl = lbase[e] + lri[F.tid]; rt_slot[2 * row0 + F.tid] = sl;
        etok[e * TT + sl] = row0 + (F.tid >> 1); ers[e * TT + sl] = lrs[F.tid >> 1]; erw[e * TT + sl] = lrw[F.tid]; }
    __syncthreads();
}
DI float rope_freq(int i) { return __expf(-1.1512925465f * (float)i); }
DI void mla_prep_rows(KParams P, Frame& F, int l) {
    const bf16_t* U = WSP(bf16_t, WS_U); bf16_t* cqn = WSP(bf16_t, WS_CQN); bf16_t* ckvn = WSP(bf16_t, WS_CKVN); bf16_t* krp = WSP(bf16_t, WS_KRP);
    for (int row = F.gw; row < TT; row += F.NGW) {
        const bf16_t* up = U + (size_t)row * PWP;
        { const u32x4 a = *(const u32x4*)(up + O_CQ + 8 * F.lane); float f[8] = {bflo(a.x), bfhi(a.x), bflo(a.y), bfhi(a.y), bflo(a.z), bfhi(a.z), bflo(a.w), bfhi(a.w)};
          float ss = 0.f;
#pragma unroll
          for (int i = 0; i < 8; ++i) ss += f[i] * f[i];
          const float rstd = 1.f / sqrtf(wave_sum(ss) * (1.f / 512.f) + EPS); const float* g = P->in[I_GQ] + l * 512 + 8 * F.lane;
          u32x4 o; o.x = pk2(f[0] * rstd * g[0], f[1] * rstd * g[1]); o.y = pk2(f[2] * rstd * g[2], f[3] * rstd * g[3]); o.z = pk2(f[4] * rstd * g[4], f[5] * rstd * g[5]); o.w = pk2(f[6] * rstd * g[6], f[7] * rstd * g[7]);
          *(u32x4*)(cqn + (size_t)row * 512 + 8 * F.lane) = o; }
        { const u32x2 a = *(const u32x2*)(up + O_CKV + 4 * F.lane); float f[4] = {bflo(a.x), bfhi(a.x), bflo(a.y), bfhi(a.y)};
          const float ss = (f[0] * f[0] + f[1] * f[1]) + (f[2] * f[2] + f[3] * f[3]);
          const float rstd = 1.f / sqrtf(wave_sum(ss) * (1.f / 256.f) + EPS); const float* g = P->in[I_GKV] + l * 256 + 4 * F.lane;
          u32x2 o; o.x = pk2(f[0] * rstd * g[0], f[1] * rstd * g[1]); o.y = pk2(f[2] * rstd * g[2], f[3] * rstd * g[3]);
          *(u32x2*)(ckvn + (size_t)row * 256 + 4 * F.lane) = o; }
        { const int e = F.lane; float val = 0.f;
          if (row < TLAT) { if (e < 32) { const int pos = row & (SEQ - 1), part = e >> 4, idx = e & 15, i = idx & 7, second = idx >> 3;
                  const float t1 = bf2f(up[O_KR + 16 * part + i]), t2 = bf2f(up[O_KR + 16 * part + 8 + i]);
                  const float ang = (float)(part ? (pos & 63) : (pos >> 6)) * rope_freq(i); const float sn = __sinf(ang), cs = __cosf(ang);
                  val = second ? (t1 * sn + t2 * cs) : (t1 * cs - t2 * sn); } }
          else { if (e >= 32) val = bf2f(up[O_KR + e - 32]); }
          krp[(size_t)row * 64 + e] = f2bf(val); }
    }
}
DI void cf_sc_tile(KParams P, Frame& F, int l, int ti) {
    const bf16_t* U = WSP(bf16_t, WS_U); bf16_t* acts = WSP(bf16_t, WS_ACTS);
    const int row0 = ti * 32; int seg_lo, seg_hi;
    if (row0 < TLAT) { seg_lo = row0 & ~(SEQ - 1); seg_hi = seg_lo + SEQ; } else { seg_lo = TLAT + ((row0 - TLAT) & ~(CTXL - 1)); seg_hi = seg_lo + CTXL; }
    LAS bf16_t* gl = (LAS bf16_t*)F.lds;
    LAS float* co = (LAS float*)(F.lds + 63488);
    const int c2 = F.tid & 255, th = F.tid >> 8;
    { const bf16_t* ub = U + O_SC + 2 * c2; const float* wp = P->in[I_WSCC] + (size_t)l * 3 * 512 + 2 * c2;
      const float w0a = wp[0], w0b = wp[1], w1a = wp[512], w1b = wp[513], w2a = wp[1024], w2b = wp[1025];
      unsigned pc[18], ph[18], gb[16];
#pragma unroll
      for (int k = 0; k < 18; ++k) { const int rr = row0 + 16 * th - 1 + k; const bool ok = rr >= seg_lo && rr < seg_hi;
          pc[k] = ok ? *(const unsigned*)(ub + (size_t)rr * PWP + 512) : 0u; ph[k] = ok ? *(const unsigned*)(ub + (size_t)rr * PWP + 1024) : 0u; }
#pragma unroll
      for (int k = 0; k < 16; ++k) gb[k] = *(const unsigned*)(ub + (size_t)(row0 + 16 * th + k) * PWP);
      float pa[18], pb[18];
#pragma unroll
      for (int k = 0; k < 18; ++k) { pa[k] = bflo(pc[k]) * bflo(ph[k]); pb[k] = bfhi(pc[k]) * bfhi(ph[k]); }
#pragma unroll
      for (int k = 0; k < 16; ++k) *(unsigned*)(acts + ((size_t)3 * TT + row0 + 16 * th + k) * 512 + 2 * c2) =
          pk2(bflo(gb[k]) * (w0a * pa[k] + w1a * pa[k + 1] + w2a * pa[k + 2]), bfhi(gb[k]) * (w0b * pb[k] + w1b * pb[k + 1] + w2b * pb[k + 2])); }
    { const int cg = F.tid & 63, ri = F.tid >> 6; u32x4 ga[8], gbv[8];
#pragma unroll
      for (int pass = 0; pass < 8; ++pass) { const int i = pass * 8 + ri, rr = row0 - 15 + i; const bool ok = i < 62 && rr >= seg_lo && rr < seg_hi;
          const bf16_t* up = U + (size_t)(ok ? rr : row0) * PWP + O_CF + 8 * cg; ga[pass] = *(const u32x4*)up; gbv[pass] = *(const u32x4*)(up + 512); }
#pragma unroll
      for (int pass = 0; pass < 8; ++pass) { const int i = pass * 8 + ri, rr = row0 - 15 + i; const bool ok = rr >= seg_lo && rr < seg_hi;
          if (i < 62) { const u32x4 a = ga[pass], b = gbv[pass]; u32x4 o;
              o.x = pk2(bflo(a.x) * sigm(bflo(b.x)), bfhi(a.x) * sigm(bfhi(b.x))); o.y = pk2(bflo(a.y) * sigm(bflo(b.y)), bfhi(a.y) * sigm(bfhi(b.y)));
              o.z = pk2(bflo(a.z) * sigm(bflo(b.z)), bfhi(a.z) * sigm(bfhi(b.z))); o.w = pk2(bflo(a.w) * sigm(bflo(b.w)), bfhi(a.w) * sigm(bfhi(b.w)));
              if (!ok) o = (u32x4){0u, 0u, 0u, 0u};
              *(LAS u32x4*)(gl + i * 512 + 8 * cg) = o; } } }
    asm volatile("" ::: "memory");
    float wva[31], wvb[31];
#pragma unroll
    for (int j = 0; j < 31; ++j) { const f32x2_t w = *(const f32x2_t*)(P->in[I_WCFDW] + (size_t)(l * 31 + j) * 512 + 2 * c2); wva[j] = w[0]; wvb[j] = w[1]; }
    const f32x2_t bias = *(const f32x2_t*)(P->in[I_BCFDW] + l * 512 + 2 * c2);
    __syncthreads();
#pragma unroll 1
    for (int hb = 0; hb < 2; ++hb) { const LAS unsigned* gp = (const LAS unsigned*)(gl + (16 * th + 8 * hb) * 512 + 2 * c2); f32x2_t xin[38];
#pragma unroll
      for (int i = 0; i < 38; ++i) { const unsigned x = gp[i * 256]; xin[i] = (f32x2_t){bflo(x), bfhi(x)}; }
#pragma unroll
      for (int t = 0; t < 8; ++t) { f32x2_t a = bias;
#pragma unroll
          for (int j = 0; j < 31; ++j) a = __builtin_elementwise_fma((f32x2_t){wva[j], wvb[j]}, xin[t + j], a);
          *(LAS f32x2_t*)(co + (16 * th + 8 * hb + t) * 512 + 2 * c2) = a; } }
    __syncthreads();
#pragma unroll 1
    for (int tt = 0; tt < 4; ++tt) { const int t = F.wave * 4 + tt; const LAS float* cr = co + t * 512 + 8 * F.lane;
        const f32x4 a = *(const LAS f32x4*)cr, b = *(const LAS f32x4*)(cr + 4);
        float x[8] = {a[0], a[1], a[2], a[3], b[0], b[1], b[2], b[3]}; float s = 0.f;
#pragma unroll
        for (int i = 0; i < 8; ++i) s += x[i];
        const float mean = wave_sum(s) * (1.f / 512.f); float q = 0.f;
#pragma unroll
        for (int i = 0; i < 8; ++i) { x[i] -= mean; q += x[i] * x[i]; }
        const float rstd = 1.f / sqrtf(wave_sum(q) * (1.f / 512.f) + EPS);
        const float* g = P->in[I_GCFLN] + l * 512 + 8 * F.lane; const float* bb = P->in[I_BCFLN] + l * 512 + 8 * F.lane; float y[8];
#pragma unroll
        for (int i = 0; i < 8; ++i) y[i] = siluf(x[i] * rstd * g[i] + bb[i]);
        u32x4 o; o.x = pk2(y[0], y[1]); o.y = pk2(y[2], y[3]); o.z = pk2(y[4], y[5]); o.w = pk2(y[6], y[7]);
        *(u32x4*)(acts + ((size_t)1 * TT + row0 + t) * 512 + 8 * F.lane) = o; }
    __syncthreads();
}

constexpr int GPD = 72;
constexpr int GL_LOW = 0, GL_GSUM = 8192, GL_VT = 10240, GL_A0 = 28672, GL_KD = 37888, GL_QI = 47104, GL_ST = 56320, GL_PP = 74752, GL_OB = 83968;
DI void gla_chunk_decode(int ci, int& b, int& row0, int& jf, int& jb) {
    if (ci < 128) { b = ci >> 5; const int c = ci & 31; row0 = b * SEQ + c * 64; jf = 4 + c; jb = 4 + (31 - c); }
    else { const int cc = ci - 128; b = cc >> 2; const int c = cc & 3; row0 = TLAT + b * CTXL + c * 64; jf = c; jb = 3 - c; }
}
DI int gla_cidx(int b, int hh, int dir, int j) { return ((b * 4 + hh) * 2 + dir) * NCHAIN + j; }
DI void lds_mma_nt(f32x16& acc, const LAS bf16_t* A, int a_row0, const LAS bf16_t* B, int b_row0, int r, int h) {
#pragma unroll
    for (int k0 = 0; k0 < 64; k0 += 16) {
        const bf16x8 a = *(const LAS bf16x8*)(A + (a_row0 + r) * GPD + k0 + 8 * h);
        const bf16x8 b = *(const LAS bf16x8*)(B + (b_row0 + r) * GPD + k0 + 8 * h);
        acc = __builtin_amdgcn_mfma_f32_32x32x16_bf16(a, b, acc, 0, 0, 0);
    }
}
DI float logsig(float z) { return fminf(z, 0.f) - __logf(1.f + __expf(-fabsf(z))); }
DI void gla_decay(Frame& F, int dir, const float (&w2v)[16], float b2, float (&cs)[8], float& off, float& total, float& mid) {
    const LAS float* low = (const LAS float*)(F.lds + GL_LOW); LAS float* gsum = (LAS float*)(F.lds + GL_GSUM);
    const int d = F.tid & 63, tg = F.tid >> 6;
    float la[8];
#pragma unroll
    for (int i = 0; i < 8; ++i) { const LAS float* lp = low + (tg * 8 + i) * 32 + dir * 16; float z = b2;
#pragma unroll
        for (int j = 0; j < 16; ++j) z += lp[j] * w2v[j];
        la[i] = logsig(z) * (1.f / 16.f); }
    if (dir == 0) { cs[0] = la[0];
#pragma unroll
        for (int i = 1; i < 8; ++i) cs[i] = cs[i - 1] + la[i];
        gsum[tg * 64 + d] = cs[7]; }
    else { cs[7] = la[7];
#pragma unroll
        for (int i = 6; i >= 0; --i) cs[i] = cs[i + 1] + la[i];
        gsum[tg * 64 + d] = cs[0]; }
    __syncthreads();
    float g[8];
#pragma unroll
    for (int q = 0; q < 8; ++q) g[q] = gsum[q * 64 + d];
    total = 0.f; off = 0.f; mid = 0.f;
#pragma unroll
    for (int q = 0; q < 8; ++q) { total += g[q]; if (dir == 0) { off += (q < tg) ? g[q] : 0.f; mid += (q <= 3) ? g[q] : 0.f; } else { off += (q > tg) ? g[q] : 0.f; mid += (q >= 4) ? g[q] : 0.f; } }
}
#define GLA_PRELOAD() \
    const int d = F.tid & 63, tg = F.tid >> 6, dcol = hh * 64 + d; \
    const u32x2 loww = *(const u32x2*)(U + (size_t)(row0 + (F.tid >> 3)) * PWP + O_GF + (F.tid & 7) * 4); \
    const u32x4 vva = *(const u32x4*)(U + (size_t)(row0 + (F.tid >> 3)) * PWP + O_GV + hh * 128 + (F.tid & 7) * 16), vvb = *(const u32x4*)(U + (size_t)(row0 + (F.tid >> 3)) * PWP + O_GV + hh * 128 + (F.tid & 7) * 16 + 8); \
    float w2f[16], w2b[16]; \
    _Pragma("unroll") for (int j = 0; j < 16; ++j) { w2f[j] = P->in[I_WGF][(size_t)l * 16 * 256 + j * 256 + dcol]; w2b[j] = P->in[I_WGB][(size_t)l * 16 * 256 + j * 256 + dcol]; } \
    const float b2f = P->in[I_BGF][l * 256 + dcol], b2b = P->in[I_BGB][l * 256 + dcol]; \
    float kraw[8]; \
    _Pragma("unroll") for (int i = 0; i < 8; ++i) kraw[i] = bf2f(U[(size_t)(row0 + tg * 8 + i) * PWP + O_GK + hh * 64 + d]);
#define GLA_STAGE_LOW_VT() do { LAS float* low_ = (LAS float*)(F.lds + GL_LOW); const int t_ = F.tid >> 3, j4_ = (F.tid & 7) * 4, v16_ = (F.tid & 7) * 16; \
    low_[t_ * 32 + j4_] = bflo(loww.x); low_[t_ * 32 + j4_ + 1] = bfhi(loww.x); low_[t_ * 32 + j4_ + 2] = bflo(loww.y); low_[t_ * 32 + j4_ + 3] = bfhi(loww.y); \
    const unsigned w_[8] = {vva.x, vva.y, vva.z, vva.w, vvb.x, vvb.y, vvb.z, vvb.w}; \
    _Pragma("unroll") for (int i = 0; i < 8; ++i) { VT[(v16_ + 2 * i) * GPD + t_] = (bf16_t)(w_[i] & 0xffffu); VT[(v16_ + 2 * i + 1) * GPD + t_] = (bf16_t)(w_[i] >> 16); } } while (0)
DI void gla_a_item(KParams P, Frame& F, int l, int ci, int hh) {
    const bf16_t* U = WSP(bf16_t, WS_U); bf16_t* Sloc = WSP(bf16_t, WS_SLOC); float* dec = WSP(float, WS_DEC);
    int b, row0, jf, jb; gla_chunk_decode(ci, b, row0, jf, jb);
    LAS bf16_t* VT = (LAS bf16_t*)(F.lds + GL_VT); LAS bf16_t* KET = (LAS bf16_t*)(F.lds + GL_A0);
    const int r = F.lane & 31, h = F.lane >> 5, mb = F.wave & 1, nb = F.wave >> 1;
    GLA_PRELOAD();
    GLA_STAGE_LOW_VT();
    __syncthreads();
#pragma unroll
    for (int dir = 0; dir < 2; ++dir) {
        float cs[8], off, total, mid; gla_decay(F, dir, dir ? w2b : w2f, dir ? b2b : b2f, cs, off, total, mid);
        const int cidx = gla_cidx(b, hh, dir, dir ? jb : jf);
#pragma unroll
        for (int i = 0; i < 8; ++i) KET[d * GPD + tg * 8 + i] = f2bf(kraw[i] * __expf(total - (off + cs[i])));
        if (tg == 0) dec[(size_t)cidx * 64 + d] = __expf(total);
        __syncthreads();
        f32x16 acc;
#pragma unroll
        for (int i = 0; i < 16; ++i) acc[i] = 0.f;
        lds_mma_nt(acc, KET, 32 * mb, VT, 32 * nb, r, h);
        bf16_t* sp = Sloc + ((size_t)cidx * 128 + 32 * nb + r) * 64 + 32 * mb + 4 * h;
#pragma unroll
        for (int g = 0; g < 4; ++g) *(u32x2*)(sp + 8 * g) = (u32x2){pk2(acc[4 * g], acc[4 * g + 1]), pk2(acc[4 * g + 2], acc[4 * g + 3])};
        __syncthreads();
    }
}
DI void gla_scan(KParams P, Frame& F) {
    const bf16_t* Sloc = WSP(bf16_t, WS_SLOC); const float* dec = WSP(float, WS_DEC); bf16_t* Sin = WSP(bf16_t, WS_SIN);
    for (int e = F.bid * 512 + F.tid; e < 32 * 4096; e += F.G * 512) { const int chain = e >> 12, vd = (e & 4095) * 2, d = vd & 63; float S0 = 0.f, S1 = 0.f;
#pragma unroll 1
        for (int j0 = 0; j0 < NCHAIN; j0 += 12) { f32x2_t sl[12], dc[12];
#pragma unroll
            for (int j = 0; j < 12; ++j) { const size_t idx = (size_t)chain * NCHAIN + j0 + j; { const unsigned w = *(const unsigned*)(Sloc + idx * 8192 + vd); sl[j] = (f32x2_t){bflo(w), bfhi(w)}; } dc[j] = *(const f32x2_t*)(dec + idx * 64 + d); }
#pragma unroll
            for (int j = 0; j < 12; ++j) { const size_t idx = (size_t)chain * NCHAIN + j0 + j; *(unsigned*)(Sin + idx * 8192 + vd) = pk2(S0, S1); S0 = dc[j][0] * S0 + sl[j][0]; S1 = dc[j][1] * S1 + sl[j][1]; } } }
}
DI void gla_b_item(KParams P, Frame& F, int l, int ci, int hh) {
    const bf16_t* U = WSP(bf16_t, WS_U); const bf16_t* Sin = WSP(bf16_t, WS_SIN); bf16_t* acts = WSP(bf16_t, WS_ACTS);
    int b, row0, jf, jb; gla_chunk_decode(ci, b, row0, jf, jb);
    LAS bf16_t* VT = (LAS bf16_t*)(F.lds + GL_VT); LAS bf16_t* QD = (LAS bf16_t*)(F.lds + GL_A0); LAS bf16_t* KD = (LAS bf16_t*)(F.lds + GL_KD); LAS bf16_t* QI = (LAS bf16_t*)(F.lds + GL_QI);
    LAS bf16_t* ST = (LAS bf16_t*)(F.lds + GL_ST); LAS bf16_t* PP = (LAS bf16_t*)(F.lds + GL_PP); LAS float* OB = (LAS float*)(F.lds + GL_OB);
    const int r = F.lane & 31, h = F.lane >> 5, tb = F.wave & 1, vb = F.wave >> 1;
    GLA_PRELOAD();
    float qraw[8];
#pragma unroll
    for (int i = 0; i < 8; ++i) qraw[i] = bf2f(U[(size_t)(row0 + tg * 8 + i) * PWP + O_GQ + hh * 64 + d]) * 0.125f;
    const int sv = F.tid >> 2, sd16 = (F.tid & 3) * 16;
    const bf16_t* spf = Sin + ((size_t)gla_cidx(b, hh, 0, jf) * 128 + sv) * 64 + sd16; const bf16_t* spb = Sin + ((size_t)gla_cidx(b, hh, 1, jb) * 128 + sv) * 64 + sd16;
    const u32x4 sf0 = *(const u32x4*)spf, sf1 = *(const u32x4*)(spf + 8), sb0 = *(const u32x4*)spb, sb1 = *(const u32x4*)(spb + 8);
    const int ot = F.tid >> 3, ov0 = (F.tid & 7) * 16;
    const bf16_t* rp = U + (size_t)(row0 + ot) * PWP + O_GR + hh * 128 + ov0; const u32x4 r0 = *(const u32x4*)rp, r1 = *(const u32x4*)(rp + 8);
    GLA_STAGE_LOW_VT();
    __syncthreads();
    f32x16 acc;
#pragma unroll
    for (int i = 0; i < 16; ++i) acc[i] = 0.f;
#pragma unroll
    for (int dir = 0; dir < 2; ++dir) {
        float cs[8], off, total, mid; gla_decay(F, dir, dir ? w2b : w2f, dir ? b2b : b2f, cs, off, total, mid);
#pragma unroll
        for (int i = 0; i < 8; ++i) { const int t = tg * 8 + i; const float bc = off + cs[i];
            QD[t * GPD + d] = f2bf(qraw[i] * __expf(bc - mid)); KD[t * GPD + d] = f2bf(kraw[i] * __expf(mid - bc)); QI[t * GPD + d] = f2bf(qraw[i] * __expf(bc)); }
        *(LAS u32x4*)(ST + sv * GPD + sd16) = dir ? sb0 : sf0; *(LAS u32x4*)(ST + sv * GPD + sd16 + 8) = dir ? sb1 : sf1;
        __syncthreads();
        if (F.wave < 4) { const int tb2 = F.wave & 1, sb = F.wave >> 1; f32x16 a;
#pragma unroll
            for (int i = 0; i < 16; ++i) a[i] = 0.f;
            lds_mma_nt(a, QD, 32 * tb2, KD, 32 * sb, r, h);
#pragma unroll
            for (int i = 0; i < 16; ++i) { const int t = 32 * tb2 + (i & 3) + 8 * (i >> 2) + 4 * h, s2 = 32 * sb + r; const bool keep = dir ? (s2 >= t) : (s2 <= t);
                PP[t * GPD + s2] = f2bf(keep ? a[i] : 0.f); } }
        __syncthreads();
        lds_mma_nt(acc, PP, 32 * tb, VT, 32 * vb, r, h);
        lds_mma_nt(acc, QI, 32 * tb, ST, 32 * vb, r, h);
        __syncthreads();
    }
#pragma unroll
    for (int i = 0; i < 16; ++i) OB[(32 * tb + (i & 3) + 8 * (i >> 2) + 4 * h) * 128 + 32 * vb + r] = acc[i];
    __syncthreads();
    { float x[16]; float ss = 0.f;
#pragma unroll
      for (int q = 0; q < 4; ++q) { const f32x4 o = *(const LAS f32x4*)(OB + ot * 128 + ov0 + 4 * q); x[4 * q] = o[0]; x[4 * q + 1] = o[1]; x[4 * q + 2] = o[2]; x[4 * q + 3] = o[3]; }
#pragma unroll
      for (int i = 0; i < 16; ++i) ss += x[i] * x[i];
      ss += __shfl_xor(ss, 1); ss += __shfl_xor(ss, 2); ss += __shfl_xor(ss, 4);
      const float rstd = 1.f / sqrtf(ss * (1.f / 128.f) + EPS);
      const unsigned rw[8] = {r0.x, r0.y, r0.z, r0.w, r1.x, r1.y, r1.z, r1.w}; const float* gn = P->in[I_GGLAN] + l * 128 + ov0; unsigned ow[8];
#pragma unroll
      for (int i = 0; i < 8; ++i) ow[i] = pk2(x[2 * i] * rstd * gn[2 * i] * siluf(bflo(rw[i])), x[2 * i + 1] * rstd * gn[2 * i + 1] * siluf(bfhi(rw[i])));
      bf16_t* op = acts + ((size_t)2 * TT + row0 + ot) * 512 + hh * 128 + ov0;
      *(u32x4*)op = (u32x4){ow[0], ow[1], ow[2], ow[3]}; *(u32x4*)(op + 8) = (u32x4){ow[4], ow[5], ow[6], ow[7]}; }
    __syncthreads();
}
DI float at_max2(float a, float b) { return __builtin_amdgcn_fmed3f(a, b, INFINITY); }
constexpr int AT_KC = 1040, AT_VG = 520;
constexpr int AT_K0 = 0, AT_K1 = 16 * AT_KC, AT_V0 = 32 * AT_KC, AT_V1 = 32 * AT_KC + 16 * AT_VG;
DI void attn_unit(KParams P, Frame& F, int b, int hh, int qrow0, int nlat) {
    const bf16_t* Q = WSP(bf16_t, WS_Q); const bf16_t* KN = WSP(bf16_t, WS_KN); const bf16_t* KRP = WSP(bf16_t, WS_KRP); const bf16_t* VT = WSP(bf16_t, WS_VT); bf16_t* acts = WSP(bf16_t, WS_ACTS);
    const int ntile = nlat + 4; const int r = F.lane & 31, h = F.lane >> 5;
    const int kvi = F.tid >> 3, kc = F.tid & 7;
    const float C = 0.10206207261596577f * 1.4426950408889634f;
    const int qrow = qrow0 + 32 * F.wave + r; const bf16_t* qp = Q + (size_t)qrow * 768 + hh * 96;
    bf16x8 qf[8];
#pragma unroll
    for (int s = 0; s < 4; ++s) { const u32x4 a = *(const u32x4*)(qp + 16 * s + 8 * h);
        u32x4 o; o.x = pk2(C * bflo(a.x), C * bfhi(a.x)); o.y = pk2(C * bflo(a.y), C * bfhi(a.y)); o.z = pk2(C * bflo(a.z), C * bfhi(a.z)); o.w = pk2(C * bflo(a.w), C * bfhi(a.w)); qf[s] = __builtin_bit_cast(bf16x8, o); }
    { const u32x4 a1 = *(const u32x4*)(qp + 64), a2 = *(const u32x4*)(qp + 72), c1 = *(const u32x4*)(qp + 80), c2 = *(const u32x4*)(qp + 88);
      const float ra1[8] = {bflo(a1.x), bfhi(a1.x), bflo(a1.y), bfhi(a1.y), bflo(a1.z), bfhi(a1.z), bflo(a1.w), bfhi(a1.w)}, ra2[8] = {bflo(a2.x), bfhi(a2.x), bflo(a2.y), bfhi(a2.y), bflo(a2.z), bfhi(a2.z), bflo(a2.w), bfhi(a2.w)};
      const float rc1[8] = {bflo(c1.x), bfhi(c1.x), bflo(c1.y), bfhi(c1.y), bflo(c1.z), bfhi(c1.z), bflo(c1.w), bfhi(c1.w)}, rc2[8] = {bflo(c2.x), bfhi(c2.x), bflo(c2.y), bfhi(c2.y), bflo(c2.z), bfhi(c2.z), bflo(c2.w), bfhi(c2.w)};
      float ur[8], uc[8], xr[8], xc[8];
      const int pos = qrow & (SEQ - 1); const float prow = (float)(pos >> 6), pcol = (float)(pos & 63);
#pragma unroll
      for (int i = 0; i < 8; ++i) { ur[i] = C * (h ? ra2[i] : ra1[i]); uc[i] = C * (h ? rc2[i] : rc1[i]);
          if (nlat > 0) { const float f = rope_freq(i); float sn = __sinf(prow * f), cs = __cosf(prow * f); xr[i] = C * (h ? (ra1[i] * sn + ra2[i] * cs) : (ra1[i] * cs - ra2[i] * sn));
              sn = __sinf(pcol * f); cs = __cosf(pcol * f); xc[i] = C * (h ? (rc1[i] * sn + rc2[i] * cs) : (rc1[i] * cs - rc2[i] * sn)); }
          else { xr[i] = 0.f; xc[i] = 0.f; } }
      u32x4 o;
      o.x = pk2(xr[0], xr[1]); o.y = pk2(xr[2], xr[3]); o.z = pk2(xr[4], xr[5]); o.w = pk2(xr[6], xr[7]); qf[4] = __builtin_bit_cast(bf16x8, o);
      o.x = pk2(xc[0], xc[1]); o.y = pk2(xc[2], xc[3]); o.z = pk2(xc[4], xc[5]); o.w = pk2(xc[6], xc[7]); qf[5] = __builtin_bit_cast(bf16x8, o);
      o.x = pk2(ur[0], ur[1]); o.y = pk2(ur[2], ur[3]); o.z = pk2(ur[4], ur[5]); o.w = pk2(ur[6], ur[7]); qf[6] = __builtin_bit_cast(bf16x8, o);
      o.x = pk2(uc[0], uc[1]); o.y = pk2(uc[2], uc[3]); o.z = pk2(uc[4], uc[5]); o.w = pk2(uc[6], uc[7]); qf[7] = __builtin_bit_cast(bf16x8, o); }
    u32x4 kA0, kA1, vA, kB0, kB1, vB;
#define AT_KROW(tl) (((tl) < nlat) ? (b * SEQ + (tl) * 64) : (TLAT + b * CTXL + ((tl) - nlat) * 64))
#define AT_LOADK(tl, R0, R1) do { const int krow0_ = AT_KROW(tl); R0 = *(const u32x4*)(KN + (size_t)(krow0_ + kvi) * 512 + hh * 64 + kc * 8); R1 = *(const u32x4*)(KRP + (size_t)(krow0_ + kvi) * 64 + kc * 8); } while (0)
#define AT_LOADV(tl, R) do { const int krow0_ = AT_KROW(tl); R = *(const u32x4*)(VT + (size_t)(hh * 64 + kvi) * TT + krow0_ + kc * 8); } while (0)
#define AT_STOREK(buf, R0, R1) do { LAS unsigned char* kb_ = F.lds + ((buf) ? AT_K1 : AT_K0); *(LAS u32x4*)(kb_ + kc * AT_KC + kvi * 16) = R0; *(LAS u32x4*)(kb_ + (8 + kc) * AT_KC + kvi * 16) = R1; } while (0)
#define AT_STOREV(buf, R) do { LAS unsigned char* vb_ = F.lds + ((buf) ? AT_V1 : AT_V0); *(LAS u32x2*)(vb_ + (kc & ~1) * AT_KC + kvi * 16 + (kc & 1) * 8) = (u32x2){R.x, R.y}; *(LAS u32x2*)(vb_ + ((kc & ~1) + 1) * AT_KC + kvi * 16 + (kc & 1) * 8) = (u32x2){R.z, R.w}; } while (0)
#define AT_QK(P0, P1, buf, LAT) do { const LAS unsigned char* kb_ = F.lds + ((buf) ? AT_K1 : AT_K0); \
        _Pragma("unroll") for (int i = 0; i < 16; ++i) { P0[i] = 0.f; P1[i] = 0.f; } \
        _Pragma("unroll") for (int s = 0; s < 8; ++s) if ((LAT) ? (s < 6) : (s < 4 || s >= 6)) { const bf16x8 ka0 = *(const LAS bf16x8*)(kb_ + (2 * s + h) * AT_KC + r * 16), ka1 = *(const LAS bf16x8*)(kb_ + (2 * s + h) * AT_KC + (32 + r) * 16); \
            P0 = __builtin_amdgcn_mfma_f32_32x32x16_bf16(ka0, qf[s], P0, 0, 0, 0); P1 = __builtin_amdgcn_mfma_f32_32x32x16_bf16(ka1, qf[s], P1, 0, 0, 0); } } while (0)
#define AT_COMPUTE(tl, LAT) do { const int cur = (tl) & 1; f32x16 pc0, pc1; \
        AT_QK(pc0, pc1, cur, LAT);                                                 \
        const LAS unsigned char* vb = F.lds + (cur ? AT_V1 : AT_V0); \
        float mxa = at_max2(pc0[0], pc0[1]), mxb = at_max2(pc1[0], pc1[1]); \
        _Pragma("unroll") for (int i = 2; i < 16; ++i) { mxa = at_max2(mxa, pc0[i]); mxb = at_max2(mxb, pc1[i]); } \
        float mx = at_max2(mxa, mxb); mx = at_max2(mx, __shfl_xor(mx, 32)); \
        const float mnew = at_max2(m_run, mx), alpha = __builtin_amdgcn_exp2f(m_run - mnew); m_run = mnew; \
        const f32x2_t nm2 = (f32x2_t){-mnew, -mnew}; f32x2_t ps2 = (f32x2_t){0.f, 0.f};                  \
        _Pragma("unroll") for (int i = 0; i < 8; ++i) { \
            f32x2_t ta = (f32x2_t){pc0[2 * i], pc0[2 * i + 1]} + nm2, tb = (f32x2_t){pc1[2 * i], pc1[2 * i + 1]} + nm2; \
            ta[0] = __builtin_amdgcn_exp2f(ta[0]); ta[1] = __builtin_amdgcn_exp2f(ta[1]); tb[0] = __builtin_amdgcn_exp2f(tb[0]); tb[1] = __builtin_amdgcn_exp2f(tb[1]); \
            ps2 = ps2 + (ta + tb); pc0[2 * i] = ta[0]; pc0[2 * i + 1] = ta[1]; pc1[2 * i] = tb[0]; pc1[2 * i + 1] = tb[1]; } \
        const float psum = ps2[0] + ps2[1]; \
        l_run = l_run * alpha + psum; \
        _Pragma("unroll") for (int i = 0; i < 16; ++i) { o0[i] *= alpha; o1[i] *= alpha; } \
        bf16x8 pf[4]; \
        { u32x4 w; \
          w.x = pk2(pc0[0], pc0[1]); w.y = pk2(pc0[2], pc0[3]); w.z = pk2(pc0[4], pc0[5]); w.w = pk2(pc0[6], pc0[7]); pf[0] = __builtin_bit_cast(bf16x8, w); \
          w.x = pk2(pc0[8], pc0[9]); w.y = pk2(pc0[10], pc0[11]); w.z = pk2(pc0[12], pc0[13]); w.w = pk2(pc0[14], pc0[15]); pf[1] = __builtin_bit_cast(bf16x8, w); \
          w.x = pk2(pc1[0], pc1[1]); w.y = pk2(pc1[2], pc1[3]); w.z = pk2(pc1[4], pc1[5]); w.w = pk2(pc1[6], pc1[7]); pf[2] = __builtin_bit_cast(bf16x8, w); \
          w.x = pk2(pc1[8], pc1[9]); w.y = pk2(pc1[10], pc1[11]); w.z = pk2(pc1[12], pc1[13]); w.w = pk2(pc1[14], pc1[15]); pf[3] = __builtin_bit_cast(bf16x8, w); } \
        _Pragma("unroll") for (int s = 0; s < 4; ++s) { \
            const u32x4 va0 = *(const LAS u32x4*)(vb + (2 * s + h) * AT_KC + r * 16), va1 = *(const LAS u32x4*)(vb + (2 * s + h) * AT_KC + (32 + r) * 16); \
            o0 = __builtin_amdgcn_mfma_f32_32x32x16_bf16(__builtin_bit_cast(bf16x8, va0), pf[s], o0, 0, 0, 0); \
            o1 = __builtin_amdgcn_mfma_f32_32x32x16_bf16(__builtin_bit_cast(bf16x8, va1), pf[s], o1, 0, 0, 0); } } while (0)
#define AT_ITER(tl, LAT, LK0, LK1, LV, SK0, SK1, SV) do { \
        if ((tl) + 2 < ntile) { AT_LOADK((tl) + 2, LK0, LK1); AT_LOADV((tl) + 2, LV); } \
        AT_COMPUTE(tl, LAT); \
        if ((tl) + 1 < ntile) { AT_STOREK(((tl) & 1) ^ 1, SK0, SK1); AT_STOREV(((tl) & 1) ^ 1, SV); } \
        __syncthreads(); } while (0)
    float m_run = -INFINITY, l_run = 0.f; f32x16 o0, o1;
#pragma unroll
    for (int i = 0; i < 16; ++i) { o0[i] = 0.f; o1[i] = 0.f; }
    AT_LOADK(0, kA0, kA1); AT_LOADV(0, vA); AT_LOADK(1, kB0, kB1); AT_LOADV(1, vB);
    AT_STOREK(0, kA0, kA1); AT_STOREV(0, vA);
    __syncthreads();
#pragma unroll 1
    for (int tl = 0; tl < nlat; tl += 2) {
        AT_ITER(tl, true, kA0, kA1, vA, kB0, kB1, vB);
        AT_ITER(tl + 1, true, kB0, kB1, vB, kA0, kA1, vA);
    }
#pragma unroll 1
    for (int tl = nlat; tl < ntile; tl += 2) {
        AT_ITER(tl, false, kA0, kA1, vA, kB0, kB1, vB);
        AT_ITER(tl + 1, false, kB0, kB1, vB, kA0, kA1, vA);
    }
#undef AT_COMPUTE
#undef AT_ITER
#undef AT_KROW
#undef AT_LOADK
#undef AT_LOADV
#undef AT_STOREK
#undef AT_STOREV
#undef AT_QK
    const float inv = 1.f / (l_run + __shfl_xor(l_run, 32));
    bf16_t* op = acts + (size_t)qrow * 512 + hh * 64 + 4 * h;
#pragma unroll
    for (int g = 0; g < 4; ++g) { u32x2 w; w.x = pk2(o0[4 * g] * inv, o0[4 * g + 1] * inv); w.y = pk2(o0[4 * g + 2] * inv, o0[4 * g + 3] * inv); *(u32x2*)(op + 8 * g) = w;
        w.x = pk2(o1[4 * g] * inv, o1[4 * g + 1] * inv); w.y = pk2(o1[4 * g + 2] * inv, o1[4 * g + 3] * inv); *(u32x2*)(op + 32 + 8 * g) = w; }
}

DI KParams load_params() { KParams kp = (KParams)__builtin_amdgcn_kernarg_segment_ptr(); asm volatile("" : "+s"(kp)); return kp; }
DI Frame phase_frame(const Frame& F0) { Frame F = F0; int t = F0.tid; asm volatile("" : "+v"(t)); { int b = F0.bid, g = F0.G; asm volatile("" : "+s"(b), "+s"(g)); F.bid = b; F.G = g; F.NGW = g * 8; } F.tid = t; F.lane = t & 63; F.wave = __builtin_amdgcn_readfirstlane(t >> 6); F.gw = F.bid * 8 + F.wave; return F; }
constexpr int PH_PER_LAYER = 10, NPHASE = 1 + DEPTH * PH_PER_LAYER + 1;
__global__ void __launch_bounds__(512, 2) hybrid_trunk_fwd(Params P) {
    extern __shared__ __attribute__((aligned(16))) unsigned char lds_raw[];
    Frame F; F.lds = (LAS unsigned char*)lds_raw; F.tid = threadIdx.x; F.lane = F.tid & 63; F.wave = __builtin_amdgcn_readfirstlane(F.tid >> 6);
    F.G = gridDim.x; F.bid = blockIdx.x; F.gw = F.bid * 8 + F.wave; F.NGW = F.G * 8;
    const int vcu = (F.G % 8 == 0) ? (F.bid % 8) * (F.G / 8) + F.bid / 8 : F.bid;
    for (int u = F.tid; u < (LDS_BYTES - LDSX_OFF) / 4; u += 512) ((LAS unsigned*)(F.lds + LDSX_OFF))[u] = 0u;
    __syncthreads();
    const int lo = P.ph_lo, hi = P.ph_hi;
    XcdBarrier bar; bar.bar = (unsigned*)(P.ws + WS_CTL) + CW_BAR; bar.x = 0; bar.st = (volatile LAS unsigned*)(F.lds + LDSX_OFF);
    if (hi - lo > 1) bar = xcd_barrier_post((unsigned*)(P.ws + WS_CTL) + CW_BAR, (volatile LAS unsigned*)(F.lds + LDSX_OFF));
#ifndef PH_MASK
#define PH_MASK 0xffff
#endif
#define PHM(b) ((PH_MASK >> (b)) & 1)
#ifndef DUP_MASK
#define DUP_MASK 0
#endif
#define REP(b) (1 + ((DUP_MASK >> (b)) & 1))
#define IN(k) (lo <= (k) && (k) < hi)
#ifndef DUP_BAR
#define DUP_BAR 0
#endif
#define SEAM(k) do { if (IN(k) && IN((k) + 1)) { xcd_barrier(bar); if (DUP_BAR) xcd_barrier(bar); } } while (0)
    if (PHM(0) && IN(0)) for (int rep_ = 0; rep_ < REP(0); ++rep_) { KParams Q = load_params(); Frame Fp = phase_frame(F); phase_prologue(Q, Fp);
        conv_mixed(Q, Fp, 0, 0, NS_ALL, 0, NL_ITEMS, Fp.bid, Fp.G); }
    SEAM(0);
    for (int l = 0; l < DEPTH; ++l) {
        const int pb = 1 + PH_PER_LAYER * l;
        if (PHM(1) && IN(pb + 0)) for (int rep_ = 0; rep_ < REP(1); ++rep_) { KParams Q = load_params(); Frame Fp = phase_frame(F); phase_norm1(Q, Fp, l, rep_ + 1 < REP(1)); }
        SEAM(pb + 0);
        if (PHM(2) && IN(pb + 1)) for (int rep_ = 0; rep_ < REP(2); ++rep_) { KParams Q = load_params(); Frame Fp = phase_frame(F);
            const bool lastl = (l == DEPTH - 1); const int nM1 = lastl ? TLAT / 256 : TT / 256;
            pg8::Gemm g8{(const bf16_t*)(Q->ws + WS_H8), (const bf16_t*)(Q->ws + WS_W8 + (size_t)l * PWP * DM), DM / 2, 0, 0};
            pg8::TrimOrder S8{nM1, PWP / 256, nM1 * (PWP / 256), lastl ? (TCTX / 256) * 6 : 0, Fp.G, Fp.bid};
            pg8::EpiStoreQ E8{(bf16_t*)(Q->ws + WS_U), PWP, (const float*)(Q->ws + WS_RA), (const float*)(Q->ws + WS_RB) + (size_t)l * PWP, Q->ws + WS_G8};
            pg8::gemm_phase_i8<pg8::EpiStoreQ, pg8::TrimOrder>(Fp.lds, g8, S8, E8); }
        SEAM(pb + 1);
        if (PHM(3) && IN(pb + 2)) for (int rep_ = 0; rep_ < REP(3); ++rep_) { KParams Q = load_params(); Frame Fp = phase_frame(F); bf16_t* U = (bf16_t*)(Q->ws + WS_U); (void)U; mla_prep_rows(Q, Fp, l);
            const int ncf = (l == DEPTH - 1) ? TLAT / 32 : TT / 32;
            for (int it = vcu; it < ncf; it += Fp.G) cf_sc_tile(Q, Fp, l, it);
            { const int extra = ncf > Fp.G ? ncf - Fp.G : 0;
              if (vcu >= extra) for (int it = vcu - extra; it < 144 * 4; it += Fp.G - extra) gla_a_item(Q, Fp, l, it >> 2, it & 3); } }
        SEAM(pb + 2);
        if (PHM(4) && IN(pb + 3)) for (int rep_ = 0; rep_ < REP(4); ++rep_) { KParams Q = load_params(); Frame Fp = phase_frame(F); bf16_t* U = (bf16_t*)(Q->ws + WS_U); (void)U;
            const int nq = ((l == DEPTH - 1) ? TLAT / 256 : TT / 256) * 3;
            { pg8::Gemm g{WSQ(bf16_t, WS_CQN), WSQ(bf16_t, WS_WUQ) + (size_t)l * 768 * 512, 512, 0, 0}; pg8::RangeOrder S{0, nq, 3, Fp.G, Fp.bid}; pg8::EpiStore E{WSQ(bf16_t, WS_Q), 768};
              pg8::gemm_phase<pg8::EpiStore, pg8::RangeOrder>(Fp.lds, g, S, E); }
            { const bf16_t* ckvn = WSQ(bf16_t, WS_CKVN); const bf16_t* wkn = WSQ(bf16_t, WS_WKN) + (size_t)l * 512 * 256; const bf16_t* wv = WSQ(bf16_t, WS_WV) + (size_t)l * 512 * 256;
              pg8::Gemm g{ckvn, wkn, 256, (size_t)((const char*)wv - (const char*)ckvn), (size_t)((const char*)ckvn - (const char*)wkn)};
              pg8::Range2Order S{nq, 72, 2, 72, 36, Fp.G, Fp.bid}; pg8::EpiStore2 E{WSQ(bf16_t, WS_KN), 512, WSQ(bf16_t, WS_VT), TT};
              pg8::gemm_phase<pg8::EpiStore2, pg8::Range2Order>(Fp.lds, g, S, E); }
            gla_scan(Q, Fp); }
        SEAM(pb + 3);
        if (PHM(5) && IN(pb + 4)) for (int rep_ = 0; rep_ < REP(5); ++rep_) { KParams Q = load_params(); Frame Fp = phase_frame(F); bf16_t* U = (bf16_t*)(Q->ws + WS_U); (void)U;
            for (int u = vcu; u < 256; u += Fp.G) attn_unit(Q, Fp, u >> 6, (u >> 3) & 7, (u >> 6) * SEQ + (u & 7) * 256, 32);
            const bool lastl = (l == DEPTH - 1);
            if (!lastl) for (int u = vcu; u < 32; u += Fp.G) attn_unit(Q, Fp, u >> 3, u & 7, TLAT + (u >> 3) * CTXL, 0);
            for (int it = vcu; it < (lastl ? 128 : 144) * 4; it += Fp.G) gla_b_item(Q, Fp, l, it >> 2, it & 3); }
        SEAM(pb + 4);
        if (PHM(6) && IN(pb + 5)) for (int rep_ = 0; rep_ < REP(6); ++rep_) { KParams Q = load_params(); Frame Fp = phase_frame(F); bf16_t* U = (bf16_t*)(Q->ws + WS_U); (void)U; pg8::Gemm g{WSQ(bf16_t, WS_ACTS), WSQ(bf16_t, WS_WBR) + (size_t)l * 4 * DM * 512, 512, (size_t)TT * 512 * 2, (size_t)DM * 512 * 2}; pg8::MergeOrder S; S.init((l == DEPTH - 1) ? TLAT : TT, DM, Fp.G, Fp.bid);
            LAS float* gtab = (LAS float*)(Fp.lds + LDSX_OFF + 4096);
            if (Fp.tid < 256) { const float x = (float)(Fp.tid - 128) * (GATE_CLIP / 127.f), e = expf(-x); gtab[Fp.tid] = 1.f / (1.f + e); gtab[256 + Fp.tid] = 1.f + e; }
            __syncthreads();
            pg8::EpiMerge E{WSQ(bf16_t, WS_YM), (const unsigned char*)(Q->ws + WS_G8), gtab}; pg8::gemm_phase<pg8::EpiMerge, pg8::MergeOrder>(Fp.lds, g, S, E);
            if (l + 1 < DEPTH && rep_ == 0) { KParams Q2 = load_params(); Frame F2 = phase_frame(F); const int extra = (TT / 256) * (DM / 256) % F2.G; conv_mixed(Q2, F2, l + 1, 0, 600, 0, NL_F1, extra ? F2.bid - extra : F2.bid, extra ? F2.G - extra : F2.G); } }
        SEAM(pb + 5);
        if (PHM(7) && IN(pb + 6)) for (int rep_ = 0; rep_ < REP(7); ++rep_) { KParams Q = load_params(); Frame Fp = phase_frame(F); bf16_t* U = (bf16_t*)(Q->ws + WS_U); (void)U; pg8::Gemm g{WSQ(bf16_t, WS_YM), WSQ(bf16_t, WS_WMIX) + (size_t)l * DM * DM, DM, 0, 0}; pg8::StaticOrder S; S.init((l == DEPTH - 1) ? TLAT : TT, DM, Fp.G, Fp.bid);
            pg8::EpiResid E{WSQ(bf16_t, WS_X), WSQ(float, WS_MOD) + (size_t)l * 5 * (6 * DM) + 2 * DM, (rep_ + 1 < REP(7)) ? WSQ(bf16_t, WS_OUTS) : WSQ(bf16_t, WS_X)}; pg8::gemm_phase<pg8::EpiResid, pg8::StaticOrder>(Fp.lds, g, S, E);
            if (l + 1 < DEPTH && rep_ == 0) { KParams Q2 = load_params(); Frame F2 = phase_frame(F); const int extra = (TT / 256) * (DM / 256) % F2.G; conv_mixed(Q2, F2, l + 1, 600, 870, NL_F1, NL_F2, extra ? F2.bid - extra : F2.bid, extra ? F2.G - extra : F2.G); } }
        SEAM(pb + 6);
        if (PHM(8) && IN(pb + 7)) for (int rep_ = 0; rep_ < REP(8); ++rep_) { KParams Q = load_params(); Frame Fp = phase_frame(F); phase_norm2_route(Q, Fp, l, (rep_ + 1 < REP(8)) ? l + 4 : l); }
        SEAM(pb + 7);
        if (PHM(10) && IN(pb + 8)) for (int rep_ = 0; rep_ < REP(10); ++rep_) { KParams Q = load_params(); Frame Fp = phase_frame(F); bf16_t* U = (bf16_t*)(Q->ws + WS_U); (void)U; moe_table(Q, Fp, l);
            const LAS int* tpt = (const LAS int*)(Fp.lds + LDSX_OFF + 64);
            pg8::Gemm g{WSQ(bf16_t, WS_H), (const bf16_t*)(Q->ws + WS_W1 + (size_t)l * 16 * 1024 * DM), DM / 2, 0, (size_t)1024 * DM}; pg8::MoeOrder S{tpt, 4, Fp.G, Fp.bid};
            pg8::EpiSwiGLUQG E{WSQ(bf16_t, WS_ACTM), (const float*)(Q->ws + WS_ERW), (const float*)(Q->ws + WS_ERS), (const float*)(Q->ws + WS_RB1) + (size_t)l * 16 * 1024, tpt};
            pg8::gemm_phase_i8<pg8::EpiSwiGLUQG, pg8::MoeOrder, true>(Fp.lds, g, S, E, (const int*)(Q->ws + WS_ETOK), tpt);
            if (l + 1 < DEPTH && rep_ == 0) { KParams Q2 = load_params(); Frame F2 = phase_frame(F); const int nun = ((const LAS int*)(F2.lds + LDSX_OFF + 64))[16] * 4, extra = nun % F2.G;
                conv_mixed(Q2, F2, l + 1, 870, NS_ALL, NL_F2, NL_ITEMS, extra ? F2.bid - extra : F2.bid, extra ? F2.G - extra : F2.G); } }
        SEAM(pb + 8);
        if (PHM(11) && IN(pb + 9)) for (int rep_ = 0; rep_ < REP(11); ++rep_) { KParams Q = load_params(); Frame Fp = phase_frame(F); bf16_t* U = (bf16_t*)(Q->ws + WS_U); (void)U; moe_table(Q, Fp, l);
            pg8::Gemm g{WSQ(bf16_t, WS_ACTM), WSQ(bf16_t, WS_W2) + (size_t)l * 16 * DM * EFF, EFF, 0, (size_t)DM * EFF * 2}; pg8::MoeOrder S{(const LAS int*)(Fp.lds + LDSX_OFF + 64), 8, Fp.G, Fp.bid};
            pg8::EpiStore E{WSQ(bf16_t, WS_OUTS), DM}; pg8::gemm_phase<pg8::EpiStore, pg8::MoeOrder>(Fp.lds, g, S, E); }
        SEAM(pb + 9);
    }
    if (PHM(12) && IN(NPHASE - 1)) for (int rep_ = 0; rep_ < REP(12); ++rep_) { KParams Q = load_params(); Frame Fp = phase_frame(F); phase_final(Q, Fp); }
#undef IN
#undef SEAM
}

#ifndef MK_ONE_LAUNCH
#define MK_ONE_LAUNCH 1
#endif
extern "C" void kernel_launch(void* const* d_in, const int* in_sizes, int n_in, void* d_out, int out_size, void* d_ws, size_t ws_size, hipStream_t stream) {
    static int grid = 0;
    if (grid == 0) {
        if (n_in != 34 || out_size != TLAT * DM || ws_size < WS_END) { fprintf(stderr, "kernel_launch: unexpected problem: n_in %d out %d ws %zu (need %zu)\n", n_in, out_size, ws_size, (size_t)WS_END); grid = -1; return; }
        int dev = 0, cus = 0, per_cu = 0;
        if (hipGetDevice(&dev) != hipSuccess || hipDeviceGetAttribute(&cus, hipDeviceAttributeMultiprocessorCount, dev) != hipSuccess) { grid = -1; return; }
        if (hipFuncSetAttribute((const void*)hybrid_trunk_fwd, hipFuncAttributeMaxDynamicSharedMemorySize, LDS_BYTES) != hipSuccess) { fprintf(stderr, "kernel_launch: hipFuncSetAttribute failed\n"); grid = -1; return; }
        if (hipOccupancyMaxActiveBlocksPerMultiprocessor(&per_cu, (const void*)hybrid_trunk_fwd, 512, LDS_BYTES) != hipSuccess || per_cu < 1) { fprintf(stderr, "kernel_launch: occupancy query says %d\n", per_cu); }
        (void)hipGetLastError();
        grid = cus;
    }
    if (grid < 0) return;
    (void)hipMemsetAsync((char*)d_ws + WS_CTL, 0, CTL_ZERO_BYTES, stream);
    Params p{};
    for (int i = 0; i < 34; ++i) p.in[i] = (const float*)d_in[i];
    p.out = (float*)d_out; p.ws = (unsigned char*)d_ws;
#if MK_ONE_LAUNCH
    p.ph_lo = 0; p.ph_hi = NPHASE;
    hipLaunchKernelGGL(hybrid_trunk_fwd, dim3(grid), dim3(512), LDS_BYTES, stream, p);
#else
    for (int k = 0; k < NPHASE; ++k) { p.ph_lo = k; p.ph_hi = k + 1; hipLaunchKernelGGL(hybrid_trunk_fwd, dim3(grid), dim3(512), LDS_BYTES, stream, p); }
#endif
}
```

```cpp
#include <hip/hip_runtime.h>
#include <cstdio>
#include <cstdint>

#define DI __device__ __forceinline__
#define LAS __attribute__((address_space(3)))
typedef unsigned short bf16_t;
typedef short bf16x8 __attribute__((ext_vector_type(8)));
typedef short s16x4 __attribute__((ext_vector_type(4)));
typedef float f32x4 __attribute__((ext_vector_type(4)));
typedef float f32x16 __attribute__((ext_vector_type(16)));
typedef unsigned u32x4 __attribute__((ext_vector_type(4)));
typedef unsigned u32x2 __attribute__((ext_vector_type(2)));
typedef float f32x2_t __attribute__((ext_vector_type(2)));
typedef __bf16 bf16x2_t __attribute__((ext_vector_type(2)));
typedef int v4i_t __attribute__((ext_vector_type(4)));

constexpr int DM = 2048, NB = 4, SEQ = 2048, DEPTH = 4, CTXL = 256;
constexpr int TLAT = NB * SEQ, TCTX = NB * CTXL, TT = TLAT + TCTX;
constexpr int PW = 13120, PWP = 13312;
constexpr int O_CQ = 0, O_CKV = 512, O_KR = 768, O_CF = 800, O_GQ = 1824, O_GK = 2080, O_GV = 2336, O_GF = 2848, O_GB = 2864, O_GR = 2880, O_SC = 3392, O_MG = 4928;
constexpr int GCOL0 = 5120; constexpr float GATE_CLIP = 8.f;
DI int wcol_dest(int n0) { return n0 < O_MG ? n0 : n0 + (GCOL0 - O_MG); }
constexpr int NEXP = 16, EFF = 512, MOE_ROWS = 22528;
constexpr float EPS = 1e-6f;
constexpr int NCHAIN = 36;

DI float bflo(unsigned w) { return __uint_as_float(w << 16); }
DI float bfhi(unsigned w) { return __uint_as_float(w & 0xffff0000u); }
DI float bf2f(bf16_t v) { return __uint_as_float(((unsigned)v) << 16); }
DI unsigned pk2(float lo, float hi) { f32x2_t v = {lo, hi}; bf16x2_t b = __builtin_convertvector(v, bf16x2_t); return __builtin_bit_cast(unsigned, b); }
DI bf16_t f2bf(float f) { return (bf16_t)(pk2(f, 0.f) & 0xffffu); }
DI unsigned q8(float v) { int q = __float2int_rn(v); q = q > 127 ? 127 : q; q = q < -127 ? -127 : q; return (unsigned)q & 255u; }
DI float dpp_f(float v, int ctrl_sel) {
    const int x = __float_as_int(v); int r;
    switch (ctrl_sel) { case 0: r = __builtin_amdgcn_mov_dpp(x, 0xB1, 0xF, 0xF, true); break;
                        case 1: r = __builtin_amdgcn_mov_dpp(x, 0x4E, 0xF, 0xF, true); break;
                        case 2: r = __builtin_amdgcn_mov_dpp(x, 0x141, 0xF, 0xF, true); break;
                        default: r = __builtin_amdgcn_mov_dpp(x, 0x140, 0xF, 0xF, true); break; }
    return __int_as_float(r);
}
DI float wave_sum(float v) {
    v += dpp_f(v, 0); v += dpp_f(v, 1); v += dpp_f(v, 2); v += dpp_f(v, 3);
    { const auto r = __builtin_amdgcn_permlane16_swap(__float_as_uint(v), __float_as_uint(v), false, false); v = __uint_as_float(r[0]) + __uint_as_float(r[1]); }
    { const auto r = __builtin_amdgcn_permlane32_swap(__float_as_uint(v), __float_as_uint(v), false, false); v = __uint_as_float(r[0]) + __uint_as_float(r[1]); }
    return v;
}
DI float sigm(float x) { return __builtin_amdgcn_rcpf(1.f + __expf(-x)); }
DI float siluf(float x) { return x * __builtin_amdgcn_rcpf(1.f + __expf(-x)); }
#define LDS_WAIT() asm volatile("s_waitcnt lgkmcnt(0)" ::: "memory")
#define VM_WAIT() asm volatile("s_waitcnt vmcnt(0)" ::: "memory")

namespace pg8 {
constexpr int BM = 256, BK = 64, HALF = 128, HTB = HALF * BK * 2, STAGE_BYTES = 8 * HTB, NXCD = 8, WGM = 8;
DI int lds_byte(int r, int c) { const int st = (r >> 4) * 2 + (c >> 5), rr = r & 15, cc = c & 31, ob = rr * 64 + cc * 2; return st * 1024 + (ob ^ (((ob >> 9) & 1) << 5)); }
DI void stage_rc(int b, int& R, int& C) { const int st = b / 1024, sb = b % 1024, swz = sb ^ (((sb >> 9) & 1) << 5); R = (st >> 1) * 16 + swz / 64; C = (st & 1) * 32 + (swz % 64) / 2; }
DI int perm32(int rho) { const int n = rho >> 4, i = rho & 15; return 8 * (i >> 2) + 4 * n + (i & 3); }

struct Unit { int pm, pn, grp; };
struct Gemm { const bf16_t* A; const bf16_t* Bt; int K; size_t gsA, gsB; };

DI void tile_of(int wgid0, int nM, int nN, int& pm, int& pn) {
    const int nwg = nM * nN; int wgid = wgid0;
    { const int q = nwg / NXCD, r = nwg % NXCD, xcd = wgid % NXCD, off = wgid / NXCD; wgid = (xcd < r ? xcd * (q + 1) : r * (q + 1) + (xcd - r) * q) + off; }
    const int nig = WGM * nN, gid = wgid / nig, fm = gid * WGM, gsz = (nM - fm) < WGM ? (nM - fm) : WGM;
    pm = fm + ((wgid % nig) % gsz); pn = (wgid % nig) / gsz;
}
struct StaticOrder {
    int nM, nN, nwg, G, c;
    DI void init(int M, int N, int G_, int c_) { nM = M / BM; nN = N / BM; nwg = nM * nN; G = G_; c = c_; }
    DI bool next(int i, Unit& u) const { const int L = i * G + c; if (L >= nwg) return false; tile_of(L, nM, nN, u.pm, u.pn); u.grp = 0; return true; }
};
struct TrimOrder {
    int nM1, nN, n1, nctx, G, c;
    DI bool next(int i, Unit& u) const { const int L = i * G + c; u.grp = 0;
        if (L < n1) { tile_of(L, nM1, nN, u.pm, u.pn); return true; }
        const int q = L - n1; if (q >= nctx) return false; const int j = q % 6; u.pm = nM1 + q / 6; u.pn = j < 2 ? 2 + j : 6 + j; return true; }
};
struct RangeOrder {
    int first, count, nN, G, c;
    DI bool next(int i, Unit& u) const { const int L = i * G + c - first; if (L < 0 || L >= count) return false; u.pm = L / nN; u.pn = L % nN; u.grp = 0; return true; }
};
struct Range2Order {
    int first, count0, nN0, count1, nN1, G, c;
    DI bool next(int i, Unit& u) const { int L = i * G + c - first; if (L < 0) return false;
        if (L < count0) { u.pm = L / nN0; u.pn = L % nN0; u.grp = 0; return true; }
        L -= count0; if (L >= count1) return false; u.pm = L / nN1; u.pn = L % nN1; u.grp = 1; return true; }
};
struct MergeOrder {
    int nM, nN, nwg, G, c;
    DI void init(int M, int N, int G_, int c_) { nM = M / BM; nN = N / BM; nwg = nM * nN; G = G_; c = c_; }
    DI bool next(int i, Unit& u) const { const int L = (i >> 2) * G + c; if (L >= nwg) return false; tile_of(L, nM, nN, u.pm, u.pn); u.grp = i & 3; return true; }
};
struct MoeOrder {
    const LAS int* tp; int ncol, G, c;
    DI bool next(int i, Unit& u) const {
        const int L = i * G + c, ntile = tp[16]; if (L >= ntile * ncol) return false;
        const int rt = L / ncol; int e = 0;
#pragma unroll
        for (int j = 1; j < 16; ++j) e += (rt >= tp[j]) ? 1 : 0;
        u.pm = rt; u.pn = L % ncol; u.grp = e; return true;
    }
};

struct EpiStore {
    static constexpr bool PERM = true;
    bf16_t* O; int ldc;
    DI bool operator()(f32x4 (&acc)[2][2][4][2], const Unit& u, int wr, int wc, int fr, int fq) const {
        const int row0 = u.pm * BM + wr * 64 + fr, col0 = u.pn * BM + wc * 32 + 8 * fq;
#pragma unroll
        for (int ai = 0; ai < 2; ++ai)
#pragma unroll
            for (int m = 0; m < 4; ++m) { bf16_t* rowp = O + (size_t)(row0 + ai * HALF + m * 16) * ldc + col0;
#pragma unroll
                for (int bj = 0; bj < 2; ++bj) { const f32x4 v0 = acc[ai][bj][m][0], v1 = acc[ai][bj][m][1];
                    u32x4 w; w.x = pk2(v0[0], v0[1]); w.y = pk2(v0[2], v0[3]); w.z = pk2(v1[0], v1[1]); w.w = pk2(v1[2], v1[3]);
                    *(u32x4*)(rowp + bj * HALF) = w; } }
        return false;
    }
};
struct EpiStoreQ {
    static constexpr bool PERM = true;
    bf16_t* O; int ldc; const float* rA; const float* rB; unsigned char* G8;
    DI bool operator()(v4i_t (&acc)[2][2][4][2], const Unit& u, int wr, int wc, int fr, int fq) const {
        const int row0 = u.pm * BM + wr * 64 + fr, col0 = u.pn * BM + wc * 32 + 8 * fq;
        f32x4 cb[2][2];
#pragma unroll
        for (int bj = 0; bj < 2; ++bj) { cb[bj][0] = *(const f32x4*)(rB + col0 + bj * HALF); cb[bj][1] = *(const f32x4*)(rB + col0 + bj * HALF + 4); }
        float rav[2][4];
#pragma unroll
        for (int ai = 0; ai < 2; ++ai)
#pragma unroll
            for (int m = 0; m < 4; ++m) rav[ai][m] = rA[row0 + ai * HALF + m * 16];
        __builtin_amdgcn_sched_barrier(0);
        if (col0 >= GCOL0) {
            const float qs = 127.f / GATE_CLIP;
#pragma unroll
            for (int ai = 0; ai < 2; ++ai)
#pragma unroll
                for (int m = 0; m < 4; ++m) { const float ra = rav[ai][m] * qs;
                    unsigned char* rowp = G8 + (size_t)(u.pm * 32 + (u.pn - GCOL0 / BM)) * 65536 + (((wr * 4 + wc) * 8 + ai * 4 + m) * 64 + fr + 16 * fq) * 16;
                    unsigned ww[4] = {0u, 0u, 0u, 0u};
#pragma unroll
                    for (int bj = 0; bj < 2; ++bj) { const v4i_t a0 = acc[ai][bj][m][0], a1 = acc[ai][bj][m][1]; const f32x4 c0 = cb[bj][0] * ra, c1 = cb[bj][1] * ra;
#pragma unroll
                        for (int j = 0; j < 4; ++j) { ww[2 * bj] = __builtin_amdgcn_cvt_pk_u8_f32((float)a0[j] * c0[j] + 128.0f, j, ww[2 * bj]); ww[2 * bj + 1] = __builtin_amdgcn_cvt_pk_u8_f32((float)a1[j] * c1[j] + 128.0f, j, ww[2 * bj + 1]); } }
                    *(u32x4*)rowp = (u32x4){ww[0], ww[1], ww[2], ww[3]}; }
            return false;
        }
#pragma unroll
        for (int ai = 0; ai < 2; ++ai)
#pragma unroll
            for (int m = 0; m < 4; ++m) { const int row = row0 + ai * HALF + m * 16; const float ra = rav[ai][m]; bf16_t* rowp = O + (size_t)row * ldc + col0;
#pragma unroll
                for (int bj = 0; bj < 2; ++bj) { const v4i_t a0 = acc[ai][bj][m][0], a1 = acc[ai][bj][m][1]; const f32x4 c0 = cb[bj][0] * ra, c1 = cb[bj][1] * ra;
                    u32x4 w; w.x = pk2((float)a0[0] * c0[0], (float)a0[1] * c0[1]); w.y = pk2((float)a0[2] * c0[2], (float)a0[3] * c0[3]);
                    w.z = pk2((float)a1[0] * c1[0], (float)a1[1] * c1[1]); w.w = pk2((float)a1[2] * c1[2], (float)a1[3] * c1[3]);
                    *(u32x4*)(rowp + bj * HALF) = w; } }
        return false;
    }
};
struct EpiStore2 {
    static constexpr bool PERM = true;
    bf16_t* O0; int ldc0; bf16_t* O1; int ldc1;
    DI bool operator()(f32x4 (&acc)[2][2][4][2], const Unit& u, int wr, int wc, int fr, int fq) const {
        const EpiStore E{u.grp ? O1 : O0, u.grp ? ldc1 : ldc0}; return E(acc, u, wr, wc, fr, fq);
    }
};
struct EpiMerge {
    static constexpr bool PERM = true;
    bf16_t* Y; const unsigned char* G8;
    const LAS float* tab;
    DI static int qi(unsigned w, int i) { return (int)((w >> (8 * i)) & 255u); }
    DI bool operator()(f32x4 (&acc)[2][2][4][2], const Unit& u, int wr, int wc, int fr, int fq) const {
        const int row0 = u.pm * BM + wr * 64 + fr, col0 = u.pn * BM + wc * 32 + 8 * fq; const int grp = u.grp;
        const unsigned char* gp = G8 + (size_t)(u.pm * 32 + grp * 8 + u.pn) * 65536 + ((wr * 4 + wc) * 8 * 64 + fr + 16 * fq) * 16;
        if (grp < 3) {
            u32x4 ca[8], cb[8];
#pragma unroll
            for (int q = 0; q < 8; ++q) { ca[q] = *(const u32x4*)(gp + q * 1024); cb[q] = *(const u32x4*)(gp + 8 * 65536 + q * 1024); }
            __builtin_amdgcn_sched_barrier(0);
#pragma unroll
            for (int ai = 0; ai < 2; ++ai)
#pragma unroll
                for (int m = 0; m < 4; ++m) { const u32x4 a = ca[ai * 4 + m], b = cb[ai * 4 + m];
#pragma unroll
                    for (int bj = 0; bj < 2; ++bj) { const unsigned ax = bj ? a.z : a.x, ay = bj ? a.w : a.y, bx = bj ? b.z : b.x, by = bj ? b.w : b.y;
                        f32x4& a0 = acc[ai][bj][m][0]; f32x4& a1 = acc[ai][bj][m][1];
#pragma unroll
                        for (int j = 0; j < 4; ++j) { a0[j] *= tab[qi(ax, j)] * tab[256 + qi(bx, j)]; a1[j] *= tab[qi(ay, j)] * tab[256 + qi(by, j)]; } } }
            return true;
        }
        u32x4 cg[8];
#pragma unroll
        for (int q = 0; q < 8; ++q) cg[q] = *(const u32x4*)(gp + q * 1024);
        __builtin_amdgcn_sched_barrier(0);
#pragma unroll
        for (int ai = 0; ai < 2; ++ai)
#pragma unroll
            for (int m = 0; m < 4; ++m) { const int row = row0 + ai * HALF + m * 16; const u32x4 g4 = cg[ai * 4 + m];
                bf16_t* yp = Y + (size_t)row * DM + col0;
#pragma unroll
                for (int bj = 0; bj < 2; ++bj) { const unsigned gx = bj ? g4.z : g4.x, gy = bj ? g4.w : g4.y; const f32x4 a0 = acc[ai][bj][m][0], a1 = acc[ai][bj][m][1];
                    u32x4 w; w.x = pk2(a0[0] * tab[qi(gx, 0)], a0[1] * tab[qi(gx, 1)]); w.y = pk2(a0[2] * tab[qi(gx, 2)], a0[3] * tab[qi(gx, 3)]);
                    w.z = pk2(a1[0] * tab[qi(gy, 0)], a1[1] * tab[qi(gy, 1)]); w.w = pk2(a1[2] * tab[qi(gy, 2)], a1[3] * tab[qi(gy, 3)]);
                    *(u32x4*)(yp + bj * HALF) = w; } }
        return false;
    }
};
struct EpiResid {
    static constexpr bool PERM = true;
    bf16_t* X; const float* gate; bf16_t* XO;
    DI bool operator()(f32x4 (&acc)[2][2][4][2], const Unit& u, int wr, int wc, int fr, int fq) const {
        const int row0 = u.pm * BM + wr * 64 + fr, col0 = u.pn * BM + wc * 32 + 8 * fq;
        const int r = (u.pm < TLAT / BM) ? (u.pm >> 3) : 4; const float* gp = gate + (size_t)r * (6 * DM) + col0;
        f32x4 gv[2][2];
#pragma unroll
        for (int bj = 0; bj < 2; ++bj)
#pragma unroll
            for (int n = 0; n < 2; ++n) gv[bj][n] = *(const f32x4*)(gp + bj * HALF + n * 4);
        u32x4 xv[2][4][2];
        const unsigned ob = (unsigned)(row0 * DM + col0) * 2u;
#pragma unroll
        for (int ai = 0; ai < 2; ++ai)
#pragma unroll
            for (int m = 0; m < 4; ++m)
#pragma unroll
                for (int bj = 0; bj < 2; ++bj) xv[ai][m][bj] = *(const u32x4*)((const char*)X + (ob + (unsigned)((ai * HALF + m * 16) * DM + bj * HALF) * 2u));
        __builtin_amdgcn_sched_barrier(0);
#pragma unroll
        for (int ai = 0; ai < 2; ++ai)
#pragma unroll
            for (int m = 0; m < 4; ++m) {
#pragma unroll
                for (int bj = 0; bj < 2; ++bj) { const u32x4 x = xv[ai][m][bj]; const f32x4 a0 = gv[bj][0] * acc[ai][bj][m][0], a1 = gv[bj][1] * acc[ai][bj][m][1];
                    u32x4 o; o.x = pk2(bflo(x.x) + a0[0], bfhi(x.x) + a0[1]); o.y = pk2(bflo(x.y) + a0[2], bfhi(x.y) + a0[3]); o.z = pk2(bflo(x.z) + a1[0], bfhi(x.z) + a1[1]); o.w = pk2(bflo(x.w) + a1[2], bfhi(x.w) + a1[3]);
                    *(u32x4*)((char*)XO + (ob + (unsigned)((ai * HALF + m * 16) * DM + bj * HALF) * 2u)) = o; }
                __builtin_amdgcn_sched_barrier(0); }
        return false;
    }
};
struct EpiSwiGLUQ {
    static constexpr bool PERM = true;
    bf16_t* O; const float* roww; const float* rs; const float* rb1;
    DI bool operator()(v4i_t (&acc)[2][2][4][2], const Unit& u, int wr, int wc, int fr, int fq) const {
        const int row0 = u.pm * BM + wr * 64 + fr, col0 = u.pn * HALF + wc * 32 + 8 * fq; const float* rb = rb1 + (size_t)u.grp * 1024 + u.pn * BM + wc * 32 + 8 * fq;
        const f32x4 bg0 = *(const f32x4*)rb, bg1 = *(const f32x4*)(rb + 4), bu0 = *(const f32x4*)(rb + HALF), bu1 = *(const f32x4*)(rb + HALF + 4);
#pragma unroll
        for (int ai = 0; ai < 2; ++ai)
#pragma unroll
            for (int m = 0; m < 4; ++m) { const int row = row0 + ai * HALF + m * 16; const float w = roww[row], sa = rs[row];
                const v4i_t g0 = acc[ai][0][m][0], g1 = acc[ai][0][m][1], u0 = acc[ai][1][m][0], u1 = acc[ai][1][m][1];
                float v[8];
#pragma unroll
                for (int j = 0; j < 4; ++j) { v[j] = siluf((float)g0[j] * sa * bg0[j]) * ((float)u0[j] * sa * bu0[j]) * w; v[4 + j] = siluf((float)g1[j] * sa * bg1[j]) * ((float)u1[j] * sa * bu1[j]) * w; }
                u32x4 o; o.x = pk2(v[0], v[1]); o.y = pk2(v[2], v[3]); o.z = pk2(v[4], v[5]); o.w = pk2(v[6], v[7]);
                *(u32x4*)(O + (size_t)row * EFF + col0) = o; }
        return false;
    }
};
struct EpiSwiGLUQG {
    static constexpr bool PERM = true;
    bf16_t* O; const float* erw; const float* ers; const float* rb1; const LAS int* tpt;
    DI bool operator()(v4i_t (&acc)[2][2][4][2], const Unit& u, int wr, int wc, int fr, int fq) const {
        const int row0 = u.pm * BM + wr * 64 + fr, col0 = u.pn * HALF + wc * 32 + 8 * fq; const float* rb = rb1 + (size_t)u.grp * 1024 + u.pn * BM + wc * 32 + 8 * fq;
        const int s0 = (u.pm - tpt[u.grp]) * 256 + wr * 64 + fr, cn = tpt[32 + u.grp]; const float* pw = erw + u.grp * TT; const float* ps = ers + u.grp * TT;
        const f32x4 bg0 = *(const f32x4*)rb, bg1 = *(const f32x4*)(rb + 4), bu0 = *(const f32x4*)(rb + HALF), bu1 = *(const f32x4*)(rb + HALF + 4);
        float wv_[2][4], sv_[2][4];
#pragma unroll
        for (int ai = 0; ai < 2; ++ai)
#pragma unroll
            for (int m = 0; m < 4; ++m) { const int sl = s0 + ai * HALF + m * 16; const bool ok = sl < cn; wv_[ai][m] = ok ? pw[ok ? sl : 0] : 0.f; sv_[ai][m] = ok ? ps[ok ? sl : 0] : 0.f; }
        __builtin_amdgcn_sched_barrier(0);
#pragma unroll
        for (int ai = 0; ai < 2; ++ai)
#pragma unroll
            for (int m = 0; m < 4; ++m) { const int row = row0 + ai * HALF + m * 16; const float w = wv_[ai][m], sa = sv_[ai][m];
                const v4i_t g0 = acc[ai][0][m][0], g1 = acc[ai][0][m][1], u0 = acc[ai][1][m][0], u1 = acc[ai][1][m][1];
                float v[8];
#pragma unroll
                for (int j = 0; j < 4; ++j) { v[j] = siluf((float)g0[j] * sa * bg0[j]) * ((float)u0[j] * sa * bu0[j]) * w; v[4 + j] = siluf((float)g1[j] * sa * bg1[j]) * ((float)u1[j] * sa * bu1[j]) * w; }
                u32x4 o; o.x = pk2(v[0], v[1]); o.y = pk2(v[2], v[3]); o.z = pk2(v[4], v[5]); o.w = pk2(v[6], v[7]);
                *(u32x4*)(O + (size_t)row * EFF + col0) = o; }
        return false;
    }
};
struct EpiSwiGLU {
    static constexpr bool PERM = true;
    bf16_t* O; const float* roww;
    DI bool operator()(f32x4 (&acc)[2][2][4][2], const Unit& u, int wr, int wc, int fr, int fq) const {
        const int row0 = u.pm * BM + wr * 64 + fr, col0 = u.pn * HALF + wc * 32 + 8 * fq;
#pragma unroll
        for (int ai = 0; ai < 2; ++ai)
#pragma unroll
            for (int m = 0; m < 4; ++m) { const int row = row0 + ai * HALF + m * 16; const float w = roww[row];
                const f32x4 g0 = acc[ai][0][m][0], g1 = acc[ai][0][m][1], u0 = acc[ai][1][m][0], u1 = acc[ai][1][m][1];
                float v[8];
#pragma unroll
                for (int j = 0; j < 4; ++j) { v[j] = siluf(g0[j]) * u0[j] * w; v[4 + j] = siluf(g1[j]) * u1[j] * w; }
                u32x4 o; o.x = pk2(v[0], v[1]); o.y = pk2(v[2], v[3]); o.z = pk2(v[4], v[5]); o.w = pk2(v[6], v[7]);
                *(u32x4*)(O + (size_t)row * EFF + col0) = o; }
        return false;
    }
};

template <class Epi, class Sched>
DI void gemm_phase(LAS unsigned char* lds, const Gemm g, const Sched& S, const Epi& E) {
    int tid = threadIdx.x; asm volatile("" : "+v"(tid));
    const int wid = __builtin_amdgcn_readfirstlane(tid >> 6), lane = tid & 63, wr = wid >> 2, wc = wid & 3, fr = lane & 15, fq = lane >> 4;
    int K = g.K; asm volatile("" : "+s"(K));
    const int nt = K / BK;
    unsigned voffA[2], voffB[2], gC[2]; int gR[2];
#pragma unroll
    for (int i = 0; i < 2; ++i) { int R, C; stage_rc(tid * 16 + i * 8192, R, C); const int Rb = Epi::PERM ? ((R & ~31) + perm32(R & 31)) : R;
        voffA[i] = (unsigned)(R * K + C) * 2u; voffB[i] = (unsigned)(Rb * K + C) * 2u; gR[i] = R; gC[i] = (unsigned)C * 2u; }
    const size_t kstep = (size_t)(BK * 2);
    const size_t hstep = (size_t)HALF * K * 2;
    const size_t tstep = 2 * hstep;
    const unsigned ldsw = (unsigned)wid * 1024u;
    const int aoff = lds_byte(wr * 64 + fr, fq * 8), boff = lds_byte(wc * 32 + fr, fq * 8);
#define PG8_SA(b, h) (((b) * 2 + (h)) * HTB)
#define PG8_SB(b, h) ((4 + (b) * 2 + (h)) * HTB)
#define PG8_STAGE(bufoff, gbase, voff) do { _Pragma("unroll") for (int _i = 0; _i < 2; ++_i) \
        __builtin_amdgcn_global_load_lds((const unsigned*)((const char*)(gbase) + (voff)[_i]), (LAS unsigned*)(lds + (bufoff) + ldsw + _i * 8192), 16, 0, 0); } while (0)
#define PG8_STAGE2(bufoff, gbase, o0, o1) do { \
        __builtin_amdgcn_global_load_lds((const unsigned*)((const char*)(gbase) + (o0)), (LAS unsigned*)(lds + (bufoff) + ldsw), 16, 0, 0); \
        __builtin_amdgcn_global_load_lds((const unsigned*)((const char*)(gbase) + (o1)), (LAS unsigned*)(lds + (bufoff) + ldsw + 8192), 16, 0, 0); } while (0)
#define PG8_GATH(u, v) do { const int e_ = (u).grp, b_ = ((u).pm - tpt[e_]) * 256, c_ = tpt[32 + e_]; const int* et_ = etok + e_ * TT; \
        _Pragma("unroll") for (int h_ = 0; h_ < 2; ++h_) _Pragma("unroll") for (int i_ = 0; i_ < 2; ++i_) { const int s_ = b_ + h_ * 128 + gR[i_]; const int t_ = (s_ < c_) ? et_[s_] : 0; \
            v[h_][i_] = (unsigned)t_ * (unsigned)(K * 2) + gC[i_]; } } while (0)
#define PG8_LDA(dst, b, h) do { _Pragma("unroll") for (int m = 0; m < 4; ++m) _Pragma("unroll") for (int k = 0; k < 2; ++k) dst[m][k] = *(const LAS bf16x8*)(lds + PG8_SA(b, h) + aoff + m * 2048 + k * 1024); } while (0)
#define PG8_LDB(dst, b, h) do { _Pragma("unroll") for (int n = 0; n < 2; ++n) _Pragma("unroll") for (int k = 0; k < 2; ++k) dst[n][k] = *(const LAS bf16x8*)(lds + PG8_SB(b, h) + boff + n * 2048 + k * 1024); } while (0)
#define PG8_MMA(ai, bj, At, Bt) do { __builtin_amdgcn_s_setprio(1); _Pragma("unroll") for (int m = 0; m < 4; ++m) _Pragma("unroll") for (int n = 0; n < 2; ++n) _Pragma("unroll") for (int k = 0; k < 2; ++k) \
        acc[ai][bj][m][n] = __builtin_amdgcn_mfma_f32_16x16x32_bf16(Bt[n][k], At[m][k], acc[ai][bj][m][n], 0, 0, 0); __builtin_amdgcn_s_setprio(0); } while (0)
#define PG8_WAIT_V(n) asm volatile("s_waitcnt vmcnt(" #n ")" ::: "memory")
#define PG8_WAIT_L(n) asm volatile("s_waitcnt lgkmcnt(" #n ")" ::: "memory")
#define PG8_BAR __builtin_amdgcn_s_barrier()
#define PG8_SCHED __builtin_amdgcn_sched_barrier(0)
    Unit cur, nxt; int ui = 0;
    if (!S.next(0, cur)) return;
    cur.pm = __builtin_amdgcn_readfirstlane(cur.pm); cur.pn = __builtin_amdgcn_readfirstlane(cur.pn); cur.grp = __builtin_amdgcn_readfirstlane(cur.grp);
    f32x4 acc[2][2][4][2];
#pragma unroll
    for (int a = 0; a < 2; ++a)
#pragma unroll
        for (int b = 0; b < 2; ++b)
#pragma unroll
            for (int m = 0; m < 4; ++m)
#pragma unroll
                for (int n = 0; n < 2; ++n) acc[a][b][m][n] = (f32x4){0.f, 0.f, 0.f, 0.f};
    bf16x8 At[4][2], B0[2][2], B1[2][2];
    const char* cA = (const char*)g.A + (size_t)cur.grp * g.gsA + (size_t)cur.pm * tstep; const char* cB = (const char*)g.Bt + (size_t)cur.grp * g.gsB + (size_t)cur.pn * tstep;
    PG8_STAGE(PG8_SB(0, 0), cB, voffB); PG8_STAGE(PG8_SB(0, 1), cB + hstep, voffB); PG8_STAGE(PG8_SA(0, 0), cA, voffA); PG8_STAGE(PG8_SA(0, 1), cA + hstep, voffA);
    if (wr == 1) PG8_BAR;
    PG8_WAIT_V(2); PG8_BAR;
    PG8_STAGE(PG8_SB(1, 0), cB + kstep, voffB); PG8_STAGE(PG8_SA(1, 0), cA + kstep, voffA); PG8_STAGE(PG8_SB(1, 1), cB + hstep + kstep, voffB);
    PG8_WAIT_V(6); PG8_BAR;
    for (;;) {
        const bool has_next = S.next(ui + 1, nxt);
        nxt.pm = __builtin_amdgcn_readfirstlane(nxt.pm); nxt.pn = __builtin_amdgcn_readfirstlane(nxt.pn); nxt.grp = __builtin_amdgcn_readfirstlane(nxt.grp);
        const char* nA = has_next ? (const char*)g.A + (size_t)nxt.grp * g.gsA + (size_t)nxt.pm * tstep : cA; const char* nB = has_next ? (const char*)g.Bt + (size_t)nxt.grp * g.gsB + (size_t)nxt.pn * tstep : cB;
        for (int t = 0; t < nt; t += 2) {
            const bool last = (t == nt - 2);
            const char* a1 = cA + (size_t)(t + 1) * kstep;
            const char* a2 = last ? nA : cA + (size_t)(t + 2) * kstep; const char* b2 = last ? nB : cB + (size_t)(t + 2) * kstep;
            const char* a3 = a2 + kstep; const char* b3 = b2 + kstep;
            PG8_LDB(B0, 0, 0); PG8_LDB(B1, 0, 1); PG8_SCHED; PG8_LDA(At, 0, 0); PG8_STAGE(PG8_SA(1, 1), a1 + hstep, voffA);
            PG8_WAIT_V(8); PG8_WAIT_L(0); PG8_BAR; PG8_MMA(0, 0, At, B0); PG8_MMA(0, 1, At, B1); PG8_BAR; PG8_SCHED;
            PG8_LDA(At, 0, 1); PG8_STAGE(PG8_SB(0, 0), b2, voffB); PG8_STAGE(PG8_SB(0, 1), b2 + hstep, voffB); PG8_STAGE(PG8_SA(0, 0), a2, voffA);
            PG8_WAIT_V(8); PG8_WAIT_L(0); PG8_BAR; PG8_MMA(1, 0, At, B0); PG8_MMA(1, 1, At, B1); PG8_BAR; PG8_SCHED;
            PG8_LDB(B0, 1, 0); PG8_LDB(B1, 1, 1); PG8_SCHED; PG8_LDA(At, 1, 0); PG8_STAGE(PG8_SA(0, 1), a2 + hstep, voffA);
            PG8_WAIT_V(8); PG8_WAIT_L(0); PG8_BAR; PG8_MMA(0, 0, At, B0); PG8_MMA(0, 1, At, B1); PG8_BAR; PG8_SCHED;
            PG8_LDA(At, 1, 1); PG8_STAGE(PG8_SB(1, 0), b3, voffB); PG8_STAGE(PG8_SB(1, 1), b3 + hstep, voffB); PG8_STAGE(PG8_SA(1, 0), a3, voffA);
            PG8_WAIT_V(8); PG8_WAIT_L(0); PG8_BAR; PG8_MMA(1, 0, At, B0); PG8_MMA(1, 1, At, B1); PG8_BAR; PG8_SCHED;
        }
        bool keep = false;
        if (wr == 0) PG8_BAR;
        { Unit eu; eu.pm = __builtin_amdgcn_readfirstlane(cur.pm); eu.pn = __builtin_amdgcn_readfirstlane(cur.pn); eu.grp = __builtin_amdgcn_readfirstlane(cur.grp); asm volatile("" : "+s"(eu.pm), "+s"(eu.pn), "+s"(eu.grp)); keep = E(acc, eu, wr, wc, fr, fq); }
        if (!has_next) break;
        if (!keep) {
#pragma unroll
        for (int a = 0; a < 2; ++a)
#pragma unroll
            for (int b = 0; b < 2; ++b)
#pragma unroll
                for (int m = 0; m < 4; ++m)
#pragma unroll
                    for (int n = 0; n < 2; ++n) acc[a][b][m][n] = (f32x4){0.f, 0.f, 0.f, 0.f};
        }
        cur = nxt; cA = nA; cB = nB; ++ui;
        if (wr == 1) PG8_BAR;
    }
    PG8_WAIT_V(0);
    PG8_BAR;
#undef PG8_SA
#undef PG8_SB
#undef PG8_STAGE
#undef PG8_LDA
#undef PG8_LDB
#undef PG8_MMA
#undef PG8_WAIT_V
#undef PG8_WAIT_L
#undef PG8_BAR
#undef PG8_SCHED
}
template <class Epi, class Sched, bool GATHER = false>
DI void gemm_phase_i8(LAS unsigned char* lds, const Gemm g, const Sched& S, const Epi& E, const int* etok = nullptr, const LAS int* tpt = nullptr) {
    int tid = threadIdx.x; asm volatile("" : "+v"(tid));
    const int wid = __builtin_amdgcn_readfirstlane(tid >> 6), lane = tid & 63, wr = wid >> 2, wc = wid & 3, fr = lane & 15, fq = lane >> 4;
    int K = g.K; asm volatile("" : "+s"(K));
    const int nt = K / BK;
    unsigned voffA[2], voffB[2], gC[2]; int gR[2];
#pragma unroll
    for (int i = 0; i < 2; ++i) { int R, C; stage_rc(tid * 16 + i * 8192, R, C); const int Rb = Epi::PERM ? ((R & ~31) + perm32(R & 31)) : R;
        voffA[i] = (unsigned)(R * K + C) * 2u; voffB[i] = (unsigned)(Rb * K + C) * 2u; gR[i] = R; gC[i] = (unsigned)C * 2u; }
    const size_t kstep = (size_t)(BK * 2);
    const size_t hstep = (size_t)HALF * K * 2;
    const size_t tstep = 2 * hstep;
    const unsigned ldsw = (unsigned)wid * 1024u;
    const int aoff = lds_byte(wr * 64 + fr, fq * 8), boff = lds_byte(wc * 32 + fr, fq * 8);
#define PG8_SA(b, h) (((b) * 2 + (h)) * HTB)
#define PG8_SB(b, h) ((4 + (b) * 2 + (h)) * HTB)
#define PG8_STAGE(bufoff, gbase, voff) do { _Pragma("unroll") for (int _i = 0; _i < 2; ++_i) \
        __builtin_amdgcn_global_load_lds((const unsigned*)((const char*)(gbase) + (voff)[_i]), (LAS unsigned*)(lds + (bufoff) + ldsw + _i * 8192), 16, 0, 0); } while (0)
#define PG8_STAGE2(bufoff, gbase, o0, o1) do { \
        __builtin_amdgcn_global_load_lds((const unsigned*)((const char*)(gbase) + (o0)), (LAS unsigned*)(lds + (bufoff) + ldsw), 16, 0, 0); \
        __builtin_amdgcn_global_load_lds((const unsigned*)((const char*)(gbase) + (o1)), (LAS unsigned*)(lds + (bufoff) + ldsw + 8192), 16, 0, 0); } while (0)
#define PG8_GATH(u, v) do { const int e_ = (u).grp, b_ = ((u).pm - tpt[e_]) * 256, c_ = tpt[32 + e_]; const int* et_ = etok + e_ * TT; \
        _Pragma("unroll") for (int h_ = 0; h_ < 2; ++h_) _Pragma("unroll") for (int i_ = 0; i_ < 2; ++i_) { const int s_ = b_ + h_ * 128 + gR[i_]; const int t_ = (s_ < c_) ? et_[s_] : 0; \
            v[h_][i_] = (unsigned)t_ * (unsigned)(K * 2) + gC[i_]; } } while (0)
#define PG8_LDA(dst, b, h) do { _Pragma("unroll") for (int m = 0; m < 4; ++m) _Pragma("unroll") for (int k = 0; k < 2; ++k) dst[m][k] = *(const LAS v4i_t*)(lds + PG8_SA(b, h) + aoff + m * 2048 + k * 1024); } while (0)
#define PG8_LDB(dst, b, h) do { _Pragma("unroll") for (int n = 0; n < 2; ++n) _Pragma("unroll") for (int k = 0; k < 2; ++k) dst[n][k] = *(const LAS v4i_t*)(lds + PG8_SB(b, h) + boff + n * 2048 + k * 1024); } while (0)
#define PG8_MMA(ai, bj, At, Bt) do { __builtin_amdgcn_s_setprio(1); _Pragma("unroll") for (int m = 0; m < 4; ++m) _Pragma("unroll") for (int n = 0; n < 2; ++n) _Pragma("unroll") for (int k = 0; k < 2; ++k) \
        acc[ai][bj][m][n] = __builtin_amdgcn_mfma_i32_16x16x64_i8(Bt[n][k], At[m][k], acc[ai][bj][m][n], 0, 0, 0); __builtin_amdgcn_s_setprio(0); } while (0)
#define PG8_WAIT_V(n) asm volatile("s_waitcnt vmcnt(" #n ")" ::: "memory")
#define PG8_WAIT_L(n) asm volatile("s_waitcnt lgkmcnt(" #n ")" ::: "memory")
#define PG8_BAR __builtin_amdgcn_s_barrier()
#define PG8_SCHED __builtin_amdgcn_sched_barrier(0)
    Unit cur, nxt; int ui = 0;
    if (!S.next(0, cur)) return;
    cur.pm = __builtin_amdgcn_readfirstlane(cur.pm); cur.pn = __builtin_amdgcn_readfirstlane(cur.pn); cur.grp = __builtin_amdgcn_readfirstlane(cur.grp);
    v4i_t acc[2][2][4][2];
#pragma unroll
    for (int a = 0; a < 2; ++a)
#pragma unroll
        for (int b = 0; b < 2; ++b)
#pragma unroll
            for (int m = 0; m < 4; ++m)
#pragma unroll
                for (int n = 0; n < 2; ++n) acc[a][b][m][n] = (v4i_t){0, 0, 0, 0};
    v4i_t At[4][2], B0[2][2], B1[2][2];
    const char* cA = GATHER ? (const char*)g.A : (const char*)g.A + (size_t)cur.grp * g.gsA + (size_t)cur.pm * tstep; const char* cB = (const char*)g.Bt + (size_t)cur.grp * g.gsB + (size_t)cur.pn * tstep;
    unsigned cv[2][2] = {{voffA[0], voffA[1]}, {voffA[0], voffA[1]}}, nv[2][2] = {{voffA[0], voffA[1]}, {voffA[0], voffA[1]}};
    if (GATHER) PG8_GATH(cur, cv);
    const size_t ahs = GATHER ? (size_t)0 : hstep;
    PG8_STAGE(PG8_SB(0, 0), cB, voffB); PG8_STAGE(PG8_SB(0, 1), cB + hstep, voffB); PG8_STAGE2(PG8_SA(0, 0), cA, cv[0][0], cv[0][1]); PG8_STAGE2(PG8_SA(0, 1), cA + ahs, cv[1][0], cv[1][1]);
    if (wr == 1) PG8_BAR;
    PG8_WAIT_V(2); PG8_BAR;
    PG8_STAGE(PG8_SB(1, 0), cB + kstep, voffB); PG8_STAGE2(PG8_SA(1, 0), cA + kstep, cv[0][0], cv[0][1]); PG8_STAGE(PG8_SB(1, 1), cB + hstep + kstep, voffB);
    PG8_WAIT_V(6); PG8_BAR;
    for (;;) {
        const bool has_next = S.next(ui + 1, nxt);
        nxt.pm = __builtin_amdgcn_readfirstlane(nxt.pm); nxt.pn = __builtin_amdgcn_readfirstlane(nxt.pn); nxt.grp = __builtin_amdgcn_readfirstlane(nxt.grp);
        const char* nA = (has_next && !GATHER) ? (const char*)g.A + (size_t)nxt.grp * g.gsA + (size_t)nxt.pm * tstep : cA; const char* nB = has_next ? (const char*)g.Bt + (size_t)nxt.grp * g.gsB + (size_t)nxt.pn * tstep : cB;
        if (GATHER) { if (has_next) PG8_GATH(nxt, nv); else { nv[0][0] = cv[0][0]; nv[0][1] = cv[0][1]; nv[1][0] = cv[1][0]; nv[1][1] = cv[1][1]; } }
        for (int t = 0; t < nt; t += 2) {
            const bool last = (t == nt - 2);
            const unsigned s00 = (GATHER && last) ? nv[0][0] : cv[0][0], s01 = (GATHER && last) ? nv[0][1] : cv[0][1], s10 = (GATHER && last) ? nv[1][0] : cv[1][0], s11 = (GATHER && last) ? nv[1][1] : cv[1][1];
            const char* a1 = cA + (size_t)(t + 1) * kstep;
            const char* a2 = last ? nA : cA + (size_t)(t + 2) * kstep; const char* b2 = last ? nB : cB + (size_t)(t + 2) * kstep;
            const char* a3 = a2 + kstep; const char* b3 = b2 + kstep;
            PG8_LDB(B0, 0, 0); PG8_LDB(B1, 0, 1); PG8_SCHED; PG8_LDA(At, 0, 0); PG8_STAGE2(PG8_SA(1, 1), a1 + ahs, cv[1][0], cv[1][1]);
            PG8_WAIT_V(8); PG8_WAIT_L(0); PG8_BAR; PG8_MMA(0, 0, At, B0); PG8_MMA(0, 1, At, B1); PG8_BAR; PG8_SCHED;
            PG8_LDA(At, 0, 1); PG8_STAGE(PG8_SB(0, 0), b2, voffB); PG8_STAGE(PG8_SB(0, 1), b2 + hstep, voffB); PG8_STAGE2(PG8_SA(0, 0), a2, s00, s01);
            PG8_WAIT_V(8); PG8_WAIT_L(0); PG8_BAR; PG8_MMA(1, 0, At, B0); PG8_MMA(1, 1, At, B1); PG8_BAR; PG8_SCHED;
            PG8_LDB(B0, 1, 0); PG8_LDB(B1, 1, 1); PG8_SCHED; PG8_LDA(At, 1, 0); PG8_STAGE2(PG8_SA(0, 1), a2 + ahs, s10, s11);
            PG8_WAIT_V(8); PG8_WAIT_L(0); PG8_BAR; PG8_MMA(0, 0, At, B0); PG8_MMA(0, 1, At, B1); PG8_BAR; PG8_SCHED;
            PG8_LDA(At, 1, 1); PG8_STAGE(PG8_SB(1, 0), b3, voffB); PG8_STAGE(PG8_SB(1, 1), b3 + hstep, voffB); PG8_STAGE2(PG8_SA(1, 0), a3, s00, s01);
            PG8_WAIT_V(8); PG8_WAIT_L(0); PG8_BAR; PG8_MMA(1, 0, At, B0); PG8_MMA(1, 1, At, B1); PG8_BAR; PG8_SCHED;
        }
        bool keep = false;
        if (wr == 0) PG8_BAR;
        { Unit eu; eu.pm = __builtin_amdgcn_readfirstlane(cur.pm); eu.pn = __builtin_amdgcn_readfirstlane(cur.pn); eu.grp = __builtin_amdgcn_readfirstlane(cur.grp); asm volatile("" : "+s"(eu.pm), "+s"(eu.pn), "+s"(eu.grp)); keep = E(acc, eu, wr, wc, fr, fq); }
        if (!has_next) break;
        if (!keep) {
#pragma unroll
        for (int a = 0; a < 2; ++a)
#pragma unroll
            for (int b = 0; b < 2; ++b)
#pragma unroll
                for (int m = 0; m < 4; ++m)
#pragma unroll
                    for (int n = 0; n < 2; ++n) acc[a][b][m][n] = (v4i_t){0, 0, 0, 0};
        }
        cur = nxt; cA = nA; cB = nB; ++ui;
        if (GATHER) { cv[0][0] = nv[0][0]; cv[0][1] = nv[0][1]; cv[1][0] = nv[1][0]; cv[1][1] = nv[1][1]; }
        if (wr == 1) PG8_BAR;
    }
    PG8_WAIT_V(0);
    PG8_BAR;
#undef PG8_SA
#undef PG8_SB
#undef PG8_STAGE
#undef PG8_STAGE2
#undef PG8_GATH
#undef PG8_LDA
#undef PG8_LDB
#undef PG8_MMA
#undef PG8_WAIT_V
#undef PG8_WAIT_L
#undef PG8_BAR
#undef PG8_SCHED
}
}

#define XB_TMO      128
#define XB_XCNT(j)  (256  + 64 * (j))
#define XB_XSUB(j)  (1280 + 64 * (j))
#define XB_XGEN(j)  (2304 + 64 * (j))
#define XB_TOP      3328
#define XB_TOPGEN   3392
#define XCD_BAR_WORDS 3456
#define XB_SPIN_CAP (1u << 18)

__device__ __forceinline__ unsigned xb_ld(unsigned* p)              { return __hip_atomic_load(p, __ATOMIC_RELAXED, __HIP_MEMORY_SCOPE_AGENT); }
__device__ __forceinline__ unsigned xb_add(unsigned* p, unsigned v) { return __hip_atomic_fetch_add(p, v, __ATOMIC_RELAXED, __HIP_MEMORY_SCOPE_AGENT); }
__device__ __forceinline__ unsigned xb_xcc_id() { return (unsigned)__builtin_amdgcn_s_getreg((3 << 11) | 20) & 0xFu; }
#define XB_SPIN(cond, bar) do { unsigned _sp = 0; while (cond) { __builtin_amdgcn_s_sleep(1); \
    if ((++_sp & 255u) == 0u) { if (xb_ld(&(bar)[XB_TMO])) break; if (_sp > XB_SPIN_CAP) { atomicAdd(&(bar)[XB_TMO], 1u); break; } } } } while (0)

struct XcdBarrier {
    unsigned* bar; unsigned x;
    volatile LAS unsigned* st;
};

__device__ __forceinline__ XcdBarrier xcd_barrier_post(unsigned* bar, volatile LAS unsigned* st) {
    XcdBarrier b; b.bar = bar; b.x = xb_xcc_id(); b.st = st;
    if (threadIdx.x == 0) (void)xb_add(&bar[XB_XCNT(b.x)], 1u);
    return b;
}
__device__ __forceinline__ void xcd_barrier_complete(unsigned* bar, unsigned x, unsigned& nloc, unsigned& nx) {
    const unsigned G = gridDim.x * gridDim.y * gridDim.z;
    unsigned sum, cnt, mine, sp = 0u;
    for (;;) {
        sum = 0u; cnt = 0u; mine = 0u;
#pragma unroll
        for (unsigned j = 0; j < 16; ++j) { const unsigned c = xb_ld(&bar[XB_XCNT(j)]); sum += c; cnt += (c > 0u) ? 1u : 0u; mine = (j == x) ? c : mine; }
        if (sum == G) break;
        __builtin_amdgcn_s_sleep(1);
        if ((++sp & 255u) == 0u) { if (xb_ld(&bar[XB_TMO])) break; if (sp > XB_SPIN_CAP) { atomicAdd(&bar[XB_TMO], 1u); break; } }
    }
    nloc = mine > 0u ? mine : 1u; nx = cnt > 0u ? cnt : 1u;
}

__device__ __forceinline__ void xcd_barrier(const XcdBarrier& b) {
    asm volatile("s_waitcnt vmcnt(0)" ::: "memory");
    __syncthreads();
    if (threadIdx.x == 0) {
        unsigned* bar = b.bar;
        __builtin_amdgcn_s_waitcnt(0);
        unsigned nloc = b.st[0], nx = b.st[1];
        if (nloc == 0u) { xcd_barrier_complete(bar, b.x, nloc, nx); b.st[0] = nloc; b.st[1] = nx; }
        const unsigned old = xb_add(&bar[XB_XSUB(b.x)], 1u);
        const unsigned gen = old / nloc;
        if (old + 1u == (gen + 1u) * nloc) {
            __builtin_amdgcn_fence(__ATOMIC_RELEASE, "agent");
            asm volatile("s_waitcnt vmcnt(0)" ::: "memory");
            const unsigned og = xb_add(&bar[XB_TOP], 1u);
            const unsigned tg = og / nx;
            if (og + 1u == (tg + 1u) * nx) xb_add(&bar[XB_TOPGEN], 1u);
            else XB_SPIN(xb_ld(&bar[XB_TOPGEN]) == tg, bar);
            __builtin_amdgcn_fence(__ATOMIC_ACQUIRE, "agent");
            xb_add(&bar[XB_XGEN(b.x)], 1u);
            asm volatile("s_waitcnt vmcnt(0)" ::: "memory");
        } else {
            XB_SPIN(xb_ld(&bar[XB_XGEN(b.x)]) == gen, bar);
            __builtin_amdgcn_fence(__ATOMIC_ACQUIRE, "agent");
            asm volatile("s_waitcnt vmcnt(0)" ::: "memory");
        }
    }
    __syncthreads();
}

constexpr size_t MiB = 1u << 20;
constexpr size_t WS_CTL = 0, CTL_ZERO_BYTES = 1 * MiB;
constexpr size_t WS_MOD  = 1 * MiB;
constexpr size_t WS_WIN  = 2 * MiB;
constexpr size_t WS_WUQ  = 210 * MiB;
constexpr size_t WS_WKN  = 213 * MiB;
constexpr size_t WS_WV   = 214 * MiB;
constexpr size_t WS_WBR  = 215 * MiB;
constexpr size_t WS_WMIX = 247 * MiB;
constexpr size_t WS_W1   = 279 * MiB;
constexpr size_t WS_W2   = 535 * MiB;
constexpr size_t WS_X    = 663 * MiB;
constexpr size_t WS_H    = 735 * MiB;
constexpr size_t WS_U    = 771 * MiB;
constexpr size_t WS_CQN  = 1005 * MiB;
constexpr size_t WS_CKVN = 1014 * MiB;
constexpr size_t WS_KRP  = 1019 * MiB;
constexpr size_t WS_Q    = 1021 * MiB;
constexpr size_t WS_KN   = 1035 * MiB;
constexpr size_t WS_VT   = 1044 * MiB;
constexpr size_t WS_ACTS = 1053 * MiB;
constexpr size_t WS_YM   = 1089 * MiB;
constexpr size_t WS_SLOC = 1125 * MiB;
constexpr size_t WS_DEC  = 1161 * MiB;
constexpr size_t WS_SIN  = 1162 * MiB;
constexpr size_t WS_ETOK = 1261 * MiB, WS_ERS = 1262 * MiB, WS_ERW = 1263 * MiB;
constexpr size_t WS_ROUTE= 1180 * MiB;
constexpr size_t WS_HS   = 1181 * MiB;
constexpr size_t WS_ACTM = 1269 * MiB;
constexpr size_t WS_OUTS = 1291 * MiB;
constexpr size_t WS_W8   = 1379 * MiB;
constexpr size_t WS_H8   = 1483 * MiB;
constexpr size_t WS_RA   = 1501 * MiB;
constexpr size_t WS_RB   = 1501 * MiB + 64 * 1024;
constexpr size_t WS_RB1  = 1501 * MiB + 512 * 1024;
constexpr size_t WS_RSORT= 1501 * MiB + 768 * 1024;
constexpr size_t WS_RAF  = 1501 * MiB + 896 * 1024;
constexpr size_t WS_G8   = 1502 * MiB;
constexpr size_t WS_END  = 1574 * MiB;
constexpr int CW_BAR = 4096;
constexpr int CW_CNT = 16384;
constexpr int CW_CMAX = 131072;

constexpr int RING_BYTES = 131072;
constexpr int LDSX_OFF = RING_BYTES;
constexpr int LDS_BYTES = 147456;

struct Params { const float* in[34]; float* out; unsigned char* ws; int ph_lo, ph_hi; };
typedef const __attribute__((address_space(4))) Params* KParams;
enum { I_X = 0, I_C, I_CTX, I_CCTX, I_WMOD, I_BMOD, I_GMIX, I_GFFN, I_WIN, I_GQ, I_WUQ, I_GKV, I_WUKV, I_WMLAO, I_WCFDW, I_BCFDW, I_GCFLN, I_BCFLN, I_WCFO,
       I_WGF, I_BGF, I_WGB, I_BGB, I_GGLAN, I_WGLAO, I_WSCC, I_WSCO, I_WMIXO, I_WROUT, I_BROUT, I_WEG, I_WEU, I_WED, I_GFIN };

struct Frame { LAS unsigned char* lds; int tid, lane, wave, G, bid, gw, NGW; };

#define WSP(T, off) ((T*)(P->ws + (off)))
#define WSQ(T, off) ((T*)(Q->ws + (off)))
DI unsigned* ctl_words(KParams P) { return (unsigned*)(P->ws + WS_CTL); }
DI int mod_row(int row) { return row < TLAT ? (row >> 11) : 4; }

DI void transpose_item(const float* W, int N, bf16_t* WT, int KD, int dest_row0, int k0, int n0, LAS float* scr, int lane) {
#pragma unroll
    for (int i = 0; i < 32; ++i) { const int kk = 2 * i + (lane >> 5); scr[kk * 33 + (lane & 31)] = __builtin_nontemporal_load(W + (size_t)(k0 + kk) * N + n0 + (lane & 31)); }
    LDS_WAIT(); asm volatile("" ::: "memory");
    const int c = lane & 7;
#pragma unroll
    for (int j = 0; j < 4; ++j) { const int n = (lane >> 3) + 8 * j; const LAS float* s = scr + (8 * c) * 33 + n;
        u32x4 o; o.x = pk2(s[0 * 33], s[1 * 33]); o.y = pk2(s[2 * 33], s[3 * 33]); o.z = pk2(s[4 * 33], s[5 * 33]); o.w = pk2(s[6 * 33], s[7 * 33]);
        __builtin_nontemporal_store(o, (u32x4*)(WT + (size_t)(dest_row0 + n) * KD + k0 + 8 * c)); }
    LDS_WAIT(); asm volatile("" ::: "memory");
}
constexpr int SLAB_AUX = LDSX_OFF + 2048;
DI int slab_off(int k, int n) { return k * 64 + ((((n >> 1) ^ ((k >> 3) & 15)) << 2) | ((n & 1) << 1)); }
DI void slab_item(const float* W, int N, int n0, unsigned char* W8, int dest_row0, float* rB, Frame& F) {
    LAS float* wmax = (LAS float*)(F.lds + SLAB_AUX); LAS float* cmax = wmax + 256;
    { const int n = F.lane & 31, kp = F.lane >> 5; float m = 0.f;
#pragma unroll 1
      for (int j = 0; j < 4; ++j) { const int kb0 = (F.wave * 4 + j) * 64; float v[32];
#pragma unroll
          for (int i = 0; i < 32; ++i) v[i] = __builtin_nontemporal_load(W + (size_t)(kb0 + 2 * i + kp) * N + n0 + n);
#pragma unroll
          for (int i = 0; i < 32; ++i) { m = fmaxf(m, fabsf(v[i])); *(LAS bf16_t*)(F.lds + slab_off(kb0 + 2 * i + kp, n)) = f2bf(v[i]); } }
      m = fmaxf(m, __shfl_xor(m, 32)); if (F.lane < 32) wmax[F.wave * 32 + n] = m; }
    __syncthreads();
    if (F.tid < 32) { float c = 0.f;
#pragma unroll
        for (int w2 = 0; w2 < 8; ++w2) c = fmaxf(c, wmax[w2 * 32 + F.tid]);
        cmax[F.tid] = c; rB[dest_row0 + F.tid] = c * (1.f / 127.f); }
    __syncthreads();
    { const int nn = ((F.tid >> 3) & 7) + 8 * (F.wave & 3); const float cm = cmax[nn], sc = cm > 0.f ? 127.f / cm : 0.f;
#pragma unroll 4
      for (int i2 = 0; i2 < 16; ++i2) { const int c = (F.tid & 7) + 8 * i2 + 128 * (F.wave >> 2); unsigned q[8];
#pragma unroll
          for (int j = 0; j < 8; ++j) q[j] = q8(sc * bf2f(*(const LAS bf16_t*)(F.lds + slab_off(8 * c + j, nn))));
          u32x2 o; o.x = q[0] | (q[1] << 8) | (q[2] << 16) | (q[3] << 24); o.y = q[4] | (q[5] << 8) | (q[6] << 16) | (q[7] << 24);
          __builtin_nontemporal_store(o, (u32x2*)(W8 + (size_t)(dest_row0 + nn) * DM + 8 * c)); } }
    __syncthreads();
}
constexpr int NS_WIN = PW / 32, NS_EXP = 16 * 2 * (EFF / 32), NS_ALL = NS_WIN + NS_EXP;
DI void slab_dispatch(KParams P, Frame& F, int l, int sidx) {
    if (sidx < NS_WIN) { slab_item(P->in[I_WIN] + (size_t)l * DM * PW, PW, 32 * sidx, WSP(unsigned char, WS_W8) + (size_t)l * PWP * DM, wcol_dest(32 * sidx), WSP(float, WS_RB) + (size_t)l * PWP, F); return; }
    const int q = sidx - NS_WIN, e = q >> 5, which = (q >> 4) & 1, n0 = (q & 15) * 32, le = l * 16 + e;
    slab_item((which ? P->in[I_WEU] : P->in[I_WEG]) + (size_t)le * DM * EFF, EFF, n0, WSP(unsigned char, WS_W1) + (size_t)le * 1024 * DM, (n0 >> 7) * 256 + which * 128 + (n0 & 127), WSP(float, WS_RB1) + (size_t)le * 1024, F);
}
constexpr int NL_UQ = 8 * 24, NL_UKV = 4 * 32, NL_BR = 4 * 8 * 64, NL_MIX = 32 * 64, NL_ED = 16 * 8 * 64, NL_PAD = PWP - PW;
constexpr int NL_ITEMS = NL_UQ + NL_UKV + NL_BR + NL_MIX + NL_ED + NL_PAD;
constexpr int NL_F1 = (NL_ITEMS * 55) / 100, NL_F2 = (NL_ITEMS * 88) / 100;
DI void conv_item_layer(KParams P, int l, int it, LAS float* scr, int lane) {
    int r = it;
    if (r < NL_UQ) { const int kb = r / 24, nb = r % 24;
        transpose_item(P->in[I_WUQ] + (size_t)l * 512 * 768, 768, WSP(bf16_t, WS_WUQ) + (size_t)l * 768 * 512, 512, 32 * nb, 64 * kb, 32 * nb, scr, lane); return; } r -= NL_UQ;
    if (r < NL_UKV) { const int kb = r / 32, nb = r % 32, n0 = 32 * nb, hh = n0 >> 7, jj = n0 & 127;
        bf16_t* dst = (jj < 64 ? WSP(bf16_t, WS_WKN) : WSP(bf16_t, WS_WV)) + (size_t)l * 512 * 256;
        transpose_item(P->in[I_WUKV] + (size_t)l * 256 * 1024, 1024, dst, 256, hh * 64 + (jj & 63), 64 * kb, n0, scr, lane); return; } r -= NL_UKV;
    if (r < NL_BR) { const int br = r / 512, q = r % 512, kb = q / 64, nb = q % 64;
        const float* src = (br == 0 ? P->in[I_WMLAO] : br == 1 ? P->in[I_WCFO] : br == 2 ? P->in[I_WGLAO] : P->in[I_WSCO]) + (size_t)l * 512 * DM;
        transpose_item(src, DM, WSP(bf16_t, WS_WBR) + (size_t)(l * 4 + br) * DM * 512, 512, 32 * nb, 64 * kb, 32 * nb, scr, lane); return; } r -= NL_BR;
    if (r < NL_MIX) { const int kb = r / 64, nb = r % 64;
        transpose_item(P->in[I_WMIXO] + (size_t)l * DM * DM, DM, WSP(bf16_t, WS_WMIX) + (size_t)l * DM * DM, DM, 32 * nb, 64 * kb, 32 * nb, scr, lane); return; } r -= NL_MIX;
    if (r < NL_ED) { const int e = r / 512, q = r % 512, kb = q / 64, nb = q % 64, le = l * 16 + e;
        transpose_item(P->in[I_WED] + (size_t)le * EFF * DM, DM, WSP(bf16_t, WS_W2) + (size_t)le * DM * EFF, EFF, 32 * nb, 64 * kb, 32 * nb, scr, lane); return; } r -= NL_ED;
    { unsigned char* row = WSP(unsigned char, WS_W8) + ((size_t)l * PWP + O_MG + r) * DM;
#pragma unroll
      for (int j = 0; j < 2; ++j) *(u32x4*)(row + 16 * lane + 1024 * j) = (u32x4){0u, 0u, 0u, 0u};
      if (lane == 0) WSP(float, WS_RB)[(size_t)l * PWP + O_MG + r] = 0.f; }
}
DI void conv_mixed(KParams P, Frame& F, int l, int s_lo, int s_hi, int w_lo, int w_hi, int rank, int nrank) {
    if (rank < 0) return;
    for (int sidx = s_lo + rank; sidx < s_hi; sidx += nrank) slab_dispatch(P, F, l, sidx);
    LAS float* scr = (LAS float*)(F.lds + F.wave * 8448);
    for (int it = w_lo + rank * 8 + F.wave; it < w_hi; it += nrank * 8) conv_item_layer(P, l, it, scr, F.lane);
    __syncthreads();
}
DI void mod_item(KParams P, Frame& F, int it) {
    const int l = it / 192, n0 = (it % 192) * 64;
    const LAS float* sil = (const LAS float*)F.lds;
    LAS float* red = (LAS float*)(F.lds + 40960);
    const int kq = F.lane >> 4, ln = F.lane & 15;
    const float* wp = P->in[I_WMOD] + (size_t)l * DM * (6 * DM) + n0 + 4 * ln;
    f32x4 acc[5];
#pragma unroll
    for (int r = 0; r < 5; ++r) acc[r] = (f32x4){0.f, 0.f, 0.f, 0.f};
    const int kbase = F.wave * 256 + kq;
#pragma unroll 8
    for (int kk = 0; kk < 64; ++kk) { const int k = kbase + 4 * kk; const f32x4 wv = *(const f32x4*)(wp + (size_t)k * (6 * DM));
#pragma unroll
        for (int r = 0; r < 5; ++r) acc[r] = acc[r] + wv * sil[r * DM + k]; }
    const int grp = F.wave * 4 + kq;
#pragma unroll
    for (int r = 0; r < 5; ++r) *(LAS f32x4*)(red + (grp * 5 + r) * 64 + 4 * ln) = acc[r];
    __syncthreads();
    if (F.tid < 320) { const int r = F.tid >> 6, n = F.tid & 63; float s = P->in[I_BMOD][(size_t)l * (6 * DM) + n0 + n];
        for (int g = 0; g < 32; ++g) s += red[(g * 5 + r) * 64 + n];
        WSP(float, WS_MOD)[(size_t)(l * 5 + r) * (6 * DM) + n0 + n] = s; }
    __syncthreads();
}
DI void phase_prologue(KParams P, Frame& F) {
    LAS float* sil = (LAS float*)F.lds;
    for (int i = F.tid; i < 5 * DM; i += 512) { const int r = i >> 11, k = i & (DM - 1); const float c = r < 4 ? P->in[I_C][r * DM + k] : P->in[I_CCTX][k]; sil[i] = c / (1.f + expf(-c)); }
    __syncthreads();
    for (int it = F.bid; it < DEPTH * 192; it += F.G) mod_item(P, F, it);
    __syncthreads();
}

DI void moe_table(KParams P, Frame& F, int l) {
    LAS int* tp = (LAS int*)(F.lds + LDSX_OFF + 64); LAS int* cn = tp + 32;
    if (F.tid < 16) { const unsigned* cnt = ctl_words(P) + CW_CNT + l * 16 * 64;
        const int c = (int)__hip_atomic_load(cnt + F.tid * 64, __ATOMIC_RELAXED, __HIP_MEMORY_SCOPE_AGENT); cn[F.tid] = c;
        int a = (c + 255) >> 8;
#pragma unroll
        for (int o = 1; o < 16; o <<= 1) { const int t = __shfl_up(a, o, 16); if ((int)F.tid >= o) a += t; }
        tp[F.tid + 1] = a; if (F.tid == 0) tp[0] = 0; }
    __syncthreads();
}
DI void phase_norm1(KParams P, Frame& F, int l, bool dummy) {
    bf16_t* X = WSP(bf16_t, WS_X); bf16_t* XO = dummy ? WSP(bf16_t, WS_HS) : X; bf16_t* H = WSP(bf16_t, WS_H); const float* mod = WSP(float, WS_MOD); const bf16_t* outs = WSP(bf16_t, WS_OUTS);
    const int* rt_e = (const int*)(P->ws + WS_ROUTE); const int* rt_slot = (const int*)(P->ws + WS_ROUTE + 2 * 73728); const LAS int* tp = (const LAS int*)(F.lds + LDSX_OFF + 64);
    if (l > 0) moe_table(P, F, l - 1);
    for (int row = F.gw; row < TT; row += F.NGW) {
        const int r = mod_row(row);
        const float* mp = mod + (size_t)(l * 5 + r) * (6 * DM); const float* gm = P->in[I_GMIX] + (size_t)l * DM; float am = 0.f;
        f32x4 v[8], gq[8], shq[8], scq[8];
        int e0 = 0, e1 = 0, s0 = 0, s1 = 0;
        if (l > 0) { e0 = rt_e[2 * row]; e1 = rt_e[2 * row + 1]; s0 = rt_slot[2 * row]; s1 = rt_slot[2 * row + 1]; }
#pragma unroll
        for (int j = 0; j < 8; ++j) { const int c = 4 * F.lane + 256 * j; gq[j] = *(const f32x4*)(gm + c); shq[j] = *(const f32x4*)(mp + c); scq[j] = *(const f32x4*)(mp + DM + c); }
        if (l == 0) { const float* src = row < TLAT ? P->in[I_X] + (size_t)row * DM : P->in[I_CTX] + (size_t)(row - TLAT) * DM;
#pragma unroll
            for (int j = 0; j < 8; ++j) v[j] = *(const f32x4*)(src + 4 * F.lane + 256 * j); }
        else { u32x2 xw[8], aw[8], bw[8]; f32x4 gtq[8];
            const int p0 = tp[e0] * 256 + s0, p1 = tp[e1] * 256 + s1; const float* gt = mod + (size_t)((l - 1) * 5 + r) * (6 * DM) + 5 * DM;
#pragma unroll
            for (int j = 0; j < 8; ++j) { const int c = 4 * F.lane + 256 * j; xw[j] = *(const u32x2*)(X + (size_t)row * DM + c); gtq[j] = *(const f32x4*)(gt + c);
                aw[j] = *(const u32x2*)(outs + (size_t)p0 * DM + c); bw[j] = *(const u32x2*)(outs + (size_t)p1 * DM + c); }
            __builtin_amdgcn_sched_barrier(0);
#pragma unroll
            for (int j = 0; j < 8; ++j) { const u32x2 w = xw[j], a = aw[j], b = bw[j]; const f32x4 g = gtq[j];
                v[j][0] = bflo(w.x) + g[0] * (bflo(a.x) + bflo(b.x)); v[j][1] = bfhi(w.x) + g[1] * (bfhi(a.x) + bfhi(b.x)); v[j][2] = bflo(w.y) + g[2] * (bflo(a.y) + bflo(b.y)); v[j][3] = bfhi(w.y) + g[3] * (bfhi(a.y) + bfhi(b.y)); } }
        __builtin_amdgcn_sched_barrier(0);
        float ss = 0.f;
#pragma unroll
        for (int j = 0; j < 8; ++j) { *(u32x2*)(XO + (size_t)row * DM + 4 * F.lane + 256 * j) = (u32x2){pk2(v[j][0], v[j][1]), pk2(v[j][2], v[j][3])}; ss += (v[j][0] * v[j][0] + v[j][1] * v[j][1]) + (v[j][2] * v[j][2] + v[j][3] * v[j][3]); }
        const float rstd = 1.f / sqrtf(wave_sum(ss) * (1.f / DM) + EPS);
#pragma unroll
        for (int j = 0; j < 8; ++j) { const f32x4 g = gq[j], sh = shq[j], sc = scq[j];
            v[j] = (v[j] * rstd * g) * (sc + 1.f) + sh; am = fmaxf(fmaxf(am, fmaxf(fabsf(v[j][0]), fabsf(v[j][1]))), fmaxf(fabsf(v[j][2]), fabsf(v[j][3]))); }
#pragma unroll
        for (int o = 1; o < 64; o <<= 1) am = fmaxf(am, __shfl_xor(am, o));
        const float qs = am > 0.f ? 127.f / am : 0.f;
#pragma unroll
        for (int j = 0; j < 8; ++j) { const int c = 4 * F.lane + 256 * j;
            *(unsigned*)(WSP(unsigned char, WS_H8) + (size_t)row * DM + c) = q8(v[j][0] * qs) | (q8(v[j][1] * qs) << 8) | (q8(v[j][2] * qs) << 16) | (q8(v[j][3] * qs) << 24); }
        if (F.lane == 0) WSP(float, WS_RA)[row] = am * (1.f / 127.f);
    }
}
DI void phase_final(KParams P, Frame& F) {
    const bf16_t* X = WSP(bf16_t, WS_X); const float* mod = WSP(float, WS_MOD); const bf16_t* outs = WSP(bf16_t, WS_OUTS);
    const int* rt_e = (const int*)(P->ws + WS_ROUTE); const int* rt_slot = (const int*)(P->ws + WS_ROUTE + 2 * 73728); const LAS int* tp = (const LAS int*)(F.lds + LDSX_OFF + 64);
    moe_table(P, F, DEPTH - 1);
    for (int row = F.gw; row < TLAT; row += F.NGW) {
        const int r = mod_row(row); const int p0 = tp[rt_e[2 * row]] * 256 + rt_slot[2 * row], p1 = tp[rt_e[2 * row + 1]] * 256 + rt_slot[2 * row + 1]; const float* gt = mod + (size_t)((DEPTH - 1) * 5 + r) * (6 * DM) + 5 * DM;
        f32x4 v[8]; float ss = 0.f;
        u32x2 xw[8], aw[8], bw[8]; f32x4 gtq[8], gfq[8];
#pragma unroll
        for (int j = 0; j < 8; ++j) { const int c = 4 * F.lane + 256 * j; xw[j] = *(const u32x2*)(X + (size_t)row * DM + c); gtq[j] = *(const f32x4*)(gt + c); gfq[j] = *(const f32x4*)(P->in[I_GFIN] + c);
            aw[j] = *(const u32x2*)(outs + (size_t)p0 * DM + c); bw[j] = *(const u32x2*)(outs + (size_t)p1 * DM + c); }
        __builtin_amdgcn_sched_barrier(0);
#pragma unroll
        for (int j = 0; j < 8; ++j) { const u32x2 w = xw[j], a = aw[j], b = bw[j]; const f32x4 g = gtq[j];
            v[j][0] = bflo(w.x) + g[0] * (bflo(a.x) + bflo(b.x)); v[j][1] = bfhi(w.x) + g[1] * (bfhi(a.x) + bfhi(b.x)); v[j][2] = bflo(w.y) + g[2] * (bflo(a.y) + bflo(b.y)); v[j][3] = bfhi(w.y) + g[3] * (bfhi(a.y) + bfhi(b.y));
            ss += (v[j][0] * v[j][0] + v[j][1] * v[j][1]) + (v[j][2] * v[j][2] + v[j][3] * v[j][3]); }
        const float rstd = 1.f / sqrtf(wave_sum(ss) * (1.f / DM) + EPS);
#pragma unroll
        for (int j = 0; j < 8; ++j) { const int c = 4 * F.lane + 256 * j; *(f32x4*)(P->out + (size_t)row * DM + c) = v[j] * rstd * gfq[j]; }
    }
}
DI float ffn_input_row(KParams P, Frame& F, int l, int row, f32x4 (&v)[8]) {
    const bf16_t* X = WSP(bf16_t, WS_X); unsigned char* H8 = WSP(unsigned char, WS_H); const float* mod = WSP(float, WS_MOD);
    const int r = mod_row(row); float ss = 0.f;
    const float* mp = mod + (size_t)(l * 5 + r) * (6 * DM); const float* gm = P->in[I_GFFN] + (size_t)l * DM; float am = 0.f;
    u32x2 xw[8]; f32x4 gq[8], shq[8], scq[8];
#pragma unroll
    for (int j = 0; j < 8; ++j) { const int c = 4 * F.lane + 256 * j; xw[j] = *(const u32x2*)(X + (size_t)row * DM + c); gq[j] = *(const f32x4*)(gm + c); shq[j] = *(const f32x4*)(mp + 3 * DM + c); scq[j] = *(const f32x4*)(mp + 4 * DM + c); }
    __builtin_amdgcn_sched_barrier(0);
#pragma unroll
    for (int j = 0; j < 8; ++j) { const u32x2 w = xw[j]; v[j] = (f32x4){bflo(w.x), bfhi(w.x), bflo(w.y), bfhi(w.y)}; ss += (v[j][0] * v[j][0] + v[j][1] * v[j][1]) + (v[j][2] * v[j][2] + v[j][3] * v[j][3]); }
    const float rstd = 1.f / sqrtf(wave_sum(ss) * (1.f / DM) + EPS);
#pragma unroll
    for (int j = 0; j < 8; ++j) { const f32x4 g = gq[j], sh = shq[j], sc = scq[j];
        v[j] = (v[j] * rstd * g) * (sc + 1.f) + sh; am = fmaxf(fmaxf(am, fmaxf(fabsf(v[j][0]), fabsf(v[j][1]))), fmaxf(fabsf(v[j][2]), fabsf(v[j][3]))); }
#pragma unroll
    for (int o = 1; o < 64; o <<= 1) am = fmaxf(am, __shfl_xor(am, o));
    const float qs = am > 0.f ? 127.f / am : 0.f;
#pragma unroll
    for (int j = 0; j < 8; ++j) { const int c = 4 * F.lane + 256 * j;
        *(unsigned*)(H8 + (size_t)row * DM + c) = q8(v[j][0] * qs) | (q8(v[j][1] * qs) << 8) | (q8(v[j][2] * qs) << 16) | (q8(v[j][3] * qs) << 24); }
    return am * (1.f / 127.f);
}
DI void route_decide(const float (&lg)[16], const float (&br)[16], int& e1, int& e2, float& wa, float& wb) {
    float aff[16], sel[16];
#pragma unroll
    for (int e = 0; e < 16; ++e) { aff[e] = __builtin_amdgcn_rcpf(1.f + expf(-lg[e])); sel[e] = aff[e] + br[e]; }
    int best = 0; float bestv = -INFINITY;
#pragma unroll
    for (int g = 0; g < 4; ++g) { const float a = sel[4 * g], b = sel[4 * g + 1], c = sel[4 * g + 2], d = sel[4 * g + 3];
        const float hi1 = fmaxf(a, b), lo1 = fminf(a, b), hi2 = fmaxf(c, d), lo2 = fminf(c, d);
        const float gs = fmaxf(hi1, hi2) + fmaxf(fminf(hi1, hi2), fmaxf(lo1, lo2));
        if (gs > bestv) { bestv = gs; best = g; } }
    float s4[4] = {0.f, 0.f, 0.f, 0.f}, a4[4] = {0.f, 0.f, 0.f, 0.f};
#pragma unroll
    for (int g = 0; g < 4; ++g)
#pragma unroll
        for (int j = 0; j < 4; ++j) { s4[j] = (best == g) ? sel[4 * g + j] : s4[j]; a4[j] = (best == g) ? aff[4 * g + j] : a4[j]; }
    int i1 = 0; float m1 = s4[0];
#pragma unroll
    for (int j = 1; j < 4; ++j) if (s4[j] > m1) { m1 = s4[j]; i1 = j; }
    int i2 = -1; float m2 = -INFINITY;
#pragma unroll
    for (int j = 0; j < 4; ++j) if (j != i1 && s4[j] > m2) { m2 = s4[j]; i2 = j; }
    float w1 = 0.f, w2 = 0.f;
#pragma unroll
    for (int j = 0; j < 4; ++j) { w1 = (j == i1) ? a4[j] : w1; w2 = (j == i2) ? a4[j] : w2; }
    const float inv = 1.f / (w1 + w2);
    e1 = 4 * best + i1; e2 = 4 * best + i2; wa = w1 * inv; wb = w2 * inv;
}
DI void phase_norm2_route(KParams P, Frame& F, int l, int cbank) {
    int* rt_e = (int*)(P->ws + WS_ROUTE); int* rt_slot = (int*)(P->ws + WS_ROUTE + 2 * 73728);
    int* etok = (int*)(P->ws + WS_ETOK); float* ers = (float*)(P->ws + WS_ERS); float* erw = (float*)(P->ws + WS_ERW);
    unsigned* cnt = ctl_words(P) + CW_CNT + cbank * 16 * 64;
    LAS float* wrT = (LAS float*)F.lds;
    for (int k = F.tid; k < DM; k += 512) { const f32x4* wp = (const f32x4*)(P->in[I_WROUT] + (size_t)k * 16);
#pragma unroll
        for (int q = 0; q < 4; ++q) { const f32x4 w = wp[q]; wrT[(4 * q + 0) * DM + k] = w[0]; wrT[(4 * q + 1) * DM + k] = w[1]; wrT[(4 * q + 2) * DM + k] = w[2]; wrT[(4 * q + 3) * DM + k] = w[3]; } }
    float br[16];
#pragma unroll
    for (int e = 0; e < 16; ++e) br[e] = P->in[I_BROUT][e];
    const int nrows = (l == DEPTH - 1) ? TLAT : TT;
    const int rpb = (nrows + F.G - 1) / F.G, row0 = F.bid * rpb, row1 = (row0 + rpb < nrows) ? row0 + rpb : nrows;
    LAS int* lcnt = (LAS int*)(F.lds + LDSX_OFF + 512); LAS int* lbase = lcnt + 16; LAS int* lre = lcnt + 32; LAS int* lri = lcnt + 112; LAS float* lrw = (LAS float*)(lcnt + 192); LAS float* lrs = (LAS float*)(lcnt + 272);
    if (F.tid < 16) lcnt[F.tid] = 0;
    __syncthreads();
#pragma unroll 1
    for (int lr = 2 * F.wave; row0 + lr < row1; lr += 16) {
        const bool hasB = row0 + lr + 1 < row1; const int rowA = row0 + lr, rowB = hasB ? rowA + 1 : rowA;
        f32x4 va[8], vb[8]; const float sA = ffn_input_row(P, F, l, rowA, va), sB = ffn_input_row(P, F, l, rowB, vb);
        f32x2_t lab[16];
#pragma unroll
        for (int e = 0; e < 16; ++e) lab[e] = (f32x2_t){0.f, 0.f};
#pragma unroll
        for (int j = 0; j < 8; ++j) {
            const f32x2_t x0 = (f32x2_t){va[j][0], vb[j][0]}, x1 = (f32x2_t){va[j][1], vb[j][1]}, x2 = (f32x2_t){va[j][2], vb[j][2]}, x3 = (f32x2_t){va[j][3], vb[j][3]};
#pragma unroll
            for (int e = 0; e < 16; ++e) { const f32x4 w = *(const LAS f32x4*)(wrT + e * DM + 4 * F.lane + 256 * j);
                lab[e] = __builtin_elementwise_fma(x3, (f32x2_t){w[3], w[3]}, __builtin_elementwise_fma(x2, (f32x2_t){w[2], w[2]}, __builtin_elementwise_fma(x1, (f32x2_t){w[1], w[1]}, __builtin_elementwise_fma(x0, (f32x2_t){w[0], w[0]}, lab[e])))); }
            asm volatile("" ::: "memory"); }
        float la[16], lb[16];
#pragma unroll
        for (int e = 0; e < 16; ++e) { la[e] = wave_sum(lab[e][0]); lb[e] = wave_sum(lab[e][1]); }
        int e1, e2, f1, f2; float wa, wb, xa, xb; route_decide(la, br, e1, e2, wa, wb); route_decide(lb, br, f1, f2, xa, xb);
        if (F.lane == 0) {
            const int j1 = __hip_atomic_fetch_add(lcnt + e1, 1, __ATOMIC_RELAXED, __HIP_MEMORY_SCOPE_WORKGROUP), j2 = __hip_atomic_fetch_add(lcnt + e2, 1, __ATOMIC_RELAXED, __HIP_MEMORY_SCOPE_WORKGROUP);
            lre[2 * lr] = e1; lre[2 * lr + 1] = e2; lri[2 * lr] = j1; lri[2 * lr + 1] = j2;
            rt_e[2 * rowA] = e1; rt_e[2 * rowA + 1] = e2; lrw[2 * lr] = wa; lrw[2 * lr + 1] = wb; lrs[lr] = sA;
            if (hasB) { const int k1 = __hip_atomic_fetch_add(lcnt + f1, 1, __ATOMIC_RELAXED, __HIP_MEMORY_SCOPE_WORKGROUP), k2 = __hip_atomic_fetch_add(lcnt + f2, 1, __ATOMIC_RELAXED, __HIP_MEMORY_SCOPE_WORKGROUP);
                lre[2 * lr + 2] = f1; lre[2 * lr + 3] = f2; lri[2 * lr + 2] = k1; lri[2 * lr + 3] = k2;
                rt_e[2 * rowB] = f1; rt_e[2 * rowB + 1] = f2; lrw[2 * lr + 2] = xa; lrw[2 * lr + 3] = xb; lrs[lr + 1] = sB; } }
    }
    __syncthreads();
    if (F.tid < 16) lbase[F.tid] = (int)atomicAdd(cnt + F.tid * 64, (unsigned)lcnt[F.tid]);
    __syncthreads();
    if (F.tid < 2 * (row1 - row0)) { const int e = lre[F.tid], sl = lbase[e] + lri[F.tid]; rt_slot[2 * row0 + F.tid] = sl;
        etok[e * TT + sl] = row0 + (F.tid >> 1); ers[e * TT + sl] = lrs[F.tid >> 1]; erw[e * TT + sl] = lrw[F.tid]; }
    __syncthreads();
}
DI float rope_freq(int i) { return __expf(-1.1512925465f * (float)i); }
DI void mla_prep_rows(KParams P, Frame& F, int l) {
    const bf16_t* U = WSP(bf16_t, WS_U); bf16_t* cqn = WSP(bf16_t, WS_CQN); bf16_t* ckvn = WSP(bf16_t, WS_CKVN); bf16_t* krp = WSP(bf16_t, WS_KRP);
    for (int row = F.gw; row < TT; row += F.NGW) {
        const bf16_t* up = U + (size_t)row * PWP;
        { const u32x4 a = *(const u32x4*)(up + O_CQ + 8 * F.lane); float f[8] = {bflo(a.x), bfhi(a.x), bflo(a.y), bfhi(a.y), bflo(a.z), bfhi(a.z), bflo(a.w), bfhi(a.w)};
          float ss = 0.f;
#pragma unroll
          for (int i = 0; i < 8; ++i) ss += f[i] * f[i];
          const float rstd = 1.f / sqrtf(wave_sum(ss) * (1.f / 512.f) + EPS); const float* g = P->in[I_GQ] + l * 512 + 8 * F.lane;
          u32x4 o; o.x = pk2(f[0] * rstd * g[0], f[1] * rstd * g[1]); o.y = pk2(f[2] * rstd * g[2], f[3] * rstd * g[3]); o.z = pk2(f[4] * rstd * g[4], f[5] * rstd * g[5]); o.w = pk2(f[6] * rstd * g[6], f[7] * rstd * g[7]);
          *(u32x4*)(cqn + (size_t)row * 512 + 8 * F.lane) = o; }
        { const u32x2 a = *(const u32x2*)(up + O_CKV + 4 * F.lane); float f[4] = {bflo(a.x), bfhi(a.x), bflo(a.y), bfhi(a.y)};
          const float ss = (f[0] * f[0] + f[1] * f[1]) + (f[2] * f[2] + f[3] * f[3]);
          const float rstd = 1.f / sqrtf(wave_sum(ss) * (1.f / 256.f) + EPS); const float* g = P->in[I_GKV] + l * 256 + 4 * F.lane;
          u32x2 o; o.x = pk2(f[0] * rstd * g[0], f[1] * rstd * g[1]); o.y = pk2(f[2] * rstd * g[2], f[3] * rstd * g[3]);
          *(u32x2*)(ckvn + (size_t)row * 256 + 4 * F.lane) = o; }
        { const int e = F.lane; float val = 0.f;
          if (row < TLAT) { if (e < 32) { const int pos = row & (SEQ - 1), part = e >> 4, idx = e & 15, i = idx & 7, second = idx >> 3;
                  const float t1 = bf2f(up[O_KR + 16 * part + i]), t2 = bf2f(up[O_KR + 16 * part + 8 + i]);
                  const float ang = (float)(part ? (pos & 63) : (pos >> 6)) * rope_freq(i); const float sn = __sinf(ang), cs = __cosf(ang);
                  val = second ? (t1 * sn + t2 * cs) : (t1 * cs - t2 * sn); } }
          else { if (e >= 32) val = bf2f(up[O_KR + e - 32]); }
          krp[(size_t)row * 64 + e] = f2bf(val); }
    }
}
DI void cf_sc_tile(KParams P, Frame& F, int l, int ti) {
    const bf16_t* U = WSP(bf16_t, WS_U); bf16_t* acts = WSP(bf16_t, WS_ACTS);
    const int row0 = ti * 32; int seg_lo, seg_hi;
    if (row0 < TLAT) { seg_lo = row0 & ~(SEQ - 1); seg_hi = seg_lo + SEQ; } else { seg_lo = TLAT + ((row0 - TLAT) & ~(CTXL - 1)); seg_hi = seg_lo + CTXL; }
    LAS bf16_t* gl = (LAS bf16_t*)F.lds;
    LAS float* co = (LAS float*)(F.lds + 63488);
    const int c2 = F.tid & 255, th = F.tid >> 8;
    { const bf16_t* ub = U + O_SC + 2 * c2; const float* wp = P->in[I_WSCC] + (size_t)l * 3 * 512 + 2 * c2;
      const float w0a = wp[0], w0b = wp[1], w1a = wp[512], w1b = wp[513], w2a = wp[1024], w2b = wp[1025];
      unsigned pc[18], ph[18], gb[16];
#pragma unroll
      for (int k = 0; k < 18; ++k) { const int rr = row0 + 16 * th - 1 + k; const bool ok = rr >= seg_lo && rr < seg_hi;
          pc[k] = ok ? *(const unsigned*)(ub + (size_t)rr * PWP + 512) : 0u; ph[k] = ok ? *(const unsigned*)(ub + (size_t)rr * PWP + 1024) : 0u; }
#pragma unroll
      for (int k = 0; k < 16; ++k) gb[k] = *(const unsigned*)(ub + (size_t)(row0 + 16 * th + k) * PWP);
      float pa[18], pb[18];
#pragma unroll
      for (int k = 0; k < 18; ++k) { pa[k] = bflo(pc[k]) * bflo(ph[k]); pb[k] = bfhi(pc[k]) * bfhi(ph[k]); }
#pragma unroll
      for (int k = 0; k < 16; ++k) *(unsigned*)(acts + ((size_t)3 * TT + row0 + 16 * th + k) * 512 + 2 * c2) =
          pk2(bflo(gb[k]) * (w0a * pa[k] + w1a * pa[k + 1] + w2a * pa[k + 2]), bfhi(gb[k]) * (w0b * pb[k] + w1b * pb[k + 1] + w2b * pb[k + 2])); }
    { const int cg = F.tid & 63, ri = F.tid >> 6; u32x4 ga[8], gbv[8];
#pragma unroll
      for (int pass = 0; pass < 8; ++pass) { const int i = pass * 8 + ri, rr = row0 - 15 + i; const bool ok = i < 62 && rr >= seg_lo && rr < seg_hi;
          const bf16_t* up = U + (size_t)(ok ? rr : row0) * PWP + O_CF + 8 * cg; ga[pass] = *(const u32x4*)up; gbv[pass] = *(const u32x4*)(up + 512); }
#pragma unroll
      for (int pass = 0; pass < 8; ++pass) { const int i = pass * 8 + ri, rr = row0 - 15 + i; const bool ok = rr >= seg_lo && rr < seg_hi;
          if (i < 62) { const u32x4 a = ga[pass], b = gbv[pass]; u32x4 o;
              o.x = pk2(bflo(a.x) * sigm(bflo(b.x)), bfhi(a.x) * sigm(bfhi(b.x))); o.y = pk2(bflo(a.y) * sigm(bflo(b.y)), bfhi(a.y) * sigm(bfhi(b.y)));
              o.z = pk2(bflo(a.z) * sigm(bflo(b.z)), bfhi(a.z) * sigm(bfhi(b.z))); o.w = pk2(bflo(a.w) * sigm(bflo(b.w)), bfhi(a.w) * sigm(bfhi(b.w)));
              if (!ok) o = (u32x4){0u, 0u, 0u, 0u};
              *(LAS u32x4*)(gl + i * 512 + 8 * cg) = o; } } }
    asm volatile("" ::: "memory");
    float wva[31], wvb[31];
#pragma unroll
    for (int j = 0; j < 31; ++j) { const f32x2_t w = *(const f32x2_t*)(P->in[I_WCFDW] + (size_t)(l * 31 + j) * 512 + 2 * c2); wva[j] = w[0]; wvb[j] = w[1]; }
    const f32x2_t bias = *(const f32x2_t*)(P->in[I_BCFDW] + l * 512 + 2 * c2);
    __syncthreads();
#pragma unroll 1
    for (int hb = 0; hb < 2; ++hb) { const LAS unsigned* gp = (const LAS unsigned*)(gl + (16 * th + 8 * hb) * 512 + 2 * c2); f32x2_t xin[38];
#pragma unroll
      for (int i = 0; i < 38; ++i) { const unsigned x = gp[i * 256]; xin[i] = (f32x2_t){bflo(x), bfhi(x)}; }
#pragma unroll
      for (int t = 0; t < 8; ++t) { f32x2_t a = bias;
#pragma unroll
          for (int j = 0; j < 31; ++j) a = __builtin_elementwise_fma((f32x2_t){wva[j], wvb[j]}, xin[t + j], a);
          *(LAS f32x2_t*)(co + (16 * th + 8 * hb + t) * 512 + 2 * c2) = a; } }
    __syncthreads();
#pragma unroll 1
    for (int tt = 0; tt < 4; ++tt) { const int t = F.wave * 4 + tt; const LAS float* cr = co + t * 512 + 8 * F.lane;
        const f32x4 a = *(const LAS f32x4*)cr, b = *(const LAS f32x4*)(cr + 4);
        float x[8] = {a[0], a[1], a[2], a[3], b[0], b[1], b[2], b[3]}; float s = 0.f;
#pragma unroll
        for (int i = 0; i < 8; ++i) s += x[i];
        const float mean = wave_sum(s) * (1.f / 512.f); float q = 0.f;
#pragma unroll
        for (int i = 0; i < 8; ++i) { x[i] -= mean; q += x[i] * x[i]; }
        const float rstd = 1.f / sqrtf(wave_sum(q) * (1.f / 512.f) + EPS);
        const float* g = P->in[I_GCFLN] + l * 512 + 8 * F.lane; const float* bb = P->in[I_BCFLN] + l * 512 + 8 * F.lane; float y[8];
#pragma unroll
        for (int i = 0; i < 8; ++i) y[i] = siluf(x[i] * rstd * g[i] + bb[i]);
        u32x4 o; o.x = pk2(y[0], y[1]); o.y = pk2(y[2], y[3]); o.z = pk2(y[4], y[5]); o.w = pk2(y[6], y[7]);
        *(u32x4*)(acts + ((size_t)1 * TT + row0 + t) * 512 + 8 * F.lane) = o; }
    __syncthreads();
}

constexpr int GPD = 72;
constexpr int GL_LOW = 0, GL_GSUM = 8192, GL_VT = 10240, GL_A0 = 28672, GL_KD = 37888, GL_QI = 47104, GL_ST = 56320, GL_PP = 74752, GL_OB = 83968;
DI void gla_chunk_decode(int ci, int& b, int& row0, int& jf, int& jb) {
    if (ci < 128) { b = ci >> 5; const int c = ci & 31; row0 = b * SEQ + c * 64; jf = 4 + c; jb = 4 + (31 - c); }
    else { const int cc = ci - 128; b = cc >> 2; const int c = cc & 3; row0 = TLAT + b * CTXL + c * 64; jf = c; jb = 3 - c; }
}
DI int gla_cidx(int b, int hh, int dir, int j) { return ((b * 4 + hh) * 2 + dir) * NCHAIN + j; }
DI void lds_mma_nt(f32x16& acc, const LAS bf16_t* A, int a_row0, const LAS bf16_t* B, int b_row0, int r, int h) {
#pragma unroll
    for (int k0 = 0; k0 < 64; k0 += 16) {
        const bf16x8 a = *(const LAS bf16x8*)(A + (a_row0 + r) * GPD + k0 + 8 * h);
        const bf16x8 b = *(const LAS bf16x8*)(B + (b_row0 + r) * GPD + k0 + 8 * h);
        acc = __builtin_amdgcn_mfma_f32_32x32x16_bf16(a, b, acc, 0, 0, 0);
    }
}
DI float logsig(float z) { return fminf(z, 0.f) - __logf(1.f + __expf(-fabsf(z))); }
DI void gla_decay(Frame& F, int dir, const float (&w2v)[16], float b2, float (&cs)[8], float& off, float& total, float& mid) {
    const LAS float* low = (const LAS float*)(F.lds + GL_LOW); LAS float* gsum = (LAS float*)(F.lds + GL_GSUM);
    const int d = F.tid & 63, tg = F.tid >> 6;
    float la[8];
#pragma unroll
    for (int i = 0; i < 8; ++i) { const LAS float* lp = low + (tg * 8 + i) * 32 + dir * 16; float z = b2;
#pragma unroll
        for (int j = 0; j < 16; ++j) z += lp[j] * w2v[j];
        la[i] = logsig(z) * (1.f / 16.f); }
    if (dir == 0) { cs[0] = la[0];
#pragma unroll
        for (int i = 1; i < 8; ++i) cs[i] = cs[i - 1] + la[i];
        gsum[tg * 64 + d] = cs[7]; }
    else { cs[7] = la[7];
#pragma unroll
        for (int i = 6; i >= 0; --i) cs[i] = cs[i + 1] + la[i];
        gsum[tg * 64 + d] = cs[0]; }
    __syncthreads();
    float g[8];
#pragma unroll
    for (int q = 0; q < 8; ++q) g[q] = gsum[q * 64 + d];
    total = 0.f; off = 0.f; mid = 0.f;
#pragma unroll
    for (int q = 0; q < 8; ++q) { total += g[q]; if (dir == 0) { off += (q < tg) ? g[q] : 0.f; mid += (q <= 3) ? g[q] : 0.f; } else { off += (q > tg) ? g[q] : 0.f; mid += (q >= 4) ? g[q] : 0.f; } }
}
#define GLA_PRELOAD() \
    const int d = F.tid & 63, tg = F.tid >> 6, dcol = hh * 64 + d; \
    const u32x2 loww = *(const u32x2*)(U + (size_t)(row0 + (F.tid >> 3)) * PWP + O_GF + (F.tid & 7) * 4); \
    const u32x4 vva = *(const u32x4*)(U + (size_t)(row0 + (F.tid >> 3)) * PWP + O_GV + hh * 128 + (F.tid & 7) * 16), vvb = *(const u32x4*)(U + (size_t)(row0 + (F.tid >> 3)) * PWP + O_GV + hh * 128 + (F.tid & 7) * 16 + 8); \
    float w2f[16], w2b[16]; \
    _Pragma("unroll") for (int j = 0; j < 16; ++j) { w2f[j] = P->in[I_WGF][(size_t)l * 16 * 256 + j * 256 + dcol]; w2b[j] = P->in[I_WGB][(size_t)l * 16 * 256 + j * 256 + dcol]; } \
    const float b2f = P->in[I_BGF][l * 256 + dcol], b2b = P->in[I_BGB][l * 256 + dcol]; \
    float kraw[8]; \
    _Pragma("unroll") for (int i = 0; i < 8; ++i) kraw[i] = bf2f(U[(size_t)(row0 + tg * 8 + i) * PWP + O_GK + hh * 64 + d]);
#define GLA_STAGE_LOW_VT() do { LAS float* low_ = (LAS float*)(F.lds + GL_LOW); const int t_ = F.tid >> 3, j4_ = (F.tid & 7) * 4, v16_ = (F.tid & 7) * 16; \
    low_[t_ * 32 + j4_] = bflo(loww.x); low_[t_ * 32 + j4_ + 1] = bfhi(loww.x); low_[t_ * 32 + j4_ + 2] = bflo(loww.y); low_[t_ * 32 + j4_ + 3] = bfhi(loww.y); \
    const unsigned w_[8] = {vva.x, vva.y, vva.z, vva.w, vvb.x, vvb.y, vvb.z, vvb.w}; \
    _Pragma("unroll") for (int i = 0; i < 8; ++i) { VT[(v16_ + 2 * i) * GPD + t_] = (bf16_t)(w_[i] & 0xffffu); VT[(v16_ + 2 * i + 1) * GPD + t_] = (bf16_t)(w_[i] >> 16); } } while (0)
DI void gla_a_item(KParams P, Frame& F, int l, int ci, int hh) {
    const bf16_t* U = WSP(bf16_t, WS_U); bf16_t* Sloc = WSP(bf16_t, WS_SLOC); float* dec = WSP(float, WS_DEC);
    int b, row0, jf, jb; gla_chunk_decode(ci, b, row0, jf, jb);
    LAS bf16_t* VT = (LAS bf16_t*)(F.lds + GL_VT); LAS bf16_t* KET = (LAS bf16_t*)(F.lds + GL_A0);
    const int r = F.lane & 31, h = F.lane >> 5, mb = F.wave & 1, nb = F.wave >> 1;
    GLA_PRELOAD();
    GLA_STAGE_LOW_VT();
    __syncthreads();
#pragma unroll
    for (int dir = 0; dir < 2; ++dir) {
        float cs[8], off, total, mid; gla_decay(F, dir, dir ? w2b : w2f, dir ? b2b : b2f, cs, off, total, mid);
        const int cidx = gla_cidx(b, hh, dir, dir ? jb : jf);
#pragma unroll
        for (int i = 0; i < 8; ++i) KET[d * GPD + tg * 8 + i] = f2bf(kraw[i] * __expf(total - (off + cs[i])));
        if (tg == 0) dec[(size_t)cidx * 64 + d] = __expf(total);
        __syncthreads();
        f32x16 acc;
#pragma unroll
        for (int i = 0; i < 16; ++i) acc[i] = 0.f;
        lds_mma_nt(acc, KET, 32 * mb, VT, 32 * nb, r, h);
        bf16_t* sp = Sloc + ((size_t)cidx * 128 + 32 * nb + r) * 64 + 32 * mb + 4 * h;
#pragma unroll
        for (int g = 0; g < 4; ++g) *(u32x2*)(sp + 8 * g) = (u32x2){pk2(acc[4 * g], acc[4 * g + 1]), pk2(acc[4 * g + 2], acc[4 * g + 3])};
        __syncthreads();
    }
}
DI void gla_scan(KParams P, Frame& F) {
    const bf16_t* Sloc = WSP(bf16_t, WS_SLOC); const float* dec = WSP(float, WS_DEC); bf16_t* Sin = WSP(bf16_t, WS_SIN);
    for (int e = F.bid * 512 + F.tid; e < 32 * 4096; e += F.G * 512) { const int chain = e >> 12, vd = (e & 4095) * 2, d = vd & 63; float S0 = 0.f, S1 = 0.f;
#pragma unroll 1
        for (int j0 = 0; j0 < NCHAIN; j0 += 12) { f32x2_t sl[12], dc[12];
#pragma unroll
            for (int j = 0; j < 12; ++j) { const size_t idx = (size_t)chain * NCHAIN + j0 + j; { const unsigned w = *(const unsigned*)(Sloc + idx * 8192 + vd); sl[j] = (f32x2_t){bflo(w), bfhi(w)}; } dc[j] = *(const f32x2_t*)(dec + idx * 64 + d); }
#pragma unroll
            for (int j = 0; j < 12; ++j) { const size_t idx = (size_t)chain * NCHAIN + j0 + j; *(unsigned*)(Sin + idx * 8192 + vd) = pk2(S0, S1); S0 = dc[j][0] * S0 + sl[j][0]; S1 = dc[j][1] * S1 + sl[j][1]; } } }
}
DI void gla_b_item(KParams P, Frame& F, int l, int ci, int hh) {
    const bf16_t* U = WSP(bf16_t, WS_U); const bf16_t* Sin = WSP(bf16_t, WS_SIN); bf16_t* acts = WSP(bf16_t, WS_ACTS);
    int b, row0, jf, jb; gla_chunk_decode(ci, b, row0, jf, jb);
    LAS bf16_t* VT = (LAS bf16_t*)(F.lds + GL_VT); LAS bf16_t* QD = (LAS bf16_t*)(F.lds + GL_A0); LAS bf16_t* KD = (LAS bf16_t*)(F.lds + GL_KD); LAS bf16_t* QI = (LAS bf16_t*)(F.lds + GL_QI);
    LAS bf16_t* ST = (LAS bf16_t*)(F.lds + GL_ST); LAS bf16_t* PP = (LAS bf16_t*)(F.lds + GL_PP); LAS float* OB = (LAS float*)(F.lds + GL_OB);
    const int r = F.lane & 31, h = F.lane >> 5, tb = F.wave & 1, vb = F.wave >> 1;
    GLA_PRELOAD();
    float qraw[8];
#pragma unroll
    for (int i = 0; i < 8; ++i) qraw[i] = bf2f(U[(size_t)(row0 + tg * 8 + i) * PWP + O_GQ + hh * 64 + d]) * 0.125f;
    const int sv = F.tid >> 2, sd16 = (F.tid & 3) * 16;
    const bf16_t* spf = Sin + ((size_t)gla_cidx(b, hh, 0, jf) * 128 + sv) * 64 + sd16; const bf16_t* spb = Sin + ((size_t)gla_cidx(b, hh, 1, jb) * 128 + sv) * 64 + sd16;
    const u32x4 sf0 = *(const u32x4*)spf, sf1 = *(const u32x4*)(spf + 8), sb0 = *(const u32x4*)spb, sb1 = *(const u32x4*)(spb + 8);
    const int ot = F.tid >> 3, ov0 = (F.tid & 7) * 16;
    const bf16_t* rp = U + (size_t)(row0 + ot) * PWP + O_GR + hh * 128 + ov0; const u32x4 r0 = *(const u32x4*)rp, r1 = *(const u32x4*)(rp + 8);
    GLA_STAGE_LOW_VT();
    __syncthreads();
    f32x16 acc;
#pragma unroll
    for (int i = 0; i < 16; ++i) acc[i] = 0.f;
#pragma unroll
    for (int dir = 0; dir < 2; ++dir) {
        float cs[8], off, total, mid; gla_decay(F, dir, dir ? w2b : w2f, dir ? b2b : b2f, cs, off, total, mid);
#pragma unroll
        for (int i = 0; i < 8; ++i) { const int t = tg * 8 + i; const float bc = off + cs[i];
            QD[t * GPD + d] = f2bf(qraw[i] * __expf(bc - mid)); KD[t * GPD + d] = f2bf(kraw[i] * __expf(mid - bc)); QI[t * GPD + d] = f2bf(qraw[i] * __expf(bc)); }
        *(LAS u32x4*)(ST + sv * GPD + sd16) = dir ? sb0 : sf0; *(LAS u32x4*)(ST + sv * GPD + sd16 + 8) = dir ? sb1 : sf1;
        __syncthreads();
        if (F.wave < 4) { const int tb2 = F.wave & 1, sb = F.wave >> 1; f32x16 a;
#pragma unroll
            for (int i = 0; i < 16; ++i) a[i] = 0.f;
            lds_mma_nt(a, QD, 32 * tb2, KD, 32 * sb, r, h);
#pragma unroll
            for (int i = 0; i < 16; ++i) { const int t = 32 * tb2 + (i & 3) + 8 * (i >> 2) + 4 * h, s2 = 32 * sb + r; const bool keep = dir ? (s2 >= t) : (s2 <= t);
                PP[t * GPD + s2] = f2bf(keep ? a[i] : 0.f); } }
        __syncthreads();
        lds_mma_nt(acc, PP, 32 * tb, VT, 32 * vb, r, h);
        lds_mma_nt(acc, QI, 32 * tb, ST, 32 * vb, r, h);
        __syncthreads();
    }
#pragma unroll
    for (int i = 0; i < 16; ++i) OB[(32 * tb + (i & 3) + 8 * (i >> 2) + 4 * h) * 128 + 32 * vb + r] = acc[i];
    __syncthreads();
    { float x[16]; float ss = 0.f;
#pragma unroll
      for (int q = 0; q < 4; ++q) { const f32x4 o = *(const LAS f32x4*)(OB + ot * 128 + ov0 + 4 * q); x[4 * q] = o[0]; x[4 * q + 1] = o[1]; x[4 * q + 2] = o[2]; x[4 * q + 3] = o[3]; }
#pragma unroll
      for (int i = 0; i < 16; ++i) ss += x[i] * x[i];
      ss += __shfl_xor(ss, 1); ss += __shfl_xor(ss, 2); ss += __shfl_xor(ss, 4);
      const float rstd = 1.f / sqrtf(ss * (1.f / 128.f) + EPS);
      const unsigned rw[8] = {r0.x, r0.y, r0.z, r0.w, r1.x, r1.y, r1.z, r1.w}; const float* gn = P->in[I_GGLAN] + l * 128 + ov0; unsigned ow[8];
#pragma unroll
      for (int i = 0; i < 8; ++i) ow[i] = pk2(x[2 * i] * rstd * gn[2 * i] * siluf(bflo(rw[i])), x[2 * i + 1] * rstd * gn[2 * i + 1] * siluf(bfhi(rw[i])));
      bf16_t* op = acts + ((size_t)2 * TT + row0 + ot) * 512 + hh * 128 + ov0;
      *(u32x4*)op = (u32x4){ow[0], ow[1], ow[2], ow[3]}; *(u32x4*)(op + 8) = (u32x4){ow[4], ow[5], ow[6], ow[7]}; }
    __syncthreads();
}
DI float at_max2(float a, float b) { return __builtin_amdgcn_fmed3f(a, b, INFINITY); }
constexpr int AT_KC = 1040, AT_VG = 520;
constexpr int AT_K0 = 0, AT_K1 = 16 * AT_KC, AT_V0 = 32 * AT_KC, AT_V1 = 32 * AT_KC + 16 * AT_VG;
DI void attn_unit(KParams P, Frame& F, int b, int hh, int qrow0, int nlat) {
    const bf16_t* Q = WSP(bf16_t, WS_Q); const bf16_t* KN = WSP(bf16_t, WS_KN); const bf16_t* KRP = WSP(bf16_t, WS_KRP); const bf16_t* VT = WSP(bf16_t, WS_VT); bf16_t* acts = WSP(bf16_t, WS_ACTS);
    const int ntile = nlat + 4; const int r = F.lane & 31, h = F.lane >> 5;
    const int kvi = F.tid >> 3, kc = F.tid & 7;
    const float C = 0.10206207261596577f * 1.4426950408889634f;
    const int qrow = qrow0 + 32 * F.wave + r; const bf16_t* qp = Q + (size_t)qrow * 768 + hh * 96;
    bf16x8 qf[8];
#pragma unroll
    for (int s = 0; s < 4; ++s) { const u32x4 a = *(const u32x4*)(qp + 16 * s + 8 * h);
        u32x4 o; o.x = pk2(C * bflo(a.x), C * bfhi(a.x)); o.y = pk2(C * bflo(a.y), C * bfhi(a.y)); o.z = pk2(C * bflo(a.z), C * bfhi(a.z)); o.w = pk2(C * bflo(a.w), C * bfhi(a.w)); qf[s] = __builtin_bit_cast(bf16x8, o); }
    { const u32x4 a1 = *(const u32x4*)(qp + 64), a2 = *(const u32x4*)(qp + 72), c1 = *(const u32x4*)(qp + 80), c2 = *(const u32x4*)(qp + 88);
      const float ra1[8] = {bflo(a1.x), bfhi(a1.x), bflo(a1.y), bfhi(a1.y), bflo(a1.z), bfhi(a1.z), bflo(a1.w), bfhi(a1.w)}, ra2[8] = {bflo(a2.x), bfhi(a2.x), bflo(a2.y), bfhi(a2.y), bflo(a2.z), bfhi(a2.z), bflo(a2.w), bfhi(a2.w)};
      const float rc1[8] = {bflo(c1.x), bfhi(c1.x), bflo(c1.y), bfhi(c1.y), bflo(c1.z), bfhi(c1.z), bflo(c1.w), bfhi(c1.w)}, rc2[8] = {bflo(c2.x), bfhi(c2.x), bflo(c2.y), bfhi(c2.y), bflo(c2.z), bfhi(c2.z), bflo(c2.w), bfhi(c2.w)};
      float ur[8], uc[8], xr[8], xc[8];
      const int pos = qrow & (SEQ - 1); const float prow = (float)(pos >> 6), pcol = (float)(pos & 63);
#pragma unroll
      for (int i = 0; i < 8; ++i) { ur[i] = C * (h ? ra2[i] : ra1[i]); uc[i] = C * (h ? rc2[i] : rc1[i]);
          if (nlat > 0) { const float f = rope_freq(i); float sn = __sinf(prow * f), cs = __cosf(prow * f); xr[i] = C * (h ? (ra1[i] * sn + ra2[i] * cs) : (ra1[i] * cs - ra2[i] * sn));
              sn = __sinf(pcol * f); cs = __cosf(pcol * f); xc[i] = C * (h ? (rc1[i] * sn + rc2[i] * cs) : (rc1[i] * cs - rc2[i] * sn)); }
          else { xr[i] = 0.f; xc[i] = 0.f; } }
      u32x4 o;
      o.x = pk2(xr[0], xr[1]); o.y = pk2(xr[2], xr[3]); o.z = pk2(xr[4], xr[5]); o.w = pk2(xr[6], xr[7]); qf[4] = __builtin_bit_cast(bf16x8, o);
      o.x = pk2(xc[0], xc[1]); o.y = pk2(xc[2], xc[3]); o.z = pk2(xc[4], xc[5]); o.w = pk2(xc[6], xc[7]); qf[5] = __builtin_bit_cast(bf16x8, o);
      o.x = pk2(ur[0], ur[1]); o.y = pk2(ur[2], ur[3]); o.z = pk2(ur[4], ur[5]); o.w = pk2(ur[6], ur[7]); qf[6] = __builtin_bit_cast(bf16x8, o);
      o.x = pk2(uc[0], uc[1]); o.y = pk2(uc[2], uc[3]); o.z = pk2(uc[4], uc[5]); o.w = pk2(uc[6], uc[7]); qf[7] = __builtin_bit_cast(bf16x8, o); }
    u32x4 kA0, kA1, vA, kB0, kB1, vB;
#define AT_KROW(tl) (((tl) < nlat) ? (b * SEQ + (tl) * 64) : (TLAT + b * CTXL + ((tl) - nlat) * 64))
#define AT_LOADK(tl, R0, R1) do { const int krow0_ = AT_KROW(tl); R0 = *(const u32x4*)(KN + (size_t)(krow0_ + kvi) * 512 + hh * 64 + kc * 8); R1 = *(const u32x4*)(KRP + (size_t)(krow0_ + kvi) * 64 + kc * 8); } while (0)
#define AT_LOADV(tl, R) do { const int krow0_ = AT_KROW(tl); R = *(const u32x4*)(VT + (size_t)(hh * 64 + kvi) * TT + krow0_ + kc * 8); } while (0)
#define AT_STOREK(buf, R0, R1) do { LAS unsigned char* kb_ = F.lds + ((buf) ? AT_K1 : AT_K0); *(LAS u32x4*)(kb_ + kc * AT_KC + kvi * 16) = R0; *(LAS u32x4*)(kb_ + (8 + kc) * AT_KC + kvi * 16) = R1; } while (0)
#define AT_STOREV(buf, R) do { LAS unsigned char* vb_ = F.lds + ((buf) ? AT_V1 : AT_V0); *(LAS u32x2*)(vb_ + (kc & ~1) * AT_KC + kvi * 16 + (kc & 1) * 8) = (u32x2){R.x, R.y}; *(LAS u32x2*)(vb_ + ((kc & ~1) + 1) * AT_KC + kvi * 16 + (kc & 1) * 8) = (u32x2){R.z, R.w}; } while (0)
#define AT_QK(P0, P1, buf, LAT) do { const LAS unsigned char* kb_ = F.lds + ((buf) ? AT_K1 : AT_K0); \
        _Pragma("unroll") for (int i = 0; i < 16; ++i) { P0[i] = 0.f; P1[i] = 0.f; } \
        _Pragma("unroll") for (int s = 0; s < 8; ++s) if ((LAT) ? (s < 6) : (s < 4 || s >= 6)) { const bf16x8 ka0 = *(const LAS bf16x8*)(kb_ + (2 * s + h) * AT_KC + r * 16), ka1 = *(const LAS bf16x8*)(kb_ + (2 * s + h) * AT_KC + (32 + r) * 16); \
            P0 = __builtin_amdgcn_mfma_f32_32x32x16_bf16(ka0, qf[s], P0, 0, 0, 0); P1 = __builtin_amdgcn_mfma_f32_32x32x16_bf16(ka1, qf[s], P1, 0, 0, 0); } } while (0)
#define AT_COMPUTE(tl, LAT) do { const int cur = (tl) & 1; f32x16 pc0, pc1; \
        AT_QK(pc0, pc1, cur, LAT);                                                 \
        const LAS unsigned char* vb = F.lds + (cur ? AT_V1 : AT_V0); \
        float mxa = at_max2(pc0[0], pc0[1]), mxb = at_max2(pc1[0], pc1[1]); \
        _Pragma("unroll") for (int i = 2; i < 16; ++i) { mxa = at_max2(mxa, pc0[i]); mxb = at_max2(mxb, pc1[i]); } \
        float mx = at_max2(mxa, mxb); mx = at_max2(mx, __shfl_xor(mx, 32)); \
        const float mnew = at_max2(m_run, mx), alpha = __builtin_amdgcn_exp2f(m_run - mnew); m_run = mnew; \
        const f32x2_t nm2 = (f32x2_t){-mnew, -mnew}; f32x2_t ps2 = (f32x2_t){0.f, 0.f};                  \
        _Pragma("unroll") for (int i = 0; i < 8; ++i) { \
            f32x2_t ta = (f32x2_t){pc0[2 * i], pc0[2 * i + 1]} + nm2, tb = (f32x2_t){pc1[2 * i], pc1[2 * i + 1]} + nm2; \
            ta[0] = __builtin_amdgcn_exp2f(ta[0]); ta[1] = __builtin_amdgcn_exp2f(ta[1]); tb[0] = __builtin_amdgcn_exp2f(tb[0]); tb[1] = __builtin_amdgcn_exp2f(tb[1]); \
            ps2 = ps2 + (ta + tb); pc0[2 * i] = ta[0]; pc0[2 * i + 1] = ta[1]; pc1[2 * i] = tb[0]; pc1[2 * i + 1] = tb[1]; } \
        const float psum = ps2[0] + ps2[1]; \
        l_run = l_run * alpha + psum; \
        _Pragma("unroll") for (int i = 0; i < 16; ++i) { o0[i] *= alpha; o1[i] *= alpha; } \
        bf16x8 pf[4]; \
        { u32x4 w; \
          w.x = pk2(pc0[0], pc0[1]); w.y = pk2(pc0[2], pc0[3]); w.z = pk2(pc0[4], pc0[5]); w.w = pk2(pc0[6], pc0[7]); pf[0] = __builtin_bit_cast(bf16x8, w); \
          w.x = pk2(pc0[8], pc0[9]); w.y = pk2(pc0[10], pc0[11]); w.z = pk2(pc0[12], pc0[13]); w.w = pk2(pc0[14], pc0[15]); pf[1] = __builtin_bit_cast(bf16x8, w); \
          w.x = pk2(pc1[0], pc1[1]); w.y = pk2(pc1[2], pc1[3]); w.z = pk2(pc1[4], pc1[5]); w.w = pk2(pc1[6], pc1[7]); pf[2] = __builtin_bit_cast(bf16x8, w); \
          w.x = pk2(pc1[8], pc1[9]); w.y = pk2(pc1[10], pc1[11]); w.z = pk2(pc1[12], pc1[13]); w.w = pk2(pc1[14], pc1[15]); pf[3] = __builtin_bit_cast(bf16x8, w); } \
        _Pragma("unroll") for (int s = 0; s < 4; ++s) { \
            const u32x4 va0 = *(const LAS u32x4*)(vb + (2 * s + h) * AT_KC + r * 16), va1 = *(const LAS u32x4*)(vb + (2 * s + h) * AT_KC + (32 + r) * 16); \
            o0 = __builtin_amdgcn_mfma_f32_32x32x16_bf16(__builtin_bit_cast(bf16x8, va0), pf[s], o0, 0, 0, 0); \
            o1 = __builtin_amdgcn_mfma_f32_32x32x16_bf16(__builtin_bit_cast(bf16x8, va1), pf[s], o1, 0, 0, 0); } } while (0)
#define AT_ITER(tl, LAT, LK0, LK1, LV, SK0, SK1, SV) do { \
        if ((tl) + 2 < ntile) { AT_LOADK((tl) + 2, LK0, LK1); AT_LOADV((tl) + 2, LV); } \
        AT_COMPUTE(tl, LAT); \
        if ((tl) + 1 < ntile) { AT_STOREK(((tl) & 1) ^ 1, SK0, SK1); AT_STOREV(((tl) & 1) ^ 1, SV); } \
        __syncthreads(); } while (0)
    float m_run = -INFINITY, l_run = 0.f; f32x16 o0, o1;
#pragma unroll
    for (int i = 0; i < 16; ++i) { o0[i] = 0.f; o1[i] = 0.f; }
    AT_LOADK(0, kA0, kA1); AT_LOADV(0, vA); AT_LOADK(1, kB0, kB1); AT_LOADV(1, vB);
    AT_STOREK(0, kA0, kA1); AT_STOREV(0, vA);
    __syncthreads();
#pragma unroll 1
    for (int tl = 0; tl < nlat; tl += 2) {
        AT_ITER(tl, true, kA0, kA1, vA, kB0, kB1, vB);
        AT_ITER(tl + 1, true, kB0, kB1, vB, kA0, kA1, vA);
    }
#pragma unroll 1
    for (int tl = nlat; tl < ntile; tl += 2) {
        AT_ITER(tl, false, kA0, kA1, vA, kB0, kB1, vB);
        AT_ITER(tl + 1, false, kB0, kB1, vB, kA0, kA1, vA);
    }
#undef AT_COMPUTE
#undef AT_ITER
#undef AT_KROW
#undef AT_LOADK
#undef AT_LOADV
#undef AT_STOREK
#undef AT_STOREV
#undef AT_QK
    const float inv = 1.f / (l_run + __shfl_xor(l_run, 32));
    bf16_t* op = acts + (size_t)qrow * 512 + hh * 64 + 4 * h;
#pragma unroll
    for (int g = 0; g < 4; ++g) { u32x2 w; w.x = pk2(o0[4 * g] * inv, o0[4 * g + 1] * inv); w.y = pk2(o0[4 * g + 2] * inv, o0[4 * g + 3] * inv); *(u32x2*)(op + 8 * g) = w;
        w.x = pk2(o1[4 * g] * inv, o1[4 * g + 1] * inv); w.y = pk2(o1[4 * g + 2] * inv, o1[4 * g + 3] * inv); *(u32x2*)(op + 32 + 8 * g) = w; }
}

DI KParams load_params() { KParams kp = (KParams)__builtin_amdgcn_kernarg_segment_ptr(); asm volatile("" : "+s"(kp)); return kp; }
DI Frame phase_frame(const Frame& F0) { Frame F = F0; int t = F0.tid; asm volatile("" : "+v"(t)); { int b = F0.bid, g = F0.G; asm volatile("" : "+s"(b), "+s"(g)); F.bid = b; F.G = g; F.NGW = g * 8; } F.tid = t; F.lane = t & 63; F.wave = __builtin_amdgcn_readfirstlane(t >> 6); F.gw = F.bid * 8 + F.wave; return F; }
constexpr int PH_PER_LAYER = 10, NPHASE = 1 + DEPTH * PH_PER_LAYER + 1;
__global__ void __launch_bounds__(512, 2) hybrid_trunk_fwd(Params P) {
    extern __shared__ __attribute__((aligned(16))) unsigned char lds_raw[];
    Frame F; F.lds = (LAS unsigned char*)lds_raw; F.tid = threadIdx.x; F.lane = F.tid & 63; F.wave = __builtin_amdgcn_readfirstlane(F.tid >> 6);
    F.G = gridDim.x; F.bid = blockIdx.x; F.gw = F.bid * 8 + F.wave; F.NGW = F.G * 8;
    const int vcu = (F.G % 8 == 0) ? (F.bid % 8) * (F.G / 8) + F.bid / 8 : F.bid;
    for (int u = F.tid; u < (LDS_BYTES - LDSX_OFF) / 4; u += 512) ((LAS unsigned*)(F.lds + LDSX_OFF))[u] = 0u;
    __syncthreads();
    const int lo = P.ph_lo, hi = P.ph_hi;
    XcdBarrier bar; bar.bar = (unsigned*)(P.ws + WS_CTL) + CW_BAR; bar.x = 0; bar.st = (volatile LAS unsigned*)(F.lds + LDSX_OFF);
    if (hi - lo > 1) bar = xcd_barrier_post((unsigned*)(P.ws + WS_CTL) + CW_BAR, (volatile LAS unsigned*)(F.lds + LDSX_OFF));
#ifndef PH_MASK
#define PH_MASK 0xffff
#endif
#define PHM(b) ((PH_MASK >> (b)) & 1)
#ifndef DUP_MASK
#define DUP_MASK 0
#endif
#define REP(b) (1 + ((DUP_MASK >> (b)) & 1))
#define IN(k) (lo <= (k) && (k) < hi)
#ifndef DUP_BAR
#define DUP_BAR 0
#endif
#define SEAM(k) do { if (IN(k) && IN((k) + 1)) { xcd_barrier(bar); if (DUP_BAR) xcd_barrier(bar); } } while (0)
    if (PHM(0) && IN(0)) for (int rep_ = 0; rep_ < REP(0); ++rep_) { KParams Q = load_params(); Frame Fp = phase_frame(F); phase_prologue(Q, Fp);
        conv_mixed(Q, Fp, 0, 0, NS_ALL, 0, NL_ITEMS, Fp.bid, Fp.G); }
    SEAM(0);
    for (int l = 0; l < DEPTH; ++l) {
        const int pb = 1 + PH_PER_LAYER * l;
        if (PHM(1) && IN(pb + 0)) for (int rep_ = 0; rep_ < REP(1); ++rep_) { KParams Q = load_params(); Frame Fp = phase_frame(F); phase_norm1(Q, Fp, l, rep_ + 1 < REP(1)); }
        SEAM(pb + 0);
        if (PHM(2) && IN(pb + 1)) for (int rep_ = 0; rep_ < REP(2); ++rep_) { KParams Q = load_params(); Frame Fp = phase_frame(F);
            const bool lastl = (l == DEPTH - 1); const int nM1 = lastl ? TLAT / 256 : TT / 256;
            pg8::Gemm g8{(const bf16_t*)(Q->ws + WS_H8), (const bf16_t*)(Q->ws + WS_W8 + (size_t)l * PWP * DM), DM / 2, 0, 0};
            pg8::TrimOrder S8{nM1, PWP / 256, nM1 * (PWP / 256), lastl ? (TCTX / 256) * 6 : 0, Fp.G, Fp.bid};
            pg8::EpiStoreQ E8{(bf16_t*)(Q->ws + WS_U), PWP, (const float*)(Q->ws + WS_RA), (const float*)(Q->ws + WS_RB) + (size_t)l * PWP, Q->ws + WS_G8};
            pg8::gemm_phase_i8<pg8::EpiStoreQ, pg8::TrimOrder>(Fp.lds, g8, S8, E8); }
        SEAM(pb + 1);
        if (PHM(3) && IN(pb + 2)) for (int rep_ = 0; rep_ < REP(3); ++rep_) { KParams Q = load_params(); Frame Fp = phase_frame(F); bf16_t* U = (bf16_t*)(Q->ws + WS_U); (void)U; mla_prep_rows(Q, Fp, l);
            const int ncf = (l == DEPTH - 1) ? TLAT / 32 : TT / 32;
            for (int it = vcu; it < ncf; it += Fp.G) cf_sc_tile(Q, Fp, l, it);
            { const int extra = ncf > Fp.G ? ncf - Fp.G : 0;
              if (vcu >= extra) for (int it = vcu - extra; it < 144 * 4; it += Fp.G - extra) gla_a_item(Q, Fp, l, it >> 2, it & 3); } }
        SEAM(pb + 2);
        if (PHM(4) && IN(pb + 3)) for (int rep_ = 0; rep_ < REP(4); ++rep_) { KParams Q = load_params(); Frame Fp = phase_frame(F); bf16_t* U = (bf16_t*)(Q->ws + WS_U); (void)U;
            const int nq = ((l == DEPTH - 1) ? TLAT / 256 : TT / 256) * 3;
            { pg8::Gemm g{WSQ(bf16_t, WS_CQN), WSQ(bf16_t, WS_WUQ) + (size_t)l * 768 * 512, 512, 0, 0}; pg8::RangeOrder S{0, nq, 3, Fp.G, Fp.bid}; pg8::EpiStore E{WSQ(bf16_t, WS_Q), 768};
              pg8::gemm_phase<pg8::EpiStore, pg8::RangeOrder>(Fp.lds, g, S, E); }
            { const bf16_t* ckvn = WSQ(bf16_t, WS_CKVN); const bf16_t* wkn = WSQ(bf16_t, WS_WKN) + (size_t)l * 512 * 256; const bf16_t* wv = WSQ(bf16_t, WS_WV) + (size_t)l * 512 * 256;
              pg8::Gemm g{ckvn, wkn, 256, (size_t)((const char*)wv - (const char*)ckvn), (size_t)((const char*)ckvn - (const char*)wkn)};
              pg8::Range2Order S{nq, 72, 2, 72, 36, Fp.G, Fp.bid}; pg8::EpiStore2 E{WSQ(bf16_t, WS_KN), 512, WSQ(bf16_t, WS_VT), TT};
              pg8::gemm_phase<pg8::EpiStore2, pg8::Range2Order>(Fp.lds, g, S, E); }
            gla_scan(Q, Fp); }
        SEAM(pb + 3);
        if (PHM(5) && IN(pb + 4)) for (int rep_ = 0; rep_ < REP(5); ++rep_) { KParams Q = load_params(); Frame Fp = phase_frame(F); bf16_t* U = (bf16_t*)(Q->ws + WS_U); (void)U;
            for (int u = vcu; u < 256; u += Fp.G) attn_unit(Q, Fp, u >> 6, (u >> 3) & 7, (u >> 6) * SEQ + (u & 7) * 256, 32);
            const bool lastl = (l == DEPTH - 1);
            if (!lastl) for (int u = vcu; u < 32; u += Fp.G) attn_unit(Q, Fp, u >> 3, u & 7, TLAT + (u >> 3) * CTXL, 0);
            for (int it = vcu; it < (lastl ? 128 : 144) * 4; it += Fp.G) gla_b_item(Q, Fp, l, it >> 2, it & 3); }
        SEAM(pb + 4);
        if (PHM(6) && IN(pb + 5)) for (int rep_ = 0; rep_ < REP(6); ++rep_) { KParams Q = load_params(); Frame Fp = phase_frame(F); bf16_t* U = (bf16_t*)(Q->ws + WS_U); (void)U; pg8::Gemm g{WSQ(bf16_t, WS_ACTS), WSQ(bf16_t, WS_WBR) + (size_t)l * 4 * DM * 512, 512, (size_t)TT * 512 * 2, (size_t)DM * 512 * 2}; pg8::MergeOrder S; S.init((l == DEPTH - 1) ? TLAT : TT, DM, Fp.G, Fp.bid);
            LAS float* gtab = (LAS float*)(Fp.lds + LDSX_OFF + 4096);
            if (Fp.tid < 256) { const float x = (float)(Fp.tid - 128) * (GATE_CLIP / 127.f), e = expf(-x); gtab[Fp.tid] = 1.f / (1.f + e); gtab[256 + Fp.tid] = 1.f + e; }
            __syncthreads();
            pg8::EpiMerge E{WSQ(bf16_t, WS_YM), (const unsigned char*)(Q->ws + WS_G8), gtab}; pg8::gemm_phase<pg8::EpiMerge, pg8::MergeOrder>(Fp.lds, g, S, E);
            if (l + 1 < DEPTH && rep_ == 0) { KParams Q2 = load_params(); Frame F2 = phase_frame(F); const int extra = (TT / 256) * (DM / 256) % F2.G; conv_mixed(Q2, F2, l + 1, 0, 600, 0, NL_F1, extra ? F2.bid - extra : F2.bid, extra ? F2.G - extra : F2.G); } }
        SEAM(pb + 5);
        if (PHM(7) && IN(pb + 6)) for (int rep_ = 0; rep_ < REP(7); ++rep_) { KParams Q = load_params(); Frame Fp = phase_frame(F); bf16_t* U = (bf16_t*)(Q->ws + WS_U); (void)U; pg8::Gemm g{WSQ(bf16_t, WS_YM), WSQ(bf16_t, WS_WMIX) + (size_t)l * DM * DM, DM, 0, 0}; pg8::StaticOrder S; S.init((l == DEPTH - 1) ? TLAT : TT, DM, Fp.G, Fp.bid);
            pg8::EpiResid E{WSQ(bf16_t, WS_X), WSQ(float, WS_MOD) + (size_t)l * 5 * (6 * DM) + 2 * DM, (rep_ + 1 < REP(7)) ? WSQ(bf16_t, WS_OUTS) : WSQ(bf16_t, WS_X)}; pg8::gemm_phase<pg8::EpiResid, pg8::StaticOrder>(Fp.lds, g, S, E);
            if (l + 1 < DEPTH && rep_ == 0) { KParams Q2 = load_params(); Frame F2 = phase_frame(F); const int extra = (TT / 256) * (DM / 256) % F2.G; conv_mixed(Q2, F2, l + 1, 600, 870, NL_F1, NL_F2, extra ? F2.bid - extra : F2.bid, extra ? F2.G - extra : F2.G); } }
        SEAM(pb + 6);
        if (PHM(8) && IN(pb + 7)) for (int rep_ = 0; rep_ < REP(8); ++rep_) { KParams Q = load_params(); Frame Fp = phase_frame(F); phase_norm2_route(Q, Fp, l, (rep_ + 1 < REP(8)) ? l + 4 : l); }
        SEAM(pb + 7);
        if (PHM(10) && IN(pb + 8)) for (int rep_ = 0; rep_ < REP(10); ++rep_) { KParams Q = load_params(); Frame Fp = phase_frame(F); bf16_t* U = (bf16_t*)(Q->ws + WS_U); (void)U; moe_table(Q, Fp, l);
            const LAS int* tpt = (const LAS int*)(Fp.lds + LDSX_OFF + 64);
            pg8::Gemm g{WSQ(bf16_t, WS_H), (const bf16_t*)(Q->ws + WS_W1 + (size_t)l * 16 * 1024 * DM), DM / 2, 0, (size_t)1024 * DM}; pg8::MoeOrder S{tpt, 4, Fp.G, Fp.bid};
            pg8::EpiSwiGLUQG E{WSQ(bf16_t, WS_ACTM), (const float*)(Q->ws + WS_ERW), (const float*)(Q->ws + WS_ERS), (const float*)(Q->ws + WS_RB1) + (size_t)l * 16 * 1024, tpt};
            pg8::gemm_phase_i8<pg8::EpiSwiGLUQG, pg8::MoeOrder, true>(Fp.lds, g, S, E, (const int*)(Q->ws + WS_ETOK), tpt);
            if (l + 1 < DEPTH && rep_ == 0) { KParams Q2 = load_params(); Frame F2 = phase_frame(F); const int nun = ((const LAS int*)(F2.lds + LDSX_OFF + 64))[16] * 4, extra = nun % F2.G;
                conv_mixed(Q2, F2, l + 1, 870, NS_ALL, NL_F2, NL_ITEMS, extra ? F2.bid - extra : F2.bid, extra ? F2.G - extra : F2.G); } }
        SEAM(pb + 8);
        if (PHM(11) && IN(pb + 9)) for (int rep_ = 0; rep_ < REP(11); ++rep_) { KParams Q = load_params(); Frame Fp = phase_frame(F); bf16_t* U = (bf16_t*)(Q->ws + WS_U); (void)U; moe_table(Q, Fp, l);
            pg8::Gemm g{WSQ(bf16_t, WS_ACTM), WSQ(bf16_t, WS_W2) + (size_t)l * 16 * DM * EFF, EFF, 0, (size_t)DM * EFF * 2}; pg8::MoeOrder S{(const LAS int*)(Fp.lds + LDSX_OFF + 64), 8, Fp.G, Fp.bid};
            pg8::EpiStore E{WSQ(bf16_t, WS_OUTS), DM}; pg8::gemm_phase<pg8::EpiStore, pg8::MoeOrder>(Fp.lds, g, S, E); }
        SEAM(pb + 9);
    }
    if (PHM(12) && IN(NPHASE - 1)) for (int rep_ = 0; rep_ < REP(12); ++rep_) { KParams Q = load_params(); Frame Fp = phase_frame(F); phase_final(Q, Fp); }
#undef IN
#undef SEAM
}

#ifndef MK_ONE_LAUNCH
#define MK_ONE_LAUNCH 1
#endif
extern "C" void kernel_launch(void* const* d_in, const int* in_sizes, int n_in, void* d_out, int out_size, void* d_ws, size_t ws_size, hipStream_t stream) {
    static int grid = 0;
    if (grid == 0) {
        if (n_in != 34 || out_size != TLAT * DM || ws_size < WS_END) { fprintf(stderr, "kernel_launch: unexpected problem: n_in %d out %d ws %zu (need %zu)\n", n_in, out_size, ws_size, (size_t)WS_END); grid = -1; return; }
        int dev = 0, cus = 0, per_cu = 0;
        if (hipGetDevice(&dev) != hipSuccess || hipDeviceGetAttribute(&cus, hipDeviceAttributeMultiprocessorCount, dev) != hipSuccess) { grid = -1; return; }
        if (hipFuncSetAttribute((const void*)hybrid_trunk_fwd, hipFuncAttributeMaxDynamicSharedMemorySize, LDS_BYTES) != hipSuccess) { fprintf(stderr, "kernel_launch: hipFuncSetAttribute failed\n"); grid = -1; return; }
        if (hipOccupancyMaxActiveBlocksPerMultiprocessor(&per_cu, (const void*)hybrid_trunk_fwd, 512, LDS_BYTES) != hipSuccess || per_cu < 1) { fprintf(stderr, "kernel_launch: occupancy query says %d\n", per_cu); }
        (void)hipGetLastError();
        grid = cus;
    }
    if (grid < 0) return;
    (void)hipMemsetAsync((char*)d_ws + WS_CTL, 0, CTL_ZERO_BYTES, stream);
    Params p{};
    for (int i = 0; i < 34; ++i) p.in[i] = (const float*)d_in[i];
    p.out = (float*)d_out; p.ws = (unsigned char*)d_ws;
#if MK_ONE_LAUNCH
    p.ph_lo = 0; p.ph_hi = NPHASE;
    hipLaunchKernelGGL(hybrid_trunk_fwd, dim3(grid), dim3(512), LDS_BYTES, stream, p);
#else
    for (int k = 0; k < NPHASE; ++k) { p.ph_lo = k; p.ph_hi = k + 1; hipLaunchKernelGGL(hybrid_trunk_fwd, dim3(grid), dim3(512), LDS_BYTES, stream, p); }
#endif
}
```

```cpp
#include <hip/hip_runtime.h>
#include <cstdio>
#include <cstdint>

#define DI __device__ __forceinline__
#define LAS __attribute__((address_space(3)))
typedef unsigned short bf16_t;
typedef short bf16x8 __attribute__((ext_vector_type(8)));
typedef short s16x4 __attribute__((ext_vector_type(4)));
typedef float f32x4 __attribute__((ext_vector_type(4)));
typedef float f32x16 __attribute__((ext_vector_type(16)));
typedef unsigned u32x4 __attribute__((ext_vector_type(4)));
typedef unsigned u32x2 __attribute__((ext_vector_type(2)));
typedef float f32x2_t __attribute__((ext_vector_type(2)));
typedef __bf16 bf16x2_t __attribute__((ext_vector_type(2)));
typedef int v4i_t __attribute__((ext_vector_type(4)));

constexpr int DM = 2048, NB = 4, SEQ = 2048, DEPTH = 4, CTXL = 256;
constexpr int TLAT = NB * SEQ, TCTX = NB * CTXL, TT = TLAT + TCTX;
constexpr int PW = 13120, PWP = 13312;
constexpr int O_CQ = 0, O_CKV = 512, O_KR = 768, O_CF = 800, O_GQ = 1824, O_GK = 2080, O_GV = 2336, O_GF = 2848, O_GB = 2864, O_GR = 2880, O_SC = 3392, O_MG = 4928;
constexpr int GCOL0 = 5120; constexpr float GATE_CLIP = 8.f;
DI int wcol_dest(int n0) { return n0 < O_MG ? n0 : n0 + (GCOL0 - O_MG); }
constexpr int NEXP = 16, EFF = 512, MOE_ROWS = 22528;
constexpr float EPS = 1e-6f;
constexpr int NCHAIN = 36;

DI float bflo(unsigned w) { return __uint_as_float(w << 16); }
DI float bfhi(unsigned w) { return __uint_as_float(w & 0xffff0000u); }
DI float bf2f(bf16_t v) { return __uint_as_float(((unsigned)v) << 16); }
DI unsigned pk2(float lo, float hi) { f32x2_t v = {lo, hi}; bf16x2_t b = __builtin_convertvector(v, bf16x2_t); return __builtin_bit_cast(unsigned, b); }
DI bf16_t f2bf(float f) { return (bf16_t)(pk2(f, 0.f) & 0xffffu); }
DI unsigned q8(float v) { int q = __float2int_rn(v); q = q > 127 ? 127 : q; q = q < -127 ? -127 : q; return (unsigned)q & 255u; }
DI float dpp_f(float v, int ctrl_sel) {
    const int x = __float_as_int(v); int r;
    switch (ctrl_sel) { case 0: r = __builtin_amdgcn_mov_dpp(x, 0xB1, 0xF, 0xF, true); break;
                        case 1: r = __builtin_amdgcn_mov_dpp(x, 0x4E, 0xF, 0xF, true); break;
                        case 2: r = __builtin_amdgcn_mov_dpp(x, 0x141, 0xF, 0xF, true); break;
                        default: r = __builtin_amdgcn_mov_dpp(x, 0x140, 0xF, 0xF, true); break; }
    return __int_as_float(r);
}
DI float wave_sum(float v) {
    v += dpp_f(v, 0); v += dpp_f(v, 1); v += dpp_f(v, 2); v += dpp_f(v, 3);
    { const auto r = __builtin_amdgcn_permlane16_swap(__float_as_uint(v), __float_as_uint(v), false, false); v = __uint_as_float(r[0]) + __uint_as_float(r[1]); }
    { const auto r = __builtin_amdgcn_permlane32_swap(__float_as_uint(v), __float_as_uint(v), false, false); v = __uint_as_float(r[0]) + __uint_as_float(r[1]); }
    return v;
}
DI float sigm(float x) { return __builtin_amdgcn_rcpf(1.f + __expf(-x)); }
DI float siluf(float x) { return x * __builtin_amdgcn_rcpf(1.f + __expf(-x)); }
#define LDS_WAIT() asm volatile("s_waitcnt lgkmcnt(0)" ::: "memory")
#define VM_WAIT() asm volatile("s_waitcnt vmcnt(0)" ::: "memory")

namespace pg8 {
constexpr int BM = 256, BK = 64, HALF = 128, HTB = HALF * BK * 2, STAGE_BYTES = 8 * HTB, NXCD = 8, WGM = 8;
DI int lds_byte(int r, int c) { const int st = (r >> 4) * 2 + (c >> 5), rr = r & 15, cc = c & 31, ob = rr * 64 + cc * 2; return st * 1024 + (ob ^ (((ob >> 9) & 1) << 5)); }
DI void stage_rc(int b, int& R, int& C) { const int st = b / 1024, sb = b % 1024, swz = sb ^ (((sb >> 9) & 1) << 5); R = (st >> 1) * 16 + swz / 64; C = (st & 1) * 32 + (swz % 64) / 2; }
DI int perm32(int rho) { const int n = rho >> 4, i = rho & 15; return 8 * (i >> 2) + 4 * n + (i & 3); }

struct Unit { int pm, pn, grp; };
struct Gemm { const bf16_t* A; const bf16_t* Bt; int K; size_t gsA, gsB; };

DI void tile_of(int wgid0, int nM, int nN, int& pm, int& pn) {
    const int nwg = nM * nN; int wgid = wgid0;
    { const int q = nwg / NXCD, r = nwg % NXCD, xcd = wgid % NXCD, off = wgid / NXCD; wgid = (xcd < r ? xcd * (q + 1) : r * (q + 1) + (xcd - r) * q) + off; }
    const int nig = WGM * nN, gid = wgid / nig, fm = gid * WGM, gsz = (nM - fm) < WGM ? (nM - fm) : WGM;
    pm = fm + ((wgid % nig) % gsz); pn = (wgid % nig) / gsz;
}
struct StaticOrder {
    int nM, nN, nwg, G, c;
    DI void init(int M, int N, int G_, int c_) { nM = M / BM; nN = N / BM; nwg = nM * nN; G = G_; c = c_; }
    DI bool next(int i, Unit& u) const { const int L = i * G + c; if (L >= nwg) return false; tile_of(L, nM, nN, u.pm, u.pn); u.grp = 0; return true; }
};
struct TrimOrder {
    int nM1, nN, n1, nctx, G, c;
    DI bool next(int i, Unit& u) const { const int L = i * G + c; u.grp = 0;
        if (L < n1) { tile_of(L, nM1, nN, u.pm, u.pn); return true; }
        const int q = L - n1; if (q >= nctx) return false; const int j = q % 6; u.pm = nM1 + q / 6; u.pn = j < 2 ? 2 + j : 6 + j; return true; }
};
struct RangeOrder {
    int first, count, nN, G, c;
    DI bool next(int i, Unit& u) const { const int L = i * G + c - first; if (L < 0 || L >= count) return false; u.pm = L / nN; u.pn = L % nN; u.grp = 0; return true; }
};
struct Range2Order {
    int first, count0, nN0, count1, nN1, G, c;
    DI bool next(int i, Unit& u) const { int L = i * G + c - first; if (L < 0) return false;
        if (L < count0) { u.pm = L / nN0; u.pn = L % nN0; u.grp = 0; return true; }
        L -= count0; if (L >= count1) return false; u.pm = L / nN1; u.pn = L % nN1; u.grp = 1; return true; }
};
struct MergeOrder {
    int nM, nN, nwg, G, c;
    DI void init(int M, int N, int G_, int c_) { nM = M / BM; nN = N / BM; nwg = nM * nN; G = G_; c = c_; }
    DI bool next(int i, Unit& u) const { const int L = (i >> 2) * G + c; if (L >= nwg) return false; tile_of(L, nM, nN, u.pm, u.pn); u.grp = i & 3; return true; }
};
struct MoeOrder {
    const LAS int* tp; int ncol, G, c;
    DI bool next(int i, Unit& u) const {
        const int L = i * G + c, ntile = tp[16]; if (L >= ntile * ncol) return false;
        const int rt = L / ncol; int e = 0;
#pragma unroll
        for (int j = 1; j < 16; ++j) e += (rt >= tp[j]) ? 1 : 0;
        u.pm = rt; u.pn = L % ncol; u.grp = e; return true;
    }
};

struct EpiStore {
    static constexpr bool PERM = true;
    bf16_t* O; int ldc;
    DI bool operator()(f32x4 (&acc)[2][2][4][2], const Unit& u, int wr, int wc, int fr, int fq) const {
        const int row0 = u.pm * BM + wr * 64 + fr, col0 = u.pn * BM + wc * 32 + 8 * fq;
#pragma unroll
        for (int ai = 0; ai < 2; ++ai)
#pragma unroll
            for (int m = 0; m < 4; ++m) { bf16_t* rowp = O + (size_t)(row0 + ai * HALF + m * 16) * ldc + col0;
#pragma unroll
                for (int bj = 0; bj < 2; ++bj) { const f32x4 v0 = acc[ai][bj][m][0], v1 = acc[ai][bj][m][1];
                    u32x4 w; w.x = pk2(v0[0], v0[1]); w.y = pk2(v0[2], v0[3]); w.z = pk2(v1[0], v1[1]); w.w = pk2(v1[2], v1[3]);
                    *(u32x4*)(rowp + bj * HALF) = w; } }
        return false;
    }
};
struct EpiStoreQ {
    static constexpr bool PERM = true;
    bf16_t* O; int ldc; const float* rA; const float* rB; unsigned char* G8;
    DI bool operator()(v4i_t (&acc)[2][2][4][2], const Unit& u, int wr, int wc, int fr, int fq) const {
        const int row0 = u.pm * BM + wr * 64 + fr, col0 = u.pn * BM + wc * 32 + 8 * fq;
        f32x4 cb[2][2];
#pragma unroll
        for (int bj = 0; bj < 2; ++bj) { cb[bj][0] = *(const f32x4*)(rB + col0 + bj * HALF); cb[bj][1] = *(const f32x4*)(rB + col0 + bj * HALF + 4); }
        float rav[2][4];
#pragma unroll
        for (int ai = 0; ai < 2; ++ai)
#pragma unroll
            for (int m = 0; m < 4; ++m) rav[ai][m] = rA[row0 + ai * HALF + m * 16];
        __builtin_amdgcn_sched_barrier(0);
        if (col0 >= GCOL0) {
            const float qs = 127.f / GATE_CLIP;
#pragma unroll
            for (int ai = 0; ai < 2; ++ai)
#pragma unroll
                for (int m = 0; m < 4; ++m) { const float ra = rav[ai][m] * qs;
                    unsigned char* rowp = G8 + (size_t)(u.pm * 32 + (u.pn - GCOL0 / BM)) * 65536 + (((wr * 4 + wc) * 8 + ai * 4 + m) * 64 + fr + 16 * fq) * 16;
                    unsigned ww[4] = {0u, 0u, 0u, 0u};
#pragma unroll
                    for (int bj = 0; bj < 2; ++bj) { const v4i_t a0 = acc[ai][bj][m][0], a1 = acc[ai][bj][m][1]; const f32x4 c0 = cb[bj][0] * ra, c1 = cb[bj][1] * ra;
#pragma unroll
                        for (int j = 0; j < 4; ++j) { ww[2 * bj] = __builtin_amdgcn_cvt_pk_u8_f32((float)a0[j] * c0[j] + 128.0f, j, ww[2 * bj]); ww[2 * bj + 1] = __builtin_amdgcn_cvt_pk_u8_f32((float)a1[j] * c1[j] + 128.0f, j, ww[2 * bj + 1]); } }
                    *(u32x4*)rowp = (u32x4){ww[0], ww[1], ww[2], ww[3]}; }
            return false;
        }
#pragma unroll
        for (int ai = 0; ai < 2; ++ai)
#pragma unroll
            for (int m = 0; m < 4; ++m) { const int row = row0 + ai * HALF + m * 16; const float ra = rav[ai][m]; bf16_t* rowp = O + (size_t)row * ldc + col0;
#pragma unroll
                for (int bj = 0; bj < 2; ++bj) { const v4i_t a0 = acc[ai][bj][m][0], a1 = acc[ai][bj][m][1]; const f32x4 c0 = cb[bj][0] * ra, c1 = cb[bj][1] * ra;
                    u32x4 w; w.x = pk2((float)a0[0] * c0[0], (float)a0[1] * c0[1]); w.y = pk2((float)a0[2] * c0[2], (float)a0[3] * c0[3]);
                    w.z = pk2((float)a1[0] * c1[0], (float)a1[1] * c1[1]); w.w = pk2((float)a1[2] * c1[2], (float)a1[3] * c1[3]);
                    *(u32x4*)(rowp + bj * HALF) = w; } }
        return false;
    }
};
struct EpiStore2 {
    static constexpr bool PERM = true;
    bf16_t* O0; int ldc0; bf16_t* O1; int ldc1;
    DI bool operator()(f32x4 (&acc)[2][2][4][2], const Unit& u, int wr, int wc, int fr, int fq) const {
        const EpiStore E{u.grp ? O1 : O0, u.grp ? ldc1 : ldc0}; return E(acc, u, wr, wc, fr, fq);
    }
};
struct EpiMerge {
    static constexpr bool PERM = true;
    bf16_t* Y; const unsigned char* G8;
    const LAS float* tab;
    DI static int qi(unsigned w, int i) { return (int)((w >> (8 * i)) & 255u); }
    DI bool operator()(f32x4 (&acc)[2][2][4][2], const Unit& u, int wr, int wc, int fr, int fq) const {
        const int row0 = u.pm * BM + wr * 64 + fr, col0 = u.pn * BM + wc * 32 + 8 * fq; const int grp = u.grp;
        const unsigned char* gp = G8 + (size_t)(u.pm * 32 + grp * 8 + u.pn) * 65536 + ((wr * 4 + wc) * 8 * 64 + fr + 16 * fq) * 16;
        if (grp < 3) {
            u32x4 ca[8], cb[8];
#pragma unroll
            for (int q = 0; q < 8; ++q) { ca[q] = *(const u32x4*)(gp + q * 1024); cb[q] = *(const u32x4*)(gp + 8 * 65536 + q * 1024); }
            __builtin_amdgcn_sched_barrier(0);
#pragma unroll
            for (int ai = 0; ai < 2; ++ai)
#pragma unroll
                for (int m = 0; m < 4; ++m) { const u32x4 a = ca[ai * 4 + m], b = cb[ai * 4 + m];
#pragma unroll
                    for (int bj = 0; bj < 2; ++bj) { const unsigned ax = bj ? a.z : a.x, ay = bj ? a.w : a.y, bx = bj ? b.z : b.x, by = bj ? b.w : b.y;
                        f32x4& a0 = acc[ai][bj][m][0]; f32x4& a1 = acc[ai][bj][m][1];
#pragma unroll
                        for (int j = 0; j < 4; ++j) { a0[j] *= tab[qi(ax, j)] * tab[256 + qi(bx, j)]; a1[j] *= tab[qi(ay, j)] * tab[256 + qi(by, j)]; } } }
            return true;
        }
        u32x4 cg[8];
#pragma unroll
        for (int q = 0; q < 8; ++q) cg[q] = *(const u32x4*)(gp + q * 1024);
        __builtin_amdgcn_sched_barrier(0);
#pragma unroll
        for (int ai = 0; ai < 2; ++ai)
#pragma unroll
            for (int m = 0; m < 4; ++m) { const int row = row0 + ai * HALF + m * 16; const u32x4 g4 = cg[ai * 4 + m];
                bf16_t* yp = Y + (size_t)row * DM + col0;
#pragma unroll
                for (int bj = 0; bj < 2; ++bj) { const unsigned gx = bj ? g4.z : g4.x, gy = bj ? g4.w : g4.y; const f32x4 a0 = acc[ai][bj][m][0], a1 = acc[ai][bj][m][1];
                    u32x4 w; w.x = pk2(a0[0] * tab[qi(gx, 0)], a0[1] * tab[qi(gx, 1)]); w.y = pk2(a0[2] * tab[qi(gx, 2)], a0[3] * tab[qi(gx, 3)]);
                    w.z = pk2(a1[0] * tab[qi(gy, 0)], a1[1] * tab[qi(gy, 1)]); w.w = pk2(a1[2] * tab[qi(gy, 2)], a1[3] * tab[qi(gy, 3)]);
                    *(u32x4*)(yp + bj * HALF) = w; } }
        return false;
    }
};
struct EpiResid {
    static constexpr bool PERM = true;
    bf16_t* X; const float* gate; bf16_t* XO;
    DI bool operator()(f32x4 (&acc)[2][2][4][2], const Unit& u, int wr, int wc, int fr, int fq) const {
        const int row0 = u.pm * BM + wr * 64 + fr, col0 = u.pn * BM + wc * 32 + 8 * fq;
        const int r = (u.pm < TLAT / BM) ? (u.pm >> 3) : 4; const float* gp = gate + (size_t)r * (6 * DM) + col0;
        f32x4 gv[2][2];
#pragma unroll
        for (int bj = 0; bj < 2; ++bj)
#pragma unroll
            for (int n = 0; n < 2; ++n) gv[bj][n] = *(const f32x4*)(gp + bj * HALF + n * 4);
        u32x4 xv[2][4][2];
        const unsigned ob = (unsigned)(row0 * DM + col0) * 2u;
#pragma unroll
        for (int ai = 0; ai < 2; ++ai)
#pragma unroll
            for (int m = 0; m < 4; ++m)
#pragma unroll
                for (int bj = 0; bj < 2; ++bj) xv[ai][m][bj] = *(const u32x4*)((const char*)X + (ob + (unsigned)((ai * HALF + m * 16) * DM + bj * HALF) * 2u));
        __builtin_amdgcn_sched_barrier(0);
#pragma unroll
        for (int ai = 0; ai < 2; ++ai)
#pragma unroll
            for (int m = 0; m < 4; ++m) {
#pragma unroll
                for (int bj = 0; bj < 2; ++bj) { const u32x4 x = xv[ai][m][bj]; const f32x4 a0 = gv[bj][0] * acc[ai][bj][m][0], a1 = gv[bj][1] * acc[ai][bj][m][1];
                    u32x4 o; o.x = pk2(bflo(x.x) + a0[0], bfhi(x.x) + a0[1]); o.y = pk2(bflo(x.y) + a0[2], bfhi(x.y) + a0[3]); o.z = pk2(bflo(x.z) + a1[0], bfhi(x.z) + a1[1]); o.w = pk2(bflo(x.w) + a1[2], bfhi(x.w) + a1[3]);
                    *(u32x4*)((char*)XO + (ob + (unsigned)((ai * HALF + m * 16) * DM + bj * HALF) * 2u)) = o; }
                __builtin_amdgcn_sched_barrier(0); }
        return false;
    }
};
struct EpiSwiGLUQ {
    static constexpr bool PERM = true;
    bf16_t* O; const float* roww; const float* rs; const float* rb1;
    DI bool operator()(v4i_t (&acc)[2][2][4][2], const Unit& u, int wr, int wc, int fr, int fq) const {
        const int row0 = u.pm * BM + wr * 64 + fr, col0 = u.pn * HALF + wc * 32 + 8 * fq; const float* rb = rb1 + (size_t)u.grp * 1024 + u.pn * BM + wc * 32 + 8 * fq;
        const f32x4 bg0 = *(const f32x4*)rb, bg1 = *(const f32x4*)(rb + 4), bu0 = *(const f32x4*)(rb + HALF), bu1 = *(const f32x4*)(rb + HALF + 4);
#pragma unroll
        for (int ai = 0; ai < 2; ++ai)
#pragma unroll
            for (int m = 0; m < 4; ++m) { const int row = row0 + ai * HALF + m * 16; const float w = roww[row], sa = rs[row];
                const v4i_t g0 = acc[ai][0][m][0], g1 = acc[ai][0][m][1], u0 = acc[ai][1][m][0], u1 = acc[ai][1][m][1];
                float v[8];
#pragma unroll
                for (int j = 0; j < 4; ++j) { v[j] = siluf((float)g0[j] * sa * bg0[j]) * ((float)u0[j] * sa * bu0[j]) * w; v[4 + j] = siluf((float)g1[j] * sa * bg1[j]) * ((float)u1[j] * sa * bu1[j]) * w; }
                u32x4 o; o.x = pk2(v[0], v[1]); o.y = pk2(v[2], v[3]); o.z = pk2(v[4], v[5]); o.w = pk2(v[6], v[7]);
                *(u32x4*)(O + (size_t)row * EFF + col0) = o; }
        return false;
    }
};
struct EpiSwiGLUQG {
    static constexpr bool PERM = true;
    bf16_t* O; const float* erw; const float* ers; const float* rb1; const LAS int* tpt;
    DI bool operator()(v4i_t (&acc)[2][2][4][2], const Unit& u, int wr, int wc, int fr, int fq) const {
        const int row0 = u.pm * BM + wr * 64 + fr, col0 = u.pn * HALF + wc * 32 + 8 * fq; const float* rb = rb1 + (size_t)u.grp * 1024 + u.pn * BM + wc * 32 + 8 * fq;
        const int s0 = (u.pm - tpt[u.grp]) * 256 + wr * 64 + fr, cn = tpt[32 + u.grp]; const float* pw = erw + u.grp * TT; const float* ps = ers + u.grp * TT;
        const f32x4 bg0 = *(const f32x4*)rb, bg1 = *(const f32x4*)(rb + 4), bu0 = *(const f32x4*)(rb + HALF), bu1 = *(const f32x4*)(rb + HALF + 4);
        float wv_[2][4], sv_[2][4];
#pragma unroll
        for (int ai = 0; ai < 2; ++ai)
#pragma unroll
            for (int m = 0; m < 4; ++m) { const int sl = s0 + ai * HALF + m * 16; const bool ok = sl < cn; wv_[ai][m] = ok ? pw[ok ? sl : 0] : 0.f; sv_[ai][m] = ok ? ps[ok ? sl : 0] : 0.f; }
        __builtin_amdgcn_sched_barrier(0);
#pragma unroll
        for (int ai = 0; ai < 2; ++ai)
#pragma unroll
            for (int m = 0; m < 4; ++m) { const int row = row0 + ai * HALF + m * 16; const float w = wv_[ai][m], sa = sv_[ai][m];
                const v4i_t g0 = acc[ai][0][m][0], g1 = acc[ai][0][m][1], u0 = acc[ai][1][m][0], u1 = acc[ai][1][m][1];
                float v[8];
#pragma unroll
                for (int j = 0; j < 4; ++j) { v[j] = siluf((float)g0[j] * sa * bg0[j]) * ((float)u0[j] * sa * bu0[j]) * w; v[4 + j] = siluf((float)g1[j] * sa * bg1[j]) * ((float)u1[j] * sa * bu1[j]) * w; }
                u32x4 o; o.x = pk2(v[0], v[1]); o.y = pk2(v[2], v[3]); o.z = pk2(v[4], v[5]); o.w = pk2(v[6], v[7]);
                *(u32x4*)(O + (size_t)row * EFF + col0) = o; }
        return false;
    }
};
struct EpiSwiGLU {
    static constexpr bool PERM = true;
    bf16_t* O; const float* roww;
    DI bool operator()(f32x4 (&acc)[2][2][4][2], const Unit& u, int wr, int wc, int fr, int fq) const {
        const int row0 = u.pm * BM + wr * 64 + fr, col0 = u.pn * HALF + wc * 32 + 8 * fq;
#pragma unroll
        for (int ai = 0; ai < 2; ++ai)
#pragma unroll
            for (int m = 0; m < 4; ++m) { const int row = row0 + ai * HALF + m * 16; const float w = roww[row];
                const f32x4 g0 = acc[ai][0][m][0], g1 = acc[ai][0][m][1], u0 = acc[ai][1][m][0], u1 = acc[ai][1][m][1];
                float v[8];
#pragma unroll
                for (int j = 0; j < 4; ++j) { v[j] = siluf(g0[j]) * u0[j] * w; v[4 + j] = siluf(g1[j]) * u1[j] * w; }
                u32x4 o; o.x = pk2(v[0], v[1]); o.y = pk2(v[2], v[3]); o.z = pk2(v[4], v[5]); o.w = pk2(v[6], v[7]);
                *(u32x4*)(O + (size_t)row * EFF + col0) = o; }
        return false;
    }
};

template <class Epi, class Sched>
DI void gemm_phase(LAS unsigned char* lds, const Gemm g, const Sched& S, const Epi& E) {
    int tid = threadIdx.x; asm volatile("" : "+v"(tid));
    const int wid = __builtin_amdgcn_readfirstlane(tid >> 6), lane = tid & 63, wr = wid >> 2, wc = wid & 3, fr = lane & 15, fq = lane >> 4;
    int K = g.K; asm volatile("" : "+s"(K));
    const int nt = K / BK;
    unsigned voffA[2], voffB[2], gC[2]; int gR[2];
#pragma unroll
    for (int i = 0; i < 2; ++i) { int R, C; stage_rc(tid * 16 + i * 8192, R, C); const int Rb = Epi::PERM ? ((R & ~31) + perm32(R & 31)) : R;
        voffA[i] = (unsigned)(R * K + C) * 2u; voffB[i] = (unsigned)(Rb * K + C) * 2u; gR[i] = R; gC[i] = (unsigned)C * 2u; }
    const size_t kstep = (size_t)(BK * 2);
    const size_t hstep = (size_t)HALF * K * 2;
    const size_t tstep = 2 * hstep;
    const unsigned ldsw = (unsigned)wid * 1024u;
    const int aoff = lds_byte(wr * 64 + fr, fq * 8), boff = lds_byte(wc * 32 + fr, fq * 8);
#define PG8_SA(b, h) (((b) * 2 + (h)) * HTB)
#define PG8_SB(b, h) ((4 + (b) * 2 + (h)) * HTB)
#define PG8_STAGE(bufoff, gbase, voff) do { _Pragma("unroll") for (int _i = 0; _i < 2; ++_i) \
        __builtin_amdgcn_global_load_lds((const unsigned*)((const char*)(gbase) + (voff)[_i]), (LAS unsigned*)(lds + (bufoff) + ldsw + _i * 8192), 16, 0, 0); } while (0)
#define PG8_STAGE2(bufoff, gbase, o0, o1) do { \
        __builtin_amdgcn_global_load_lds((const unsigned*)((const char*)(gbase) + (o0)), (LAS unsigned*)(lds + (bufoff) + ldsw), 16, 0, 0); \
        __builtin_amdgcn_global_load_lds((const unsigned*)((const char*)(gbase) + (o1)), (LAS unsigned*)(lds + (bufoff) + ldsw + 8192), 16, 0, 0); } while (0)
#define PG8_GATH(u, v) do { const int e_ = (u).grp, b_ = ((u).pm - tpt[e_]) * 256, c_ = tpt[32 + e_]; const int* et_ = etok + e_ * TT; \
        _Pragma("unroll") for (int h_ = 0; h_ < 2; ++h_) _Pragma("unroll") for (int i_ = 0; i_ < 2; ++i_) { const int s_ = b_ + h_ * 128 + gR[i_]; const int t_ = (s_ < c_) ? et_[s_] : 0; \
            v[h_][i_] = (unsigned)t_ * (unsigned)(K * 2) + gC[i_]; } } while (0)
#define PG8_LDA(dst, b, h) do { _Pragma("unroll") for (int m = 0; m < 4; ++m) _Pragma("unroll") for (int k = 0; k < 2; ++k) dst[m][k] = *(const LAS bf16x8*)(lds + PG8_SA(b, h) + aoff + m * 2048 + k * 1024); } while (0)
#define PG8_LDB(dst, b, h) do { _Pragma("unroll") for (int n = 0; n < 2; ++n) _Pragma("unroll") for (int k = 0; k < 2; ++k) dst[n][k] = *(const LAS bf16x8*)(lds + PG8_SB(b, h) + boff + n * 2048 + k * 1024); } while (0)
#define PG8_MMA(ai, bj, At, Bt) do { __builtin_amdgcn_s_setprio(1); _Pragma("unroll") for (int m = 0; m < 4; ++m) _Pragma("unroll") for (int n = 0; n < 2; ++n) _Pragma("unroll") for (int k = 0; k < 2; ++k) \
        acc[ai][bj][m][n] = __builtin_amdgcn_mfma_f32_16x16x32_bf16(Bt[n][k], At[m][k], acc[ai][bj][m][n], 0, 0, 0); __builtin_amdgcn_s_setprio(0); } while (0)
#define PG8_WAIT_V(n) asm volatile("s_waitcnt vmcnt(" #n ")" ::: "memory")
#define PG8_WAIT_L(n) asm volatile("s_waitcnt lgkmcnt(" #n ")" ::: "memory")
#define PG8_BAR __builtin_amdgcn_s_barrier()
#define PG8_SCHED __builtin_amdgcn_sched_barrier(0)
    Unit cur, nxt; int ui = 0;
    if (!S.next(0, cur)) return;
    cur.pm = __builtin_amdgcn_readfirstlane(cur.pm); cur.pn = __builtin_amdgcn_readfirstlane(cur.pn); cur.grp = __builtin_amdgcn_readfirstlane(cur.grp);
    f32x4 acc[2][2][4][2];
#pragma unroll
    for (int a = 0; a < 2; ++a)
#pragma unroll
        for (int b = 0; b < 2; ++b)
#pragma unroll
            for (int m = 0; m < 4; ++m)
#pragma unroll
                for (int n = 0; n < 2; ++n) acc[a][b][m][n] = (f32x4){0.f, 0.f, 0.f, 0.f};
    bf16x8 At[4][2], B0[2][2], B1[2][2];
    const char* cA = (const char*)g.A + (size_t)cur.grp * g.gsA + (size_t)cur.pm * tstep; const char* cB = (const char*)g.Bt + (size_t)cur.grp * g.gsB + (size_t)cur.pn * tstep;
    PG8_STAGE(PG8_SB(0, 0), cB, voffB); PG8_STAGE(PG8_SB(0, 1), cB + hstep, voffB); PG8_STAGE(PG8_SA(0, 0), cA, voffA); PG8_STAGE(PG8_SA(0, 1), cA + hstep, voffA);
    if (wr == 1) PG8_BAR;
    PG8_WAIT_V(2); PG8_BAR;
    PG8_STAGE(PG8_SB(1, 0), cB + kstep, voffB); PG8_STAGE(PG8_SA(1, 0), cA + kstep, voffA); PG8_STAGE(PG8_SB(1, 1), cB + hstep + kstep, voffB);
    PG8_WAIT_V(6); PG8_BAR;
    for (;;) {
        const bool has_next = S.next(ui + 1, nxt);
        nxt.pm = __builtin_amdgcn_readfirstlane(nxt.pm); nxt.pn = __builtin_amdgcn_readfirstlane(nxt.pn); nxt.grp = __builtin_amdgcn_readfirstlane(nxt.grp);
        const char* nA = has_next ? (const char*)g.A + (size_t)nxt.grp * g.gsA + (size_t)nxt.pm * tstep : cA; const char* nB = has_next ? (const char*)g.Bt + (size_t)nxt.grp * g.gsB + (size_t)nxt.pn * tstep : cB;
        for (int t = 0; t < nt; t += 2) {
            const bool last = (t == nt - 2);
            const char* a1 = cA + (size_t)(t + 1) * kstep;
            const char* a2 = last ? nA : cA + (size_t)(t + 2) * kstep; const char* b2 = last ? nB : cB + (size_t)(t + 2) * kstep;
            const char* a3 = a2 + kstep; const char* b3 = b2 + kstep;
            PG8_LDB(B0, 0, 0); PG8_LDB(B1, 0, 1); PG8_SCHED; PG8_LDA(At, 0, 0); PG8_STAGE(PG8_SA(1, 1), a1 + hstep, voffA);
            PG8_WAIT_V(8); PG8_WAIT_L(0); PG8_BAR; PG8_MMA(0, 0, At, B0); PG8_MMA(0, 1, At, B1); PG8_BAR; PG8_SCHED;
            PG8_LDA(At, 0, 1); PG8_STAGE(PG8_SB(0, 0), b2, voffB); PG8_STAGE(PG8_SB(0, 1), b2 + hstep, voffB); PG8_STAGE(PG8_SA(0, 0), a2, voffA);
            PG8_WAIT_V(8); PG8_WAIT_L(0); PG8_BAR; PG8_MMA(1, 0, At, B0); PG8_MMA(1, 1, At, B1); PG8_BAR; PG8_SCHED;
            PG8_LDB(B0, 1, 0); PG8_LDB(B1, 1, 1); PG8_SCHED; PG8_LDA(At, 1, 0); PG8_STAGE(PG8_SA(0, 1), a2 + hstep, voffA);
            PG8_WAIT_V(8); PG8_WAIT_L(0); PG8_BAR; PG8_MMA(0, 0, At, B0); PG8_MMA(0, 1, At, B1); PG8_BAR; PG8_SCHED;
            PG8_LDA(At, 1, 1); PG8_STAGE(PG8_SB(1, 0), b3, voffB); PG8_STAGE(PG8_SB(1, 1), b3 + hstep, voffB); PG8_STAGE(PG8_SA(1, 0), a3, voffA);
            PG8_WAIT_V(8); PG8_WAIT_L(0); PG8_BAR; PG8_MMA(1, 0, At, B0); PG8_MMA(1, 1, At, B1); PG8_BAR; PG8_SCHED;
        }
        bool keep = false;
        if (wr == 0) PG8_BAR;
        { Unit eu; eu.pm = __builtin_amdgcn_readfirstlane(cur.pm); eu.pn = __builtin_amdgcn_readfirstlane(cur.pn); eu.grp = __builtin_amdgcn_readfirstlane(cur.grp); asm volatile("" : "+s"(eu.pm), "+s"(eu.pn), "+s"(eu.grp)); keep = E(acc, eu, wr, wc, fr, fq); }
        if (!has_next) break;
        if (!keep) {
#pragma unroll
        for (int a = 0; a < 2; ++a)
#pragma unroll
            for (int b = 0; b < 2; ++b)
#pragma unroll
                for (int m = 0; m < 4; ++m)
#pragma unroll
                    for (int n = 0; n < 2; ++n) acc[a][b][m][n] = (f32x4){0.f, 0.f, 0.f, 0.f};
        }
        cur = nxt; cA = nA; cB = nB; ++ui;
        if (wr == 1) PG8_BAR;
    }
    PG8_WAIT_V(0);
    PG8_BAR;
#undef PG8_SA
#undef PG8_SB
#undef PG8_STAGE
#undef PG8_LDA
#undef PG8_LDB
#undef PG8_MMA
#undef PG8_WAIT_V
#undef PG8_WAIT_L
#undef PG8_BAR
#undef PG8_SCHED
}
template <class Epi, class Sched, bool GATHER = false>
DI void gemm_phase_i8(LAS unsigned char* lds, const Gemm g, const Sched& S, const Epi& E, const int* etok = nullptr, const LAS int* tpt = nullptr) {
    int tid = threadIdx.x; asm volatile("" : "+v"(tid));
    const int wid = __builtin_amdgcn_readfirstlane(tid >> 6), lane = tid & 63, wr = wid >> 2, wc = wid & 3, fr = lane & 15, fq = lane >> 4;
    int K = g.K; asm volatile("" : "+s"(K));
    const int nt = K / BK;
    unsigned voffA[2], voffB[2], gC[2]; int gR[2];
#pragma unroll
    for (int i = 0; i < 2; ++i) { int R, C; stage_rc(tid * 16 + i * 8192, R, C); const int Rb = Epi::PERM ? ((R & ~31) + perm32(R & 31)) : R;
        voffA[i] = (unsigned)(R * K + C) * 2u; voffB[i] = (unsigned)(Rb * K + C) * 2u; gR[i] = R; gC[i] = (unsigned)C * 2u; }
    const size_t kstep = (size_t)(BK * 2);
    const size_t hstep = (size_t)HALF * K * 2;
    const size_t tstep = 2 * hstep;
    const unsigned ldsw = (unsigned)wid * 1024u;
    const int aoff = lds_byte(wr * 64 + fr, fq * 8), boff = lds_byte(wc * 32 + fr, fq * 8);
#define PG8_SA(b, h) (((b) * 2 + (h)) * HTB)
#define PG8_SB(b, h) ((4 + (b) * 2 + (h)) * HTB)
#define PG8_STAGE(bufoff, gbase, voff) do { _Pragma("unroll") for (int _i = 0; _i < 2; ++_i) \
        __builtin_amdgcn_global_load_lds((const unsigned*)((const char*)(gbase) + (voff)[_i]), (LAS unsigned*)(lds + (bufoff) + ldsw + _i * 8192), 16, 0, 0); } while (0)
#define PG8_STAGE2(bufoff, gbase, o0, o1) do { \
        __builtin_amdgcn_global_load_lds((const unsigned*)((const char*)(gbase) + (o0)), (LAS unsigned*)(lds + (bufoff) + ldsw), 16, 0, 0); \
        __builtin_amdgcn_global_load_lds((const unsigned*)((const char*)(gbase) + (o1)), (LAS unsigned*)(lds + (bufoff) + ldsw + 8192), 16, 0, 0); } while (0)
#define PG8_GATH(u, v) do { const int e_ = (u).grp, b_ = ((u).pm - tpt[e_]) * 256, c_ = tpt[32 + e_]; const int* et_ = etok + e_ * TT; \
        _Pragma("unroll") for (int h_ = 0; h_ < 2; ++h_) _Pragma("unroll") for (int i_ = 0; i_ < 2; ++i_) { const int s_ = b_ + h_ * 128 + gR[i_]; const int t_ = (s_ < c_) ? et_[s_] : 0; \
            v[h_][i_] = (unsigned)t_ * (unsigned)(K * 2) + gC[i_]; } } while (0)
#define PG8_LDA(dst, b, h) do { _Pragma("unroll") for (int m = 0; m < 4; ++m) _Pragma("unroll") for (int k = 0; k < 2; ++k) dst[m][k] = *(const LAS v4i_t*)(lds + PG8_SA(b, h) + aoff + m * 2048 + k * 1024); } while (0)
#define PG8_LDB(dst, b, h) do { _Pragma("unroll") for (int n = 0; n < 2; ++n) _Pragma("unroll") for (int k = 0; k < 2; ++k) dst[n][k] = *(const LAS v4i_t*)(lds + PG8_SB(b, h) + boff + n * 2048 + k * 1024); } while (0)
#define PG8_MMA(ai, bj, At, Bt) do { __builtin_amdgcn_s_setprio(1); _Pragma("unroll") for (int m = 0; m < 4; ++m) _Pragma("unroll") for (int n = 0; n < 2; ++n) _Pragma("unroll") for (int k = 0; k < 2; ++k) \
        acc[ai][bj][m][n] = __builtin_amdgcn_mfma_i32_16x16x64_i8(Bt[n][k], At[m][k], acc[ai][bj][m][n], 0, 0, 0); __builtin_amdgcn_s_setprio(0); } while (0)
#define PG8_WAIT_V(n) asm volatile("s_waitcnt vmcnt(" #n ")" ::: "memory")
#define PG8_WAIT_L(n) asm volatile("s_waitcnt lgkmcnt(" #n ")" ::: "memory")
#define PG8_BAR __builtin_amdgcn_s_barrier()
#define PG8_SCHED __builtin_amdgcn_sched_barrier(0)
    Unit cur, nxt; int ui = 0;
    if (!S.next(0, cur)) return;
    cur.pm = __builtin_amdgcn_readfirstlane(cur.pm); cur.pn = __builtin_amdgcn_readfirstlane(cur.pn); cur.grp = __builtin_amdgcn_readfirstlane(cur.grp);
    v4i_t acc[2][2][4][2];
#pragma unroll
    for (int a = 0; a < 2; ++a)
#pragma unroll
        for (int b = 0; b < 2; ++b)
#pragma unroll
            for (int m = 0; m < 4; ++m)
#pragma unroll
                for (int n = 0; n < 2; ++n) acc[a][b][m][n] = (v4i_t){0, 0, 0, 0};
    v4i_t At[4][2], B0[2][2], B1[2][2];
    const char* cA = GATHER ? (const char*)g.A : (const char*)g.A + (size_t)cur.grp * g.gsA + (size_t)cur.pm * tstep; const char* cB = (const char*)g.Bt + (size_t)cur.grp * g.gsB + (size_t)cur.pn * tstep;
    unsigned cv[2][2] = {{voffA[0], voffA[1]}, {voffA[0], voffA[1]}}, nv[2][2] = {{voffA[0], voffA[1]}, {voffA[0], voffA[1]}};
    if (GATHER) PG8_GATH(cur, cv);
    const size_t ahs = GATHER ? (size_t)0 : hstep;
    PG8_STAGE(PG8_SB(0, 0), cB, voffB); PG8_STAGE(PG8_SB(0, 1), cB + hstep, voffB); PG8_STAGE2(PG8_SA(0, 0), cA, cv[0][0], cv[0][1]); PG8_STAGE2(PG8_SA(0, 1), cA + ahs, cv[1][0], cv[1][1]);
    if (wr == 1) PG8_BAR;
    PG8_WAIT_V(2); PG8_BAR;
    PG8_STAGE(PG8_SB(1, 0), cB + kstep, voffB); PG8_STAGE2(PG8_SA(1, 0), cA + kstep, cv[0][0], cv[0][1]); PG8_STAGE(PG8_SB(1, 1), cB + hstep + kstep, voffB);
    PG8_WAIT_V(6); PG8_BAR;
    for (;;) {
        const bool has_next = S.next(ui + 1, nxt);
        nxt.pm = __builtin_amdgcn_readfirstlane(nxt.pm); nxt.pn = __builtin_amdgcn_readfirstlane(nxt.pn); nxt.grp = __builtin_amdgcn_readfirstlane(nxt.grp);
        const char* nA = (has_next && !GATHER) ? (const char*)g.A + (size_t)nxt.grp * g.gsA + (size_t)nxt.pm * tstep : cA; const char* nB = has_next ? (const char*)g.Bt + (size_t)nxt.grp * g.gsB + (size_t)nxt.pn * tstep : cB;
        if (GATHER) { if (has_next) PG8_GATH(nxt, nv); else { nv[0][0] = cv[0][0]; nv[0][1] = cv[0][1]; nv[1][0] = cv[1][0]; nv[1][1] = cv[1][1]; } }
        for (int t = 0; t < nt; t += 2) {
            const bool last = (t == nt - 2);
            const unsigned s00 = (GATHER && last) ? nv[0][0] : cv[0][0], s01 = (GATHER && last) ? nv[0][1] : cv[0][1], s10 = (GATHER && last) ? nv[1][0] : cv[1][0], s11 = (GATHER && last) ? nv[1][1] : cv[1][1];
            const char* a1 = cA + (size_t)(t + 1) * kstep;
            const char* a2 = last ? nA : cA + (size_t)(t + 2) * kstep; const char* b2 = last ? nB : cB + (size_t)(t + 2) * kstep;
            const char* a3 = a2 + kstep; const char* b3 = b2 + kstep;
            PG8_LDB(B0, 0, 0); PG8_LDB(B1, 0, 1); PG8_SCHED; PG8_LDA(At, 0, 0); PG8_STAGE2(PG8_SA(1, 1), a1 + ahs, cv[1][0], cv[1][1]);
            PG8_WAIT_V(8); PG8_WAIT_L(0); PG8_BAR; PG8_MMA(0, 0, At, B0); PG8_MMA(0, 1, At, B1); PG8_BAR; PG8_SCHED;
            PG8_LDA(At, 0, 1); PG8_STAGE(PG8_SB(0, 0), b2, voffB); PG8_STAGE(PG8_SB(0, 1), b2 + hstep, voffB); PG8_STAGE2(PG8_SA(0, 0), a2, s00, s01);
            PG8_WAIT_V(8); PG8_WAIT_L(0); PG8_BAR; PG8_MMA(1, 0, At, B0); PG8_MMA(1, 1, At, B1); PG8_BAR; PG8_SCHED;
            PG8_LDB(B0, 1, 0); PG8_LDB(B1, 1, 1); PG8_SCHED; PG8_LDA(At, 1, 0); PG8_STAGE2(PG8_SA(0, 1), a2 + ahs, s10, s11);
            PG8_WAIT_V(8); PG8_WAIT_L(0); PG8_BAR; PG8_MMA(0, 0, At, B0); PG8_MMA(0, 1, At, B1); PG8_BAR; PG8_SCHED;
            PG8_LDA(At, 1, 1); PG8_STAGE(PG8_SB(1, 0), b3, voffB); PG8_STAGE(PG8_SB(1, 1), b3 + hstep, voffB); PG8_STAGE2(PG8_SA(1, 0), a3, s00, s01);
            PG8_WAIT_V(8); PG8_WAIT_L(0); PG8_BAR; PG8_MMA(1, 0, At, B0); PG8_MMA(1, 1, At, B1); PG8_BAR; PG8_SCHED;
        }
        bool keep = false;
        if (wr == 0) PG8_BAR;
        { Unit eu; eu.pm = __builtin_amdgcn_readfirstlane(cur.pm); eu.pn = __builtin_amdgcn_readfirstlane(cur.pn); eu.grp = __builtin_amdgcn_readfirstlane(cur.grp); asm volatile("" : "+s"(eu.pm), "+s"(eu.pn), "+s"(eu.grp)); keep = E(acc, eu, wr, wc, fr, fq); }
        if (!has_next) break;
        if (!keep) {
#pragma unroll
        for (int a = 0; a < 2; ++a)
#pragma unroll
            for (int b = 0; b < 2; ++b)
#pragma unroll
                for (int m = 0; m < 4; ++m)
#pragma unroll
                    for (int n = 0; n < 2; ++n) acc[a][b][m][n] = (v4i_t){0, 0, 0, 0};
        }
        cur = nxt; cA = nA; cB = nB; ++ui;
        if (GATHER) { cv[0][0] = nv[0][0]; cv[0][1] = nv[0][1]; cv[1][0] = nv[1][0]; cv[1][1] = nv[1][1]; }
        if (wr == 1) PG8_BAR;
    }
    PG8_WAIT_V(0);
    PG8_BAR;
#undef PG8_SA
#undef PG8_SB
#undef PG8_STAGE
#undef PG8_STAGE2
#undef PG8_GATH
#undef PG8_LDA
#undef PG8_LDB
#undef PG8_MMA
#undef PG8_WAIT_V
#undef PG8_WAIT_L
#undef PG8_BAR
#undef PG8_SCHED
}
}

#define XB_TMO      128
#define XB_XCNT(j)  (256  + 64 * (j))
#define XB_XSUB(j)  (1280 + 64 * (j))
#define XB_XGEN(j)  (2304 + 64 * (j))
#define XB_TOP      3328
#define XB_TOPGEN   3392
#define XCD_BAR_WORDS 3456
#define XB_SPIN_CAP (1u << 18)

__device__ __forceinline__ unsigned xb_ld(unsigned* p)              { return __hip_atomic_load(p, __ATOMIC_RELAXED, __HIP_MEMORY_SCOPE_AGENT); }
__device__ __forceinline__ unsigned xb_add(unsigned* p, unsigned v) { return __hip_atomic_fetch_add(p, v, __ATOMIC_RELAXED, __HIP_MEMORY_SCOPE_AGENT); }
__device__ __forceinline__ unsigned xb_xcc_id() { return (unsigned)__builtin_amdgcn_s_getreg((3 << 11) | 20) & 0xFu; }
#define XB_SPIN(cond, bar) do { unsigned _sp = 0; while (cond) { __builtin_amdgcn_s_sleep(1); \
    if ((++_sp & 255u) == 0u) { if (xb_ld(&(bar)[XB_TMO])) break; if (_sp > XB_SPIN_CAP) { atomicAdd(&(bar)[XB_TMO], 1u); break; } } } } while (0)

struct XcdBarrier {
    unsigned* bar; unsigned x;
    volatile LAS unsigned* st;
};

__device__ __forceinline__ XcdBarrier xcd_barrier_post(unsigned* bar, volatile LAS unsigned* st) {
    XcdBarrier b; b.bar = bar; b.x = xb_xcc_id(); b.st = st;
    if (threadIdx.x == 0) (void)xb_add(&bar[XB_XCNT(b.x)], 1u);
    return b;
}
__device__ __forceinline__ void xcd_barrier_complete(unsigned* bar, unsigned x, unsigned& nloc, unsigned& nx) {
    const unsigned G = gridDim.x * gridDim.y * gridDim.z;
    unsigned sum, cnt, mine, sp = 0u;
    for (;;) {
        sum = 0u; cnt = 0u; mine = 0u;
#pragma unroll
        for (unsigned j = 0; j < 16; ++j) { const unsigned c = xb_ld(&bar[XB_XCNT(j)]); sum += c; cnt += (c > 0u) ? 1u : 0u; mine = (j == x) ? c : mine; }
        if (sum == G) break;
        __builtin_amdgcn_s_sleep(1);
        if ((++sp & 255u) == 0u) { if (xb_ld(&bar[XB_TMO])) break; if (sp > XB_SPIN_CAP) { atomicAdd(&bar[XB_TMO], 1u); break; } }
    }
    nloc = mine > 0u ? mine : 1u; nx = cnt > 0u ? cnt : 1u;
}

__device__ __forceinline__ void xcd_barrier(const XcdBarrier& b) {
    asm volatile("s_waitcnt vmcnt(0)" ::: "memory");
    __syncthreads();
    if (threadIdx.x == 0) {
        unsigned* bar = b.bar;
        __builtin_amdgcn_s_waitcnt(0);
        unsigned nloc = b.st[0], nx = b.st[1];
        if (nloc == 0u) { xcd_barrier_complete(bar, b.x, nloc, nx); b.st[0] = nloc; b.st[1] = nx; }
        const unsigned old = xb_add(&bar[XB_XSUB(b.x)], 1u);
        const unsigned gen = old / nloc;
        if (old + 1u == (gen + 1u) * nloc) {
            __builtin_amdgcn_fence(__ATOMIC_RELEASE, "agent");
            asm volatile("s_waitcnt vmcnt(0)" ::: "memory");
            const unsigned og = xb_add(&bar[XB_TOP], 1u);
            const unsigned tg = og / nx;
            if (og + 1u == (tg + 1u) * nx) xb_add(&bar[XB_TOPGEN], 1u);
            else XB_SPIN(xb_ld(&bar[XB_TOPGEN]) == tg, bar);
            __builtin_amdgcn_fence(__ATOMIC_ACQUIRE, "agent");
            xb_add(&bar[XB_XGEN(b.x)], 1u);
            asm volatile("s_waitcnt vmcnt(0)" ::: "memory");
        } else {
            XB_SPIN(xb_ld(&bar[XB_XGEN(b.x)]) == gen, bar);
            __builtin_amdgcn_fence(__ATOMIC_ACQUIRE, "agent");
            asm volatile("s_waitcnt vmcnt(0)" ::: "memory");
        }
    }
    __syncthreads();
}

constexpr size_t MiB = 1u << 20;
constexpr size_t WS_CTL = 0, CTL_ZERO_BYTES = 1 * MiB;
constexpr size_t WS_MOD  = 1 * MiB;
constexpr size_t WS_WIN  = 2 * MiB;
constexpr size_t WS_WUQ  = 210 * MiB;
constexpr size_t WS_WKN  = 213 * MiB;
constexpr size_t WS_WV   = 214 * MiB;
constexpr size_t WS_WBR  = 215 * MiB;
constexpr size_t WS_WMIX = 247 * MiB;
constexpr size_t WS_W1   = 279 * MiB;
constexpr size_t WS_W2   = 535 * MiB;
constexpr size_t WS_X    = 663 * MiB;
constexpr size_t WS_H    = 735 * MiB;
constexpr size_t WS_U    = 771 * MiB;
constexpr size_t WS_CQN  = 1005 * MiB;
constexpr size_t WS_CKVN = 1014 * MiB;
constexpr size_t WS_KRP  = 1019 * MiB;
constexpr size_t WS_Q    = 1021 * MiB;
constexpr size_t WS_KN   = 1035 * MiB;
constexpr size_t WS_VT   = 1044 * MiB;
constexpr size_t WS_ACTS = 1053 * MiB;
constexpr size_t WS_YM   = 1089 * MiB;
constexpr size_t WS_SLOC = 1125 * MiB;
constexpr size_t WS_DEC  = 1161 * MiB;
constexpr size_t WS_SIN  = 1162 * MiB;
constexpr size_t WS_ETOK = 1261 * MiB, WS_ERS = 1262 * MiB, WS_ERW = 1263 * MiB;
constexpr size_t WS_ROUTE= 1180 * MiB;
constexpr size_t WS_HS   = 1181 * MiB;
constexpr size_t WS_ACTM = 1269 * MiB;
constexpr size_t WS_OUTS = 1291 * MiB;
constexpr size_t WS_W8   = 1379 * MiB;
constexpr size_t WS_H8   = 1483 * MiB;
constexpr size_t WS_RA   = 1501 * MiB;
constexpr size_t WS_RB   = 1501 * MiB + 64 * 1024;
constexpr size_t WS_RB1  = 1501 * MiB + 512 * 1024;
constexpr size_t WS_RSORT= 1501 * MiB + 768 * 1024;
constexpr size_t WS_RAF  = 1501 * MiB + 896 * 1024;
constexpr size_t WS_G8   = 1502 * MiB;
constexpr size_t WS_END  = 1574 * MiB;
constexpr int CW_BAR = 4096;
constexpr int CW_CNT = 16384;
constexpr int CW_CMAX = 131072;

constexpr int RING_BYTES = 131072;
constexpr int LDSX_OFF = RING_BYTES;
constexpr int LDS_BYTES = 147456;

struct Params { const float* in[34]; float* out; unsigned char* ws; int ph_lo, ph_hi; };
typedef const __attribute__((address_space(4))) Params* KParams;
enum { I_X = 0, I_C, I_CTX, I_CCTX, I_WMOD, I_BMOD, I_GMIX, I_GFFN, I_WIN, I_GQ, I_WUQ, I_GKV, I_WUKV, I_WMLAO, I_WCFDW, I_BCFDW, I_GCFLN, I_BCFLN, I_WCFO,
       I_WGF, I_BGF, I_WGB, I_BGB, I_GGLAN, I_WGLAO, I_WSCC, I_WSCO, I_WMIXO, I_WROUT, I_BROUT, I_WEG, I_WEU, I_WED, I_GFIN };

struct Frame { LAS unsigned char* lds; int tid, lane, wave, G, bid, gw, NGW; };

#define WSP(T, off) ((T*)(P->ws + (off)))
#define WSQ(T, off) ((T*)(Q->ws + (off)))
DI unsigned* ctl_words(KParams P) { return (unsigned*)(P->ws + WS_CTL); }
DI int mod_row(int row) { return row < TLAT ? (row >> 11) : 4; }

DI void transpose_item(const float* W, int N, bf16_t* WT, int KD, int dest_row0, int k0, int n0, LAS float* scr, int lane) {
    float tv[32];
#pragma unroll
    for (int i = 0; i < 32; ++i) { const int kk = 2 * i + (lane >> 5); tv[i] = __builtin_nontemporal_load(W + (size_t)(k0 + kk) * N + n0 + (lane & 31)); }
    __builtin_amdgcn_sched_barrier(0);
#pragma unroll
    for (int i = 0; i < 32; ++i) { const int kk = 2 * i + (lane >> 5); scr[kk * 33 + (lane & 31)] = tv[i]; }
    LDS_WAIT(); asm volatile("" ::: "memory");
    const int c = lane & 7;
#pragma unroll
    for (int j = 0; j < 4; ++j) { const int n = (lane >> 3) + 8 * j; const LAS float* s = scr + (8 * c) * 33 + n;
        u32x4 o; o.x = pk2(s[0 * 33], s[1 * 33]); o.y = pk2(s[2 * 33], s[3 * 33]); o.z = pk2(s[4 * 33], s[5 * 33]); o.w = pk2(s[6 * 33], s[7 * 33]);
        __builtin_nontemporal_store(o, (u32x4*)(WT + (size_t)(dest_row0 + n) * KD + k0 + 8 * c)); }
    LDS_WAIT(); asm volatile("" ::: "memory");
}
constexpr int SLAB_AUX = LDSX_OFF + 2048;
DI int slab_off(int k, int n) { return k * 64 + ((((n >> 1) ^ ((k >> 3) & 15)) << 2) | ((n & 1) << 1)); }
DI void slab_item(const float* W, int N, int n0, unsigned char* W8, int dest_row0, float* rB, Frame& F) {
    LAS float* wmax = (LAS float*)(F.lds + SLAB_AUX); LAS float* cmax = wmax + 256;
    { const int n = F.lane & 31, kp = F.lane >> 5; float m = 0.f;
#pragma unroll 1
      for (int j = 0; j < 4; ++j) { const int kb0 = (F.wave * 4 + j) * 64; float v[32];
#pragma unroll
          for (int i = 0; i < 32; ++i) v[i] = __builtin_nontemporal_load(W + (size_t)(kb0 + 2 * i + kp) * N + n0 + n);
#pragma unroll
          for (int i = 0; i < 32; ++i) { m = fmaxf(m, fabsf(v[i])); *(LAS bf16_t*)(F.lds + slab_off(kb0 + 2 * i + kp, n)) = f2bf(v[i]); } }
      m = fmaxf(m, __shfl_xor(m, 32)); if (F.lane < 32) wmax[F.wave * 32 + n] = m; }
    __syncthreads();
    if (F.tid < 32) { float c = 0.f;
#pragma unroll
        for (int w2 = 0; w2 < 8; ++w2) c = fmaxf(c, wmax[w2 * 32 + F.tid]);
        cmax[F.tid] = c; rB[dest_row0 + F.tid] = c * (1.f / 127.f); }
    __syncthreads();
    { const int nn = ((F.tid >> 3) & 7) + 8 * (F.wave & 3); const float cm = cmax[nn], sc = cm > 0.f ? 127.f / cm : 0.f;
#pragma unroll 4
      for (int i2 = 0; i2 < 16; ++i2) { const int c = (F.tid & 7) + 8 * i2 + 128 * (F.wave >> 2); unsigned q[8];
#pragma unroll
          for (int j = 0; j < 8; ++j) q[j] = q8(sc * bf2f(*(const LAS bf16_t*)(F.lds + slab_off(8 * c + j, nn))));
          u32x2 o; o.x = q[0] | (q[1] << 8) | (q[2] << 16) | (q[3] << 24); o.y = q[4] | (q[5] << 8) | (q[6] << 16) | (q[7] << 24);
          __builtin_nontemporal_store(o, (u32x2*)(W8 + (size_t)(dest_row0 + nn) * DM + 8 * c)); } }
    __syncthreads();
}
constexpr int NS_WIN = PW / 32, NS_EXP = 16 * 2 * (EFF / 32), NS_ALL = NS_WIN + NS_EXP;
DI void slab_dispatch(KParams P, Frame& F, int l, int sidx) {
    if (sidx < NS_WIN) { slab_item(P->in[I_WIN] + (size_t)l * DM * PW, PW, 32 * sidx, WSP(unsigned char, WS_W8) + (size_t)l * PWP * DM, wcol_dest(32 * sidx), WSP(float, WS_RB) + (size_t)l * PWP, F); return; }
    const int q = sidx - NS_WIN, e = q >> 5, which = (q >> 4) & 1, n0 = (q & 15) * 32, le = l * 16 + e;
    slab_item((which ? P->in[I_WEU] : P->in[I_WEG]) + (size_t)le * DM * EFF, EFF, n0, WSP(unsigned char, WS_W1) + (size_t)le * 1024 * DM, (n0 >> 7) * 256 + which * 128 + (n0 & 127), WSP(float, WS_RB1) + (size_t)le * 1024, F);
}
constexpr int NL_UQ = 8 * 24, NL_UKV = 4 * 32, NL_BR = 4 * 8 * 64, NL_MIX = 32 * 64, NL_ED = 16 * 8 * 64, NL_PAD = PWP - PW;
constexpr int NL_ITEMS = NL_UQ + NL_UKV + NL_BR + NL_MIX + NL_ED + NL_PAD;
constexpr int NL_F1 = (NL_ITEMS * 55) / 100, NL_F2 = (NL_ITEMS * 88) / 100;
DI void conv_item_layer(KParams P, int l, int it, LAS float* scr, int lane) {
    int r = it;
    if (r < NL_UQ) { const int kb = r / 24, nb = r % 24;
        transpose_item(P->in[I_WUQ] + (size_t)l * 512 * 768, 768, WSP(bf16_t, WS_WUQ) + (size_t)l * 768 * 512, 512, 32 * nb, 64 * kb, 32 * nb, scr, lane); return; } r -= NL_UQ;
    if (r < NL_UKV) { const int kb = r / 32, nb = r % 32, n0 = 32 * nb, hh = n0 >> 7, jj = n0 & 127;
        bf16_t* dst = (jj < 64 ? WSP(bf16_t, WS_WKN) : WSP(bf16_t, WS_WV)) + (size_t)l * 512 * 256;
        transpose_item(P->in[I_WUKV] + (size_t)l * 256 * 1024, 1024, dst, 256, hh * 64 + (jj & 63), 64 * kb, n0, scr, lane); return; } r -= NL_UKV;
    if (r < NL_BR) { const int br = r / 512, q = r % 512, kb = q / 64, nb = q % 64;
        const float* src = (br == 0 ? P->in[I_WMLAO] : br == 1 ? P->in[I_WCFO] : br == 2 ? P->in[I_WGLAO] : P->in[I_WSCO]) + (size_t)l * 512 * DM;
        transpose_item(src, DM, WSP(bf16_t, WS_WBR) + (size_t)(l * 4 + br) * DM * 512, 512, 32 * nb, 64 * kb, 32 * nb, scr, lane); return; } r -= NL_BR;
    if (r < NL_MIX) { const int kb = r / 64, nb = r % 64;
        transpose_item(P->in[I_WMIXO] + (size_t)l * DM * DM, DM, WSP(bf16_t, WS_WMIX) + (size_t)l * DM * DM, DM, 32 * nb, 64 * kb, 32 * nb, scr, lane); return; } r -= NL_MIX;
    if (r < NL_ED) { const int e = r / 512, q = r % 512, kb = q / 64, nb = q % 64, le = l * 16 + e;
        transpose_item(P->in[I_WED] + (size_t)le * EFF * DM, DM, WSP(bf16_t, WS_W2) + (size_t)le * DM * EFF, EFF, 32 * nb, 64 * kb, 32 * nb, scr, lane); return; } r -= NL_ED;
    { unsigned char* row = WSP(unsigned char, WS_W8) + ((size_t)l * PWP + O_MG + r) * DM;
#pragma unroll
      for (int j = 0; j < 2; ++j) *(u32x4*)(row + 16 * lane + 1024 * j) = (u32x4){0u, 0u, 0u, 0u};
      if (lane == 0) WSP(float, WS_RB)[(size_t)l * PWP + O_MG + r] = 0.f; }
}
DI void conv_mixed(KParams P, Frame& F, int l, int s_lo, int s_hi, int w_lo, int w_hi, int rank, int nrank) {
    if (rank < 0) return;
    for (int sidx = s_lo + rank; sidx < s_hi; sidx += nrank) slab_dispatch(P, F, l, sidx);
    LAS float* scr = (LAS float*)(F.lds + F.wave * 8448);
    for (int it = w_lo + rank * 8 + F.wave; it < w_hi; it += nrank * 8) conv_item_layer(P, l, it, scr, F.lane);
    __syncthreads();
}
DI void mod_item(KParams P, Frame& F, int it) {
    const int l = it / 192, n0 = (it % 192) * 64;
    const LAS float* sil = (const LAS float*)F.lds;
    LAS float* red = (LAS float*)(F.lds + 40960);
    const int kq = F.lane >> 4, ln = F.lane & 15;
    const float* wp = P->in[I_WMOD] + (size_t)l * DM * (6 * DM) + n0 + 4 * ln;
    f32x4 acc[5];
#pragma unroll
    for (int r = 0; r < 5; ++r) acc[r] = (f32x4){0.f, 0.f, 0.f, 0.f};
    const int kbase = F.wave * 256 + kq;
#pragma unroll 8
    for (int kk = 0; kk < 64; ++kk) { const int k = kbase + 4 * kk; const f32x4 wv = *(const f32x4*)(wp + (size_t)k * (6 * DM));
#pragma unroll
        for (int r = 0; r < 5; ++r) acc[r] = acc[r] + wv * sil[r * DM + k]; }
    const int grp = F.wave * 4 + kq;
#pragma unroll
    for (int r = 0; r < 5; ++r) *(LAS f32x4*)(red + (grp * 5 + r) * 64 + 4 * ln) = acc[r];
    __syncthreads();
    if (F.tid < 320) { const int r = F.tid >> 6, n = F.tid & 63; float s = P->in[I_BMOD][(size_t)l * (6 * DM) + n0 + n];
        for (int g = 0; g < 32; ++g) s += red[(g * 5 + r) * 64 + n];
        WSP(float, WS_MOD)[(size_t)(l * 5 + r) * (6 * DM) + n0 + n] = s; }
    __syncthreads();
}
DI void phase_prologue(KParams P, Frame& F) {
    LAS float* sil = (LAS float*)F.lds;
    for (int i = F.tid; i < 5 * DM; i += 512) { const int r = i >> 11, k = i & (DM - 1); const float c = r < 4 ? P->in[I_C][r * DM + k] : P->in[I_CCTX][k]; sil[i] = c / (1.f + expf(-c)); }
    __syncthreads();
    for (int it = F.bid; it < DEPTH * 192; it += F.G) mod_item(P, F, it);
    __syncthreads();
}

DI void moe_table(KParams P, Frame& F, int l) {
    LAS int* tp = (LAS int*)(F.lds + LDSX_OFF + 64); LAS int* cn = tp + 32;
    if (F.tid < 16) { const unsigned* cnt = ctl_words(P) + CW_CNT + l * 16 * 64;
        const int c = (int)__hip_atomic_load(cnt + F.tid * 64, __ATOMIC_RELAXED, __HIP_MEMORY_SCOPE_AGENT); cn[F.tid] = c;
        int a = (c + 255) >> 8;
#pragma unroll
        for (int o = 1; o < 16; o <<= 1) { const int t = __shfl_up(a, o, 16); if ((int)F.tid >= o) a += t; }
        tp[F.tid + 1] = a; if (F.tid == 0) tp[0] = 0; }
    __syncthreads();
}
DI void phase_norm1(KParams P, Frame& F, int l, bool dummy) {
    bf16_t* X = WSP(bf16_t, WS_X); bf16_t* XO = dummy ? WSP(bf16_t, WS_HS) : X; bf16_t* H = WSP(bf16_t, WS_H); const float* mod = WSP(float, WS_MOD); const bf16_t* outs = WSP(bf16_t, WS_OUTS);
    const int* rt_e = (const int*)(P->ws + WS_ROUTE); const int* rt_slot = (const int*)(P->ws + WS_ROUTE + 2 * 73728); const LAS int* tp = (const LAS int*)(F.lds + LDSX_OFF + 64);
    if (l > 0) moe_table(P, F, l - 1);
    for (int row = F.gw; row < TT; row += F.NGW) {
        const int r = mod_row(row);
        const float* mp = mod + (size_t)(l * 5 + r) * (6 * DM); const float* gm = P->in[I_GMIX] + (size_t)l * DM; float am = 0.f;
        f32x4 v[8], gq[8], shq[8], scq[8];
        int e0 = 0, e1 = 0, s0 = 0, s1 = 0;
        if (l > 0) { e0 = rt_e[2 * row]; e1 = rt_e[2 * row + 1]; s0 = rt_slot[2 * row]; s1 = rt_slot[2 * row + 1]; }
#pragma unroll
        for (int j = 0; j < 8; ++j) { const int c = 4 * F.lane + 256 * j; gq[j] = *(const f32x4*)(gm + c); shq[j] = *(const f32x4*)(mp + c); scq[j] = *(const f32x4*)(mp + DM + c); }
        if (l == 0) { const float* src = row < TLAT ? P->in[I_X] + (size_t)row * DM : P->in[I_CTX] + (size_t)(row - TLAT) * DM;
#pragma unroll
            for (int j = 0; j < 8; ++j) v[j] = *(const f32x4*)(src + 4 * F.lane + 256 * j); }
        else { u32x2 xw[8], aw[8], bw[8]; f32x4 gtq[8];
            const int p0 = tp[e0] * 256 + s0, p1 = tp[e1] * 256 + s1; const float* gt = mod + (size_t)((l - 1) * 5 + r) * (6 * DM) + 5 * DM;
#pragma unroll
            for (int j = 0; j < 8; ++j) { const int c = 4 * F.lane + 256 * j; xw[j] = *(const u32x2*)(X + (size_t)row * DM + c); gtq[j] = *(const f32x4*)(gt + c);
                aw[j] = *(const u32x2*)(outs + (size_t)p0 * DM + c); bw[j] = *(const u32x2*)(outs + (size_t)p1 * DM + c); }
            __builtin_amdgcn_sched_barrier(0);
#pragma unroll
            for (int j = 0; j < 8; ++j) { const u32x2 w = xw[j], a = aw[j], b = bw[j]; const f32x4 g = gtq[j];
                v[j][0] = bflo(w.x) + g[0] * (bflo(a.x) + bflo(b.x)); v[j][1] = bfhi(w.x) + g[1] * (bfhi(a.x) + bfhi(b.x)); v[j][2] = bflo(w.y) + g[2] * (bflo(a.y) + bflo(b.y)); v[j][3] = bfhi(w.y) + g[3] * (bfhi(a.y) + bfhi(b.y)); } }
        __builtin_amdgcn_sched_barrier(0);
        float ss = 0.f;
#pragma unroll
        for (int j = 0; j < 8; ++j) { *(u32x2*)(XO + (size_t)row * DM + 4 * F.lane + 256 * j) = (u32x2){pk2(v[j][0], v[j][1]), pk2(v[j][2], v[j][3])}; ss += (v[j][0] * v[j][0] + v[j][1] * v[j][1]) + (v[j][2] * v[j][2] + v[j][3] * v[j][3]); }
        const float rstd = 1.f / sqrtf(wave_sum(ss) * (1.f / DM) + EPS);
#pragma unroll
        for (int j = 0; j < 8; ++j) { const f32x4 g = gq[j], sh = shq[j], sc = scq[j];
            v[j] = (v[j] * rstd * g) * (sc + 1.f) + sh; am = fmaxf(fmaxf(am, fmaxf(fabsf(v[j][0]), fabsf(v[j][1]))), fmaxf(fabsf(v[j][2]), fabsf(v[j][3]))); }
#pragma unroll
        for (int o = 1; o < 64; o <<= 1) am = fmaxf(am, __shfl_xor(am, o));
        const float qs = am > 0.f ? 127.f / am : 0.f;
#pragma unroll
        for (int j = 0; j < 8; ++j) { const int c = 4 * F.lane + 256 * j;
            *(unsigned*)(WSP(unsigned char, WS_H8) + (size_t)row * DM + c) = q8(v[j][0] * qs) | (q8(v[j][1] * qs) << 8) | (q8(v[j][2] * qs) << 16) | (q8(v[j][3] * qs) << 24); }
        if (F.lane == 0) WSP(float, WS_RA)[row] = am * (1.f / 127.f);
    }
}
DI void phase_final(KParams P, Frame& F) {
    const bf16_t* X = WSP(bf16_t, WS_X); const float* mod = WSP(float, WS_MOD); const bf16_t* outs = WSP(bf16_t, WS_OUTS);
    const int* rt_e = (const int*)(P->ws + WS_ROUTE); const int* rt_slot = (const int*)(P->ws + WS_ROUTE + 2 * 73728); const LAS int* tp = (const LAS int*)(F.lds + LDSX_OFF + 64);
    moe_table(P, F, DEPTH - 1);
    for (int row = F.gw; row < TLAT; row += F.NGW) {
        const int r = mod_row(row); const int p0 = tp[rt_e[2 * row]] * 256 + rt_slot[2 * row], p1 = tp[rt_e[2 * row + 1]] * 256 + rt_slot[2 * row + 1]; const float* gt = mod + (size_t)((DEPTH - 1) * 5 + r) * (6 * DM) + 5 * DM;
        f32x4 v[8]; float ss = 0.f;
        u32x2 xw[8], aw[8], bw[8]; f32x4 gtq[8], gfq[8];
#pragma unroll
        for (int j = 0; j < 8; ++j) { const int c = 4 * F.lane + 256 * j; xw[j] = *(const u32x2*)(X + (size_t)row * DM + c); gtq[j] = *(const f32x4*)(gt + c); gfq[j] = *(const f32x4*)(P->in[I_GFIN] + c);
            aw[j] = *(const u32x2*)(outs + (size_t)p0 * DM + c); bw[j] = *(const u32x2*)(outs + (size_t)p1 * DM + c); }
        __builtin_amdgcn_sched_barrier(0);
#pragma unroll
        for (int j = 0; j < 8; ++j) { const u32x2 w = xw[j], a = aw[j], b = bw[j]; const f32x4 g = gtq[j];
            v[j][0] = bflo(w.x) + g[0] * (bflo(a.x) + bflo(b.x)); v[j][1] = bfhi(w.x) + g[1] * (bfhi(a.x) + bfhi(b.x)); v[j][2] = bflo(w.y) + g[2] * (bflo(a.y) + bflo(b.y)); v[j][3] = bfhi(w.y) + g[3] * (bfhi(a.y) + bfhi(b.y));
            ss += (v[j][0] * v[j][0] + v[j][1] * v[j][1]) + (v[j][2] * v[j][2] + v[j][3] * v[j][3]); }
        const float rstd = 1.f / sqrtf(wave_sum(ss) * (1.f / DM) + EPS);
#pragma unroll
        for (int j = 0; j < 8; ++j) { const int c = 4 * F.lane + 256 * j; *(f32x4*)(P->out + (size_t)row * DM + c) = v[j] * rstd * gfq[j]; }
    }
}
DI float ffn_input_row(KParams P, Frame& F, int l, int row, f32x4 (&v)[8]) {
    const bf16_t* X = WSP(bf16_t, WS_X); unsigned char* H8 = WSP(unsigned char, WS_H); const float* mod = WSP(float, WS_MOD);
    const int r = mod_row(row); float ss = 0.f;
    const float* mp = mod + (size_t)(l * 5 + r) * (6 * DM); const float* gm = P->in[I_GFFN] + (size_t)l * DM; float am = 0.f;
    u32x2 xw[8]; f32x4 gq[8], shq[8], scq[8];
#pragma unroll
    for (int j = 0; j < 8; ++j) { const int c = 4 * F.lane + 256 * j; xw[j] = *(const u32x2*)(X + (size_t)row * DM + c); gq[j] = *(const f32x4*)(gm + c); shq[j] = *(const f32x4*)(mp + 3 * DM + c); scq[j] = *(const f32x4*)(mp + 4 * DM + c); }
    __builtin_amdgcn_sched_barrier(0);
#pragma unroll
    for (int j = 0; j < 8; ++j) { const u32x2 w = xw[j]; v[j] = (f32x4){bflo(w.x), bfhi(w.x), bflo(w.y), bfhi(w.y)}; ss += (v[j][0] * v[j][0] + v[j][1] * v[j][1]) + (v[j][2] * v[j][2] + v[j][3] * v[j][3]); }
    const float rstd = 1.f / sqrtf(wave_sum(ss) * (1.f / DM) + EPS);
#pragma unroll
    for (int j = 0; j < 8; ++j) { const f32x4 g = gq[j], sh = shq[j], sc = scq[j];
        v[j] = (v[j] * rstd * g) * (sc + 1.f) + sh; am = fmaxf(fmaxf(am, fmaxf(fabsf(v[j][0]), fabsf(v[j][1]))), fmaxf(fabsf(v[j][2]), fabsf(v[j][3]))); }
#pragma unroll
    for (int o = 1; o < 64; o <<= 1) am = fmaxf(am, __shfl_xor(am, o));
    const float qs = am > 0.f ? 127.f / am : 0.f;
#pragma unroll
    for (int j = 0; j < 8; ++j) { const int c = 4 * F.lane + 256 * j;
        *(unsigned*)(H8 + (size_t)row * DM + c) = q8(v[j][0] * qs) | (q8(v[j][1] * qs) << 8) | (q8(v[j][2] * qs) << 16) | (q8(v[j][3] * qs) << 24); }
    return am * (1.f / 127.f);
}
DI void route_decide(const float (&lg)[16], const float (&br)[16], int& e1, int& e2, float& wa, float& wb) {
    float aff[16], sel[16];
#pragma unroll
    for (int e = 0; e < 16; ++e) { aff[e] = __builtin_amdgcn_rcpf(1.f + expf(-lg[e])); sel[e] = aff[e] + br[e]; }
    int best = 0; float bestv = -INFINITY;
#pragma unroll
    for (int g = 0; g < 4; ++g) { const float a = sel[4 * g], b = sel[4 * g + 1], c = sel[4 * g + 2], d = sel[4 * g + 3];
        const float hi1 = fmaxf(a, b), lo1 = fminf(a, b), hi2 = fmaxf(c, d), lo2 = fminf(c, d);
        const float gs = fmaxf(hi1, hi2) + fmaxf(fminf(hi1, hi2), fmaxf(lo1, lo2));
        if (gs > bestv) { bestv = gs; best = g; } }
    float s4[4] = {0.f, 0.f, 0.f, 0.f}, a4[4] = {0.f, 0.f, 0.f, 0.f};
#pragma unroll
    for (int g = 0; g < 4; ++g)
#pragma unroll
        for (int j = 0; j < 4; ++j) { s4[j] = (best == g) ? sel[4 * g + j] : s4[j]; a4[j] = (best == g) ? aff[4 * g + j] : a4[j]; }
    int i1 = 0; float m1 = s4[0];
#pragma unroll
    for (int j = 1; j < 4; ++j) if (s4[j] > m1) { m1 = s4[j]; i1 = j; }
    int i2 = -1; float m2 = -INFINITY;
#pragma unroll
    for (int j = 0; j < 4; ++j) if (j != i1 && s4[j] > m2) { m2 = s4[j]; i2 = j; }
    float w1 = 0.f, w2 = 0.f;
#pragma unroll
    for (int j = 0; j < 4; ++j) { w1 = (j == i1) ? a4[j] : w1; w2 = (j == i2) ? a4[j] : w2; }
    const float inv = 1.f / (w1 + w2);
    e1 = 4 * best + i1; e2 = 4 * best + i2; wa = w1 * inv; wb = w2 * inv;
}
DI void phase_norm2_route(KParams P, Frame& F, int l, int cbank) {
    int* rt_e = (int*)(P->ws + WS_ROUTE); int* rt_slot = (int*)(P->ws + WS_ROUTE + 2 * 73728);
    int* etok = (int*)(P->ws + WS_ETOK); float* ers = (float*)(P->ws + WS_ERS); float* erw = (float*)(P->ws + WS_ERW);
    unsigned* cnt = ctl_words(P) + CW_CNT + cbank * 16 * 64;
    LAS float* wrT = (LAS float*)F.lds;
    for (int k = F.tid; k < DM; k += 512) { const f32x4* wp = (const f32x4*)(P->in[I_WROUT] + (size_t)k * 16);
#pragma unroll
        for (int q = 0; q < 4; ++q) { const f32x4 w = wp[q]; wrT[(4 * q + 0) * DM + k] = w[0]; wrT[(4 * q + 1) * DM + k] = w[1]; wrT[(4 * q + 2) * DM + k] = w[2]; wrT[(4 * q + 3) * DM + k] = w[3]; } }
    float br[16];
#pragma unroll
    for (int e = 0; e < 16; ++e) br[e] = P->in[I_BROUT][e];
    const int nrows = (l == DEPTH - 1) ? TLAT : TT;
    const int rpb = (nrows + F.G - 1) / F.G, row0 = F.bid * rpb, row1 = (row0 + rpb < nrows) ? row0 + rpb : nrows;
    LAS int* lcnt = (LAS int*)(F.lds + LDSX_OFF + 512); LAS int* lbase = lcnt + 16; LAS int* lre = lcnt + 32; LAS int* lri = lcnt + 112; LAS float* lrw = (LAS float*)(lcnt + 192); LAS float* lrs = (LAS float*)(lcnt + 272);
    if (F.tid < 16) lcnt[F.tid] = 0;
    __syncthreads();
#pragma unroll 1
    for (int lr = 2 * F.wave; row0 + lr < row1; lr += 16) {
        const bool hasB = row0 + lr + 1 < row1; const int rowA = row0 + lr, rowB = hasB ? rowA + 1 : rowA;
        f32x4 va[8], vb[8]; const float sA = ffn_input_row(P, F, l, rowA, va), sB = ffn_input_row(P, F, l, rowB, vb);
        f32x2_t lab[16];
#pragma unroll
        for (int e = 0; e < 16; ++e) lab[e] = (f32x2_t){0.f, 0.f};
#pragma unroll
        for (int j = 0; j < 8; ++j) {
            const f32x2_t x0 = (f32x2_t){va[j][0], vb[j][0]}, x1 = (f32x2_t){va[j][1], vb[j][1]}, x2 = (f32x2_t){va[j][2], vb[j][2]}, x3 = (f32x2_t){va[j][3], vb[j][3]};
#pragma unroll
            for (int e = 0; e < 16; ++e) { const f32x4 w = *(const LAS f32x4*)(wrT + e * DM + 4 * F.lane + 256 * j);
                lab[e] = __builtin_elementwise_fma(x3, (f32x2_t){w[3], w[3]}, __builtin_elementwise_fma(x2, (f32x2_t){w[2], w[2]}, __builtin_elementwise_fma(x1, (f32x2_t){w[1], w[1]}, __builtin_elementwise_fma(x0, (f32x2_t){w[0], w[0]}, lab[e])))); }
            asm volatile("" ::: "memory"); }
        float la[16], lb[16];
#pragma unroll
        for (int e = 0; e < 16; ++e) { la[e] = wave_sum(lab[e][0]); lb[e] = wave_sum(lab[e][1]); }
        int e1, e2, f1, f2; float wa, wb, xa, xb; route_decide(la, br, e1, e2, wa, wb); route_decide(lb, br, f1, f2, xa, xb);
        if (F.lane == 0) {
            const int j1 = __hip_atomic_fetch_add(lcnt + e1, 1, __ATOMIC_RELAXED, __HIP_MEMORY_SCOPE_WORKGROUP), j2 = __hip_atomic_fetch_add(lcnt + e2, 1, __ATOMIC_RELAXED, __HIP_MEMORY_SCOPE_WORKGROUP);
            lre[2 * lr] = e1; lre[2 * lr + 1] = e2; lri[2 * lr] = j1; lri[2 * lr + 1] = j2;
            rt_e[2 * rowA] = e1; rt_e[2 * rowA + 1] = e2; lrw[2 * lr] = wa; lrw[2 * lr + 1] = wb; lrs[lr] = sA;
            if (hasB) { const int k1 = __hip_atomic_fetch_add(lcnt + f1, 1, __ATOMIC_RELAXED, __HIP_MEMORY_SCOPE_WORKGROUP), k2 = __hip_atomic_fetch_add(lcnt + f2, 1, __ATOMIC_RELAXED, __HIP_MEMORY_SCOPE_WORKGROUP);
                lre[2 * lr + 2] = f1; lre[2 * lr + 3] = f2; lri[2 * lr + 2] = k1; lri[2 * lr + 3] = k2;
                rt_e[2 * rowB] = f1; rt_e[2 * rowB + 1] = f2; lrw[2 * lr + 2] = xa; lrw[2 * lr + 3] = xb; lrs[lr + 1] = sB; } }
    }
    __syncthreads();
    if (F.tid < 16) lbase[F.tid] = (int)atomicAdd(cnt + F.tid * 64, (unsigned)lcnt[F.tid]);
    __syncthreads();
    if (F.tid < 2 * (row1 - row0)) { const int e = lre[F.tid], sl = lbase[e] + lri[F.tid]; rt_slot[2 * row0 + F.tid] = sl;
        etok[e * TT + sl] = row0 + (F.tid >> 1); ers[e * TT + sl] = lrs[F.tid >> 1]; erw[e * TT + sl] = lrw[F.tid]; }
    __syncthreads();
}
DI float rope_freq(int i) { return __expf(-1.1512925465f * (float)i); }
DI void mla_prep_rows(KParams P, Frame& F, int l) {
    const bf16_t* U = WSP(bf16_t, WS_U); bf16_t* cqn = WSP(bf16_t, WS_CQN); bf16_t* ckvn = WSP(bf16_t, WS_CKVN); bf16_t* krp = WSP(bf16_t, WS_KRP);
    for (int row = F.gw; row < TT; row += F.NGW) {
        const bf16_t* up = U + (size_t)row * PWP;
        { const u32x4 a = *(const u32x4*)(up + O_CQ + 8 * F.lane); float f[8] = {bflo(a.x), bfhi(a.x), bflo(a.y), bfhi(a.y), bflo(a.z), bfhi(a.z), bflo(a.w), bfhi(a.w)};
          float ss = 0.f;
#pragma unroll
          for (int i = 0; i < 8; ++i) ss += f[i] * f[i];
          const float rstd = 1.f / sqrtf(wave_sum(ss) * (1.f / 512.f) + EPS); const float* g = P->in[I_GQ] + l * 512 + 8 * F.lane;
          u32x4 o; o.x = pk2(f[0] * rstd * g[0], f[1] * rstd * g[1]); o.y = pk2(f[2] * rstd * g[2], f[3] * rstd * g[3]); o.z = pk2(f[4] * rstd * g[4], f[5] * rstd * g[5]); o.w = pk2(f[6] * rstd * g[6], f[7] * rstd * g[7]);
          *(u32x4*)(cqn + (size_t)row * 512 + 8 * F.lane) = o; }
        { const u32x2 a = *(const u32x2*)(up + O_CKV + 4 * F.lane); float f[4] = {bflo(a.x), bfhi(a.x), bflo(a.y), bfhi(a.y)};
          const float ss = (f[0] * f[0] + f[1] * f[1]) + (f[2] * f[2] + f[3] * f[3]);
          const float rstd = 1.f / sqrtf(wave_sum(ss) * (1.f / 256.f) + EPS); const float* g = P->in[I_GKV] + l * 256 + 4 * F.lane;
          u32x2 o; o.x = pk2(f[0] * rstd * g[0], f[1] * rstd * g[1]); o.y = pk2(f[2] * rstd * g[2], f[3] * rstd * g[3]);
          *(u32x2*)(ckvn + (size_t)row * 256 + 4 * F.lane) = o; }
        { const int e = F.lane; float val = 0.f;
          if (row < TLAT) { if (e < 32) { const int pos = row & (SEQ - 1), part = e >> 4, idx = e & 15, i = idx & 7, second = idx >> 3;
                  const float t1 = bf2f(up[O_KR + 16 * part + i]), t2 = bf2f(up[O_KR + 16 * part + 8 + i]);
                  const float ang = (float)(part ? (pos & 63) : (pos >> 6)) * rope_freq(i); const float sn = __sinf(ang), cs = __cosf(ang);
                  val = second ? (t1 * sn + t2 * cs) : (t1 * cs - t2 * sn); } }
          else { if (e >= 32) val = bf2f(up[O_KR + e - 32]); }
          krp[(size_t)row * 64 + e] = f2bf(val); }
    }
}
DI void cf_sc_tile(KParams P, Frame& F, int l, int ti) {
    const bf16_t* U = WSP(bf16_t, WS_U); bf16_t* acts = WSP(bf16_t, WS_ACTS);
    const int row0 = ti * 32; int seg_lo, seg_hi;
    if (row0 < TLAT) { seg_lo = row0 & ~(SEQ - 1); seg_hi = seg_lo + SEQ; } else { seg_lo = TLAT + ((row0 - TLAT) & ~(CTXL - 1)); seg_hi = seg_lo + CTXL; }
    LAS bf16_t* gl = (LAS bf16_t*)F.lds;
    LAS float* co = (LAS float*)(F.lds + 63488);
    const int c2 = F.tid & 255, th = F.tid >> 8;
    { const bf16_t* ub = U + O_SC + 2 * c2; const float* wp = P->in[I_WSCC] + (size_t)l * 3 * 512 + 2 * c2;
      const float w0a = wp[0], w0b = wp[1], w1a = wp[512], w1b = wp[513], w2a = wp[1024], w2b = wp[1025];
      unsigned pc[18], ph[18], gb[16];
#pragma unroll
      for (int k = 0; k < 18; ++k) { const int rr = row0 + 16 * th - 1 + k; const bool ok = rr >= seg_lo && rr < seg_hi;
          pc[k] = ok ? *(const unsigned*)(ub + (size_t)rr * PWP + 512) : 0u; ph[k] = ok ? *(const unsigned*)(ub + (size_t)rr * PWP + 1024) : 0u; }
#pragma unroll
      for (int k = 0; k < 16; ++k) gb[k] = *(const unsigned*)(ub + (size_t)(row0 + 16 * th + k) * PWP);
      float pa[18], pb[18];
#pragma unroll
      for (int k = 0; k < 18; ++k) { pa[k] = bflo(pc[k]) * bflo(ph[k]); pb[k] = bfhi(pc[k]) * bfhi(ph[k]); }
#pragma unroll
      for (int k = 0; k < 16; ++k) *(unsigned*)(acts + ((size_t)3 * TT + row0 + 16 * th + k) * 512 + 2 * c2) =
          pk2(bflo(gb[k]) * (w0a * pa[k] + w1a * pa[k + 1] + w2a * pa[k + 2]), bfhi(gb[k]) * (w0b * pb[k] + w1b * pb[k + 1] + w2b * pb[k + 2])); }
    { const int cg = F.tid & 63, ri = F.tid >> 6; u32x4 ga[8], gbv[8];
#pragma unroll
      for (int pass = 0; pass < 8; ++pass) { const int i = pass * 8 + ri, rr = row0 - 15 + i; const bool ok = i < 62 && rr >= seg_lo && rr < seg_hi;
          const bf16_t* up = U + (size_t)(ok ? rr : row0) * PWP + O_CF + 8 * cg; ga[pass] = *(const u32x4*)up; gbv[pass] = *(const u32x4*)(up + 512); }
#pragma unroll
      for (int pass = 0; pass < 8; ++pass) { const int i = pass * 8 + ri, rr = row0 - 15 + i; const bool ok = rr >= seg_lo && rr < seg_hi;
          if (i < 62) { const u32x4 a = ga[pass], b = gbv[pass]; u32x4 o;
              o.x = pk2(bflo(a.x) * sigm(bflo(b.x)), bfhi(a.x) * sigm(bfhi(b.x))); o.y = pk2(bflo(a.y) * sigm(bflo(b.y)), bfhi(a.y) * sigm(bfhi(b.y)));
              o.z = pk2(bflo(a.z) * sigm(bflo(b.z)), bfhi(a.z) * sigm(bfhi(b.z))); o.w = pk2(bflo(a.w) * sigm(bflo(b.w)), bfhi(a.w) * sigm(bfhi(b.w)));
              if (!ok) o = (u32x4){0u, 0u, 0u, 0u};
              *(LAS u32x4*)(gl + i * 512 + 8 * cg) = o; } } }
    asm volatile("" ::: "memory");
    float wva[31], wvb[31];
#pragma unroll
    for (int j = 0; j < 31; ++j) { const f32x2_t w = *(const f32x2_t*)(P->in[I_WCFDW] + (size_t)(l * 31 + j) * 512 + 2 * c2); wva[j] = w[0]; wvb[j] = w[1]; }
    const f32x2_t bias = *(const f32x2_t*)(P->in[I_BCFDW] + l * 512 + 2 * c2);
    __syncthreads();
#pragma unroll 1
    for (int hb = 0; hb < 2; ++hb) { const LAS unsigned* gp = (const LAS unsigned*)(gl + (16 * th + 8 * hb) * 512 + 2 * c2); f32x2_t xin[38];
#pragma unroll
      for (int i = 0; i < 38; ++i) { const unsigned x = gp[i * 256]; xin[i] = (f32x2_t){bflo(x), bfhi(x)}; }
#pragma unroll
      for (int t = 0; t < 8; ++t) { f32x2_t a = bias;
#pragma unroll
          for (int j = 0; j < 31; ++j) a = __builtin_elementwise_fma((f32x2_t){wva[j], wvb[j]}, xin[t + j], a);
          *(LAS f32x2_t*)(co + (16 * th + 8 * hb + t) * 512 + 2 * c2) = a; } }
    __syncthreads();
#pragma unroll 1
    for (int tt = 0; tt < 4; ++tt) { const int t = F.wave * 4 + tt; const LAS float* cr = co + t * 512 + 8 * F.lane;
        const f32x4 a = *(const LAS f32x4*)cr, b = *(const LAS f32x4*)(cr + 4);
        float x[8] = {a[0], a[1], a[2], a[3], b[0], b[1], b[2], b[3]}; float s = 0.f;
#pragma unroll
        for (int i = 0; i < 8; ++i) s += x[i];
        const float mean = wave_sum(s) * (1.f / 512.f); float q = 0.f;
#pragma unroll
        for (int i = 0; i < 8; ++i) { x[i] -= mean; q += x[i] * x[i]; }
        const float rstd = 1.f / sqrtf(wave_sum(q) * (1.f / 512.f) + EPS);
        const float* g = P->in[I_GCFLN] + l * 512 + 8 * F.lane; const float* bb = P->in[I_BCFLN] + l * 512 + 8 * F.lane; float y[8];
#pragma unroll
        for (int i = 0; i < 8; ++i) y[i] = siluf(x[i] * rstd * g[i] + bb[i]);
        u32x4 o; o.x = pk2(y[0], y[1]); o.y = pk2(y[2], y[3]); o.z = pk2(y[4], y[5]); o.w = pk2(y[6], y[7]);
        *(u32x4*)(acts + ((size_t)1 * TT + row0 + t) * 512 + 8 * F.lane) = o; }
    __syncthreads();
}

constexpr int GPD = 72;
constexpr int GL_LOW = 0, GL_GSUM = 8192, GL_VT = 10240, GL_A0 = 28672, GL_KD = 37888, GL_QI = 47104, GL_ST = 56320, GL_PP = 74752, GL_OB = 83968;
DI void gla_chunk_decode(int ci, int& b, int& row0, int& jf, int& jb) {
    if (ci < 128) { b = ci >> 5; const int c = ci & 31; row0 = b * SEQ + c * 64; jf = 4 + c; jb = 4 + (31 - c); }
    else { const int cc = ci - 128; b = cc >> 2; const int c = cc & 3; row0 = TLAT + b * CTXL + c * 64; jf = c; jb = 3 - c; }
}
DI int gla_cidx(int b, int hh, int dir, int j) { return ((b * 4 + hh) * 2 + dir) * NCHAIN + j; }
DI void lds_mma_nt(f32x16& acc, const LAS bf16_t* A, int a_row0, const LAS bf16_t* B, int b_row0, int r, int h) {
#pragma unroll
    for (int k0 = 0; k0 < 64; k0 += 16) {
        const bf16x8 a = *(const LAS bf16x8*)(A + (a_row0 + r) * GPD + k0 + 8 * h);
        const bf16x8 b = *(const LAS bf16x8*)(B + (b_row0 + r) * GPD + k0 + 8 * h);
        acc = __builtin_amdgcn_mfma_f32_32x32x16_bf16(a, b, acc, 0, 0, 0);
    }
}
DI float logsig(float z) { return fminf(z, 0.f) - __logf(1.f + __expf(-fabsf(z))); }
DI void gla_decay(Frame& F, int dir, const float (&w2v)[16], float b2, float (&cs)[8], float& off, float& total, float& mid) {
    const LAS float* low = (const LAS float*)(F.lds + GL_LOW); LAS float* gsum = (LAS float*)(F.lds + GL_GSUM);
    const int d = F.tid & 63, tg = F.tid >> 6;
    float la[8];
#pragma unroll
    for (int i = 0; i < 8; ++i) { const LAS float* lp = low + (tg * 8 + i) * 32 + dir * 16; float z = b2;
#pragma unroll
        for (int j = 0; j < 16; ++j) z += lp[j] * w2v[j];
        la[i] = logsig(z) * (1.f / 16.f); }
    if (dir == 0) { cs[0] = la[0];
#pragma unroll
        for (int i = 1; i < 8; ++i) cs[i] = cs[i - 1] + la[i];
        gsum[tg * 64 + d] = cs[7]; }
    else { cs[7] = la[7];
#pragma unroll
        for (int i = 6; i >= 0; --i) cs[i] = cs[i + 1] + la[i];
        gsum[tg * 64 + d] = cs[0]; }
    __syncthreads();
    float g[8];
#pragma unroll
    for (int q = 0; q < 8; ++q) g[q] = gsum[q * 64 + d];
    total = 0.f; off = 0.f; mid = 0.f;
#pragma unroll
    for (int q = 0; q < 8; ++q) { total += g[q]; if (dir == 0) { off += (q < tg) ? g[q] : 0.f; mid += (q <= 3) ? g[q] : 0.f; } else { off += (q > tg) ? g[q] : 0.f; mid += (q >= 4) ? g[q] : 0.f; } }
}
#define GLA_PRELOAD() \
    const int d = F.tid & 63, tg = F.tid >> 6, dcol = hh * 64 + d; \
    const u32x2 loww = *(const u32x2*)(U + (size_t)(row0 + (F.tid >> 3)) * PWP + O_GF + (F.tid & 7) * 4); \
    const u32x4 vva = *(const u32x4*)(U + (size_t)(row0 + (F.tid >> 3)) * PWP + O_GV + hh * 128 + (F.tid & 7) * 16), vvb = *(const u32x4*)(U + (size_t)(row0 + (F.tid >> 3)) * PWP + O_GV + hh * 128 + (F.tid & 7) * 16 + 8); \
    float w2f[16], w2b[16]; \
    _Pragma("unroll") for (int j = 0; j < 16; ++j) { w2f[j] = P->in[I_WGF][(size_t)l * 16 * 256 + j * 256 + dcol]; w2b[j] = P->in[I_WGB][(size_t)l * 16 * 256 + j * 256 + dcol]; } \
    const float b2f = P->in[I_BGF][l * 256 + dcol], b2b = P->in[I_BGB][l * 256 + dcol]; \
    bf16_t kh_[8]; \
    _Pragma("unroll") for (int i = 0; i < 8; ++i) kh_[i] = U[(size_t)(row0 + tg * 8 + i) * PWP + O_GK + hh * 64 + d];
#define GLA_PRELOAD_DONE() __builtin_amdgcn_sched_barrier(0); float kraw[8]; _Pragma("unroll") for (int i = 0; i < 8; ++i) kraw[i] = bf2f(kh_[i]);
#define GLA_STAGE_LOW_VT() do { LAS float* low_ = (LAS float*)(F.lds + GL_LOW); const int t_ = F.tid >> 3, j4_ = (F.tid & 7) * 4, v16_ = (F.tid & 7) * 16; \
    low_[t_ * 32 + j4_] = bflo(loww.x); low_[t_ * 32 + j4_ + 1] = bfhi(loww.x); low_[t_ * 32 + j4_ + 2] = bflo(loww.y); low_[t_ * 32 + j4_ + 3] = bfhi(loww.y); \
    const unsigned w_[8] = {vva.x, vva.y, vva.z, vva.w, vvb.x, vvb.y, vvb.z, vvb.w}; \
    _Pragma("unroll") for (int i = 0; i < 8; ++i) { VT[(v16_ + 2 * i) * GPD + t_] = (bf16_t)(w_[i] & 0xffffu); VT[(v16_ + 2 * i + 1) * GPD + t_] = (bf16_t)(w_[i] >> 16); } } while (0)
DI void gla_a_item(KParams P, Frame& F, int l, int ci, int hh) {
    const bf16_t* U = WSP(bf16_t, WS_U); bf16_t* Sloc = WSP(bf16_t, WS_SLOC); float* dec = WSP(float, WS_DEC);
    int b, row0, jf, jb; gla_chunk_decode(ci, b, row0, jf, jb);
    LAS bf16_t* VT = (LAS bf16_t*)(F.lds + GL_VT); LAS bf16_t* KET = (LAS bf16_t*)(F.lds + GL_A0);
    const int r = F.lane & 31, h = F.lane >> 5, mb = F.wave & 1, nb = F.wave >> 1;
    GLA_PRELOAD();
    GLA_PRELOAD_DONE();
    GLA_STAGE_LOW_VT();
    __syncthreads();
#pragma unroll
    for (int dir = 0; dir < 2; ++dir) {
        float cs[8], off, total, mid; gla_decay(F, dir, dir ? w2b : w2f, dir ? b2b : b2f, cs, off, total, mid);
        const int cidx = gla_cidx(b, hh, dir, dir ? jb : jf);
#pragma unroll
        for (int i = 0; i < 8; ++i) KET[d * GPD + tg * 8 + i] = f2bf(kraw[i] * __expf(total - (off + cs[i])));
        if (tg == 0) dec[(size_t)cidx * 64 + d] = __expf(total);
        __syncthreads();
        f32x16 acc;
#pragma unroll
        for (int i = 0; i < 16; ++i) acc[i] = 0.f;
        lds_mma_nt(acc, KET, 32 * mb, VT, 32 * nb, r, h);
        bf16_t* sp = Sloc + ((size_t)cidx * 128 + 32 * nb + r) * 64 + 32 * mb + 4 * h;
#pragma unroll
        for (int g = 0; g < 4; ++g) *(u32x2*)(sp + 8 * g) = (u32x2){pk2(acc[4 * g], acc[4 * g + 1]), pk2(acc[4 * g + 2], acc[4 * g + 3])};
        __syncthreads();
    }
}
DI void gla_scan(KParams P, Frame& F) {
    const bf16_t* Sloc = WSP(bf16_t, WS_SLOC); const float* dec = WSP(float, WS_DEC); bf16_t* Sin = WSP(bf16_t, WS_SIN);
    for (int e = F.bid * 512 + F.tid; e < 32 * 4096; e += F.G * 512) { const int chain = e >> 12, vd = (e & 4095) * 2, d = vd & 63; float S0 = 0.f, S1 = 0.f;
#pragma unroll 1
        for (int j0 = 0; j0 < NCHAIN; j0 += 12) { f32x2_t sl[12], dc[12];
#pragma unroll
            for (int j = 0; j < 12; ++j) { const size_t idx = (size_t)chain * NCHAIN + j0 + j; { const unsigned w = *(const unsigned*)(Sloc + idx * 8192 + vd); sl[j] = (f32x2_t){bflo(w), bfhi(w)}; } dc[j] = *(const f32x2_t*)(dec + idx * 64 + d); }
#pragma unroll
            for (int j = 0; j < 12; ++j) { const size_t idx = (size_t)chain * NCHAIN + j0 + j; *(unsigned*)(Sin + idx * 8192 + vd) = pk2(S0, S1); S0 = dc[j][0] * S0 + sl[j][0]; S1 = dc[j][1] * S1 + sl[j][1]; } } }
}
DI void gla_b_item(KParams P, Frame& F, int l, int ci, int hh) {
    const bf16_t* U = WSP(bf16_t, WS_U); const bf16_t* Sin = WSP(bf16_t, WS_SIN); bf16_t* acts = WSP(bf16_t, WS_ACTS);
    int b, row0, jf, jb; gla_chunk_decode(ci, b, row0, jf, jb);
    LAS bf16_t* VT = (LAS bf16_t*)(F.lds + GL_VT); LAS bf16_t* QD = (LAS bf16_t*)(F.lds + GL_A0); LAS bf16_t* KD = (LAS bf16_t*)(F.lds + GL_KD); LAS bf16_t* QI = (LAS bf16_t*)(F.lds + GL_QI);
    LAS bf16_t* ST = (LAS bf16_t*)(F.lds + GL_ST); LAS bf16_t* PP = (LAS bf16_t*)(F.lds + GL_PP); LAS float* OB = (LAS float*)(F.lds + GL_OB);
    const int r = F.lane & 31, h = F.lane >> 5, tb = F.wave & 1, vb = F.wave >> 1;
    GLA_PRELOAD();
    bf16_t qh_[8];
#pragma unroll
    for (int i = 0; i < 8; ++i) qh_[i] = U[(size_t)(row0 + tg * 8 + i) * PWP + O_GQ + hh * 64 + d];
    const int sv = F.tid >> 2, sd16 = (F.tid & 3) * 16;
    const bf16_t* spf = Sin + ((size_t)gla_cidx(b, hh, 0, jf) * 128 + sv) * 64 + sd16; const bf16_t* spb = Sin + ((size_t)gla_cidx(b, hh, 1, jb) * 128 + sv) * 64 + sd16;
    const u32x4 sf0 = *(const u32x4*)spf, sf1 = *(const u32x4*)(spf + 8), sb0 = *(const u32x4*)spb, sb1 = *(const u32x4*)(spb + 8);
    const int ot = F.tid >> 3, ov0 = (F.tid & 7) * 16;
    const bf16_t* rp = U + (size_t)(row0 + ot) * PWP + O_GR + hh * 128 + ov0; const u32x4 r0 = *(const u32x4*)rp, r1 = *(const u32x4*)(rp + 8);
    GLA_PRELOAD_DONE();
    float qraw[8];
#pragma unroll
    for (int i = 0; i < 8; ++i) qraw[i] = bf2f(qh_[i]) * 0.125f;
    GLA_STAGE_LOW_VT();
    __syncthreads();
    f32x16 acc;
#pragma unroll
    for (int i = 0; i < 16; ++i) acc[i] = 0.f;
#pragma unroll
    for (int dir = 0; dir < 2; ++dir) {
        float cs[8], off, total, mid; gla_decay(F, dir, dir ? w2b : w2f, dir ? b2b : b2f, cs, off, total, mid);
#pragma unroll
        for (int i = 0; i < 8; ++i) { const int t = tg * 8 + i; const float bc = off + cs[i];
            QD[t * GPD + d] = f2bf(qraw[i] * __expf(bc - mid)); KD[t * GPD + d] = f2bf(kraw[i] * __expf(mid - bc)); QI[t * GPD + d] = f2bf(qraw[i] * __expf(bc)); }
        *(LAS u32x4*)(ST + sv * GPD + sd16) = dir ? sb0 : sf0; *(LAS u32x4*)(ST + sv * GPD + sd16 + 8) = dir ? sb1 : sf1;
        __syncthreads();
        if (F.wave < 4) { const int tb2 = F.wave & 1, sb = F.wave >> 1; f32x16 a;
#pragma unroll
            for (int i = 0; i < 16; ++i) a[i] = 0.f;
            lds_mma_nt(a, QD, 32 * tb2, KD, 32 * sb, r, h);
#pragma unroll
            for (int i = 0; i < 16; ++i) { const int t = 32 * tb2 + (i & 3) + 8 * (i >> 2) + 4 * h, s2 = 32 * sb + r; const bool keep = dir ? (s2 >= t) : (s2 <= t);
                PP[t * GPD + s2] = f2bf(keep ? a[i] : 0.f); } }
        __syncthreads();
        lds_mma_nt(acc, PP, 32 * tb, VT, 32 * vb, r, h);
        lds_mma_nt(acc, QI, 32 * tb, ST, 32 * vb, r, h);
        __syncthreads();
    }
#pragma unroll
    for (int i = 0; i < 16; ++i) OB[(32 * tb + (i & 3) + 8 * (i >> 2) + 4 * h) * 128 + 32 * vb + r] = acc[i];
    __syncthreads();
    { float x[16]; float ss = 0.f;
#pragma unroll
      for (int q = 0; q < 4; ++q) { const f32x4 o = *(const LAS f32x4*)(OB + ot * 128 + ov0 + 4 * q); x[4 * q] = o[0]; x[4 * q + 1] = o[1]; x[4 * q + 2] = o[2]; x[4 * q + 3] = o[3]; }
#pragma unroll
      for (int i = 0; i < 16; ++i) ss += x[i] * x[i];
      ss += __shfl_xor(ss, 1); ss += __shfl_xor(ss, 2); ss += __shfl_xor(ss, 4);
      const float rstd = 1.f / sqrtf(ss * (1.f / 128.f) + EPS);
      const unsigned rw[8] = {r0.x, r0.y, r0.z, r0.w, r1.x, r1.y, r1.z, r1.w}; const float* gn = P->in[I_GGLAN] + l * 128 + ov0; unsigned ow[8];
#pragma unroll
      for (int i = 0; i < 8; ++i) ow[i] = pk2(x[2 * i] * rstd * gn[2 * i] * siluf(bflo(rw[i])), x[2 * i + 1] * rstd * gn[2 * i + 1] * siluf(bfhi(rw[i])));
      bf16_t* op = acts + ((size_t)2 * TT + row0 + ot) * 512 + hh * 128 + ov0;
      *(u32x4*)op = (u32x4){ow[0], ow[1], ow[2], ow[3]}; *(u32x4*)(op + 8) = (u32x4){ow[4], ow[5], ow[6], ow[7]}; }
    __syncthreads();
}
DI float at_max2(float a, float b) { return __builtin_amdgcn_fmed3f(a, b, INFINITY); }
constexpr int AT_KC = 1040, AT_VG = 520;
constexpr int AT_K0 = 0, AT_K1 = 16 * AT_KC, AT_V0 = 32 * AT_KC, AT_V1 = 32 * AT_KC + 16 * AT_VG;
DI void attn_unit(KParams P, Frame& F, int b, int hh, int qrow0, int nlat) {
    const bf16_t* Q = WSP(bf16_t, WS_Q); const bf16_t* KN = WSP(bf16_t, WS_KN); const bf16_t* KRP = WSP(bf16_t, WS_KRP); const bf16_t* VT = WSP(bf16_t, WS_VT); bf16_t* acts = WSP(bf16_t, WS_ACTS);
    const int ntile = nlat + 4; const int r = F.lane & 31, h = F.lane >> 5;
    const int kvi = F.tid >> 3, kc = F.tid & 7;
    const float C = 0.10206207261596577f * 1.4426950408889634f;
    const int qrow = qrow0 + 32 * F.wave + r; const bf16_t* qp = Q + (size_t)qrow * 768 + hh * 96;
    bf16x8 qf[8];
#pragma unroll
    for (int s = 0; s < 4; ++s) { const u32x4 a = *(const u32x4*)(qp + 16 * s + 8 * h);
        u32x4 o; o.x = pk2(C * bflo(a.x), C * bfhi(a.x)); o.y = pk2(C * bflo(a.y), C * bfhi(a.y)); o.z = pk2(C * bflo(a.z), C * bfhi(a.z)); o.w = pk2(C * bflo(a.w), C * bfhi(a.w)); qf[s] = __builtin_bit_cast(bf16x8, o); }
    { const u32x4 a1 = *(const u32x4*)(qp + 64), a2 = *(const u32x4*)(qp + 72), c1 = *(const u32x4*)(qp + 80), c2 = *(const u32x4*)(qp + 88);
      const float ra1[8] = {bflo(a1.x), bfhi(a1.x), bflo(a1.y), bfhi(a1.y), bflo(a1.z), bfhi(a1.z), bflo(a1.w), bfhi(a1.w)}, ra2[8] = {bflo(a2.x), bfhi(a2.x), bflo(a2.y), bfhi(a2.y), bflo(a2.z), bfhi(a2.z), bflo(a2.w), bfhi(a2.w)};
      const float rc1[8] = {bflo(c1.x), bfhi(c1.x), bflo(c1.y), bfhi(c1.y), bflo(c1.z), bfhi(c1.z), bflo(c1.w), bfhi(c1.w)}, rc2[8] = {bflo(c2.x), bfhi(c2.x), bflo(c2.y), bfhi(c2.y), bflo(c2.z), bfhi(c2.z), bflo(c2.w), bfhi(c2.w)};
      float ur[8], uc[8], xr[8], xc[8];
      const int pos = qrow & (SEQ - 1); const float prow = (float)(pos >> 6), pcol = (float)(pos & 63);
#pragma unroll
      for (int i = 0; i < 8; ++i) { ur[i] = C * (h ? ra2[i] : ra1[i]); uc[i] = C * (h ? rc2[i] : rc1[i]);
          if (nlat > 0) { const float f = rope_freq(i); float sn = __sinf(prow * f), cs = __cosf(prow * f); xr[i] = C * (h ? (ra1[i] * sn + ra2[i] * cs) : (ra1[i] * cs - ra2[i] * sn));
              sn = __sinf(pcol * f); cs = __cosf(pcol * f); xc[i] = C * (h ? (rc1[i] * sn + rc2[i] * cs) : (rc1[i] * cs - rc2[i] * sn)); }
          else { xr[i] = 0.f; xc[i] = 0.f; } }
      u32x4 o;
      o.x = pk2(xr[0], xr[1]); o.y = pk2(xr[2], xr[3]); o.z = pk2(xr[4], xr[5]); o.w = pk2(xr[6], xr[7]); qf[4] = __builtin_bit_cast(bf16x8, o);
      o.x = pk2(xc[0], xc[1]); o.y = pk2(xc[2], xc[3]); o.z = pk2(xc[4], xc[5]); o.w = pk2(xc[6], xc[7]); qf[5] = __builtin_bit_cast(bf16x8, o);
      o.x = pk2(ur[0], ur[1]); o.y = pk2(ur[2], ur[3]); o.z = pk2(ur[4], ur[5]); o.w = pk2(ur[6], ur[7]); qf[6] = __builtin_bit_cast(bf16x8, o);
      o.x = pk2(uc[0], uc[1]); o.y = pk2(uc[2], uc[3]); o.z = pk2(uc[4], uc[5]); o.w = pk2(uc[6], uc[7]); qf[7] = __builtin_bit_cast(bf16x8, o); }
    u32x4 kA0, kA1, vA, kB0, kB1, vB;
#define AT_KROW(tl) (((tl) < nlat) ? (b * SEQ + (tl) * 64) : (TLAT + b * CTXL + ((tl) - nlat) * 64))
#define AT_LOADK(tl, R0, R1) do { const int krow0_ = AT_KROW(tl); R0 = *(const u32x4*)(KN + (size_t)(krow0_ + kvi) * 512 + hh * 64 + kc * 8); R1 = *(const u32x4*)(KRP + (size_t)(krow0_ + kvi) * 64 + kc * 8); } while (0)
#define AT_LOADV(tl, R) do { const int krow0_ = AT_KROW(tl); R = *(const u32x4*)(VT + (size_t)(hh * 64 + kvi) * TT + krow0_ + kc * 8); } while (0)
#define AT_STOREK(buf, R0, R1) do { LAS unsigned char* kb_ = F.lds + ((buf) ? AT_K1 : AT_K0); *(LAS u32x4*)(kb_ + kc * AT_KC + kvi * 16) = R0; *(LAS u32x4*)(kb_ + (8 + kc) * AT_KC + kvi * 16) = R1; } while (0)
#define AT_STOREV(buf, R) do { LAS unsigned char* vb_ = F.lds + ((buf) ? AT_V1 : AT_V0); *(LAS u32x2*)(vb_ + (kc & ~1) * AT_KC + kvi * 16 + (kc & 1) * 8) = (u32x2){R.x, R.y}; *(LAS u32x2*)(vb_ + ((kc & ~1) + 1) * AT_KC + kvi * 16 + (kc & 1) * 8) = (u32x2){R.z, R.w}; } while (0)
#define AT_QK(P0, P1, buf, LAT) do { const LAS unsigned char* kb_ = F.lds + ((buf) ? AT_K1 : AT_K0); \
        _Pragma("unroll") for (int i = 0; i < 16; ++i) { P0[i] = 0.f; P1[i] = 0.f; } \
        _Pragma("unroll") for (int s = 0; s < 8; ++s) if ((LAT) ? (s < 6) : (s < 4 || s >= 6)) { const bf16x8 ka0 = *(const LAS bf16x8*)(kb_ + (2 * s + h) * AT_KC + r * 16), ka1 = *(const LAS bf16x8*)(kb_ + (2 * s + h) * AT_KC + (32 + r) * 16); \
            P0 = __builtin_amdgcn_mfma_f32_32x32x16_bf16(ka0, qf[s], P0, 0, 0, 0); P1 = __builtin_amdgcn_mfma_f32_32x32x16_bf16(ka1, qf[s], P1, 0, 0, 0); } } while (0)
#define AT_COMPUTE(tl, LAT) do { const int cur = (tl) & 1; f32x16 pc0, pc1; \
        AT_QK(pc0, pc1, cur, LAT);                                                 \
        const LAS unsigned char* vb = F.lds + (cur ? AT_V1 : AT_V0); \
        float mxa = at_max2(pc0[0], pc0[1]), mxb = at_max2(pc1[0], pc1[1]); \
        _Pragma("unroll") for (int i = 2; i < 16; ++i) { mxa = at_max2(mxa, pc0[i]); mxb = at_max2(mxb, pc1[i]); } \
        float mx = at_max2(mxa, mxb); mx = at_max2(mx, __shfl_xor(mx, 32)); \
        const float mnew = at_max2(m_run, mx), alpha = __builtin_amdgcn_exp2f(m_run - mnew); m_run = mnew; \
        const f32x2_t nm2 = (f32x2_t){-mnew, -mnew}; f32x2_t ps2 = (f32x2_t){0.f, 0.f};                  \
        _Pragma("unroll") for (int i = 0; i < 8; ++i) { \
            f32x2_t ta = (f32x2_t){pc0[2 * i], pc0[2 * i + 1]} + nm2, tb = (f32x2_t){pc1[2 * i], pc1[2 * i + 1]} + nm2; \
            ta[0] = __builtin_amdgcn_exp2f(ta[0]); ta[1] = __builtin_amdgcn_exp2f(ta[1]); tb[0] = __builtin_amdgcn_exp2f(tb[0]); tb[1] = __builtin_amdgcn_exp2f(tb[1]); \
            ps2 = ps2 + (ta + tb); pc0[2 * i] = ta[0]; pc0[2 * i + 1] = ta[1]; pc1[2 * i] = tb[0]; pc1[2 * i + 1] = tb[1]; } \
        const float psum = ps2[0] + ps2[1]; \
        l_run = l_run * alpha + psum; \
        _Pragma("unroll") for (int i = 0; i < 16; ++i) { o0[i] *= alpha; o1[i] *= alpha; } \
        bf16x8 pf[4]; \
        { u32x4 w; \
          w.x = pk2(pc0[0], pc0[1]); w.y = pk2(pc0[2], pc0[3]); w.z = pk2(pc0[4], pc0[5]); w.w = pk2(pc0[6], pc0[7]); pf[0] = __builtin_bit_cast(bf16x8, w); \
          w.x = pk2(pc0[8], pc0[9]); w.y = pk2(pc0[10], pc0[11]); w.z = pk2(pc0[12], pc0[13]); w.w = pk2(pc0[14], pc0[15]); pf[1] = __builtin_bit_cast(bf16x8, w); \
          w.x = pk2(pc1[0], pc1[1]); w.y = pk2(pc1[2], pc1[3]); w.z = pk2(pc1[4], pc1[5]); w.w = pk2(pc1[6], pc1[7]); pf[2] = __builtin_bit_cast(bf16x8, w); \
          w.x = pk2(pc1[8], pc1[9]); w.y = pk2(pc1[10], pc1[11]); w.z = pk2(pc1[12], pc1[13]); w.w = pk2(pc1[14], pc1[15]); pf[3] = __builtin_bit_cast(bf16x8, w); } \
        _Pragma("unroll") for (int s = 0; s < 4; ++s) { \
            const u32x4 va0 = *(const LAS u32x4*)(vb + (2 * s + h) * AT_KC + r * 16), va1 = *(const LAS u32x4*)(vb + (2 * s + h) * AT_KC + (32 + r) * 16); \
            o0 = __builtin_amdgcn_mfma_f32_32x32x16_bf16(__builtin_bit_cast(bf16x8, va0), pf[s], o0, 0, 0, 0); \
            o1 = __builtin_amdgcn_mfma_f32_32x32x16_bf16(__builtin_bit_cast(bf16x8, va1), pf[s], o1, 0, 0, 0); } } while (0)
#define AT_ITER(tl, LAT, LK0, LK1, LV, SK0, SK1, SV) do { \
        if ((tl) + 2 < ntile) { AT_LOADK((tl) + 2, LK0, LK1); AT_LOADV((tl) + 2, LV); } \
        AT_COMPUTE(tl, LAT); \
        if ((tl) + 1 < ntile) { AT_STOREK(((tl) & 1) ^ 1, SK0, SK1); AT_STOREV(((tl) & 1) ^ 1, SV); } \
        __syncthreads(); } while (0)
    float m_run = -INFINITY, l_run = 0.f; f32x16 o0, o1;
#pragma unroll
    for (int i = 0; i < 16; ++i) { o0[i] = 0.f; o1[i] = 0.f; }
    AT_LOADK(0, kA0, kA1); AT_LOADV(0, vA); AT_LOADK(1, kB0, kB1); AT_LOADV(1, vB);
    AT_STOREK(0, kA0, kA1); AT_STOREV(0, vA);
    __syncthreads();
#pragma unroll 1
    for (int tl = 0; tl < nlat; tl += 2) {
        AT_ITER(tl, true, kA0, kA1, vA, kB0, kB1, vB);
        AT_ITER(tl + 1, true, kB0, kB1, vB, kA0, kA1, vA);
    }
#pragma unroll 1
    for (int tl = nlat; tl < ntile; tl += 2) {
        AT_ITER(tl, false, kA0, kA1, vA, kB0, kB1, vB);
        AT_ITER(tl + 1, false, kB0, kB1, vB, kA0, kA1, vA);
    }
#undef AT_COMPUTE
#undef AT_ITER
#undef AT_KROW
#undef AT_LOADK
#undef AT_LOADV
#undef AT_STOREK
#undef AT_STOREV
#undef AT_QK
    const float inv = 1.f / (l_run + __shfl_xor(l_run, 32));
    bf16_t* op = acts + (size_t)qrow * 512 + hh * 64 + 4 * h;
#pragma unroll
    for (int g = 0; g < 4; ++g) { u32x2 w; w.x = pk2(o0[4 * g] * inv, o0[4 * g + 1] * inv); w.y = pk2(o0[4 * g + 2] * inv, o0[4 * g + 3] * inv); *(u32x2*)(op + 8 * g) = w;
        w.x = pk2(o1[4 * g] * inv, o1[4 * g + 1] * inv); w.y = pk2(o1[4 * g + 2] * inv, o1[4 * g + 3] * inv); *(u32x2*)(op + 32 + 8 * g) = w; }
}

DI KParams load_params() { KParams kp = (KParams)__builtin_amdgcn_kernarg_segment_ptr(); asm volatile("" : "+s"(kp)); return kp; }
DI Frame phase_frame(const Frame& F0) { Frame F = F0; int t = F0.tid; asm volatile("" : "+v"(t)); { int b = F0.bid, g = F0.G; asm volatile("" : "+s"(b), "+s"(g)); F.bid = b; F.G = g; F.NGW = g * 8; } F.tid = t; F.lane = t & 63; F.wave = __builtin_amdgcn_readfirstlane(t >> 6); F.gw = F.bid * 8 + F.wave; return F; }
constexpr int PH_PER_LAYER = 10, NPHASE = 1 + DEPTH * PH_PER_LAYER + 1;
__global__ void __launch_bounds__(512, 2) hybrid_trunk_fwd(Params P) {
    extern __shared__ __attribute__((aligned(16))) unsigned char lds_raw[];
    Frame F; F.lds = (LAS unsigned char*)lds_raw; F.tid = threadIdx.x; F.lane = F.tid & 63; F.wave = __builtin_amdgcn_readfirstlane(F.tid >> 6);
    F.G = gridDim.x; F.bid = blockIdx.x; F.gw = F.bid * 8 + F.wave; F.NGW = F.G * 8;
    const int vcu = (F.G % 8 == 0) ? (F.bid % 8) * (F.G / 8) + F.bid / 8 : F.bid;
    for (int u = F.tid; u < (LDS_BYTES - LDSX_OFF) / 4; u += 512) ((LAS unsigned*)(F.lds + LDSX_OFF))[u] = 0u;
    __syncthreads();
    const int lo = P.ph_lo, hi = P.ph_hi;
    XcdBarrier bar; bar.bar = (unsigned*)(P.ws + WS_CTL) + CW_BAR; bar.x = 0; bar.st = (volatile LAS unsigned*)(F.lds + LDSX_OFF);
    if (hi - lo > 1) bar = xcd_barrier_post((unsigned*)(P.ws + WS_CTL) + CW_BAR, (volatile LAS unsigned*)(F.lds + LDSX_OFF));
#ifndef PH_MASK
#define PH_MASK 0xffff
#endif
#define PHM(b) ((PH_MASK >> (b)) & 1)
#ifndef DUP_MASK
#define DUP_MASK 0
#endif
#define REP(b) (1 + ((DUP_MASK >> (b)) & 1))
#define IN(k) (lo <= (k) && (k) < hi)
#ifndef DUP_BAR
#define DUP_BAR 0
#endif
#define SEAM(k) do { if (IN(k) && IN((k) + 1)) { xcd_barrier(bar); if (DUP_BAR) xcd_barrier(bar); } } while (0)
    if (PHM(0) && IN(0)) for (int rep_ = 0; rep_ < REP(0); ++rep_) { KParams Q = load_params(); Frame Fp = phase_frame(F); phase_prologue(Q, Fp);
        conv_mixed(Q, Fp, 0, 0, NS_ALL, 0, NL_ITEMS, Fp.bid, Fp.G); }
    SEAM(0);
    for (int l = 0; l < DEPTH; ++l) {
        const int pb = 1 + PH_PER_LAYER * l;
        if (PHM(1) && IN(pb + 0)) for (int rep_ = 0; rep_ < REP(1); ++rep_) { KParams Q = load_params(); Frame Fp = phase_frame(F); phase_norm1(Q, Fp, l, rep_ + 1 < REP(1)); }
        SEAM(pb + 0);
        if (PHM(2) && IN(pb + 1)) for (int rep_ = 0; rep_ < REP(2); ++rep_) { KParams Q = load_params(); Frame Fp = phase_frame(F);
            const bool lastl = (l == DEPTH - 1); const int nM1 = lastl ? TLAT / 256 : TT / 256;
            pg8::Gemm g8{(const bf16_t*)(Q->ws + WS_H8), (const bf16_t*)(Q->ws + WS_W8 + (size_t)l * PWP * DM), DM / 2, 0, 0};
            pg8::TrimOrder S8{nM1, PWP / 256, nM1 * (PWP / 256), lastl ? (TCTX / 256) * 6 : 0, Fp.G, Fp.bid};
            pg8::EpiStoreQ E8{(bf16_t*)(Q->ws + WS_U), PWP, (const float*)(Q->ws + WS_RA), (const float*)(Q->ws + WS_RB) + (size_t)l * PWP, Q->ws + WS_G8};
            pg8::gemm_phase_i8<pg8::EpiStoreQ, pg8::TrimOrder>(Fp.lds, g8, S8, E8); }
        SEAM(pb + 1);
        if (PHM(3) && IN(pb + 2)) for (int rep_ = 0; rep_ < REP(3); ++rep_) { KParams Q = load_params(); Frame Fp = phase_frame(F); bf16_t* U = (bf16_t*)(Q->ws + WS_U); (void)U; mla_prep_rows(Q, Fp, l);
            const int ncf = (l == DEPTH - 1) ? TLAT / 32 : TT / 32;
            for (int it = vcu; it < ncf; it += Fp.G) cf_sc_tile(Q, Fp, l, it);
            { const int extra = ncf > Fp.G ? ncf - Fp.G : 0;
              if (vcu >= extra) for (int it = vcu - extra; it < 144 * 4; it += Fp.G - extra) gla_a_item(Q, Fp, l, it >> 2, it & 3); } }
        SEAM(pb + 2);
        if (PHM(4) && IN(pb + 3)) for (int rep_ = 0; rep_ < REP(4); ++rep_) { KParams Q = load_params(); Frame Fp = phase_frame(F); bf16_t* U = (bf16_t*)(Q->ws + WS_U); (void)U;
            const int nq = ((l == DEPTH - 1) ? TLAT / 256 : TT / 256) * 3;
            { pg8::Gemm g{WSQ(bf16_t, WS_CQN), WSQ(bf16_t, WS_WUQ) + (size_t)l * 768 * 512, 512, 0, 0}; pg8::RangeOrder S{0, nq, 3, Fp.G, Fp.bid}; pg8::EpiStore E{WSQ(bf16_t, WS_Q), 768};
              pg8::gemm_phase<pg8::EpiStore, pg8::RangeOrder>(Fp.lds, g, S, E); }
            { const bf16_t* ckvn = WSQ(bf16_t, WS_CKVN); const bf16_t* wkn = WSQ(bf16_t, WS_WKN) + (size_t)l * 512 * 256; const bf16_t* wv = WSQ(bf16_t, WS_WV) + (size_t)l * 512 * 256;
              pg8::Gemm g{ckvn, wkn, 256, (size_t)((const char*)wv - (const char*)ckvn), (size_t)((const char*)ckvn - (const char*)wkn)};
              pg8::Range2Order S{nq, 72, 2, 72, 36, Fp.G, Fp.bid}; pg8::EpiStore2 E{WSQ(bf16_t, WS_KN), 512, WSQ(bf16_t, WS_VT), TT};
              pg8::gemm_phase<pg8::EpiStore2, pg8::Range2Order>(Fp.lds, g, S, E); }
            gla_scan(Q, Fp); }
        SEAM(pb + 3);
        if (PHM(5) && IN(pb + 4)) for (int rep_ = 0; rep_ < REP(5); ++rep_) { KParams Q = load_params(); Frame Fp = phase_frame(F); bf16_t* U = (bf16_t*)(Q->ws + WS_U); (void)U;
            for (int u = vcu; u < 256; u += Fp.G) attn_unit(Q, Fp, u >> 6, (u >> 3) & 7, (u >> 6) * SEQ + (u & 7) * 256, 32);
            const bool lastl = (l == DEPTH - 1);
            if (!lastl) for (int u = vcu; u < 32; u += Fp.G) attn_unit(Q, Fp, u >> 3, u & 7, TLAT + (u >> 3) * CTXL, 0);
            for (int it = vcu; it < (lastl ? 128 : 144) * 4; it += Fp.G) gla_b_item(Q, Fp, l, it >> 2, it & 3); }
        SEAM(pb + 4);
        if (PHM(6) && IN(pb + 5)) for (int rep_ = 0; rep_ < REP(6); ++rep_) { KParams Q = load_params(); Frame Fp = phase_frame(F); bf16_t* U = (bf16_t*)(Q->ws + WS_U); (void)U; pg8::Gemm g{WSQ(bf16_t, WS_ACTS), WSQ(bf16_t, WS_WBR) + (size_t)l * 4 * DM * 512, 512, (size_t)TT * 512 * 2, (size_t)DM * 512 * 2}; pg8::MergeOrder S; S.init((l == DEPTH - 1) ? TLAT : TT, DM, Fp.G, Fp.bid);
            LAS float* gtab = (LAS float*)(Fp.lds + LDSX_OFF + 4096);
            if (Fp.tid < 256) { const float x = (float)(Fp.tid - 128) * (GATE_CLIP / 127.f), e = expf(-x); gtab[Fp.tid] = 1.f / (1.f + e); gtab[256 + Fp.tid] = 1.f + e; }
            __syncthreads();
            pg8::EpiMerge E{WSQ(bf16_t, WS_YM), (const unsigned char*)(Q->ws + WS_G8), gtab}; pg8::gemm_phase<pg8::EpiMerge, pg8::MergeOrder>(Fp.lds, g, S, E);
            if (l + 1 < DEPTH && rep_ == 0) { KParams Q2 = load_params(); Frame F2 = phase_frame(F); const int extra = (TT / 256) * (DM / 256) % F2.G; conv_mixed(Q2, F2, l + 1, 0, 600, 0, NL_F1, extra ? F2.bid - extra : F2.bid, extra ? F2.G - extra : F2.G); } }
        SEAM(pb + 5);
        if (PHM(7) && IN(pb + 6)) for (int rep_ = 0; rep_ < REP(7); ++rep_) { KParams Q = load_params(); Frame Fp = phase_frame(F); bf16_t* U = (bf16_t*)(Q->ws + WS_U); (void)U; pg8::Gemm g{WSQ(bf16_t, WS_YM), WSQ(bf16_t, WS_WMIX) + (size_t)l * DM * DM, DM, 0, 0}; pg8::StaticOrder S; S.init((l == DEPTH - 1) ? TLAT : TT, DM, Fp.G, Fp.bid);
            pg8::EpiResid E{WSQ(bf16_t, WS_X), WSQ(float, WS_MOD) + (size_t)l * 5 * (6 * DM) + 2 * DM, (rep_ + 1 < REP(7)) ? WSQ(bf16_t, WS_OUTS) : WSQ(bf16_t, WS_X)}; pg8::gemm_phase<pg8::EpiResid, pg8::StaticOrder>(Fp.lds, g, S, E);
            if (l + 1 < DEPTH && rep_ == 0) { KParams Q2 = load_params(); Frame F2 = phase_frame(F); const int extra = (TT / 256) * (DM / 256) % F2.G; conv_mixed(Q2, F2, l + 1, 600, 870, NL_F1, NL_F2, extra ? F2.bid - extra : F2.bid, extra ? F2.G - extra : F2.G); } }
        SEAM(pb + 6);
        if (PHM(8) && IN(pb + 7)) for (int rep_ = 0; rep_ < REP(8); ++rep_) { KParams Q = load_params(); Frame Fp = phase_frame(F); phase_norm2_route(Q, Fp, l, (rep_ + 1 < REP(8)) ? l + 4 : l); }
        SEAM(pb + 7);
        if (PHM(10) && IN(pb + 8)) for (int rep_ = 0; rep_ < REP(10); ++rep_) { KParams Q = load_params(); Frame Fp = phase_frame(F); bf16_t* U = (bf16_t*)(Q->ws + WS_U); (void)U; moe_table(Q, Fp, l);
            const LAS int* tpt = (const LAS int*)(Fp.lds + LDSX_OFF + 64);
            pg8::Gemm g{WSQ(bf16_t, WS_H), (const bf16_t*)(Q->ws + WS_W1 + (size_t)l * 16 * 1024 * DM), DM / 2, 0, (size_t)1024 * DM}; pg8::MoeOrder S{tpt, 4, Fp.G, Fp.bid};
            pg8::EpiSwiGLUQG E{WSQ(bf16_t, WS_ACTM), (const float*)(Q->ws + WS_ERW), (const float*)(Q->ws + WS_ERS), (const float*)(Q->ws + WS_RB1) + (size_t)l * 16 * 1024, tpt};
            pg8::gemm_phase_i8<pg8::EpiSwiGLUQG, pg8::MoeOrder, true>(Fp.lds, g, S, E, (const int*)(Q->ws + WS_ETOK), tpt);
            if (l + 1 < DEPTH && rep_ == 0) { KParams Q2 = load_params(); Frame F2 = phase_frame(F); const int nun = ((const LAS int*)(F2.lds + LDSX_OFF + 64))[16] * 4, extra = nun % F2.G;
                conv_mixed(Q2, F2, l + 1, 870, NS_ALL, NL_F2, NL_ITEMS, extra ? F2.bid - extra : F2.bid, extra ? F2.G - extra : F2.G); } }
        SEAM(pb + 8);
        if (PHM(11) && IN(pb + 9)) for (int rep_ = 0; rep_ < REP(11); ++rep_) { KParams Q = load_params(); Frame Fp = phase_frame(F); bf16_t* U = (bf16_t*)(Q->ws + WS_U); (void)U; moe_table(Q, Fp, l);
            pg8::Gemm g{WSQ(bf16_t, WS_ACTM), WSQ(bf16_t, WS_W2) + (size_t)l * 16 * DM * EFF, EFF, 0, (size_t)DM * EFF * 2}; pg8::MoeOrder S{(const LAS int*)(Fp.lds + LDSX_OFF + 64), 8, Fp.G, Fp.bid};
            pg8::EpiStore E{WSQ(bf16_t, WS_OUTS), DM}; pg8::gemm_phase<pg8::EpiStore, pg8::MoeOrder>(Fp.lds, g, S, E); }
        SEAM(pb + 9);
    }
    if (PHM(12) && IN(NPHASE - 1)) for (int rep_ = 0; rep_ < REP(12); ++rep_) { KParams Q = load_params(); Frame Fp = phase_frame(F); phase_final(Q, Fp); }
#undef IN
#undef SEAM
}

#ifndef MK_ONE_LAUNCH
#define MK_ONE_LAUNCH 1
#endif
extern "C" void kernel_launch(void* const* d_in, const int* in_sizes, int n_in, void* d_out, int out_size, void* d_ws, size_t ws_size, hipStream_t stream) {
    static int grid = 0;
    if (grid == 0) {
        if (n_in != 34 || out_size != TLAT * DM || ws_size < WS_END) { fprintf(stderr, "kernel_launch: unexpected problem: n_in %d out %d ws %zu (need %zu)\n", n_in, out_size, ws_size, (size_t)WS_END); grid = -1; return; }
        int dev = 0, cus = 0, per_cu = 0;
        if (hipGetDevice(&dev) != hipSuccess || hipDeviceGetAttribute(&cus, hipDeviceAttributeMultiprocessorCount, dev) != hipSuccess) { grid = -1; return; }
        if (hipFuncSetAttribute((const void*)hybrid_trunk_fwd, hipFuncAttributeMaxDynamicSharedMemorySize, LDS_BYTES) != hipSuccess) { fprintf(stderr, "kernel_launch: hipFuncSetAttribute failed\n"); grid = -1; return; }
        if (hipOccupancyMaxActiveBlocksPerMultiprocessor(&per_cu, (const void*)hybrid_trunk_fwd, 512, LDS_BYTES) != hipSuccess || per_cu < 1) { fprintf(stderr, "kernel_launch: occupancy query says %d\n", per_cu); }
        (void)hipGetLastError();
        grid = cus;
    }
    if (grid < 0) return;
    (void)hipMemsetAsync((char*)d_ws + WS_CTL, 0, CTL_ZERO_BYTES, stream);
    Params p{};
    for (int i = 0; i < 34; ++i) p.in[i] = (const float*)d_in[i];
    p.out = (float*)d_out; p.ws = (unsigned char*)d_ws;
#if MK_ONE_LAUNCH
    p.ph_lo = 0; p.ph_hi = NPHASE;
    hipLaunchKernelGGL(hybrid_trunk_fwd, dim3(grid), dim3(512), LDS_BYTES, stream, p);
#else
    for (int k = 0; k < NPHASE; ++k) { p.ph_lo = k; p.ph_hi = k + 1; hipLaunchKernelGGL(hybrid_trunk_fwd, dim3(grid), dim3(512), LDS_BYTES, stream, p); }
#endif
}
```

```cpp
#include <hip/hip_runtime.h>
#include <cstdio>
#include <cstdint>

#define DI __device__ __forceinline__
#define LAS __attribute__((address_space(3)))
typedef unsigned short bf16_t;
typedef short bf16x8 __attribute__((ext_vector_type(8)));
typedef short s16x4 __attribute__((ext_vector_type(4)));
typedef float f32x4 __attribute__((ext_vector_type(4)));
typedef float f32x16 __attribute__((ext_vector_type(16)));
typedef unsigned u32x4 __attribute__((ext_vector_type(4)));
typedef unsigned u32x2 __attribute__((ext_vector_type(2)));
typedef float f32x2_t __attribute__((ext_vector_type(2)));
typedef __bf16 bf16x2_t __attribute__((ext_vector_type(2)));
typedef int v4i_t __attribute__((ext_vector_type(4)));

constexpr int DM = 2048, NB = 4, SEQ = 2048, DEPTH = 4, CTXL = 256;
constexpr int TLAT = NB * SEQ, TCTX = NB * CTXL, TT = TLAT + TCTX;
constexpr int PW = 13120, PWP = 13312;
constexpr int O_CQ = 0, O_CKV = 512, O_KR = 768, O_CF = 800, O_GQ = 1824, O_GK = 2080, O_GV = 2336, O_GF = 2848, O_GB = 2864, O_GR = 2880, O_SC = 3392, O_MG = 4928;
constexpr int GCOL0 = 5120; constexpr float GATE_CLIP = 8.f;
DI int wcol_dest(int n0) { return n0 < O_MG ? n0 : n0 + (GCOL0 - O_MG); }
constexpr int NEXP = 16, EFF = 512, MOE_ROWS = 22528;
constexpr float EPS = 1e-6f;
constexpr int NCHAIN = 36;

DI float bflo(unsigned w) { return __uint_as_float(w << 16); }
DI float bfhi(unsigned w) { return __uint_as_float(w & 0xffff0000u); }
DI float bf2f(bf16_t v) { return __uint_as_float(((unsigned)v) << 16); }
DI unsigned pk2(float lo, float hi) { f32x2_t v = {lo, hi}; bf16x2_t b = __builtin_convertvector(v, bf16x2_t); return __builtin_bit_cast(unsigned, b); }
DI bf16_t f2bf(float f) { return (bf16_t)(pk2(f, 0.f) & 0xffffu); }
DI unsigned q8(float v) { int q = __float2int_rn(v); q = q > 127 ? 127 : q; q = q < -127 ? -127 : q; return (unsigned)q & 255u; }
DI float dpp_f(float v, int ctrl_sel) {
    const int x = __float_as_int(v); int r;
    switch (ctrl_sel) { case 0: r = __builtin_amdgcn_mov_dpp(x, 0xB1, 0xF, 0xF, true); break;
                        case 1: r = __builtin_amdgcn_mov_dpp(x, 0x4E, 0xF, 0xF, true); break;
                        case 2: r = __builtin_amdgcn_mov_dpp(x, 0x141, 0xF, 0xF, true); break;
                        default: r = __builtin_amdgcn_mov_dpp(x, 0x140, 0xF, 0xF, true); break; }
    return __int_as_float(r);
}
DI float wave_sum(float v) {
    v += dpp_f(v, 0); v += dpp_f(v, 1); v += dpp_f(v, 2); v += dpp_f(v, 3);
    { const auto r = __builtin_amdgcn_permlane16_swap(__float_as_uint(v), __float_as_uint(v), false, false); v = __uint_as_float(r[0]) + __uint_as_float(r[1]); }
    { const auto r = __builtin_amdgcn_permlane32_swap(__float_as_uint(v), __float_as_uint(v), false, false); v = __uint_as_float(r[0]) + __uint_as_float(r[1]); }
    return v;
}
DI float sigm(float x) { return __builtin_amdgcn_rcpf(1.f + __expf(-x)); }
DI float siluf(float x) { return x * __builtin_amdgcn_rcpf(1.f + __expf(-x)); }
#define LDS_WAIT() asm volatile("s_waitcnt lgkmcnt(0)" ::: "memory")
#define VM_WAIT() asm volatile("s_waitcnt vmcnt(0)" ::: "memory")

namespace pg8 {
constexpr int BM = 256, BK = 64, HALF = 128, HTB = HALF * BK * 2, STAGE_BYTES = 8 * HTB, NXCD = 8, WGM = 8;
DI int lds_byte(int r, int c) { const int st = (r >> 4) * 2 + (c >> 5), rr = r & 15, cc = c & 31, ob = rr * 64 + cc * 2; return st * 1024 + (ob ^ (((ob >> 9) & 1) << 5)); }
DI void stage_rc(int b, int& R, int& C) { const int st = b / 1024, sb = b % 1024, swz = sb ^ (((sb >> 9) & 1) << 5); R = (st >> 1) * 16 + swz / 64; C = (st & 1) * 32 + (swz % 64) / 2; }
DI int perm32(int rho) { const int n = rho >> 4, i = rho & 15; return 8 * (i >> 2) + 4 * n + (i & 3); }

struct Unit { int pm, pn, grp; };
struct Gemm { const bf16_t* A; const bf16_t* Bt; int K; size_t gsA, gsB; };

DI void tile_of(int wgid0, int nM, int nN, int& pm, int& pn) {
    const int nwg = nM * nN; int wgid = wgid0;
    { const int q = nwg / NXCD, r = nwg % NXCD, xcd = wgid % NXCD, off = wgid / NXCD; wgid = (xcd < r ? xcd * (q + 1) : r * (q + 1) + (xcd - r) * q) + off; }
    const int nig = WGM * nN, gid = wgid / nig, fm = gid * WGM, gsz = (nM - fm) < WGM ? (nM - fm) : WGM;
    pm = fm + ((wgid % nig) % gsz); pn = (wgid % nig) / gsz;
}
struct StaticOrder {
    int nM, nN, nwg, G, c;
    DI void init(int M, int N, int G_, int c_) { nM = M / BM; nN = N / BM; nwg = nM * nN; G = G_; c = c_; }
    DI bool next(int i, Unit& u) const { const int L = i * G + c; if (L >= nwg) return false; tile_of(L, nM, nN, u.pm, u.pn); u.grp = 0; return true; }
};
struct TrimOrder {
    int nM1, nN, n1, nctx, G, c;
    DI bool next(int i, Unit& u) const { const int L = i * G + c; u.grp = 0;
        if (L < n1) { tile_of(L, nM1, nN, u.pm, u.pn); return true; }
        const int q = L - n1; if (q >= nctx) return false; const int j = q % 6; u.pm = nM1 + q / 6; u.pn = j < 2 ? 2 + j : 6 + j; return true; }
};
struct RangeOrder {
    int first, count, nN, G, c;
    DI bool next(int i, Unit& u) const { const int L = i * G + c - first; if (L < 0 || L >= count) return false; u.pm = L / nN; u.pn = L % nN; u.grp = 0; return true; }
};
struct Range2Order {
    int first, count0, nN0, count1, nN1, G, c;
    DI bool next(int i, Unit& u) const { int L = i * G + c - first; if (L < 0) return false;
        if (L < count0) { u.pm = L / nN0; u.pn = L % nN0; u.grp = 0; return true; }
        L -= count0; if (L >= count1) return false; u.pm = L / nN1; u.pn = L % nN1; u.grp = 1; return true; }
};
struct MergeOrder {
    int nM, nN, nwg, G, c;
    DI void init(int M, int N, int G_, int c_) { nM = M / BM; nN = N / BM; nwg = nM * nN; G = G_; c = c_; }
    DI bool next(int i, Unit& u) const { const int L = (i >> 2) * G + c; if (L >= nwg) return false; tile_of(L, nM, nN, u.pm, u.pn); u.grp = i & 3; return true; }
};
struct MoeOrder {
    const LAS int* tp; int ncol, G, c;
    DI bool next(int i, Unit& u) const {
        const int L = i * G + c, ntile = tp[16]; if (L >= ntile * ncol) return false;
        const int rt = L / ncol; int e = 0;
#pragma unroll
        for (int j = 1; j < 16; ++j) e += (rt >= tp[j]) ? 1 : 0;
        u.pm = rt; u.pn = L % ncol; u.grp = e; return true;
    }
};

struct EpiStore {
    static constexpr bool PERM = true;
    bf16_t* O; int ldc;
    DI bool operator()(f32x4 (&acc)[2][2][4][2], const Unit& u, int wr, int wc, int fr, int fq) const {
        const int row0 = u.pm * BM + wr * 64 + fr, col0 = u.pn * BM + wc * 32 + 8 * fq;
#pragma unroll
        for (int ai = 0; ai < 2; ++ai)
#pragma unroll
            for (int m = 0; m < 4; ++m) { bf16_t* rowp = O + (size_t)(row0 + ai * HALF + m * 16) * ldc + col0;
#pragma unroll
                for (int bj = 0; bj < 2; ++bj) { const f32x4 v0 = acc[ai][bj][m][0], v1 = acc[ai][bj][m][1];
                    u32x4 w; w.x = pk2(v0[0], v0[1]); w.y = pk2(v0[2], v0[3]); w.z = pk2(v1[0], v1[1]); w.w = pk2(v1[2], v1[3]);
                    *(u32x4*)(rowp + bj * HALF) = w; } }
        return false;
    }
};
struct EpiStoreQ {
    static constexpr bool PERM = true;
    bf16_t* O; int ldc; const float* rA; const float* rB; unsigned char* G8;
    DI bool operator()(v4i_t (&acc)[2][2][4][2], const Unit& u, int wr, int wc, int fr, int fq) const {
        const int row0 = u.pm * BM + wr * 64 + fr, col0 = u.pn * BM + wc * 32 + 8 * fq;
        f32x4 cb[2][2];
#pragma unroll
        for (int bj = 0; bj < 2; ++bj) { cb[bj][0] = *(const f32x4*)(rB + col0 + bj * HALF); cb[bj][1] = *(const f32x4*)(rB + col0 + bj * HALF + 4); }
        float rav[2][4];
#pragma unroll
        for (int ai = 0; ai < 2; ++ai)
#pragma unroll
            for (int m = 0; m < 4; ++m) rav[ai][m] = rA[row0 + ai * HALF + m * 16];
        __builtin_amdgcn_sched_barrier(0);
        if (col0 >= GCOL0) {
            const float qs = 127.f / GATE_CLIP;
#pragma unroll
            for (int ai = 0; ai < 2; ++ai)
#pragma unroll
                for (int m = 0; m < 4; ++m) { const float ra = rav[ai][m] * qs;
                    unsigned char* rowp = G8 + (size_t)(u.pm * 32 + (u.pn - GCOL0 / BM)) * 65536 + (((wr * 4 + wc) * 8 + ai * 4 + m) * 64 + fr + 16 * fq) * 16;
                    unsigned ww[4] = {0u, 0u, 0u, 0u};
#pragma unroll
                    for (int bj = 0; bj < 2; ++bj) { const v4i_t a0 = acc[ai][bj][m][0], a1 = acc[ai][bj][m][1]; const f32x4 c0 = cb[bj][0] * ra, c1 = cb[bj][1] * ra;
#pragma unroll
                        for (int j = 0; j < 4; ++j) { ww[2 * bj] = __builtin_amdgcn_cvt_pk_u8_f32((float)a0[j] * c0[j] + 128.0f, j, ww[2 * bj]); ww[2 * bj + 1] = __builtin_amdgcn_cvt_pk_u8_f32((float)a1[j] * c1[j] + 128.0f, j, ww[2 * bj + 1]); } }
                    *(u32x4*)rowp = (u32x4){ww[0], ww[1], ww[2], ww[3]}; }
            return false;
        }
#pragma unroll
        for (int ai = 0; ai < 2; ++ai)
#pragma unroll
            for (int m = 0; m < 4; ++m) { const int row = row0 + ai * HALF + m * 16; const float ra = rav[ai][m]; bf16_t* rowp = O + (size_t)row * ldc + col0;
#pragma unroll
                for (int bj = 0; bj < 2; ++bj) { const v4i_t a0 = acc[ai][bj][m][0], a1 = acc[ai][bj][m][1]; const f32x4 c0 = cb[bj][0] * ra, c1 = cb[bj][1] * ra;
                    u32x4 w; w.x = pk2((float)a0[0] * c0[0], (float)a0[1] * c0[1]); w.y = pk2((float)a0[2] * c0[2], (float)a0[3] * c0[3]);
                    w.z = pk2((float)a1[0] * c1[0], (float)a1[1] * c1[1]); w.w = pk2((float)a1[2] * c1[2], (float)a1[3] * c1[3]);
                    *(u32x4*)(rowp + bj * HALF) = w; } }
        return false;
    }
};
struct EpiStore2 {
    static constexpr bool PERM = true;
    bf16_t* O0; int ldc0; bf16_t* O1; int ldc1;
    DI bool operator()(f32x4 (&acc)[2][2][4][2], const Unit& u, int wr, int wc, int fr, int fq) const {
        const EpiStore E{u.grp ? O1 : O0, u.grp ? ldc1 : ldc0}; return E(acc, u, wr, wc, fr, fq);
    }
};
struct EpiMerge {
    static constexpr bool PERM = true;
    bf16_t* Y; const unsigned char* G8;
    const LAS float* tab;
    DI static int qi(unsigned w, int i) { return (int)((w >> (8 * i)) & 255u); }
    DI bool operator()(f32x4 (&acc)[2][2][4][2], const Unit& u, int wr, int wc, int fr, int fq) const {
        const int row0 = u.pm * BM + wr * 64 + fr, col0 = u.pn * BM + wc * 32 + 8 * fq; const int grp = u.grp;
        const unsigned char* gp = G8 + (size_t)(u.pm * 32 + grp * 8 + u.pn) * 65536 + ((wr * 4 + wc) * 8 * 64 + fr + 16 * fq) * 16;
        if (grp < 3) {
            u32x4 ca[8], cb[8];
#pragma unroll
            for (int q = 0; q < 8; ++q) { ca[q] = *(const u32x4*)(gp + q * 1024); cb[q] = *(const u32x4*)(gp + 8 * 65536 + q * 1024); }
            __builtin_amdgcn_sched_barrier(0);
#pragma unroll
            for (int ai = 0; ai < 2; ++ai)
#pragma unroll
                for (int m = 0; m < 4; ++m) { const u32x4 a = ca[ai * 4 + m], b = cb[ai * 4 + m];
#pragma unroll
                    for (int bj = 0; bj < 2; ++bj) { const unsigned ax = bj ? a.z : a.x, ay = bj ? a.w : a.y, bx = bj ? b.z : b.x, by = bj ? b.w : b.y;
                        f32x4& a0 = acc[ai][bj][m][0]; f32x4& a1 = acc[ai][bj][m][1];
#pragma unroll
                        for (int j = 0; j < 4; ++j) { a0[j] *= tab[qi(ax, j)] * tab[256 + qi(bx, j)]; a1[j] *= tab[qi(ay, j)] * tab[256 + qi(by, j)]; } } }
            return true;
        }
        u32x4 cg[8];
#pragma unroll
        for (int q = 0; q < 8; ++q) cg[q] = *(const u32x4*)(gp + q * 1024);
        __builtin_amdgcn_sched_barrier(0);
#pragma unroll
        for (int ai = 0; ai < 2; ++ai)
#pragma unroll
            for (int m = 0; m < 4; ++m) { const int row = row0 + ai * HALF + m * 16; const u32x4 g4 = cg[ai * 4 + m];
                bf16_t* yp = Y + (size_t)row * DM + col0;
#pragma unroll
                for (int bj = 0; bj < 2; ++bj) { const unsigned gx = bj ? g4.z : g4.x, gy = bj ? g4.w : g4.y; const f32x4 a0 = acc[ai][bj][m][0], a1 = acc[ai][bj][m][1];
                    u32x4 w; w.x = pk2(a0[0] * tab[qi(gx, 0)], a0[1] * tab[qi(gx, 1)]); w.y = pk2(a0[2] * tab[qi(gx, 2)], a0[3] * tab[qi(gx, 3)]);
                    w.z = pk2(a1[0] * tab[qi(gy, 0)], a1[1] * tab[qi(gy, 1)]); w.w = pk2(a1[2] * tab[qi(gy, 2)], a1[3] * tab[qi(gy, 3)]);
                    *(u32x4*)(yp + bj * HALF) = w; } }
        return false;
    }
};
struct EpiResid {
    static constexpr bool PERM = true;
    bf16_t* X; const float* gate; bf16_t* XO;
    DI bool operator()(f32x4 (&acc)[2][2][4][2], const Unit& u, int wr, int wc, int fr, int fq) const {
        const int row0 = u.pm * BM + wr * 64 + fr, col0 = u.pn * BM + wc * 32 + 8 * fq;
        const int r = (u.pm < TLAT / BM) ? (u.pm >> 3) : 4; const float* gp = gate + (size_t)r * (6 * DM) + col0;
        f32x4 gv[2][2];
#pragma unroll
        for (int bj = 0; bj < 2; ++bj)
#pragma unroll
            for (int n = 0; n < 2; ++n) gv[bj][n] = *(const f32x4*)(gp + bj * HALF + n * 4);
        u32x4 xv[2][4][2];
        const unsigned ob = (unsigned)(row0 * DM + col0) * 2u;
#pragma unroll
        for (int ai = 0; ai < 2; ++ai)
#pragma unroll
            for (int m = 0; m < 4; ++m)
#pragma unroll
                for (int bj = 0; bj < 2; ++bj) xv[ai][m][bj] = *(const u32x4*)((const char*)X + (ob + (unsigned)((ai * HALF + m * 16) * DM + bj * HALF) * 2u));
        __builtin_amdgcn_sched_barrier(0);
#pragma unroll
        for (int ai = 0; ai < 2; ++ai)
#pragma unroll
            for (int m = 0; m < 4; ++m) {
#pragma unroll
                for (int bj = 0; bj < 2; ++bj) { const u32x4 x = xv[ai][m][bj]; const f32x4 a0 = gv[bj][0] * acc[ai][bj][m][0], a1 = gv[bj][1] * acc[ai][bj][m][1];
                    u32x4 o; o.x = pk2(bflo(x.x) + a0[0], bfhi(x.x) + a0[1]); o.y = pk2(bflo(x.y) + a0[2], bfhi(x.y) + a0[3]); o.z = pk2(bflo(x.z) + a1[0], bfhi(x.z) + a1[1]); o.w = pk2(bflo(x.w) + a1[2], bfhi(x.w) + a1[3]);
                    *(u32x4*)((char*)XO + (ob + (unsigned)((ai * HALF + m * 16) * DM + bj * HALF) * 2u)) = o; }
                __builtin_amdgcn_sched_barrier(0); }
        return false;
    }
};
struct EpiSwiGLUQ {
    static constexpr bool PERM = true;
    bf16_t* O; const float* roww; const float* rs; const float* rb1;
    DI bool operator()(v4i_t (&acc)[2][2][4][2], const Unit& u, int wr, int wc, int fr, int fq) const {
        const int row0 = u.pm * BM + wr * 64 + fr, col0 = u.pn * HALF + wc * 32 + 8 * fq; const float* rb = rb1 + (size_t)u.grp * 1024 + u.pn * BM + wc * 32 + 8 * fq;
        const f32x4 bg0 = *(const f32x4*)rb, bg1 = *(const f32x4*)(rb + 4), bu0 = *(const f32x4*)(rb + HALF), bu1 = *(const f32x4*)(rb + HALF + 4);
#pragma unroll
        for (int ai = 0; ai < 2; ++ai)
#pragma unroll
            for (int m = 0; m < 4; ++m) { const int row = row0 + ai * HALF + m * 16; const float w = roww[row], sa = rs[row];
                const v4i_t g0 = acc[ai][0][m][0], g1 = acc[ai][0][m][1], u0 = acc[ai][1][m][0], u1 = acc[ai][1][m][1];
                float v[8];
#pragma unroll
                for (int j = 0; j < 4; ++j) { v[j] = siluf((float)g0[j] * sa * bg0[j]) * ((float)u0[j] * sa * bu0[j]) * w; v[4 + j] = siluf((float)g1[j] * sa * bg1[j]) * ((float)u1[j] * sa * bu1[j]) * w; }
                u32x4 o; o.x = pk2(v[0], v[1]); o.y = pk2(v[2], v[3]); o.z = pk2(v[4], v[5]); o.w = pk2(v[6], v[7]);
                *(u32x4*)(O + (size_t)row * EFF + col0) = o; }
        return false;
    }
};
struct EpiSwiGLUQG {
    static constexpr bool PERM = true;
    bf16_t* O; const float* erw; const float* ers; const float* rb1; const LAS int* tpt;
    DI bool operator()(v4i_t (&acc)[2][2][4][2], const Unit& u, int wr, int wc, int fr, int fq) const {
        const int row0 = u.pm * BM + wr * 64 + fr, col0 = u.pn * HALF + wc * 32 + 8 * fq; const float* rb = rb1 + (size_t)u.grp * 1024 + u.pn * BM + wc * 32 + 8 * fq;
        const int s0 = (u.pm - tpt[u.grp]) * 256 + wr * 64 + fr, cn = tpt[32 + u.grp]; const float* pw = erw + u.grp * TT; const float* ps = ers + u.grp * TT;
        const f32x4 bg0 = *(const f32x4*)rb, bg1 = *(const f32x4*)(rb + 4), bu0 = *(const f32x4*)(rb + HALF), bu1 = *(const f32x4*)(rb + HALF + 4);
        float wv_[2][4], sv_[2][4];
#pragma unroll
        for (int ai = 0; ai < 2; ++ai)
#pragma unroll
            for (int m = 0; m < 4; ++m) { const int sl = s0 + ai * HALF + m * 16; const bool ok = sl < cn; wv_[ai][m] = ok ? pw[ok ? sl : 0] : 0.f; sv_[ai][m] = ok ? ps[ok ? sl : 0] : 0.f; }
        __builtin_amdgcn_sched_barrier(0);
#pragma unroll
        for (int ai = 0; ai < 2; ++ai)
#pragma unroll
            for (int m = 0; m < 4; ++m) { const int row = row0 + ai * HALF + m * 16; const float w = wv_[ai][m], sa = sv_[ai][m];
                const v4i_t g0 = acc[ai][0][m][0], g1 = acc[ai][0][m][1], u0 = acc[ai][1][m][0], u1 = acc[ai][1][m][1];
                float v[8];
#pragma unroll
                for (int j = 0; j < 4; ++j) { v[j] = siluf((float)g0[j] * sa * bg0[j]) * ((float)u0[j] * sa * bu0[j]) * w; v[4 + j] = siluf((float)g1[j] * sa * bg1[j]) * ((float)u1[j] * sa * bu1[j]) * w; }
                u32x4 o; o.x = pk2(v[0], v[1]); o.y = pk2(v[2], v[3]); o.z = pk2(v[4], v[5]); o.w = pk2(v[6], v[7]);
                *(u32x4*)(O + (size_t)row * EFF + col0) = o; }
        return false;
    }
};
struct EpiSwiGLU {
    static constexpr bool PERM = true;
    bf16_t* O; const float* roww;
    DI bool operator()(f32x4 (&acc)[2][2][4][2], const Unit& u, int wr, int wc, int fr, int fq) const {
        const int row0 = u.pm * BM + wr * 64 + fr, col0 = u.pn * HALF + wc * 32 + 8 * fq;
#pragma unroll
        for (int ai = 0; ai < 2; ++ai)
#pragma unroll
            for (int m = 0; m < 4; ++m) { const int row = row0 + ai * HALF + m * 16; const float w = roww[row];
                const f32x4 g0 = acc[ai][0][m][0], g1 = acc[ai][0][m][1], u0 = acc[ai][1][m][0], u1 = acc[ai][1][m][1];
                float v[8];
#pragma unroll
                for (int j = 0; j < 4; ++j) { v[j] = siluf(g0[j]) * u0[j] * w; v[4 + j] = siluf(g1[j]) * u1[j] * w; }
                u32x4 o; o.x = pk2(v[0], v[1]); o.y = pk2(v[2], v[3]); o.z = pk2(v[4], v[5]); o.w = pk2(v[6], v[7]);
                *(u32x4*)(O + (size_t)row * EFF + col0) = o; }
        return false;
    }
};

template <class Epi, class Sched>
DI void gemm_phase(LAS unsigned char* lds, const Gemm g, const Sched& S, const Epi& E) {
    int tid = threadIdx.x; asm volatile("" : "+v"(tid));
    const int wid = __builtin_amdgcn_readfirstlane(tid >> 6), lane = tid & 63, wr = wid >> 2, wc = wid & 3, fr = lane & 15, fq = lane >> 4;
    int K = g.K; asm volatile("" : "+s"(K));
    const int nt = K / BK;
    unsigned voffA[2], voffB[2], gC[2]; int gR[2];
#pragma unroll
    for (int i = 0; i < 2; ++i) { int R, C; stage_rc(tid * 16 + i * 8192, R, C); const int Rb = Epi::PERM ? ((R & ~31) + perm32(R & 31)) : R;
        voffA[i] = (unsigned)(R * K + C) * 2u; voffB[i] = (unsigned)(Rb * K + C) * 2u; gR[i] = R; gC[i] = (unsigned)C * 2u; }
    const size_t kstep = (size_t)(BK * 2);
    const size_t hstep = (size_t)HALF * K * 2;
    const size_t tstep = 2 * hstep;
    const unsigned ldsw = (unsigned)wid * 1024u;
    const int aoff = lds_byte(wr * 64 + fr, fq * 8), boff = lds_byte(wc * 32 + fr, fq * 8);
#define PG8_SA(b, h) (((b) * 2 + (h)) * HTB)
#define PG8_SB(b, h) ((4 + (b) * 2 + (h)) * HTB)
#define PG8_STAGE(bufoff, gbase, voff) do { _Pragma("unroll") for (int _i = 0; _i < 2; ++_i) \
        __builtin_amdgcn_global_load_lds((const unsigned*)((const char*)(gbase) + (voff)[_i]), (LAS unsigned*)(lds + (bufoff) + ldsw + _i * 8192), 16, 0, 0); } while (0)
#define PG8_STAGE2(bufoff, gbase, o0, o1) do { \
        __builtin_amdgcn_global_load_lds((const unsigned*)((const char*)(gbase) + (o0)), (LAS unsigned*)(lds + (bufoff) + ldsw), 16, 0, 0); \
        __builtin_amdgcn_global_load_lds((const unsigned*)((const char*)(gbase) + (o1)), (LAS unsigned*)(lds + (bufoff) + ldsw + 8192), 16, 0, 0); } while (0)
#define PG8_GATH(u, v) do { const int e_ = (u).grp, b_ = ((u).pm - tpt[e_]) * 256, c_ = tpt[32 + e_]; const int* et_ = etok + e_ * TT; \
        _Pragma("unroll") for (int h_ = 0; h_ < 2; ++h_) _Pragma("unroll") for (int i_ = 0; i_ < 2; ++i_) { const int s_ = b_ + h_ * 128 + gR[i_]; const int t_ = (s_ < c_) ? et_[s_] : 0; \
            v[h_][i_] = (unsigned)t_ * (unsigned)(K * 2) + gC[i_]; } } while (0)
#define PG8_LDA(dst, b, h) do { _Pragma("unroll") for (int m = 0; m < 4; ++m) _Pragma("unroll") for (int k = 0; k < 2; ++k) dst[m][k] = *(const LAS bf16x8*)(lds + PG8_SA(b, h) + aoff + m * 2048 + k * 1024); } while (0)
#define PG8_LDB(dst, b, h) do { _Pragma("unroll") for (int n = 0; n < 2; ++n) _Pragma("unroll") for (int k = 0; k < 2; ++k) dst[n][k] = *(const LAS bf16x8*)(lds + PG8_SB(b, h) + boff + n * 2048 + k * 1024); } while (0)
#define PG8_MMA(ai, bj, At, Bt) do { __builtin_amdgcn_s_setprio(1); _Pragma("unroll") for (int m = 0; m < 4; ++m) _Pragma("unroll") for (int n = 0; n < 2; ++n) _Pragma("unroll") for (int k = 0; k < 2; ++k) \
        acc[ai][bj][m][n] = __builtin_amdgcn_mfma_f32_16x16x32_bf16(Bt[n][k], At[m][k], acc[ai][bj][m][n], 0, 0, 0); __builtin_amdgcn_s_setprio(0); } while (0)
#define PG8_WAIT_V(n) asm volatile("s_waitcnt vmcnt(" #n ")" ::: "memory")
#define PG8_WAIT_L(n) asm volatile("s_waitcnt lgkmcnt(" #n ")" ::: "memory")
#define PG8_BAR __builtin_amdgcn_s_barrier()
#define PG8_SCHED __builtin_amdgcn_sched_barrier(0)
    Unit cur, nxt; int ui = 0;
    if (!S.next(0, cur)) return;
    cur.pm = __builtin_amdgcn_readfirstlane(cur.pm); cur.pn = __builtin_amdgcn_readfirstlane(cur.pn); cur.grp = __builtin_amdgcn_readfirstlane(cur.grp);
    f32x4 acc[2][2][4][2];
#pragma unroll
    for (int a = 0; a < 2; ++a)
#pragma unroll
        for (int b = 0; b < 2; ++b)
#pragma unroll
            for (int m = 0; m < 4; ++m)
#pragma unroll
                for (int n = 0; n < 2; ++n) acc[a][b][m][n] = (f32x4){0.f, 0.f, 0.f, 0.f};
    bf16x8 At[4][2], B0[2][2], B1[2][2];
    const char* cA = (const char*)g.A + (size_t)cur.grp * g.gsA + (size_t)cur.pm * tstep; const char* cB = (const char*)g.Bt + (size_t)cur.grp * g.gsB + (size_t)cur.pn * tstep;
    PG8_STAGE(PG8_SB(0, 0), cB, voffB); PG8_STAGE(PG8_SB(0, 1), cB + hstep, voffB); PG8_STAGE(PG8_SA(0, 0), cA, voffA); PG8_STAGE(PG8_SA(0, 1), cA + hstep, voffA);
    if (wr == 1) PG8_BAR;
    PG8_WAIT_V(2); PG8_BAR;
    PG8_STAGE(PG8_SB(1, 0), cB + kstep, voffB); PG8_STAGE(PG8_SA(1, 0), cA + kstep, voffA); PG8_STAGE(PG8_SB(1, 1), cB + hstep + kstep, voffB);
    PG8_WAIT_V(6); PG8_BAR;
    for (;;) {
        const bool has_next = S.next(ui + 1, nxt);
        nxt.pm = __builtin_amdgcn_readfirstlane(nxt.pm); nxt.pn = __builtin_amdgcn_readfirstlane(nxt.pn); nxt.grp = __builtin_amdgcn_readfirstlane(nxt.grp);
        const char* nA = has_next ? (const char*)g.A + (size_t)nxt.grp * g.gsA + (size_t)nxt.pm * tstep : cA; const char* nB = has_next ? (const char*)g.Bt + (size_t)nxt.grp * g.gsB + (size_t)nxt.pn * tstep : cB;
        for (int t = 0; t < nt; t += 2) {
            const bool last = (t == nt - 2);
            const char* a1 = cA + (size_t)(t + 1) * kstep;
            const char* a2 = last ? nA : cA + (size_t)(t + 2) * kstep; const char* b2 = last ? nB : cB + (size_t)(t + 2) * kstep;
            const char* a3 = a2 + kstep; const char* b3 = b2 + kstep;
            PG8_LDB(B0, 0, 0); PG8_LDB(B1, 0, 1); PG8_SCHED; PG8_LDA(At, 0, 0); PG8_STAGE(PG8_SA(1, 1), a1 + hstep, voffA);
            PG8_WAIT_V(8); PG8_WAIT_L(0); PG8_BAR; PG8_MMA(0, 0, At, B0); PG8_MMA(0, 1, At, B1); PG8_BAR; PG8_SCHED;
            PG8_LDA(At, 0, 1); PG8_STAGE(PG8_SB(0, 0), b2, voffB); PG8_STAGE(PG8_SB(0, 1), b2 + hstep, voffB); PG8_STAGE(PG8_SA(0, 0), a2, voffA);
            PG8_WAIT_V(8); PG8_WAIT_L(0); PG8_BAR; PG8_MMA(1, 0, At, B0); PG8_MMA(1, 1, At, B1); PG8_BAR; PG8_SCHED;
            PG8_LDB(B0, 1, 0); PG8_LDB(B1, 1, 1); PG8_SCHED; PG8_LDA(At, 1, 0); PG8_STAGE(PG8_SA(0, 1), a2 + hstep, voffA);
            PG8_WAIT_V(8); PG8_WAIT_L(0); PG8_BAR; PG8_MMA(0, 0, At, B0); PG8_MMA(0, 1, At, B1); PG8_BAR; PG8_SCHED;
            PG8_LDA(At, 1, 1); PG8_STAGE(PG8_SB(1, 0), b3, voffB); PG8_STAGE(PG8_SB(1, 1), b3 + hstep, voffB); PG8_STAGE(PG8_SA(1, 0), a3, voffA);
            PG8_WAIT_V(8); PG8_WAIT_L(0); PG8_BAR; PG8_MMA(1, 0, At, B0); PG8_MMA(1, 1, At, B1); PG8_BAR; PG8_SCHED;
        }
        bool keep = false;
        if (wr == 0) PG8_BAR;
        { Unit eu; eu.pm = __builtin_amdgcn_readfirstlane(cur.pm); eu.pn = __builtin_amdgcn_readfirstlane(cur.pn); eu.grp = __builtin_amdgcn_readfirstlane(cur.grp); asm volatile("" : "+s"(eu.pm), "+s"(eu.pn), "+s"(eu.grp)); keep = E(acc, eu, wr, wc, fr, fq); }
        if (!has_next) break;
        if (!keep) {
#pragma unroll
        for (int a = 0; a < 2; ++a)
#pragma unroll
            for (int b = 0; b < 2; ++b)
#pragma unroll
                for (int m = 0; m < 4; ++m)
#pragma unroll
                    for (int n = 0; n < 2; ++n) acc[a][b][m][n] = (f32x4){0.f, 0.f, 0.f, 0.f};
        }
        cur = nxt; cA = nA; cB = nB; ++ui;
        if (wr == 1) PG8_BAR;
    }
    PG8_WAIT_V(0);
    PG8_BAR;
#undef PG8_SA
#undef PG8_SB
#undef PG8_STAGE
#undef PG8_LDA
#undef PG8_LDB
#undef PG8_MMA
#undef PG8_WAIT_V
#undef PG8_WAIT_L
#undef PG8_BAR
#undef PG8_SCHED
}
template <class Epi, class Sched, bool GATHER = false>
DI void gemm_phase_i8(LAS unsigned char* lds, const Gemm g, const Sched& S, const Epi& E, const int* etok = nullptr, const LAS int* tpt = nullptr) {
    int tid = threadIdx.x; asm volatile("" : "+v"(tid));
    const int wid = __builtin_amdgcn_readfirstlane(tid >> 6), lane = tid & 63, wr = wid >> 2, wc = wid & 3, fr = lane & 15, fq = lane >> 4;
    int K = g.K; asm volatile("" : "+s"(K));
    const int nt = K / BK;
    unsigned voffA[2], voffB[2], gC[2]; int gR[2];
#pragma unroll
    for (int i = 0; i < 2; ++i) { int R, C; stage_rc(tid * 16 + i * 8192, R, C); const int Rb = Epi::PERM ? ((R & ~31) + perm32(R & 31)) : R;
        voffA[i] = (unsigned)(R * K + C) * 2u; voffB[i] = (unsigned)(Rb * K + C) * 2u; gR[i] = R; gC[i] = (unsigned)C * 2u; }
    const size_t kstep = (size_t)(BK * 2);
    const size_t hstep = (size_t)HALF * K * 2;
    const size_t tstep = 2 * hstep;
    const unsigned ldsw = (unsigned)wid * 1024u;
    const int aoff = lds_byte(wr * 64 + fr, fq * 8), boff = lds_byte(wc * 32 + fr, fq * 8);
#define PG8_SA(b, h) (((b) * 2 + (h)) * HTB)
#define PG8_SB(b, h) ((4 + (b) * 2 + (h)) * HTB)
#define PG8_STAGE(bufoff, gbase, voff) do { _Pragma("unroll") for (int _i = 0; _i < 2; ++_i) \
        __builtin_amdgcn_global_load_lds((const unsigned*)((const char*)(gbase) + (voff)[_i]), (LAS unsigned*)(lds + (bufoff) + ldsw + _i * 8192), 16, 0, 0); } while (0)
#define PG8_STAGE2(bufoff, gbase, o0, o1) do { \
        __builtin_amdgcn_global_load_lds((const unsigned*)((const char*)(gbase) + (o0)), (LAS unsigned*)(lds + (bufoff) + ldsw), 16, 0, 0); \
        __builtin_amdgcn_global_load_lds((const unsigned*)((const char*)(gbase) + (o1)), (LAS unsigned*)(lds + (bufoff) + ldsw + 8192), 16, 0, 0); } while (0)
#define PG8_GATH(u, v) do { const int e_ = (u).grp, b_ = ((u).pm - tpt[e_]) * 256, c_ = tpt[32 + e_]; const int* et_ = etok + e_ * TT; \
        _Pragma("unroll") for (int h_ = 0; h_ < 2; ++h_) _Pragma("unroll") for (int i_ = 0; i_ < 2; ++i_) { const int s_ = b_ + h_ * 128 + gR[i_]; const int t_ = (s_ < c_) ? et_[s_] : 0; \
            v[h_][i_] = (unsigned)t_ * (unsigned)(K * 2) + gC[i_]; } } while (0)
#define PG8_LDA(dst, b, h) do { _Pragma("unroll") for (int m = 0; m < 4; ++m) _Pragma("unroll") for (int k = 0; k < 2; ++k) dst[m][k] = *(const LAS v4i_t*)(lds + PG8_SA(b, h) + aoff + m * 2048 + k * 1024); } while (0)
#define PG8_LDB(dst, b, h) do { _Pragma("unroll") for (int n = 0; n < 2; ++n) _Pragma("unroll") for (int k = 0; k < 2; ++k) dst[n][k] = *(const LAS v4i_t*)(lds + PG8_SB(b, h) + boff + n * 2048 + k * 1024); } while (0)
#define PG8_MMA(ai, bj, At, Bt) do { __builtin_amdgcn_s_setprio(1); _Pragma("unroll") for (int m = 0; m < 4; ++m) _Pragma("unroll") for (int n = 0; n < 2; ++n) _Pragma("unroll") for (int k = 0; k < 2; ++k) \
        acc[ai][bj][m][n] = __builtin_amdgcn_mfma_i32_16x16x64_i8(Bt[n][k], At[m][k], acc[ai][bj][m][n], 0, 0, 0); __builtin_amdgcn_s_setprio(0); } while (0)
#define PG8_WAIT_V(n) asm volatile("s_waitcnt vmcnt(" #n ")" ::: "memory")
#define PG8_WAIT_L(n) asm volatile("s_waitcnt lgkmcnt(" #n ")" ::: "memory")
#define PG8_BAR __builtin_amdgcn_s_barrier()
#define PG8_SCHED __builtin_amdgcn_sched_barrier(0)
    Unit cur, nxt; int ui = 0;
    if (!S.next(0, cur)) return;
    cur.pm = __builtin_amdgcn_readfirstlane(cur.pm); cur.pn = __builtin_amdgcn_readfirstlane(cur.pn); cur.grp = __builtin_amdgcn_readfirstlane(cur.grp);
    v4i_t acc[2][2][4][2];
#pragma unroll
    for (int a = 0; a < 2; ++a)
#pragma unroll
        for (int b = 0; b < 2; ++b)
#pragma unroll
            for (int m = 0; m < 4; ++m)
#pragma unroll
                for (int n = 0; n < 2; ++n) acc[a][b][m][n] = (v4i_t){0, 0, 0, 0};
    v4i_t At[4][2], B0[2][2], B1[2][2];
    const char* cA = GATHER ? (const char*)g.A : (const char*)g.A + (size_t)cur.grp * g.gsA + (size_t)cur.pm * tstep; const char* cB = (const char*)g.Bt + (size_t)cur.grp * g.gsB + (size_t)cur.pn * tstep;
    unsigned cv[2][2] = {{voffA[0], voffA[1]}, {voffA[0], voffA[1]}}, nv[2][2] = {{voffA[0], voffA[1]}, {voffA[0], voffA[1]}};
    if (GATHER) PG8_GATH(cur, cv);
    const size_t ahs = GATHER ? (size_t)0 : hstep;
    PG8_STAGE(PG8_SB(0, 0), cB, voffB); PG8_STAGE(PG8_SB(0, 1), cB + hstep, voffB); PG8_STAGE2(PG8_SA(0, 0), cA, cv[0][0], cv[0][1]); PG8_STAGE2(PG8_SA(0, 1), cA + ahs, cv[1][0], cv[1][1]);
    if (wr == 1) PG8_BAR;
    PG8_WAIT_V(2); PG8_BAR;
    PG8_STAGE(PG8_SB(1, 0), cB + kstep, voffB); PG8_STAGE2(PG8_SA(1, 0), cA + kstep, cv[0][0], cv[0][1]); PG8_STAGE(PG8_SB(1, 1), cB + hstep + kstep, voffB);
    PG8_WAIT_V(6); PG8_BAR;
    for (;;) {
        const bool has_next = S.next(ui + 1, nxt);
        nxt.pm = __builtin_amdgcn_readfirstlane(nxt.pm); nxt.pn = __builtin_amdgcn_readfirstlane(nxt.pn); nxt.grp = __builtin_amdgcn_readfirstlane(nxt.grp);
        const char* nA = (has_next && !GATHER) ? (const char*)g.A + (size_t)nxt.grp * g.gsA + (size_t)nxt.pm * tstep : cA; const char* nB = has_next ? (const char*)g.Bt + (size_t)nxt.grp * g.gsB + (size_t)nxt.pn * tstep : cB;
        if (GATHER) { if (has_next) PG8_GATH(nxt, nv); else { nv[0][0] = cv[0][0]; nv[0][1] = cv[0][1]; nv[1][0] = cv[1][0]; nv[1][1] = cv[1][1]; } }
        for (int t = 0; t < nt; t += 2) {
            const bool last = (t == nt - 2);
            const unsigned s00 = (GATHER && last) ? nv[0][0] : cv[0][0], s01 = (GATHER && last) ? nv[0][1] : cv[0][1], s10 = (GATHER && last) ? nv[1][0] : cv[1][0], s11 = (GATHER && last) ? nv[1][1] : cv[1][1];
            const char* a1 = cA + (size_t)(t + 1) * kstep;
            const char* a2 = last ? nA : cA + (size_t)(t + 2) * kstep; const char* b2 = last ? nB : cB + (size_t)(t + 2) * kstep;
            const char* a3 = a2 + kstep; const char* b3 = b2 + kstep;
            PG8_LDB(B0, 0, 0); PG8_LDB(B1, 0, 1); PG8_SCHED; PG8_LDA(At, 0, 0); PG8_STAGE2(PG8_SA(1, 1), a1 + ahs, cv[1][0], cv[1][1]);
            PG8_WAIT_V(8); PG8_WAIT_L(0); PG8_BAR; PG8_MMA(0, 0, At, B0); PG8_MMA(0, 1, At, B1); PG8_BAR; PG8_SCHED;
            PG8_LDA(At, 0, 1); PG8_STAGE(PG8_SB(0, 0), b2, voffB); PG8_STAGE(PG8_SB(0, 1), b2 + hstep, voffB); PG8_STAGE2(PG8_SA(0, 0), a2, s00, s01);
            PG8_WAIT_V(8); PG8_WAIT_L(0); PG8_BAR; PG8_MMA(1, 0, At, B0); PG8_MMA(1, 1, At, B1); PG8_BAR; PG8_SCHED;
            PG8_LDB(B0, 1, 0); PG8_LDB(B1, 1, 1); PG8_SCHED; PG8_LDA(At, 1, 0); PG8_STAGE2(PG8_SA(0, 1), a2 + ahs, s10, s11);
            PG8_WAIT_V(8); PG8_WAIT_L(0); PG8_BAR; PG8_MMA(0, 0, At, B0); PG8_MMA(0, 1, At, B1); PG8_BAR; PG8_SCHED;
            PG8_LDA(At, 1, 1); PG8_STAGE(PG8_SB(1, 0), b3, voffB); PG8_STAGE(PG8_SB(1, 1), b3 + hstep, voffB); PG8_STAGE2(PG8_SA(1, 0), a3, s00, s01);
            PG8_WAIT_V(8); PG8_WAIT_L(0); PG8_BAR; PG8_MMA(1, 0, At, B0); PG8_MMA(1, 1, At, B1); PG8_BAR; PG8_SCHED;
        }
        bool keep = false;
        if (wr == 0) PG8_BAR;
        { Unit eu; eu.pm = __builtin_amdgcn_readfirstlane(cur.pm); eu.pn = __builtin_amdgcn_readfirstlane(cur.pn); eu.grp = __builtin_amdgcn_readfirstlane(cur.grp); asm volatile("" : "+s"(eu.pm), "+s"(eu.pn), "+s"(eu.grp)); keep = E(acc, eu, wr, wc, fr, fq); }
        if (!has_next) break;
        if (!keep) {
#pragma unroll
        for (int a = 0; a < 2; ++a)
#pragma unroll
            for (int b = 0; b < 2; ++b)
#pragma unroll
                for (int m = 0; m < 4; ++m)
#pragma unroll
                    for (int n = 0; n < 2; ++n) acc[a][b][m][n] = (v4i_t){0, 0, 0, 0};
        }
        cur = nxt; cA = nA; cB = nB; ++ui;
        if (GATHER) { cv[0][0] = nv[0][0]; cv[0][1] = nv[0][1]; cv[1][0] = nv[1][0]; cv[1][1] = nv[1][1]; }
        if (wr == 1) PG8_BAR;
    }
    PG8_WAIT_V(0);
    PG8_BAR;
#undef PG8_SA
#undef PG8_SB
#undef PG8_STAGE
#undef PG8_STAGE2
#undef PG8_GATH
#undef PG8_LDA
#undef PG8_LDB
#undef PG8_MMA
#undef PG8_WAIT_V
#undef PG8_WAIT_L
#undef PG8_BAR
#undef PG8_SCHED
}
}

#define XB_TMO      128
#define XB_XCNT(j)  (256  + 64 * (j))
#define XB_XSUB(j)  (1280 + 64 * (j))
#define XB_XGEN(j)  (2304 + 64 * (j))
#define XB_TOP      3328
#define XB_TOPGEN   3392
#define XCD_BAR_WORDS 3456
#define XB_SPIN_CAP (1u << 18)

__device__ __forceinline__ unsigned xb_ld(unsigned* p)              { return __hip_atomic_load(p, __ATOMIC_RELAXED, __HIP_MEMORY_SCOPE_AGENT); }
__device__ __forceinline__ unsigned xb_add(unsigned* p, unsigned v) { return __hip_atomic_fetch_add(p, v, __ATOMIC_RELAXED, __HIP_MEMORY_SCOPE_AGENT); }
__device__ __forceinline__ unsigned xb_xcc_id() { return (unsigned)__builtin_amdgcn_s_getreg((3 << 11) | 20) & 0xFu; }
#define XB_SPIN(cond, bar) do { unsigned _sp = 0; while (cond) { __builtin_amdgcn_s_sleep(1); \
    if ((++_sp & 255u) == 0u) { if (xb_ld(&(bar)[XB_TMO])) break; if (_sp > XB_SPIN_CAP) { atomicAdd(&(bar)[XB_TMO], 1u); break; } } } } while (0)

struct XcdBarrier {
    unsigned* bar; unsigned x;
    volatile LAS unsigned* st;
};

__device__ __forceinline__ XcdBarrier xcd_barrier_post(unsigned* bar, volatile LAS unsigned* st) {
    XcdBarrier b; b.bar = bar; b.x = xb_xcc_id(); b.st = st;
    if (threadIdx.x == 0) (void)xb_add(&bar[XB_XCNT(b.x)], 1u);
    return b;
}
__device__ __forceinline__ void xcd_barrier_complete(unsigned* bar, unsigned x, unsigned& nloc, unsigned& nx) {
    const unsigned G = gridDim.x * gridDim.y * gridDim.z;
    unsigned sum, cnt, mine, sp = 0u;
    for (;;) {
        sum = 0u; cnt = 0u; mine = 0u;
#pragma unroll
        for (unsigned j = 0; j < 16; ++j) { const unsigned c = xb_ld(&bar[XB_XCNT(j)]); sum += c; cnt += (c > 0u) ? 1u : 0u; mine = (j == x) ? c : mine; }
        if (sum == G) break;
        __builtin_amdgcn_s_sleep(1);
        if ((++sp & 255u) == 0u) { if (xb_ld(&bar[XB_TMO])) break; if (sp > XB_SPIN_CAP) { atomicAdd(&bar[XB_TMO], 1u); break; } }
    }
    nloc = mine > 0u ? mine : 1u; nx = cnt > 0u ? cnt : 1u;
}

__device__ __forceinline__ void xcd_barrier(const XcdBarrier& b) {
    asm volatile("s_waitcnt vmcnt(0)" ::: "memory");
    __syncthreads();
    if (threadIdx.x == 0) {
        unsigned* bar = b.bar;
        __builtin_amdgcn_s_waitcnt(0);
        unsigned nloc = b.st[0], nx = b.st[1];
        if (nloc == 0u) { xcd_barrier_complete(bar, b.x, nloc, nx); b.st[0] = nloc; b.st[1] = nx; }
        const unsigned old = xb_add(&bar[XB_XSUB(b.x)], 1u);
        const unsigned gen = old / nloc;
        if (old + 1u == (gen + 1u) * nloc) {
            __builtin_amdgcn_fence(__ATOMIC_RELEASE, "agent");
            asm volatile("s_waitcnt vmcnt(0)" ::: "memory");
            const unsigned og = xb_add(&bar[XB_TOP], 1u);
            const unsigned tg = og / nx;
            if (og + 1u == (tg + 1u) * nx) xb_add(&bar[XB_TOPGEN], 1u);
            else XB_SPIN(xb_ld(&bar[XB_TOPGEN]) == tg, bar);
            __builtin_amdgcn_fence(__ATOMIC_ACQUIRE, "agent");
            xb_add(&bar[XB_XGEN(b.x)], 1u);
            asm volatile("s_waitcnt vmcnt(0)" ::: "memory");
        } else {
            XB_SPIN(xb_ld(&bar[XB_XGEN(b.x)]) == gen, bar);
            __builtin_amdgcn_fence(__ATOMIC_ACQUIRE, "agent");
            asm volatile("s_waitcnt vmcnt(0)" ::: "memory");
        }
    }
    __syncthreads();
}

constexpr size_t MiB = 1u << 20;
constexpr size_t WS_CTL = 0, CTL_ZERO_BYTES = 1 * MiB;
constexpr size_t WS_MOD  = 1 * MiB;
constexpr size_t WS_WIN  = 2 * MiB;
constexpr size_t WS_WUQ  = 210 * MiB;
constexpr size_t WS_WKN  = 213 * MiB;
constexpr size_t WS_WV   = 214 * MiB;
constexpr size_t WS_WBR  = 215 * MiB;
constexpr size_t WS_WMIX = 247 * MiB;
constexpr size_t WS_W1   = 279 * MiB;
constexpr size_t WS_W2   = 535 * MiB;
constexpr size_t WS_X    = 663 * MiB;
constexpr size_t WS_H    = 735 * MiB;
constexpr size_t WS_U    = 771 * MiB;
constexpr size_t WS_CQN  = 1005 * MiB;
constexpr size_t WS_CKVN = 1014 * MiB;
constexpr size_t WS_KRP  = 1019 * MiB;
constexpr size_t WS_Q    = 1021 * MiB;
constexpr size_t WS_KN   = 1035 * MiB;
constexpr size_t WS_VT   = 1044 * MiB;
constexpr size_t WS_ACTS = 1053 * MiB;
constexpr size_t WS_YM   = 1089 * MiB;
constexpr size_t WS_SLOC = 1125 * MiB;
constexpr size_t WS_DEC  = 1161 * MiB;
constexpr size_t WS_SIN  = 1162 * MiB;
constexpr size_t WS_ETOK = 1261 * MiB, WS_ERS = 1262 * MiB, WS_ERW = 1263 * MiB;
constexpr size_t WS_ROUTE= 1180 * MiB;
constexpr size_t WS_HS   = 1181 * MiB;
constexpr size_t WS_ACTM = 1269 * MiB;
constexpr size_t WS_OUTS = 1291 * MiB;
constexpr size_t WS_W8   = 1379 * MiB;
constexpr size_t WS_H8   = 1483 * MiB;
constexpr size_t WS_RA   = 1501 * MiB;
constexpr size_t WS_RB   = 1501 * MiB + 64 * 1024;
constexpr size_t WS_RB1  = 1501 * MiB + 512 * 1024;
constexpr size_t WS_RSORT= 1501 * MiB + 768 * 1024;
constexpr size_t WS_RAF  = 1501 * MiB + 896 * 1024;
constexpr size_t WS_G8   = 1502 * MiB;
constexpr size_t WS_END  = 1574 * MiB;
constexpr int CW_BAR = 4096;
constexpr int CW_CNT = 16384;
constexpr int CW_CMAX = 131072;

constexpr int RING_BYTES = 131072;
constexpr int LDSX_OFF = RING_BYTES;
constexpr int LDS_BYTES = 147456;

struct Params { const float* in[34]; float* out; unsigned char* ws; int ph_lo, ph_hi; };
typedef const __attribute__((address_space(4))) Params* KParams;
enum { I_X = 0, I_C, I_CTX, I_CCTX, I_WMOD, I_BMOD, I_GMIX, I_GFFN, I_WIN, I_GQ, I_WUQ, I_GKV, I_WUKV, I_WMLAO, I_WCFDW, I_BCFDW, I_GCFLN, I_BCFLN, I_WCFO,
       I_WGF, I_BGF, I_WGB, I_BGB, I_GGLAN, I_WGLAO, I_WSCC, I_WSCO, I_WMIXO, I_WROUT, I_BROUT, I_WEG, I_WEU, I_WED, I_GFIN };

struct Frame { LAS unsigned char* lds; int tid, lane, wave, G, bid, gw, NGW; };

#define WSP(T, off) ((T*)(P->ws + (off)))
#define WSQ(T, off) ((T*)(Q->ws + (off)))
DI unsigned* ctl_words(KParams P) { return (unsigned*)(P->ws + WS_CTL); }
DI int mod_row(int row) { return row < TLAT ? (row >> 11) : 4; }

DI void transpose_item(const float* W, int N, bf16_t* WT, int KD, int dest_row0, int k0, int n0, LAS float* scr, int lane) {
    float tv[32];
#pragma unroll
    for (int i = 0; i < 32; ++i) { const int kk = 2 * i + (lane >> 5); tv[i] = __builtin_nontemporal_load(W + (size_t)(k0 + kk) * N + n0 + (lane & 31)); }
    __builtin_amdgcn_sched_barrier(0);
#pragma unroll
    for (int i = 0; i < 32; ++i) { const int kk = 2 * i + (lane >> 5); scr[kk * 33 + (lane & 31)] = tv[i]; }
    LDS_WAIT(); asm volatile("" ::: "memory");
    const int c = lane & 7;
#pragma unroll
    for (int j = 0; j < 4; ++j) { const int n = (lane >> 3) + 8 * j; const LAS float* s = scr + (8 * c) * 33 + n;
        u32x4 o; o.x = pk2(s[0 * 33], s[1 * 33]); o.y = pk2(s[2 * 33], s[3 * 33]); o.z = pk2(s[4 * 33], s[5 * 33]); o.w = pk2(s[6 * 33], s[7 * 33]);
        __builtin_nontemporal_store(o, (u32x4*)(WT + (size_t)(dest_row0 + n) * KD + k0 + 8 * c)); }
    LDS_WAIT(); asm volatile("" ::: "memory");
}
constexpr int SLAB_AUX = LDSX_OFF + 2048;
DI int slab_off(int k, int n) { return k * 64 + ((((n >> 1) ^ ((k >> 3) & 15)) << 2) | ((n & 1) << 1)); }
DI void slab_item(const float* W, int N, int n0, unsigned char* W8, int dest_row0, float* rB, Frame& F) {
    LAS float* wmax = (LAS float*)(F.lds + SLAB_AUX); LAS float* cmax = wmax + 256;
    { const int n = F.lane & 31, kp = F.lane >> 5; float m = 0.f;
#pragma unroll 1
      for (int j = 0; j < 4; ++j) { const int kb0 = (F.wave * 4 + j) * 64; float v[32];
#pragma unroll
          for (int i = 0; i < 32; ++i) v[i] = __builtin_nontemporal_load(W + (size_t)(kb0 + 2 * i + kp) * N + n0 + n);
#pragma unroll
          for (int i = 0; i < 32; ++i) { m = fmaxf(m, fabsf(v[i])); *(LAS bf16_t*)(F.lds + slab_off(kb0 + 2 * i + kp, n)) = f2bf(v[i]); } }
      m = fmaxf(m, __shfl_xor(m, 32)); if (F.lane < 32) wmax[F.wave * 32 + n] = m; }
    __syncthreads();
    if (F.tid < 32) { float c = 0.f;
#pragma unroll
        for (int w2 = 0; w2 < 8; ++w2) c = fmaxf(c, wmax[w2 * 32 + F.tid]);
        cmax[F.tid] = c; rB[dest_row0 + F.tid] = c * (1.f / 127.f); }
    __syncthreads();
    { const int nn = ((F.tid >> 3) & 7) + 8 * (F.wave & 3); const float cm = cmax[nn], sc = cm > 0.f ? 127.f / cm : 0.f;
#pragma unroll 4
      for (int i2 = 0; i2 < 16; ++i2) { const int c = (F.tid & 7) + 8 * i2 + 128 * (F.wave >> 2); unsigned q[8];
#pragma unroll
          for (int j = 0; j < 8; ++j) q[j] = q8(sc * bf2f(*(const LAS bf16_t*)(F.lds + slab_off(8 * c + j, nn))));
          u32x2 o; o.x = q[0] | (q[1] << 8) | (q[2] << 16) | (q[3] << 24); o.y = q[4] | (q[5] << 8) | (q[6] << 16) | (q[7] << 24);
          __builtin_nontemporal_store(o, (u32x2*)(W8 + (size_t)(dest_row0 + nn) * DM + 8 * c)); } }
    __syncthreads();
}
constexpr int NS_WIN = PW / 32, NS_EXP = 16 * 2 * (EFF / 32), NS_ALL = NS_WIN + NS_EXP;
DI void slab_dispatch(KParams P, Frame& F, int l, int sidx) {
    if (sidx < NS_WIN) { slab_item(P->in[I_WIN] + (size_t)l * DM * PW, PW, 32 * sidx, WSP(unsigned char, WS_W8) + (size_t)l * PWP * DM, wcol_dest(32 * sidx), WSP(float, WS_RB) + (size_t)l * PWP, F); return; }
    const int q = sidx - NS_WIN, e = q >> 5, which = (q >> 4) & 1, n0 = (q & 15) * 32, le = l * 16 + e;
    slab_item((which ? P->in[I_WEU] : P->in[I_WEG]) + (size_t)le * DM * EFF, EFF, n0, WSP(unsigned char, WS_W1) + (size_t)le * 1024 * DM, (n0 >> 7) * 256 + which * 128 + (n0 & 127), WSP(float, WS_RB1) + (size_t)le * 1024, F);
}
constexpr int NL_UQ = 8 * 24, NL_UKV = 4 * 32, NL_BR = 4 * 8 * 64, NL_MIX = 32 * 64, NL_ED = 16 * 8 * 64, NL_PAD = PWP - PW;
constexpr int NL_ITEMS = NL_UQ + NL_UKV + NL_BR + NL_MIX + NL_ED + NL_PAD;
constexpr int NL_F1 = (NL_ITEMS * 55) / 100, NL_F2 = (NL_ITEMS * 88) / 100;
DI void conv_item_layer(KParams P, int l, int it, LAS float* scr, int lane) {
    int r = it;
    if (r < NL_UQ) { const int kb = r / 24, nb = r % 24;
        transpose_item(P->in[I_WUQ] + (size_t)l * 512 * 768, 768, WSP(bf16_t, WS_WUQ) + (size_t)l * 768 * 512, 512, 32 * nb, 64 * kb, 32 * nb, scr, lane); return; } r -= NL_UQ;
    if (r < NL_UKV) { const int kb = r / 32, nb = r % 32, n0 = 32 * nb, hh = n0 >> 7, jj = n0 & 127;
        bf16_t* dst = (jj < 64 ? WSP(bf16_t, WS_WKN) : WSP(bf16_t, WS_WV)) + (size_t)l * 512 * 256;
        transpose_item(P->in[I_WUKV] + (size_t)l * 256 * 1024, 1024, dst, 256, hh * 64 + (jj & 63), 64 * kb, n0, scr, lane); return; } r -= NL_UKV;
    if (r < NL_BR) { const int br = r / 512, q = r % 512, kb = q / 64, nb = q % 64;
        const float* src = (br == 0 ? P->in[I_WMLAO] : br == 1 ? P->in[I_WCFO] : br == 2 ? P->in[I_WGLAO] : P->in[I_WSCO]) + (size_t)l * 512 * DM;
        transpose_item(src, DM, WSP(bf16_t, WS_WBR) + (size_t)(l * 4 + br) * DM * 512, 512, 32 * nb, 64 * kb, 32 * nb, scr, lane); return; } r -= NL_BR;
    if (r < NL_MIX) { const int kb = r / 64, nb = r % 64;
        transpose_item(P->in[I_WMIXO] + (size_t)l * DM * DM, DM, WSP(bf16_t, WS_WMIX) + (size_t)l * DM * DM, DM, 32 * nb, 64 * kb, 32 * nb, scr, lane); return; } r -= NL_MIX;
    if (r < NL_ED) { const int e = r / 512, q = r % 512, kb = q / 64, nb = q % 64, le = l * 16 + e;
        transpose_item(P->in[I_WED] + (size_t)le * EFF * DM, DM, WSP(bf16_t, WS_W2) + (size_t)le * DM * EFF, EFF, 32 * nb, 64 * kb, 32 * nb, scr, lane); return; } r -= NL_ED;
    { unsigned char* row = WSP(unsigned char, WS_W8) + ((size_t)l * PWP + O_MG + r) * DM;
#pragma unroll
      for (int j = 0; j < 2; ++j) *(u32x4*)(row + 16 * lane + 1024 * j) = (u32x4){0u, 0u, 0u, 0u};
      if (lane == 0) WSP(float, WS_RB)[(size_t)l * PWP + O_MG + r] = 0.f; }
}
DI void conv_mixed(KParams P, Frame& F, int l, int s_lo, int s_hi, int w_lo, int w_hi, int rank, int nrank) {
    if (rank < 0) return;
    for (int sidx = s_lo + rank; sidx < s_hi; sidx += nrank) slab_dispatch(P, F, l, sidx);
    LAS float* scr = (LAS float*)(F.lds + F.wave * 8448);
    for (int it = w_lo + rank * 8 + F.wave; it < w_hi; it += nrank * 8) conv_item_layer(P, l, it, scr, F.lane);
    __syncthreads();
}
DI void mod_item(KParams P, Frame& F, int it) {
    const int l = it / 192, n0 = (it % 192) * 64;
    const LAS float* sil = (const LAS float*)F.lds;
    LAS float* red = (LAS float*)(F.lds + 40960);
    const int kq = F.lane >> 4, ln = F.lane & 15;
    const float* wp = P->in[I_WMOD] + (size_t)l * DM * (6 * DM) + n0 + 4 * ln;
    f32x4 acc[5];
#pragma unroll
    for (int r = 0; r < 5; ++r) acc[r] = (f32x4){0.f, 0.f, 0.f, 0.f};
    const int kbase = F.wave * 256 + kq;
#pragma unroll 8
    for (int kk = 0; kk < 64; ++kk) { const int k = kbase + 4 * kk; const f32x4 wv = *(const f32x4*)(wp + (size_t)k * (6 * DM));
#pragma unroll
        for (int r = 0; r < 5; ++r) acc[r] = acc[r] + wv * sil[r * DM + k]; }
    const int grp = F.wave * 4 + kq;
#pragma unroll
    for (int r = 0; r < 5; ++r) *(LAS f32x4*)(red + (grp * 5 + r) * 64 + 4 * ln) = acc[r];
    __syncthreads();
    if (F.tid < 320) { const int r = F.tid >> 6, n = F.tid & 63; float s = P->in[I_BMOD][(size_t)l * (6 * DM) + n0 + n];
        for (int g = 0; g < 32; ++g) s += red[(g * 5 + r) * 64 + n];
        WSP(float, WS_MOD)[(size_t)(l * 5 + r) * (6 * DM) + n0 + n] = s; }
    __syncthreads();
}
DI void phase_prologue(KParams P, Frame& F) {
    LAS float* sil = (LAS float*)F.lds;
    for (int i = F.tid; i < 5 * DM; i += 512) { const int r = i >> 11, k = i & (DM - 1); const float c = r < 4 ? P->in[I_C][r * DM + k] : P->in[I_CCTX][k]; sil[i] = c / (1.f + expf(-c)); }
    __syncthreads();
    for (int it = F.bid; it < DEPTH * 192; it += F.G) mod_item(P, F, it);
    __syncthreads();
}

DI void moe_table(KParams P, Frame& F, int l) {
    LAS int* tp = (LAS int*)(F.lds + LDSX_OFF + 64); LAS int* cn = tp + 32;
    if (F.tid < 16) { const unsigned* cnt = ctl_words(P) + CW_CNT + l * 16 * 64;
        const int c = (int)__hip_atomic_load(cnt + F.tid * 64, __ATOMIC_RELAXED, __HIP_MEMORY_SCOPE_AGENT); cn[F.tid] = c;
        int a = (c + 255) >> 8;
#pragma unroll
        for (int o = 1; o < 16; o <<= 1) { const int t = __shfl_up(a, o, 16); if ((int)F.tid >= o) a += t; }
        tp[F.tid + 1] = a; if (F.tid == 0) tp[0] = 0; }
    __syncthreads();
}
DI void phase_norm1(KParams P, Frame& F, int l, bool dummy) {
    bf16_t* X = WSP(bf16_t, WS_X); bf16_t* XO = dummy ? WSP(bf16_t, WS_HS) : X; bf16_t* H = WSP(bf16_t, WS_H); const float* mod = WSP(float, WS_MOD); const bf16_t* outs = WSP(bf16_t, WS_OUTS);
    const int* rt_e = (const int*)(P->ws + WS_ROUTE); const int* rt_slot = (const int*)(P->ws + WS_ROUTE + 2 * 73728); const LAS int* tp = (const LAS int*)(F.lds + LDSX_OFF + 64);
    if (l > 0) moe_table(P, F, l - 1);
    for (int row = F.gw; row < TT; row += F.NGW) {
        const int r = mod_row(row);
        const float* mp = mod + (size_t)(l * 5 + r) * (6 * DM); const float* gm = P->in[I_GMIX] + (size_t)l * DM; float am = 0.f;
        f32x4 v[8], gq[8], shq[8], scq[8];
        int e0 = 0, e1 = 0, s0 = 0, s1 = 0;
        if (l > 0) { e0 = rt_e[2 * row]; e1 = rt_e[2 * row + 1]; s0 = rt_slot[2 * row]; s1 = rt_slot[2 * row + 1]; }
#pragma unroll
        for (int j = 0; j < 8; ++j) { const int c = 4 * F.lane + 256 * j; gq[j] = *(const f32x4*)(gm + c); shq[j] = *(const f32x4*)(mp + c); scq[j] = *(const f32x4*)(mp + DM + c); }
        if (l == 0) { const float* src = row < TLAT ? P->in[I_X] + (size_t)row * DM : P->in[I_CTX] + (size_t)(row - TLAT) * DM;
#pragma unroll
            for (int j = 0; j < 8; ++j) v[j] = *(const f32x4*)(src + 4 * F.lane + 256 * j); }
        else { u32x2 xw[8], aw[8], bw[8]; f32x4 gtq[8];
            const int p0 = tp[e0] * 256 + s0, p1 = tp[e1] * 256 + s1; const float* gt = mod + (size_t)((l - 1) * 5 + r) * (6 * DM) + 5 * DM;
#pragma unroll
            for (int j = 0; j < 8; ++j) { const int c = 4 * F.lane + 256 * j; xw[j] = *(const u32x2*)(X + (size_t)row * DM + c); gtq[j] = *(const f32x4*)(gt + c);
                aw[j] = *(const u32x2*)(outs + (size_t)p0 * DM + c); bw[j] = *(const u32x2*)(outs + (size_t)p1 * DM + c); }
            __builtin_amdgcn_sched_barrier(0);
#pragma unroll
            for (int j = 0; j < 8; ++j) { const u32x2 w = xw[j], a = aw[j], b = bw[j]; const f32x4 g = gtq[j];
                v[j][0] = bflo(w.x) + g[0] * (bflo(a.x) + bflo(b.x)); v[j][1] = bfhi(w.x) + g[1] * (bfhi(a.x) + bfhi(b.x)); v[j][2] = bflo(w.y) + g[2] * (bflo(a.y) + bflo(b.y)); v[j][3] = bfhi(w.y) + g[3] * (bfhi(a.y) + bfhi(b.y)); } }
        __builtin_amdgcn_sched_barrier(0);
        float ss = 0.f;
#pragma unroll
        for (int j = 0; j < 8; ++j) { *(u32x2*)(XO + (size_t)row * DM + 4 * F.lane + 256 * j) = (u32x2){pk2(v[j][0], v[j][1]), pk2(v[j][2], v[j][3])}; ss += (v[j][0] * v[j][0] + v[j][1] * v[j][1]) + (v[j][2] * v[j][2] + v[j][3] * v[j][3]); }
        const float rstd = 1.f / sqrtf(wave_sum(ss) * (1.f / DM) + EPS);
#pragma unroll
        for (int j = 0; j < 8; ++j) { const f32x4 g = gq[j], sh = shq[j], sc = scq[j];
            v[j] = (v[j] * rstd * g) * (sc + 1.f) + sh; am = fmaxf(fmaxf(am, fmaxf(fabsf(v[j][0]), fabsf(v[j][1]))), fmaxf(fabsf(v[j][2]), fabsf(v[j][3]))); }
#pragma unroll
        for (int o = 1; o < 64; o <<= 1) am = fmaxf(am, __shfl_xor(am, o));
        const float qs = am > 0.f ? 127.f / am : 0.f;
#pragma unroll
        for (int j = 0; j < 8; ++j) { const int c = 4 * F.lane + 256 * j;
            *(unsigned*)(WSP(unsigned char, WS_H8) + (size_t)row * DM + c) = q8(v[j][0] * qs) | (q8(v[j][1] * qs) << 8) | (q8(v[j][2] * qs) << 16) | (q8(v[j][3] * qs) << 24); }
        if (F.lane == 0) WSP(float, WS_RA)[row] = am * (1.f / 127.f);
    }
}
DI void phase_final(KParams P, Frame& F) {
    const bf16_t* X = WSP(bf16_t, WS_X); const float* mod = WSP(float, WS_MOD); const bf16_t* outs = WSP(bf16_t, WS_OUTS);
    const int* rt_e = (const int*)(P->ws + WS_ROUTE); const int* rt_slot = (const int*)(P->ws + WS_ROUTE + 2 * 73728); const LAS int* tp = (const LAS int*)(F.lds + LDSX_OFF + 64);
    moe_table(P, F, DEPTH - 1);
    for (int row = F.gw; row < TLAT; row += F.NGW) {
        const int r = mod_row(row); const int p0 = tp[rt_e[2 * row]] * 256 + rt_slot[2 * row], p1 = tp[rt_e[2 * row + 1]] * 256 + rt_slot[2 * row + 1]; const float* gt = mod + (size_t)((DEPTH - 1) * 5 + r) * (6 * DM) + 5 * DM;
        f32x4 v[8]; float ss = 0.f;
        u32x2 xw[8], aw[8], bw[8]; f32x4 gtq[8], gfq[8];
#pragma unroll
        for (int j = 0; j < 8; ++j) { const int c = 4 * F.lane + 256 * j; xw[j] = *(const u32x2*)(X + (size_t)row * DM + c); gtq[j] = *(const f32x4*)(gt + c); gfq[j] = *(const f32x4*)(P->in[I_GFIN] + c);
            aw[j] = *(const u32x2*)(outs + (size_t)p0 * DM + c); bw[j] = *(const u32x2*)(outs + (size_t)p1 * DM + c); }
        __builtin_amdgcn_sched_barrier(0);
#pragma unroll
        for (int j = 0; j < 8; ++j) { const u32x2 w = xw[j], a = aw[j], b = bw[j]; const f32x4 g = gtq[j];
            v[j][0] = bflo(w.x) + g[0] * (bflo(a.x) + bflo(b.x)); v[j][1] = bfhi(w.x) + g[1] * (bfhi(a.x) + bfhi(b.x)); v[j][2] = bflo(w.y) + g[2] * (bflo(a.y) + bflo(b.y)); v[j][3] = bfhi(w.y) + g[3] * (bfhi(a.y) + bfhi(b.y));
            ss += (v[j][0] * v[j][0] + v[j][1] * v[j][1]) + (v[j][2] * v[j][2] + v[j][3] * v[j][3]); }
        const float rstd = 1.f / sqrtf(wave_sum(ss) * (1.f / DM) + EPS);
#pragma unroll
        for (int j = 0; j < 8; ++j) { const int c = 4 * F.lane + 256 * j; *(f32x4*)(P->out + (size_t)row * DM + c) = v[j] * rstd * gfq[j]; }
    }
}
DI float ffn_input_row(KParams P, Frame& F, int l, int row, f32x4 (&v)[8]) {
    const bf16_t* X = WSP(bf16_t, WS_X); unsigned char* H8 = WSP(unsigned char, WS_H); const float* mod = WSP(float, WS_MOD);
    const int r = mod_row(row); float ss = 0.f;
    const float* mp = mod + (size_t)(l * 5 + r) * (6 * DM); const float* gm = P->in[I_GFFN] + (size_t)l * DM; float am = 0.f;
    u32x2 xw[8]; f32x4 gq[8], shq[8], scq[8];
#pragma unroll
    for (int j = 0; j < 8; ++j) { const int c = 4 * F.lane + 256 * j; xw[j] = *(const u32x2*)(X + (size_t)row * DM + c); gq[j] = *(const f32x4*)(gm + c); shq[j] = *(const f32x4*)(mp + 3 * DM + c); scq[j] = *(const f32x4*)(mp + 4 * DM + c); }
    __builtin_amdgcn_sched_barrier(0);
#pragma unroll
    for (int j = 0; j < 8; ++j) { const u32x2 w = xw[j]; v[j] = (f32x4){bflo(w.x), bfhi(w.x), bflo(w.y), bfhi(w.y)}; ss += (v[j][0] * v[j][0] + v[j][1] * v[j][1]) + (v[j][2] * v[j][2] + v[j][3] * v[j][3]); }
    const float rstd = 1.f / sqrtf(wave_sum(ss) * (1.f / DM) + EPS);
#pragma unroll
    for (int j = 0; j < 8; ++j) { const f32x4 g = gq[j], sh = shq[j], sc = scq[j];
        v[j] = (v[j] * rstd * g) * (sc + 1.f) + sh; am = fmaxf(fmaxf(am, fmaxf(fabsf(v[j][0]), fabsf(v[j][1]))), fmaxf(fabsf(v[j][2]), fabsf(v[j][3]))); }
#pragma unroll
    for (int o = 1; o < 64; o <<= 1) am = fmaxf(am, __shfl_xor(am, o));
    const float qs = am > 0.f ? 127.f / am : 0.f;
#pragma unroll
    for (int j = 0; j < 8; ++j) { const int c = 4 * F.lane + 256 * j;
        *(unsigned*)(H8 + (size_t)row * DM + c) = q8(v[j][0] * qs) | (q8(v[j][1] * qs) << 8) | (q8(v[j][2] * qs) << 16) | (q8(v[j][3] * qs) << 24); }
    return am * (1.f / 127.f);
}
DI void route_decide(const float (&lg)[16], const float (&br)[16], int& e1, int& e2, float& wa, float& wb) {
    float aff[16], sel[16];
#pragma unroll
    for (int e = 0; e < 16; ++e) { aff[e] = __builtin_amdgcn_rcpf(1.f + expf(-lg[e])); sel[e] = aff[e] + br[e]; }
    int best = 0; float bestv = -INFINITY;
#pragma unroll
    for (int g = 0; g < 4; ++g) { const float a = sel[4 * g], b = sel[4 * g + 1], c = sel[4 * g + 2], d = sel[4 * g + 3];
        const float hi1 = fmaxf(a, b), lo1 = fminf(a, b), hi2 = fmaxf(c, d), lo2 = fminf(c, d);
        const float gs = fmaxf(hi1, hi2) + fmaxf(fminf(hi1, hi2), fmaxf(lo1, lo2));
        if (gs > bestv) { bestv = gs; best = g; } }
    float s4[4] = {0.f, 0.f, 0.f, 0.f}, a4[4] = {0.f, 0.f, 0.f, 0.f};
#pragma unroll
    for (int g = 0; g < 4; ++g)
#pragma unroll
        for (int j = 0; j < 4; ++j) { s4[j] = (best == g) ? sel[4 * g + j] : s4[j]; a4[j] = (best == g) ? aff[4 * g + j] : a4[j]; }
    int i1 = 0; float m1 = s4[0];
#pragma unroll
    for (int j = 1; j < 4; ++j) if (s4[j] > m1) { m1 = s4[j]; i1 = j; }
    int i2 = -1; float m2 = -INFINITY;
#pragma unroll
    for (int j = 0; j < 4; ++j) if (j != i1 && s4[j] > m2) { m2 = s4[j]; i2 = j; }
    float w1 = 0.f, w2 = 0.f;
#pragma unroll
    for (int j = 0; j < 4; ++j) { w1 = (j == i1) ? a4[j] : w1; w2 = (j == i2) ? a4[j] : w2; }
    const float inv = 1.f / (w1 + w2);
    e1 = 4 * best + i1; e2 = 4 * best + i2; wa = w1 * inv; wb = w2 * inv;
}
DI void phase_norm2_route(KParams P, Frame& F, int l, int cbank) {
    int* rt_e = (int*)(P->ws + WS_ROUTE); int* rt_slot = (int*)(P->ws + WS_ROUTE + 2 * 73728);
    int* etok = (int*)(P->ws + WS_ETOK); float* ers = (float*)(P->ws + WS_ERS); float* erw = (float*)(P->ws + WS_ERW);
    unsigned* cnt = ctl_words(P) + CW_CNT + cbank * 16 * 64;
    LAS float* wrT = (LAS float*)F.lds;
    for (int k = F.tid; k < DM; k += 512) { const f32x4* wp = (const f32x4*)(P->in[I_WROUT] + (size_t)k * 16);
#pragma unroll
        for (int q = 0; q < 4; ++q) { const f32x4 w = wp[q]; wrT[(4 * q + 0) * DM + k] = w[0]; wrT[(4 * q + 1) * DM + k] = w[1]; wrT[(4 * q + 2) * DM + k] = w[2]; wrT[(4 * q + 3) * DM + k] = w[3]; } }
    float br[16];
#pragma unroll
    for (int e = 0; e < 16; ++e) br[e] = P->in[I_BROUT][e];
    const int nrows = (l == DEPTH - 1) ? TLAT : TT;
    const int rpb = (nrows + F.G - 1) / F.G, row0 = F.bid * rpb, row1 = (row0 + rpb < nrows) ? row0 + rpb : nrows;
    LAS int* lcnt = (LAS int*)(F.lds + LDSX_OFF + 512); LAS int* lbase = lcnt + 16; LAS int* lre = lcnt + 32; LAS int* lri = lcnt + 112; LAS float* lrw = (LAS float*)(lcnt + 192); LAS float* lrs = (LAS float*)(lcnt + 272);
    if (F.tid < 16) lcnt[F.tid] = 0;
    __syncthreads();
#pragma unroll 1
    for (int lr = 2 * F.wave; row0 + lr < row1; lr += 16) {
        const bool hasB = row0 + lr + 1 < row1; const int rowA = row0 + lr, rowB = hasB ? rowA + 1 : rowA;
        f32x4 va[8], vb[8]; const float sA = ffn_input_row(P, F, l, rowA, va), sB = ffn_input_row(P, F, l, rowB, vb);
        f32x2_t lab[16];
#pragma unroll
        for (int e = 0; e < 16; ++e) lab[e] = (f32x2_t){0.f, 0.f};
#pragma unroll
        for (int j = 0; j < 8; ++j) {
            const f32x2_t x0 = (f32x2_t){va[j][0], vb[j][0]}, x1 = (f32x2_t){va[j][1], vb[j][1]}, x2 = (f32x2_t){va[j][2], vb[j][2]}, x3 = (f32x2_t){va[j][3], vb[j][3]};
#pragma unroll
            for (int e = 0; e < 16; ++e) { const f32x4 w = *(const LAS f32x4*)(wrT + e * DM + 4 * F.lane + 256 * j);
                lab[e] = __builtin_elementwise_fma(x3, (f32x2_t){w[3], w[3]}, __builtin_elementwise_fma(x2, (f32x2_t){w[2], w[2]}, __builtin_elementwise_fma(x1, (f32x2_t){w[1], w[1]}, __builtin_elementwise_fma(x0, (f32x2_t){w[0], w[0]}, lab[e])))); }
            asm volatile("" ::: "memory"); }
        float la[16], lb[16];
#pragma unroll
        for (int e = 0; e < 16; ++e) { la[e] = wave_sum(lab[e][0]); lb[e] = wave_sum(lab[e][1]); }
        int e1, e2, f1, f2; float wa, wb, xa, xb; route_decide(la, br, e1, e2, wa, wb); route_decide(lb, br, f1, f2, xa, xb);
        if (F.lane == 0) {
            const int j1 = __hip_atomic_fetch_add(lcnt + e1, 1, __ATOMIC_RELAXED, __HIP_MEMORY_SCOPE_WORKGROUP), j2 = __hip_atomic_fetch_add(lcnt + e2, 1, __ATOMIC_RELAXED, __HIP_MEMORY_SCOPE_WORKGROUP);
            lre[2 * lr] = e1; lre[2 * lr + 1] = e2; lri[2 * lr] = j1; lri[2 * lr + 1] = j2;
            rt_e[2 * rowA] = e1; rt_e[2 * rowA + 1] = e2; lrw[2 * lr] = wa; lrw[2 * lr + 1] = wb; lrs[lr] = sA;
            if (hasB) { const int k1 = __hip_atomic_fetch_add(lcnt + f1, 1, __ATOMIC_RELAXED, __HIP_MEMORY_SCOPE_WORKGROUP), k2 = __hip_atomic_fetch_add(lcnt + f2, 1, __ATOMIC_RELAXED, __HIP_MEMORY_SCOPE_WORKGROUP);
                lre[2 * lr + 2] = f1; lre[2 * lr + 3] = f2; lri[2 * lr + 2] = k1; lri[2 * lr + 3] = k2;
                rt_e[2 * rowB] = f1; rt_e[2 * rowB + 1] = f2; lrw[2 * lr + 2] = xa; lrw[2 * lr + 3] = xb; lrs[lr + 1] = sB; } }
    }
    __syncthreads();
    if (F.tid < 16) lbase[F.tid] = (int)atomicAdd(cnt + F.tid * 64, (unsigned)lcnt[F.tid]);
    __syncthreads();
    if (F.tid < 2 * (row1 - row0)) { const int e = lre[F.tid], sl = lbase[e] + lri[F.tid]; rt_slot[2 * row0 + F.tid] = sl;
        etok[e * TT + sl] = row0 + (F.tid >> 1); ers[e * TT + sl] = lrs[F.tid >> 1]; erw[e * TT + sl] = lrw[F.tid]; }
    __syncthreads();
}
DI float rope_freq(int i) { return __expf(-1.1512925465f * (float)i); }
DI void mla_prep_rows(KParams P, Frame& F, int l) {
    const bf16_t* U = WSP(bf16_t, WS_U); bf16_t* cqn = WSP(bf16_t, WS_CQN); bf16_t* ckvn = WSP(bf16_t, WS_CKVN); bf16_t* krp = WSP(bf16_t, WS_KRP);
    f32x4 gq0, gq1, gkv;
    { const float* g = P->in[I_GQ] + l * 512 + 8 * F.lane; gq0 = *(const f32x4*)g; gq1 = *(const f32x4*)(g + 4); gkv = *(const f32x4*)(P->in[I_GKV] + l * 256 + 4 * F.lane); }
    for (int row = F.gw; row < TT; row += F.NGW) {
        const bf16_t* up = U + (size_t)row * PWP; const int e = F.lane;
        const u32x4 a = *(const u32x4*)(up + O_CQ + 8 * F.lane); const u32x2 a2 = *(const u32x2*)(up + O_CKV + 4 * F.lane);
        const int part = (e >> 4) & 1, idx = e & 15, i8 = idx & 7, second = idx >> 3;
        const bf16_t h1 = up[O_KR + 16 * part + i8], h2 = up[O_KR + 16 * part + 8 + i8], h3 = up[O_KR + (e & 31)];
        __builtin_amdgcn_sched_barrier(0);
        { float f[8] = {bflo(a.x), bfhi(a.x), bflo(a.y), bfhi(a.y), bflo(a.z), bfhi(a.z), bflo(a.w), bfhi(a.w)};
          float ss = 0.f;
#pragma unroll
          for (int i = 0; i < 8; ++i) ss += f[i] * f[i];
          const float rstd = 1.f / sqrtf(wave_sum(ss) * (1.f / 512.f) + EPS);
          u32x4 o; o.x = pk2(f[0] * rstd * gq0[0], f[1] * rstd * gq0[1]); o.y = pk2(f[2] * rstd * gq0[2], f[3] * rstd * gq0[3]); o.z = pk2(f[4] * rstd * gq1[0], f[5] * rstd * gq1[1]); o.w = pk2(f[6] * rstd * gq1[2], f[7] * rstd * gq1[3]);
          *(u32x4*)(cqn + (size_t)row * 512 + 8 * F.lane) = o; }
        { float f[4] = {bflo(a2.x), bfhi(a2.x), bflo(a2.y), bfhi(a2.y)};
          const float ss = (f[0] * f[0] + f[1] * f[1]) + (f[2] * f[2] + f[3] * f[3]);
          const float rstd = 1.f / sqrtf(wave_sum(ss) * (1.f / 256.f) + EPS);
          u32x2 o; o.x = pk2(f[0] * rstd * gkv[0], f[1] * rstd * gkv[1]); o.y = pk2(f[2] * rstd * gkv[2], f[3] * rstd * gkv[3]);
          *(u32x2*)(ckvn + (size_t)row * 256 + 4 * F.lane) = o; }
        { float val = 0.f;
          if (row < TLAT) { if (e < 32) { const int pos = row & (SEQ - 1);
                  const float t1 = bf2f(h1), t2 = bf2f(h2);
                  const float ang = (float)(part ? (pos & 63) : (pos >> 6)) * rope_freq(i8); const float sn = __sinf(ang), cs = __cosf(ang);
                  val = second ? (t1 * sn + t2 * cs) : (t1 * cs - t2 * sn); } }
          else { if (e >= 32) val = bf2f(h3); }
          krp[(size_t)row * 64 + e] = f2bf(val); }
    }
}
DI void cf_sc_tile(KParams P, Frame& F, int l, int ti) {
    const bf16_t* U = WSP(bf16_t, WS_U); bf16_t* acts = WSP(bf16_t, WS_ACTS);
    const int row0 = ti * 32; int seg_lo, seg_hi;
    if (row0 < TLAT) { seg_lo = row0 & ~(SEQ - 1); seg_hi = seg_lo + SEQ; } else { seg_lo = TLAT + ((row0 - TLAT) & ~(CTXL - 1)); seg_hi = seg_lo + CTXL; }
    LAS bf16_t* gl = (LAS bf16_t*)F.lds;
    LAS float* co = (LAS float*)(F.lds + 63488);
    const int c2 = F.tid & 255, th = F.tid >> 8;
    { const bf16_t* ub = U + O_SC + 2 * c2; const float* wp = P->in[I_WSCC] + (size_t)l * 3 * 512 + 2 * c2;
      const float w0a = wp[0], w0b = wp[1], w1a = wp[512], w1b = wp[513], w2a = wp[1024], w2b = wp[1025];
      unsigned pc[18], ph[18], gb[16];
#pragma unroll
      for (int k = 0; k < 18; ++k) { const int rr = row0 + 16 * th - 1 + k; const bool ok = rr >= seg_lo && rr < seg_hi;
          pc[k] = ok ? *(const unsigned*)(ub + (size_t)rr * PWP + 512) : 0u; ph[k] = ok ? *(const unsigned*)(ub + (size_t)rr * PWP + 1024) : 0u; }
#pragma unroll
      for (int k = 0; k < 16; ++k) gb[k] = *(const unsigned*)(ub + (size_t)(row0 + 16 * th + k) * PWP);
      float pa[18], pb[18];
#pragma unroll
      for (int k = 0; k < 18; ++k) { pa[k] = bflo(pc[k]) * bflo(ph[k]); pb[k] = bfhi(pc[k]) * bfhi(ph[k]); }
#pragma unroll
      for (int k = 0; k < 16; ++k) *(unsigned*)(acts + ((size_t)3 * TT + row0 + 16 * th + k) * 512 + 2 * c2) =
          pk2(bflo(gb[k]) * (w0a * pa[k] + w1a * pa[k + 1] + w2a * pa[k + 2]), bfhi(gb[k]) * (w0b * pb[k] + w1b * pb[k + 1] + w2b * pb[k + 2])); }
    { const int cg = F.tid & 63, ri = F.tid >> 6; u32x4 ga[8], gbv[8];
#pragma unroll
      for (int pass = 0; pass < 8; ++pass) { const int i = pass * 8 + ri, rr = row0 - 15 + i; const bool ok = i < 62 && rr >= seg_lo && rr < seg_hi;
          const bf16_t* up = U + (size_t)(ok ? rr : row0) * PWP + O_CF + 8 * cg; ga[pass] = *(const u32x4*)up; gbv[pass] = *(const u32x4*)(up + 512); }
#pragma unroll
      for (int pass = 0; pass < 8; ++pass) { const int i = pass * 8 + ri, rr = row0 - 15 + i; const bool ok = rr >= seg_lo && rr < seg_hi;
          if (i < 62) { const u32x4 a = ga[pass], b = gbv[pass]; u32x4 o;
              o.x = pk2(bflo(a.x) * sigm(bflo(b.x)), bfhi(a.x) * sigm(bfhi(b.x))); o.y = pk2(bflo(a.y) * sigm(bflo(b.y)), bfhi(a.y) * sigm(bfhi(b.y)));
              o.z = pk2(bflo(a.z) * sigm(bflo(b.z)), bfhi(a.z) * sigm(bfhi(b.z))); o.w = pk2(bflo(a.w) * sigm(bflo(b.w)), bfhi(a.w) * sigm(bfhi(b.w)));
              if (!ok) o = (u32x4){0u, 0u, 0u, 0u};
              *(LAS u32x4*)(gl + i * 512 + 8 * cg) = o; } } }
    asm volatile("" ::: "memory");
    float wva[31], wvb[31];
#pragma unroll
    for (int j = 0; j < 31; ++j) { const f32x2_t w = *(const f32x2_t*)(P->in[I_WCFDW] + (size_t)(l * 31 + j) * 512 + 2 * c2); wva[j] = w[0]; wvb[j] = w[1]; }
    const f32x2_t bias = *(const f32x2_t*)(P->in[I_BCFDW] + l * 512 + 2 * c2);
    __syncthreads();
#pragma unroll 1
    for (int hb = 0; hb < 2; ++hb) { const LAS unsigned* gp = (const LAS unsigned*)(gl + (16 * th + 8 * hb) * 512 + 2 * c2); f32x2_t xin[38];
#pragma unroll
      for (int i = 0; i < 38; ++i) { const unsigned x = gp[i * 256]; xin[i] = (f32x2_t){bflo(x), bfhi(x)}; }
#pragma unroll
      for (int t = 0; t < 8; ++t) { f32x2_t a = bias;
#pragma unroll
          for (int j = 0; j < 31; ++j) a = __builtin_elementwise_fma((f32x2_t){wva[j], wvb[j]}, xin[t + j], a);
          *(LAS f32x2_t*)(co + (16 * th + 8 * hb + t) * 512 + 2 * c2) = a; } }
    __syncthreads();
    f32x4 lng0, lng1, lnb0, lnb1;
    { const float* g = P->in[I_GCFLN] + l * 512 + 8 * F.lane; const float* bb = P->in[I_BCFLN] + l * 512 + 8 * F.lane; lng0 = *(const f32x4*)g; lng1 = *(const f32x4*)(g + 4); lnb0 = *(const f32x4*)bb; lnb1 = *(const f32x4*)(bb + 4); }
#pragma unroll 1
    for (int tt = 0; tt < 4; ++tt) { const int t = F.wave * 4 + tt; const LAS float* cr = co + t * 512 + 8 * F.lane;
        const f32x4 a = *(const LAS f32x4*)cr, b = *(const LAS f32x4*)(cr + 4);
        float x[8] = {a[0], a[1], a[2], a[3], b[0], b[1], b[2], b[3]}; float s = 0.f;
#pragma unroll
        for (int i = 0; i < 8; ++i) s += x[i];
        const float mean = wave_sum(s) * (1.f / 512.f); float q = 0.f;
#pragma unroll
        for (int i = 0; i < 8; ++i) { x[i] -= mean; q += x[i] * x[i]; }
        const float rstd = 1.f / sqrtf(wave_sum(q) * (1.f / 512.f) + EPS);
        const float g[8] = {lng0[0], lng0[1], lng0[2], lng0[3], lng1[0], lng1[1], lng1[2], lng1[3]}, bb[8] = {lnb0[0], lnb0[1], lnb0[2], lnb0[3], lnb1[0], lnb1[1], lnb1[2], lnb1[3]}; float y[8];
#pragma unroll
        for (int i = 0; i < 8; ++i) y[i] = siluf(x[i] * rstd * g[i] + bb[i]);
        u32x4 o; o.x = pk2(y[0], y[1]); o.y = pk2(y[2], y[3]); o.z = pk2(y[4], y[5]); o.w = pk2(y[6], y[7]);
        *(u32x4*)(acts + ((size_t)1 * TT + row0 + t) * 512 + 8 * F.lane) = o; }
    __syncthreads();
}

constexpr int GPD = 72;
constexpr int GL_LOW = 0, GL_GSUM = 8192, GL_VT = 10240, GL_A0 = 28672, GL_KD = 37888, GL_QI = 47104, GL_ST = 56320, GL_PP = 74752, GL_OB = 83968;
DI void gla_chunk_decode(int ci, int& b, int& row0, int& jf, int& jb) {
    if (ci < 128) { b = ci >> 5; const int c = ci & 31; row0 = b * SEQ + c * 64; jf = 4 + c; jb = 4 + (31 - c); }
    else { const int cc = ci - 128; b = cc >> 2; const int c = cc & 3; row0 = TLAT + b * CTXL + c * 64; jf = c; jb = 3 - c; }
}
DI int gla_cidx(int b, int hh, int dir, int j) { return ((b * 4 + hh) * 2 + dir) * NCHAIN + j; }
DI void lds_mma_nt(f32x16& acc, const LAS bf16_t* A, int a_row0, const LAS bf16_t* B, int b_row0, int r, int h) {
#pragma unroll
    for (int k0 = 0; k0 < 64; k0 += 16) {
        const bf16x8 a = *(const LAS bf16x8*)(A + (a_row0 + r) * GPD + k0 + 8 * h);
        const bf16x8 b = *(const LAS bf16x8*)(B + (b_row0 + r) * GPD + k0 + 8 * h);
        acc = __builtin_amdgcn_mfma_f32_32x32x16_bf16(a, b, acc, 0, 0, 0);
    }
}
DI float logsig(float z) { return fminf(z, 0.f) - __logf(1.f + __expf(-fabsf(z))); }
DI void gla_decay(Frame& F, int dir, const float (&w2v)[16], float b2, float (&cs)[8], float& off, float& total, float& mid) {
    const LAS float* low = (const LAS float*)(F.lds + GL_LOW); LAS float* gsum = (LAS float*)(F.lds + GL_GSUM);
    const int d = F.tid & 63, tg = F.tid >> 6;
    float la[8];
#pragma unroll
    for (int i = 0; i < 8; ++i) { const LAS float* lp = low + (tg * 8 + i) * 32 + dir * 16; float z = b2;
#pragma unroll
        for (int j = 0; j < 16; ++j) z += lp[j] * w2v[j];
        la[i] = logsig(z) * (1.f / 16.f); }
    if (dir == 0) { cs[0] = la[0];
#pragma unroll
        for (int i = 1; i < 8; ++i) cs[i] = cs[i - 1] + la[i];
        gsum[tg * 64 + d] = cs[7]; }
    else { cs[7] = la[7];
#pragma unroll
        for (int i = 6; i >= 0; --i) cs[i] = cs[i + 1] + la[i];
        gsum[tg * 64 + d] = cs[0]; }
    __syncthreads();
    float g[8];
#pragma unroll
    for (int q = 0; q < 8; ++q) g[q] = gsum[q * 64 + d];
    total = 0.f; off = 0.f; mid = 0.f;
#pragma unroll
    for (int q = 0; q < 8; ++q) { total += g[q]; if (dir == 0) { off += (q < tg) ? g[q] : 0.f; mid += (q <= 3) ? g[q] : 0.f; } else { off += (q > tg) ? g[q] : 0.f; mid += (q >= 4) ? g[q] : 0.f; } }
}
#define GLA_PRELOAD() \
    const int d = F.tid & 63, tg = F.tid >> 6, dcol = hh * 64 + d; \
    const u32x2 loww = *(const u32x2*)(U + (size_t)(row0 + (F.tid >> 3)) * PWP + O_GF + (F.tid & 7) * 4); \
    const u32x4 vva = *(const u32x4*)(U + (size_t)(row0 + (F.tid >> 3)) * PWP + O_GV + hh * 128 + (F.tid & 7) * 16), vvb = *(const u32x4*)(U + (size_t)(row0 + (F.tid >> 3)) * PWP + O_GV + hh * 128 + (F.tid & 7) * 16 + 8); \
    float w2f[16], w2b[16]; \
    _Pragma("unroll") for (int j = 0; j < 16; ++j) { w2f[j] = P->in[I_WGF][(size_t)l * 16 * 256 + j * 256 + dcol]; w2b[j] = P->in[I_WGB][(size_t)l * 16 * 256 + j * 256 + dcol]; } \
    const float b2f = P->in[I_BGF][l * 256 + dcol], b2b = P->in[I_BGB][l * 256 + dcol]; \
    bf16_t kh_[8]; \
    _Pragma("unroll") for (int i = 0; i < 8; ++i) kh_[i] = U[(size_t)(row0 + tg * 8 + i) * PWP + O_GK + hh * 64 + d];
#define GLA_PRELOAD_DONE() __builtin_amdgcn_sched_barrier(0); float kraw[8]; _Pragma("unroll") for (int i = 0; i < 8; ++i) kraw[i] = bf2f(kh_[i]);
#define GLA_STAGE_LOW_VT() do { LAS float* low_ = (LAS float*)(F.lds + GL_LOW); const int t_ = F.tid >> 3, j4_ = (F.tid & 7) * 4, v16_ = (F.tid & 7) * 16; \
    low_[t_ * 32 + j4_] = bflo(loww.x); low_[t_ * 32 + j4_ + 1] = bfhi(loww.x); low_[t_ * 32 + j4_ + 2] = bflo(loww.y); low_[t_ * 32 + j4_ + 3] = bfhi(loww.y); \
    const unsigned w_[8] = {vva.x, vva.y, vva.z, vva.w, vvb.x, vvb.y, vvb.z, vvb.w}; \
    _Pragma("unroll") for (int i = 0; i < 8; ++i) { VT[(v16_ + 2 * i) * GPD + t_] = (bf16_t)(w_[i] & 0xffffu); VT[(v16_ + 2 * i + 1) * GPD + t_] = (bf16_t)(w_[i] >> 16); } } while (0)
DI void gla_a_item(KParams P, Frame& F, int l, int ci, int hh) {
    const bf16_t* U = WSP(bf16_t, WS_U); bf16_t* Sloc = WSP(bf16_t, WS_SLOC); float* dec = WSP(float, WS_DEC);
    int b, row0, jf, jb; gla_chunk_decode(ci, b, row0, jf, jb);
    LAS bf16_t* VT = (LAS bf16_t*)(F.lds + GL_VT); LAS bf16_t* KET = (LAS bf16_t*)(F.lds + GL_A0);
    const int r = F.lane & 31, h = F.lane >> 5, mb = F.wave & 1, nb = F.wave >> 1;
    GLA_PRELOAD();
    GLA_PRELOAD_DONE();
    GLA_STAGE_LOW_VT();
    __syncthreads();
#pragma unroll
    for (int dir = 0; dir < 2; ++dir) {
        float cs[8], off, total, mid; gla_decay(F, dir, dir ? w2b : w2f, dir ? b2b : b2f, cs, off, total, mid);
        const int cidx = gla_cidx(b, hh, dir, dir ? jb : jf);
#pragma unroll
        for (int i = 0; i < 8; ++i) KET[d * GPD + tg * 8 + i] = f2bf(kraw[i] * __expf(total - (off + cs[i])));
        if (tg == 0) dec[(size_t)cidx * 64 + d] = __expf(total);
        __syncthreads();
        f32x16 acc;
#pragma unroll
        for (int i = 0; i < 16; ++i) acc[i] = 0.f;
        lds_mma_nt(acc, KET, 32 * mb, VT, 32 * nb, r, h);
        bf16_t* sp = Sloc + ((size_t)cidx * 128 + 32 * nb + r) * 64 + 32 * mb + 4 * h;
#pragma unroll
        for (int g = 0; g < 4; ++g) *(u32x2*)(sp + 8 * g) = (u32x2){pk2(acc[4 * g], acc[4 * g + 1]), pk2(acc[4 * g + 2], acc[4 * g + 3])};
        __syncthreads();
    }
}
DI void gla_scan(KParams P, Frame& F) {
    const bf16_t* Sloc = WSP(bf16_t, WS_SLOC); const float* dec = WSP(float, WS_DEC); bf16_t* Sin = WSP(bf16_t, WS_SIN);
    for (int e = F.bid * 512 + F.tid; e < 32 * 4096; e += F.G * 512) { const int chain = e >> 12, vd = (e & 4095) * 2, d = vd & 63; float S0 = 0.f, S1 = 0.f;
#pragma unroll 1
        for (int j0 = 0; j0 < NCHAIN; j0 += 12) { f32x2_t sl[12], dc[12];
#pragma unroll
            for (int j = 0; j < 12; ++j) { const size_t idx = (size_t)chain * NCHAIN + j0 + j; { const unsigned w = *(const unsigned*)(Sloc + idx * 8192 + vd); sl[j] = (f32x2_t){bflo(w), bfhi(w)}; } dc[j] = *(const f32x2_t*)(dec + idx * 64 + d); }
#pragma unroll
            for (int j = 0; j < 12; ++j) { const size_t idx = (size_t)chain * NCHAIN + j0 + j; *(unsigned*)(Sin + idx * 8192 + vd) = pk2(S0, S1); S0 = dc[j][0] * S0 + sl[j][0]; S1 = dc[j][1] * S1 + sl[j][1]; } } }
}
DI void gla_b_item(KParams P, Frame& F, int l, int ci, int hh) {
    const bf16_t* U = WSP(bf16_t, WS_U); const bf16_t* Sin = WSP(bf16_t, WS_SIN); bf16_t* acts = WSP(bf16_t, WS_ACTS);
    int b, row0, jf, jb; gla_chunk_decode(ci, b, row0, jf, jb);
    LAS bf16_t* VT = (LAS bf16_t*)(F.lds + GL_VT); LAS bf16_t* QD = (LAS bf16_t*)(F.lds + GL_A0); LAS bf16_t* KD = (LAS bf16_t*)(F.lds + GL_KD); LAS bf16_t* QI = (LAS bf16_t*)(F.lds + GL_QI);
    LAS bf16_t* ST = (LAS bf16_t*)(F.lds + GL_ST); LAS bf16_t* PP = (LAS bf16_t*)(F.lds + GL_PP); LAS float* OB = (LAS float*)(F.lds + GL_OB);
    const int r = F.lane & 31, h = F.lane >> 5, tb = F.wave & 1, vb = F.wave >> 1;
    GLA_PRELOAD();
    bf16_t qh_[8];
#pragma unroll
    for (int i = 0; i < 8; ++i) qh_[i] = U[(size_t)(row0 + tg * 8 + i) * PWP + O_GQ + hh * 64 + d];
    const int sv = F.tid >> 2, sd16 = (F.tid & 3) * 16;
    const bf16_t* spf = Sin + ((size_t)gla_cidx(b, hh, 0, jf) * 128 + sv) * 64 + sd16; const bf16_t* spb = Sin + ((size_t)gla_cidx(b, hh, 1, jb) * 128 + sv) * 64 + sd16;
    const u32x4 sf0 = *(const u32x4*)spf, sf1 = *(const u32x4*)(spf + 8), sb0 = *(const u32x4*)spb, sb1 = *(const u32x4*)(spb + 8);
    const int ot = F.tid >> 3, ov0 = (F.tid & 7) * 16;
    const bf16_t* rp = U + (size_t)(row0 + ot) * PWP + O_GR + hh * 128 + ov0; const u32x4 r0 = *(const u32x4*)rp, r1 = *(const u32x4*)(rp + 8);
    GLA_PRELOAD_DONE();
    float qraw[8];
#pragma unroll
    for (int i = 0; i < 8; ++i) qraw[i] = bf2f(qh_[i]) * 0.125f;
    GLA_STAGE_LOW_VT();
    __syncthreads();
    f32x16 acc;
#pragma unroll
    for (int i = 0; i < 16; ++i) acc[i] = 0.f;
#pragma unroll
    for (int dir = 0; dir < 2; ++dir) {
        float cs[8], off, total, mid; gla_decay(F, dir, dir ? w2b : w2f, dir ? b2b : b2f, cs, off, total, mid);
#pragma unroll
        for (int i = 0; i < 8; ++i) { const int t = tg * 8 + i; const float bc = off + cs[i];
            QD[t * GPD + d] = f2bf(qraw[i] * __expf(bc - mid)); KD[t * GPD + d] = f2bf(kraw[i] * __expf(mid - bc)); QI[t * GPD + d] = f2bf(qraw[i] * __expf(bc)); }
        *(LAS u32x4*)(ST + sv * GPD + sd16) = dir ? sb0 : sf0; *(LAS u32x4*)(ST + sv * GPD + sd16 + 8) = dir ? sb1 : sf1;
        __syncthreads();
        if (F.wave < 4) { const int tb2 = F.wave & 1, sb = F.wave >> 1; f32x16 a;
#pragma unroll
            for (int i = 0; i < 16; ++i) a[i] = 0.f;
            lds_mma_nt(a, QD, 32 * tb2, KD, 32 * sb, r, h);
#pragma unroll
            for (int i = 0; i < 16; ++i) { const int t = 32 * tb2 + (i & 3) + 8 * (i >> 2) + 4 * h, s2 = 32 * sb + r; const bool keep = dir ? (s2 >= t) : (s2 <= t);
                PP[t * GPD + s2] = f2bf(keep ? a[i] : 0.f); } }
        __syncthreads();
        lds_mma_nt(acc, PP, 32 * tb, VT, 32 * vb, r, h);
        lds_mma_nt(acc, QI, 32 * tb, ST, 32 * vb, r, h);
        __syncthreads();
    }
#pragma unroll
    for (int i = 0; i < 16; ++i) OB[(32 * tb + (i & 3) + 8 * (i >> 2) + 4 * h) * 128 + 32 * vb + r] = acc[i];
    __syncthreads();
    { float x[16]; float ss = 0.f;
#pragma unroll
      for (int q = 0; q < 4; ++q) { const f32x4 o = *(const LAS f32x4*)(OB + ot * 128 + ov0 + 4 * q); x[4 * q] = o[0]; x[4 * q + 1] = o[1]; x[4 * q + 2] = o[2]; x[4 * q + 3] = o[3]; }
#pragma unroll
      for (int i = 0; i < 16; ++i) ss += x[i] * x[i];
      ss += __shfl_xor(ss, 1); ss += __shfl_xor(ss, 2); ss += __shfl_xor(ss, 4);
      const float rstd = 1.f / sqrtf(ss * (1.f / 128.f) + EPS);
      const unsigned rw[8] = {r0.x, r0.y, r0.z, r0.w, r1.x, r1.y, r1.z, r1.w}; const float* gn = P->in[I_GGLAN] + l * 128 + ov0; unsigned ow[8];
#pragma unroll
      for (int i = 0; i < 8; ++i) ow[i] = pk2(x[2 * i] * rstd * gn[2 * i] * siluf(bflo(rw[i])), x[2 * i + 1] * rstd * gn[2 * i + 1] * siluf(bfhi(rw[i])));
      bf16_t* op = acts + ((size_t)2 * TT + row0 + ot) * 512 + hh * 128 + ov0;
      *(u32x4*)op = (u32x4){ow[0], ow[1], ow[2], ow[3]}; *(u32x4*)(op + 8) = (u32x4){ow[4], ow[5], ow[6], ow[7]}; }
    __syncthreads();
}
DI float at_max2(float a, float b) { return __builtin_amdgcn_fmed3f(a, b, INFINITY); }
constexpr int AT_KC = 1040, AT_VG = 520;
constexpr int AT_K0 = 0, AT_K1 = 16 * AT_KC, AT_V0 = 32 * AT_KC, AT_V1 = 32 * AT_KC + 16 * AT_VG;
DI void attn_unit(KParams P, Frame& F, int b, int hh, int qrow0, int nlat) {
    const bf16_t* Q = WSP(bf16_t, WS_Q); const bf16_t* KN = WSP(bf16_t, WS_KN); const bf16_t* KRP = WSP(bf16_t, WS_KRP); const bf16_t* VT = WSP(bf16_t, WS_VT); bf16_t* acts = WSP(bf16_t, WS_ACTS);
    const int ntile = nlat + 4; const int r = F.lane & 31, h = F.lane >> 5;
    const int kvi = F.tid >> 3, kc = F.tid & 7;
    const float C = 0.10206207261596577f * 1.4426950408889634f;
    const int qrow = qrow0 + 32 * F.wave + r; const bf16_t* qp = Q + (size_t)qrow * 768 + hh * 96;
    bf16x8 qf[8];
#pragma unroll
    for (int s = 0; s < 4; ++s) { const u32x4 a = *(const u32x4*)(qp + 16 * s + 8 * h);
        u32x4 o; o.x = pk2(C * bflo(a.x), C * bfhi(a.x)); o.y = pk2(C * bflo(a.y), C * bfhi(a.y)); o.z = pk2(C * bflo(a.z), C * bfhi(a.z)); o.w = pk2(C * bflo(a.w), C * bfhi(a.w)); qf[s] = __builtin_bit_cast(bf16x8, o); }
    { const u32x4 a1 = *(const u32x4*)(qp + 64), a2 = *(const u32x4*)(qp + 72), c1 = *(const u32x4*)(qp + 80), c2 = *(const u32x4*)(qp + 88);
      const float ra1[8] = {bflo(a1.x), bfhi(a1.x), bflo(a1.y), bfhi(a1.y), bflo(a1.z), bfhi(a1.z), bflo(a1.w), bfhi(a1.w)}, ra2[8] = {bflo(a2.x), bfhi(a2.x), bflo(a2.y), bfhi(a2.y), bflo(a2.z), bfhi(a2.z), bflo(a2.w), bfhi(a2.w)};
      const float rc1[8] = {bflo(c1.x), bfhi(c1.x), bflo(c1.y), bfhi(c1.y), bflo(c1.z), bfhi(c1.z), bflo(c1.w), bfhi(c1.w)}, rc2[8] = {bflo(c2.x), bfhi(c2.x), bflo(c2.y), bfhi(c2.y), bflo(c2.z), bfhi(c2.z), bflo(c2.w), bfhi(c2.w)};
      float ur[8], uc[8], xr[8], xc[8];
      const int pos = qrow & (SEQ - 1); const float prow = (float)(pos >> 6), pcol = (float)(pos & 63);
#pragma unroll
      for (int i = 0; i < 8; ++i) { ur[i] = C * (h ? ra2[i] : ra1[i]); uc[i] = C * (h ? rc2[i] : rc1[i]);
          if (nlat > 0) { const float f = rope_freq(i); float sn = __sinf(prow * f), cs = __cosf(prow * f); xr[i] = C * (h ? (ra1[i] * sn + ra2[i] * cs) : (ra1[i] * cs - ra2[i] * sn));
              sn = __sinf(pcol * f); cs = __cosf(pcol * f); xc[i] = C * (h ? (rc1[i] * sn + rc2[i] * cs) : (rc1[i] * cs - rc2[i] * sn)); }
          else { xr[i] = 0.f; xc[i] = 0.f; } }
      u32x4 o;
      o.x = pk2(xr[0], xr[1]); o.y = pk2(xr[2], xr[3]); o.z = pk2(xr[4], xr[5]); o.w = pk2(xr[6], xr[7]); qf[4] = __builtin_bit_cast(bf16x8, o);
      o.x = pk2(xc[0], xc[1]); o.y = pk2(xc[2], xc[3]); o.z = pk2(xc[4], xc[5]); o.w = pk2(xc[6], xc[7]); qf[5] = __builtin_bit_cast(bf16x8, o);
      o.x = pk2(ur[0], ur[1]); o.y = pk2(ur[2], ur[3]); o.z = pk2(ur[4], ur[5]); o.w = pk2(ur[6], ur[7]); qf[6] = __builtin_bit_cast(bf16x8, o);
      o.x = pk2(uc[0], uc[1]); o.y = pk2(uc[2], uc[3]); o.z = pk2(uc[4], uc[5]); o.w = pk2(uc[6], uc[7]); qf[7] = __builtin_bit_cast(bf16x8, o); }
    u32x4 kA0, kA1, vA, kB0, kB1, vB;
#define AT_KROW(tl) (((tl) < nlat) ? (b * SEQ + (tl) * 64) : (TLAT + b * CTXL + ((tl) - nlat) * 64))
#define AT_LOADK(tl, R0, R1) do { const int krow0_ = AT_KROW(tl); R0 = *(const u32x4*)(KN + (size_t)(krow0_ + kvi) * 512 + hh * 64 + kc * 8); R1 = *(const u32x4*)(KRP + (size_t)(krow0_ + kvi) * 64 + kc * 8); } while (0)
#define AT_LOADV(tl, R) do { const int krow0_ = AT_KROW(tl); R = *(const u32x4*)(VT + (size_t)(hh * 64 + kvi) * TT + krow0_ + kc * 8); } while (0)
#define AT_STOREK(buf, R0, R1) do { LAS unsigned char* kb_ = F.lds + ((buf) ? AT_K1 : AT_K0); *(LAS u32x4*)(kb_ + kc * AT_KC + kvi * 16) = R0; *(LAS u32x4*)(kb_ + (8 + kc) * AT_KC + kvi * 16) = R1; } while (0)
#define AT_STOREV(buf, R) do { LAS unsigned char* vb_ = F.lds + ((buf) ? AT_V1 : AT_V0); *(LAS u32x2*)(vb_ + (kc & ~1) * AT_KC + kvi * 16 + (kc & 1) * 8) = (u32x2){R.x, R.y}; *(LAS u32x2*)(vb_ + ((kc & ~1) + 1) * AT_KC + kvi * 16 + (kc & 1) * 8) = (u32x2){R.z, R.w}; } while (0)
#define AT_QK(P0, P1, buf, LAT) do { const LAS unsigned char* kb_ = F.lds + ((buf) ? AT_K1 : AT_K0); \
        _Pragma("unroll") for (int i = 0; i < 16; ++i) { P0[i] = 0.f; P1[i] = 0.f; } \
        _Pragma("unroll") for (int s = 0; s < 8; ++s) if ((LAT) ? (s < 6) : (s < 4 || s >= 6)) { const bf16x8 ka0 = *(const LAS bf16x8*)(kb_ + (2 * s + h) * AT_KC + r * 16), ka1 = *(const LAS bf16x8*)(kb_ + (2 * s + h) * AT_KC + (32 + r) * 16); \
            P0 = __builtin_amdgcn_mfma_f32_32x32x16_bf16(ka0, qf[s], P0, 0, 0, 0); P1 = __builtin_amdgcn_mfma_f32_32x32x16_bf16(ka1, qf[s], P1, 0, 0, 0); } } while (0)
#define AT_COMPUTE(tl, LAT) do { const int cur = (tl) & 1; f32x16 pc0, pc1; \
        AT_QK(pc0, pc1, cur, LAT);                                                 \
        const LAS unsigned char* vb = F.lds + (cur ? AT_V1 : AT_V0); \
        float mxa = at_max2(pc0[0], pc0[1]), mxb = at_max2(pc1[0], pc1[1]); \
        _Pragma("unroll") for (int i = 2; i < 16; ++i) { mxa = at_max2(mxa, pc0[i]); mxb = at_max2(mxb, pc1[i]); } \
        float mx = at_max2(mxa, mxb); mx = at_max2(mx, __shfl_xor(mx, 32)); \
        const float mnew = at_max2(m_run, mx), alpha = __builtin_amdgcn_exp2f(m_run - mnew); m_run = mnew; \
        const f32x2_t nm2 = (f32x2_t){-mnew, -mnew}; f32x2_t ps2 = (f32x2_t){0.f, 0.f};                  \
        _Pragma("unroll") for (int i = 0; i < 8; ++i) { \
            f32x2_t ta = (f32x2_t){pc0[2 * i], pc0[2 * i + 1]} + nm2, tb = (f32x2_t){pc1[2 * i], pc1[2 * i + 1]} + nm2; \
            ta[0] = __builtin_amdgcn_exp2f(ta[0]); ta[1] = __builtin_amdgcn_exp2f(ta[1]); tb[0] = __builtin_amdgcn_exp2f(tb[0]); tb[1] = __builtin_amdgcn_exp2f(tb[1]); \
            ps2 = ps2 + (ta + tb); pc0[2 * i] = ta[0]; pc0[2 * i + 1] = ta[1]; pc1[2 * i] = tb[0]; pc1[2 * i + 1] = tb[1]; } \
        const float psum = ps2[0] + ps2[1]; \
        l_run = l_run * alpha + psum; \
        _Pragma("unroll") for (int i = 0; i < 16; ++i) { o0[i] *= alpha; o1[i] *= alpha; } \
        bf16x8 pf[4]; \
        { u32x4 w; \
          w.x = pk2(pc0[0], pc0[1]); w.y = pk2(pc0[2], pc0[3]); w.z = pk2(pc0[4], pc0[5]); w.w = pk2(pc0[6], pc0[7]); pf[0] = __builtin_bit_cast(bf16x8, w); \
          w.x = pk2(pc0[8], pc0[9]); w.y = pk2(pc0[10], pc0[11]); w.z = pk2(pc0[12], pc0[13]); w.w = pk2(pc0[14], pc0[15]); pf[1] = __builtin_bit_cast(bf16x8, w); \
          w.x = pk2(pc1[0], pc1[1]); w.y = pk2(pc1[2], pc1[3]); w.z = pk2(pc1[4], pc1[5]); w.w = pk2(pc1[6], pc1[7]); pf[2] = __builtin_bit_cast(bf16x8, w); \
          w.x = pk2(pc1[8], pc1[9]); w.y = pk2(pc1[10], pc1[11]); w.z = pk2(pc1[12], pc1[13]); w.w = pk2(pc1[14], pc1[15]); pf[3] = __builtin_bit_cast(bf16x8, w); } \
        _Pragma("unroll") for (int s = 0; s < 4; ++s) { \
            const u32x4 va0 = *(const LAS u32x4*)(vb + (2 * s + h) * AT_KC + r * 16), va1 = *(const LAS u32x4*)(vb + (2 * s + h) * AT_KC + (32 + r) * 16); \
            o0 = __builtin_amdgcn_mfma_f32_32x32x16_bf16(__builtin_bit_cast(bf16x8, va0), pf[s], o0, 0, 0, 0); \
            o1 = __builtin_amdgcn_mfma_f32_32x32x16_bf16(__builtin_bit_cast(bf16x8, va1), pf[s], o1, 0, 0, 0); } } while (0)
#define AT_ITER(tl, LAT, LK0, LK1, LV, SK0, SK1, SV) do { \
        if ((tl) + 2 < ntile) { AT_LOADK((tl) + 2, LK0, LK1); AT_LOADV((tl) + 2, LV); } \
        AT_COMPUTE(tl, LAT); \
        if ((tl) + 1 < ntile) { AT_STOREK(((tl) & 1) ^ 1, SK0, SK1); AT_STOREV(((tl) & 1) ^ 1, SV); } \
        __syncthreads(); } while (0)
    float m_run = -INFINITY, l_run = 0.f; f32x16 o0, o1;
#pragma unroll
    for (int i = 0; i < 16; ++i) { o0[i] = 0.f; o1[i] = 0.f; }
    AT_LOADK(0, kA0, kA1); AT_LOADV(0, vA); AT_LOADK(1, kB0, kB1); AT_LOADV(1, vB);
    AT_STOREK(0, kA0, kA1); AT_STOREV(0, vA);
    __syncthreads();
#pragma unroll 1
    for (int tl = 0; tl < nlat; tl += 2) {
        AT_ITER(tl, true, kA0, kA1, vA, kB0, kB1, vB);
        AT_ITER(tl + 1, true, kB0, kB1, vB, kA0, kA1, vA);
    }
#pragma unroll 1
    for (int tl = nlat; tl < ntile; tl += 2) {
        AT_ITER(tl, false, kA0, kA1, vA, kB0, kB1, vB);
        AT_ITER(tl + 1, false, kB0, kB1, vB, kA0, kA1, vA);
    }
#undef AT_COMPUTE
#undef AT_ITER
#undef AT_KROW
#undef AT_LOADK
#undef AT_LOADV
#undef AT_STOREK
#undef AT_STOREV
#undef AT_QK
    const float inv = 1.f / (l_run + __shfl_xor(l_run, 32));
    bf16_t* op = acts + (size_t)qrow * 512 + hh * 64 + 4 * h;
#pragma unroll
    for (int g = 0; g < 4; ++g) { u32x2 w; w.x = pk2(o0[4 * g] * inv, o0[4 * g + 1] * inv); w.y = pk2(o0[4 * g + 2] * inv, o0[4 * g + 3] * inv); *(u32x2*)(op + 8 * g) = w;
        w.x = pk2(o1[4 * g] * inv, o1[4 * g + 1] * inv); w.y = pk2(o1[4 * g + 2] * inv, o1[4 * g + 3] * inv); *(u32x2*)(op + 32 + 8 * g) = w; }
}

DI KParams load_params() { KParams kp = (KParams)__builtin_amdgcn_kernarg_segment_ptr(); asm volatile("" : "+s"(kp)); return kp; }
DI Frame phase_frame(const Frame& F0) { Frame F = F0; int t = F0.tid; asm volatile("" : "+v"(t)); { int b = F0.bid, g = F0.G; asm volatile("" : "+s"(b), "+s"(g)); F.bid = b; F.G = g; F.NGW = g * 8; } F.tid = t; F.lane = t & 63; F.wave = __builtin_amdgcn_readfirstlane(t >> 6); F.gw = F.bid * 8 + F.wave; return F; }
constexpr int PH_PER_LAYER = 10, NPHASE = 1 + DEPTH * PH_PER_LAYER + 1;
__global__ void __launch_bounds__(512, 2) hybrid_trunk_fwd(Params P) {
    extern __shared__ __attribute__((aligned(16))) unsigned char lds_raw[];
    Frame F; F.lds = (LAS unsigned char*)lds_raw; F.tid = threadIdx.x; F.lane = F.tid & 63; F.wave = __builtin_amdgcn_readfirstlane(F.tid >> 6);
    F.G = gridDim.x; F.bid = blockIdx.x; F.gw = F.bid * 8 + F.wave; F.NGW = F.G * 8;
    const int vcu = (F.G % 8 == 0) ? (F.bid % 8) * (F.G / 8) + F.bid / 8 : F.bid;
    for (int u = F.tid; u < (LDS_BYTES - LDSX_OFF) / 4; u += 512) ((LAS unsigned*)(F.lds + LDSX_OFF))[u] = 0u;
    __syncthreads();
    const int lo = P.ph_lo, hi = P.ph_hi;
    XcdBarrier bar; bar.bar = (unsigned*)(P.ws + WS_CTL) + CW_BAR; bar.x = 0; bar.st = (volatile LAS unsigned*)(F.lds + LDSX_OFF);
    if (hi - lo > 1) bar = xcd_barrier_post((unsigned*)(P.ws + WS_CTL) + CW_BAR, (volatile LAS unsigned*)(F.lds + LDSX_OFF));
#ifndef PH_MASK
#define PH_MASK 0xffff
#endif
#define PHM(b) ((PH_MASK >> (b)) & 1)
#ifndef DUP_MASK
#define DUP_MASK 0
#endif
#define REP(b) (1 + ((DUP_MASK >> (b)) & 1))
#define IN(k) (lo <= (k) && (k) < hi)
#ifndef DUP_BAR
#define DUP_BAR 0
#endif
#define SEAM(k) do { if (IN(k) && IN((k) + 1)) { xcd_barrier(bar); if (DUP_BAR) xcd_barrier(bar); } } while (0)
    if (PHM(0) && IN(0)) for (int rep_ = 0; rep_ < REP(0); ++rep_) { KParams Q = load_params(); Frame Fp = phase_frame(F); phase_prologue(Q, Fp);
        conv_mixed(Q, Fp, 0, 0, NS_ALL, 0, NL_ITEMS, Fp.bid, Fp.G); }
    SEAM(0);
    for (int l = 0; l < DEPTH; ++l) {
        const int pb = 1 + PH_PER_LAYER * l;
        if (PHM(1) && IN(pb + 0)) for (int rep_ = 0; rep_ < REP(1); ++rep_) { KParams Q = load_params(); Frame Fp = phase_frame(F); phase_norm1(Q, Fp, l, rep_ + 1 < REP(1)); }
        SEAM(pb + 0);
        if (PHM(2) && IN(pb + 1)) for (int rep_ = 0; rep_ < REP(2); ++rep_) { KParams Q = load_params(); Frame Fp = phase_frame(F);
            const bool lastl = (l == DEPTH - 1); const int nM1 = lastl ? TLAT / 256 : TT / 256;
            pg8::Gemm g8{(const bf16_t*)(Q->ws + WS_H8), (const bf16_t*)(Q->ws + WS_W8 + (size_t)l * PWP * DM), DM / 2, 0, 0};
            pg8::TrimOrder S8{nM1, PWP / 256, nM1 * (PWP / 256), lastl ? (TCTX / 256) * 6 : 0, Fp.G, Fp.bid};
            pg8::EpiStoreQ E8{(bf16_t*)(Q->ws + WS_U), PWP, (const float*)(Q->ws + WS_RA), (const float*)(Q->ws + WS_RB) + (size_t)l * PWP, Q->ws + WS_G8};
            pg8::gemm_phase_i8<pg8::EpiStoreQ, pg8::TrimOrder>(Fp.lds, g8, S8, E8); }
        SEAM(pb + 1);
        if (PHM(3) && IN(pb + 2)) for (int rep_ = 0; rep_ < REP(3); ++rep_) { KParams Q = load_params(); Frame Fp = phase_frame(F); bf16_t* U = (bf16_t*)(Q->ws + WS_U); (void)U; mla_prep_rows(Q, Fp, l);
            const int ncf = (l == DEPTH - 1) ? TLAT / 32 : TT / 32;
            for (int it = vcu; it < ncf; it += Fp.G) cf_sc_tile(Q, Fp, l, it);
            { const int extra = ncf > Fp.G ? ncf - Fp.G : 0;
              if (vcu >= extra) for (int it = vcu - extra; it < 144 * 4; it += Fp.G - extra) gla_a_item(Q, Fp, l, it >> 2, it & 3); } }
        SEAM(pb + 2);
        if (PHM(4) && IN(pb + 3)) for (int rep_ = 0; rep_ < REP(4); ++rep_) { KParams Q = load_params(); Frame Fp = phase_frame(F); bf16_t* U = (bf16_t*)(Q->ws + WS_U); (void)U;
            const int nq = ((l == DEPTH - 1) ? TLAT / 256 : TT / 256) * 3;
            { pg8::Gemm g{WSQ(bf16_t, WS_CQN), WSQ(bf16_t, WS_WUQ) + (size_t)l * 768 * 512, 512, 0, 0}; pg8::RangeOrder S{0, nq, 3, Fp.G, Fp.bid}; pg8::EpiStore E{WSQ(bf16_t, WS_Q), 768};
              pg8::gemm_phase<pg8::EpiStore, pg8::RangeOrder>(Fp.lds, g, S, E); }
            { const bf16_t* ckvn = WSQ(bf16_t, WS_CKVN); const bf16_t* wkn = WSQ(bf16_t, WS_WKN) + (size_t)l * 512 * 256; const bf16_t* wv = WSQ(bf16_t, WS_WV) + (size_t)l * 512 * 256;
              pg8::Gemm g{ckvn, wkn, 256, (size_t)((const char*)wv - (const char*)ckvn), (size_t)((const char*)ckvn - (const char*)wkn)};
              pg8::Range2Order S{nq, 72, 2, 72, 36, Fp.G, Fp.bid}; pg8::EpiStore2 E{WSQ(bf16_t, WS_KN), 512, WSQ(bf16_t, WS_VT), TT};
              pg8::gemm_phase<pg8::EpiStore2, pg8::Range2Order>(Fp.lds, g, S, E); }
            gla_scan(Q, Fp); }
        SEAM(pb + 3);
        if (PHM(5) && IN(pb + 4)) for (int rep_ = 0; rep_ < REP(5); ++rep_) { KParams Q = load_params(); Frame Fp = phase_frame(F); bf16_t* U = (bf16_t*)(Q->ws + WS_U); (void)U;
            for (int u = vcu; u < 256; u += Fp.G) attn_unit(Q, Fp, u >> 6, (u >> 3) & 7, (u >> 6) * SEQ + (u & 7) * 256, 32);
            const bool lastl = (l == DEPTH - 1);
            if (!lastl) for (int u = vcu; u < 32; u += Fp.G) attn_unit(Q, Fp, u >> 3, u & 7, TLAT + (u >> 3) * CTXL, 0);
            for (int it = vcu; it < (lastl ? 128 : 144) * 4; it += Fp.G) gla_b_item(Q, Fp, l, it >> 2, it & 3); }
        SEAM(pb + 4);
        if (PHM(6) && IN(pb + 5)) for (int rep_ = 0; rep_ < REP(6); ++rep_) { KParams Q = load_params(); Frame Fp = phase_frame(F); bf16_t* U = (bf16_t*)(Q->ws + WS_U); (void)U; pg8::Gemm g{WSQ(bf16_t, WS_ACTS), WSQ(bf16_t, WS_WBR) + (size_t)l * 4 * DM * 512, 512, (size_t)TT * 512 * 2, (size_t)DM * 512 * 2}; pg8::MergeOrder S; S.init((l == DEPTH - 1) ? TLAT : TT, DM, Fp.G, Fp.bid);
            LAS float* gtab = (LAS float*)(Fp.lds + LDSX_OFF + 4096);
            if (Fp.tid < 256) { const float x = (float)(Fp.tid - 128) * (GATE_CLIP / 127.f), e = expf(-x); gtab[Fp.tid] = 1.f / (1.f + e); gtab[256 + Fp.tid] = 1.f + e; }
            __syncthreads();
            pg8::EpiMerge E{WSQ(bf16_t, WS_YM), (const unsigned char*)(Q->ws + WS_G8), gtab}; pg8::gemm_phase<pg8::EpiMerge, pg8::MergeOrder>(Fp.lds, g, S, E);
            if (l + 1 < DEPTH && rep_ == 0) { KParams Q2 = load_params(); Frame F2 = phase_frame(F); const int extra = (TT / 256) * (DM / 256) % F2.G; conv_mixed(Q2, F2, l + 1, 0, 600, 0, NL_F1, extra ? F2.bid - extra : F2.bid, extra ? F2.G - extra : F2.G); } }
        SEAM(pb + 5);
        if (PHM(7) && IN(pb + 6)) for (int rep_ = 0; rep_ < REP(7); ++rep_) { KParams Q = load_params(); Frame Fp = phase_frame(F); bf16_t* U = (bf16_t*)(Q->ws + WS_U); (void)U; pg8::Gemm g{WSQ(bf16_t, WS_YM), WSQ(bf16_t, WS_WMIX) + (size_t)l * DM * DM, DM, 0, 0}; pg8::StaticOrder S; S.init((l == DEPTH - 1) ? TLAT : TT, DM, Fp.G, Fp.bid);
            pg8::EpiResid E{WSQ(bf16_t, WS_X), WSQ(float, WS_MOD) + (size_t)l * 5 * (6 * DM) + 2 * DM, (rep_ + 1 < REP(7)) ? WSQ(bf16_t, WS_OUTS) : WSQ(bf16_t, WS_X)}; pg8::gemm_phase<pg8::EpiResid, pg8::StaticOrder>(Fp.lds, g, S, E);
            if (l + 1 < DEPTH && rep_ == 0) { KParams Q2 = load_params(); Frame F2 = phase_frame(F); const int extra = (TT / 256) * (DM / 256) % F2.G; conv_mixed(Q2, F2, l + 1, 600, 870, NL_F1, NL_F2, extra ? F2.bid - extra : F2.bid, extra ? F2.G - extra : F2.G); } }
        SEAM(pb + 6);
        if (PHM(8) && IN(pb + 7)) for (int rep_ = 0; rep_ < REP(8); ++rep_) { KParams Q = load_params(); Frame Fp = phase_frame(F); phase_norm2_route(Q, Fp, l, (rep_ + 1 < REP(8)) ? l + 4 : l); }
        SEAM(pb + 7);
        if (PHM(10) && IN(pb + 8)) for (int rep_ = 0; rep_ < REP(10); ++rep_) { KParams Q = load_params(); Frame Fp = phase_frame(F); bf16_t* U = (bf16_t*)(Q->ws + WS_U); (void)U; moe_table(Q, Fp, l);
            const LAS int* tpt = (const LAS int*)(Fp.lds + LDSX_OFF + 64);
            pg8::Gemm g{WSQ(bf16_t, WS_H), (const bf16_t*)(Q->ws + WS_W1 + (size_t)l * 16 * 1024 * DM), DM / 2, 0, (size_t)1024 * DM}; pg8::MoeOrder S{tpt, 4, Fp.G, Fp.bid};
            pg8::EpiSwiGLUQG E{WSQ(bf16_t, WS_ACTM), (const float*)(Q->ws + WS_ERW), (const float*)(Q->ws + WS_ERS), (const float*)(Q->ws + WS_RB1) + (size_t)l * 16 * 1024, tpt};
            pg8::gemm_phase_i8<pg8::EpiSwiGLUQG, pg8::MoeOrder, true>(Fp.lds, g, S, E, (const int*)(Q->ws + WS_ETOK), tpt);
            if (l + 1 < DEPTH && rep_ == 0) { KParams Q2 = load_params(); Frame F2 = phase_frame(F); const int nun = ((const LAS int*)(F2.lds + LDSX_OFF + 64))[16] * 4, extra = nun % F2.G;
                conv_mixed(Q2, F2, l + 1, 870, NS_ALL, NL_F2, NL_ITEMS, extra ? F2.bid - extra : F2.bid, extra ? F2.G - extra : F2.G); } }
        SEAM(pb + 8);
        if (PHM(11) && IN(pb + 9)) for (int rep_ = 0; rep_ < REP(11); ++rep_) { KParams Q = load_params(); Frame Fp = phase_frame(F); bf16_t* U = (bf16_t*)(Q->ws + WS_U); (void)U; moe_table(Q, Fp, l);
            pg8::Gemm g{WSQ(bf16_t, WS_ACTM), WSQ(bf16_t, WS_W2) + (size_t)l * 16 * DM * EFF, EFF, 0, (size_t)DM * EFF * 2}; pg8::MoeOrder S{(const LAS int*)(Fp.lds + LDSX_OFF + 64), 8, Fp.G, Fp.bid};
            pg8::EpiStore E{WSQ(bf16_t, WS_OUTS), DM}; pg8::gemm_phase<pg8::EpiStore, pg8::MoeOrder>(Fp.lds, g, S, E); }
        SEAM(pb + 9);
    }
    if (PHM(12) && IN(NPHASE - 1)) for (int rep_ = 0; rep_ < REP(12); ++rep_) { KParams Q = load_params(); Frame Fp = phase_frame(F); phase_final(Q, Fp); }
#undef IN
#undef SEAM
}

#ifndef MK_ONE_LAUNCH
#define MK_ONE_LAUNCH 1
#endif
extern "C" void kernel_launch(void* const* d_in, const int* in_sizes, int n_in, void* d_out, int out_size, void* d_ws, size_t ws_size, hipStream_t stream) {
    static int grid = 0;
    if (grid == 0) {
        if (n_in != 34 || out_size != TLAT * DM || ws_size < WS_END) { fprintf(stderr, "kernel_launch: unexpected problem: n_in %d out %d ws %zu (need %zu)\n", n_in, out_size, ws_size, (size_t)WS_END); grid = -1; return; }
        int dev = 0, cus = 0, per_cu = 0;
        if (hipGetDevice(&dev) != hipSuccess || hipDeviceGetAttribute(&cus, hipDeviceAttributeMultiprocessorCount, dev) != hipSuccess) { grid = -1; return; }
        if (hipFuncSetAttribute((const void*)hybrid_trunk_fwd, hipFuncAttributeMaxDynamicSharedMemorySize, LDS_BYTES) != hipSuccess) { fprintf(stderr, "kernel_launch: hipFuncSetAttribute failed\n"); grid = -1; return; }
        if (hipOccupancyMaxActiveBlocksPerMultiprocessor(&per_cu, (const void*)hybrid_trunk_fwd, 512, LDS_BYTES) != hipSuccess || per_cu < 1) { fprintf(stderr, "kernel_launch: occupancy query says %d\n", per_cu); }
        (void)hipGetLastError();
        grid = cus;
    }
    if (grid < 0) return;
    (void)hipMemsetAsync((char*)d_ws + WS_CTL, 0, CTL_ZERO_BYTES, stream);
    Params p{};
    for (int i = 0; i < 34; ++i) p.in[i] = (const float*)d_in[i];
    p.out = (float*)d_out; p.ws = (unsigned char*)d_ws;
#if MK_ONE_LAUNCH
    p.ph_lo = 0; p.ph_hi = NPHASE;
    hipLaunchKernelGGL(hybrid_trunk_fwd, dim3(grid), dim3(512), LDS_BYTES, stream, p);
#else
    for (int k = 0; k < NPHASE; ++k) { p.ph_lo = k; p.ph_hi = k + 1; hipLaunchKernelGGL(hybrid_trunk_fwd, dim3(grid), dim3(512), LDS_BYTES, stream, p); }
#endif
}
```
